# Optimizing an MI355X kernel written in HIP

```python
import math
import jax, jax.numpy as jnp
from jax import lax
import numpy as np

D_MODEL = 1024
BATCH = 4
SEQ = 8192
DEPTH = 1

CHUNK = 64
D_MIX = D_MODEL
M_HEADS = 4
M_WIDTH = D_MIX // 2
M_HEAD_DIM = M_WIDTH // M_HEADS
CONV_K = 4
A_HEADS = 4
A_WIDTH = D_MIX - M_WIDTH
A_VDIM = A_WIDTH // A_HEADS
A_QKDIM = A_VDIM // 2
D_IN = 4 * M_WIDTH + 2 * M_HEADS + 3 * A_WIDTH
N_BUCKETS = 32
MAX_DISTANCE = 128
Q_BLOCK = 128
N_EXPERTS = 32
TOP_K = 4
D_FF = D_MODEL
SWIGLU_LIMIT = 7.0
SWIGLU_ALPHA = 1.702
EXPERT_BLOCK = 128
EPS = 1e-5

kernel_name = "hybrid_mlstm_diffattn_moe_block"


def rms_norm(x, g):
    xf = x.astype(jnp.float32)
    y = xf * lax.rsqrt(jnp.mean(xf * xf, axis=-1, keepdims=True) + EPS)
    return (y * g.astype(jnp.float32)).astype(x.dtype)


def t5_buckets(rel):
    nb = N_BUCKETS // 2
    max_exact = nb // 2
    ret = (rel > 0).astype(jnp.int32) * nb
    n = jnp.abs(rel)
    nf = jnp.maximum(n, 1).astype(jnp.float32)
    large = max_exact + (jnp.log(nf / max_exact) / math.log(MAX_DISTANCE / max_exact)
                         * (nb - max_exact)).astype(jnp.int32)
    large = jnp.minimum(large, nb - 1)
    return ret + jnp.where(n < max_exact, n, large)


def causal_conv(u, w, b):
    c = u.shape[-1]
    y = lax.conv_general_dilated(u, w[:, None, :], window_strides=(1,),
                                 padding=[(CONV_K - 1, 0)],
                                 dimension_numbers=('NWC', 'WIO', 'NWC'),
                                 feature_group_count=c)
    return y + b


def mlstm_chunkwise(q, k, v, i_pre, f_pre):
    b_, s_, h_, d_ = q.shape
    nc = s_ // CHUNK
    f32 = jnp.float32

    def chunks(t):
        return t.astype(f32).reshape(b_, nc, CHUNK, h_, d_).transpose(1, 0, 3, 2, 4)

    def gchunks(t):
        return t.astype(f32).reshape(b_, nc, CHUNK, h_).transpose(1, 0, 3, 2)

    qc, vc = chunks(q), chunks(v)
    kc = chunks(k) * (d_ ** -0.5)
    log_i = gchunks(i_pre)
    log_f = jax.nn.log_sigmoid(gchunks(f_pre))
    tri = jnp.tril(jnp.ones((CHUNK, CHUNK), bool))

    def step(carry, inp):
        C, n, m = carry
        qb, kb, vb, li, lf = inp
        bcum = jnp.cumsum(lf, axis=-1)
        dmat = jnp.where(tri, bcum[..., :, None] - bcum[..., None, :] + li[..., None, :], -jnp.inf)
        m_inter = bcum + m[..., None]
        m_t = jnp.maximum(jnp.max(dmat, axis=-1), m_inter)
        w = jnp.exp(dmat - m_t[..., None]) * jnp.einsum('bhtd,bhsd->bhts', qb, kb)
        sc = jnp.exp(m_inter - m_t)
        num = jnp.einsum('bhts,bhse->bhte', w, vb) + sc[..., None] * jnp.einsum('bhtd,bhde->bhte', qb, C)
        den = jnp.sum(w, axis=-1) + sc * jnp.einsum('bhtd,bhd->bht', qb, n)
        h_out = num / jnp.maximum(jnp.abs(den), jnp.exp(-m_t))[..., None]
        b_last = bcum[..., -1]
        g = b_last[..., None] - bcum + li
        m_new = jnp.maximum(b_last + m, jnp.max(g, axis=-1))
        wk = jnp.exp(g - m_new[..., None])[..., None] * kb
        decay = jnp.exp(b_last + m - m_new)
        C_new = decay[..., None, None] * C + jnp.einsum('bhsd,bhse->bhde', wk, vb)
        n_new = decay[..., None] * n + jnp.sum(wk, axis=-2)
        return (C_new, n_new, m_new), h_out

    init = (jnp.zeros((b_, h_, d_, d_), f32), jnp.zeros((b_, h_, d_), f32), jnp.zeros((b_, h_), f32))
    _, hs = lax.scan(step, init, (qc, kc, vc, log_i, log_f))
    return hs.transpose(1, 0, 3, 2, 4).reshape(b_, s_, h_, d_)


def diff_attention(q, k, v, rel_bias, lam):
    b_, s_ = q.shape[:2]
    scale = A_QKDIM ** -0.5
    k_pos = jnp.arange(s_)
    k_chunk = k_pos // CHUNK
    vf = v.astype(jnp.float32)
    table = rel_bias.astype(jnp.float32)

    def block(qi):
        start = qi * Q_BLOCK
        qb = lax.dynamic_slice_in_dim(q, start, Q_BLOCK, axis=1)
        q_pos = start + jnp.arange(Q_BLOCK)
        bias = jnp.transpose(table[t5_buckets(k_pos[None, :] - q_pos[:, None])], (2, 0, 1))
        s = jnp.einsum('bqhmd,bkhmd->bhmqk', qb, k).astype(jnp.float32) * scale + bias[None, :, None]
        mask = k_chunk[None, :] <= (q_pos // CHUNK)[:, None]
        p = jax.nn.softmax(jnp.where(mask, s, -jnp.inf), axis=-1)
        pd = p[:, :, 0] - lam * p[:, :, 1]
        return jnp.einsum('bhqk,bkhe->bqhe', pd, vf)

    out = lax.map(block, jnp.arange(s_ // Q_BLOCK))
    return out.transpose(1, 0, 2, 3, 4).reshape(b_, s_, A_HEADS, A_VDIM)


def moe(u, router_w, router_b, w_gu, b_gu, w_down, b_down):
    t_ = u.shape[0]
    tk = t_ * TOP_K
    logits = (u @ router_w + router_b).astype(jnp.float32)
    top_vals, top_idx = lax.top_k(logits, TOP_K)
    gates = jax.nn.softmax(top_vals, axis=-1).astype(u.dtype)
    flat_e = top_idx.reshape(-1)
    flat_tok = jnp.arange(tk, dtype=jnp.int32) // TOP_K
    flat_g = gates.reshape(-1)
    order = jnp.argsort(flat_e)
    sorted_e = flat_e[order]
    counts = jnp.bincount(flat_e, length=N_EXPERTS)
    padded = ((counts + EXPERT_BLOCK - 1) // EXPERT_BLOCK) * EXPERT_BLOCK
    starts = jnp.cumsum(counts) - counts
    pends = jnp.cumsum(padded)
    pstarts = pends - padded
    dest = pstarts[sorted_e] + jnp.arange(tk) - starts[sorted_e]
    p_rows = tk + N_EXPERTS * EXPERT_BLOCK
    n_blocks = p_rows // EXPERT_BLOCK
    buf_tok = jnp.zeros((p_rows,), jnp.int32).at[dest].set(flat_tok[order])
    buf_g = jnp.zeros((p_rows,), u.dtype).at[dest].set(flat_g[order])
    block_e = jnp.minimum(jnp.searchsorted(pends, jnp.arange(n_blocks) * EXPERT_BLOCK, side='right'),
                          N_EXPERTS - 1)

    def expert_block(args):
        tok, e = args
        xb = u[tok]
        gu = xb @ w_gu[e] + b_gu[e]
        gate = jnp.minimum(gu[:, :D_FF], SWIGLU_LIMIT)
        up = jnp.clip(gu[:, D_FF:], -SWIGLU_LIMIT, SWIGLU_LIMIT)
        act = (up + 1) * gate * jax.nn.sigmoid(SWIGLU_ALPHA * gate)
        return act @ w_down[e] + b_down[e]

    out = lax.map(expert_block, (buf_tok.reshape(n_blocks, EXPERT_BLOCK), block_e))
    out = out.reshape(p_rows, -1) * buf_g[:, None]
    return jnp.zeros_like(u).at[buf_tok].add(out)


def setup_inputs(seed: int = 0) -> dict:
    key = jax.random.key(seed)
    ks = jax.random.split(key, 24)
    f32 = jnp.float32
    nrm = lambda k, s, sc: jax.random.normal(k, s, f32) * sc
    gate_b = jnp.concatenate([
        nrm(ks[5], (DEPTH, M_HEADS), 0.1),
        3.0 + 3.0 * jax.random.uniform(ks[6], (DEPTH, M_HEADS), f32)], axis=-1)
    return {
        "x": jax.random.normal(ks[0], (BATCH, SEQ, D_MODEL), f32),
        "rel_bias": nrm(ks[1], (N_BUCKETS, A_HEADS), 0.5),
        "norm1_g": 1.0 + nrm(ks[2], (DEPTH, D_MODEL), 0.02),
        "w_in": nrm(ks[3], (DEPTH, D_MODEL, D_IN), D_MODEL ** -0.5),
        "conv_w": nrm(ks[4], (DEPTH, CONV_K, 2 * M_WIDTH), CONV_K ** -0.5),
        "conv_b": nrm(ks[7], (DEPTH, 2 * M_WIDTH), 0.01),
        "gate_b": gate_b,
        "mlstm_norm_g": 1.0 + nrm(ks[8], (DEPTH, M_WIDTH), 0.02),
        "lam_q1": nrm(ks[9], (DEPTH, A_QKDIM), 0.1),
        "lam_k1": nrm(ks[10], (DEPTH, A_QKDIM), 0.1),
        "lam_q2": nrm(ks[11], (DEPTH, A_QKDIM), 0.1),
        "lam_k2": nrm(ks[12], (DEPTH, A_QKDIM), 0.1),
        "diff_norm_g": 1.0 + nrm(ks[13], (DEPTH, A_VDIM), 0.02),
        "w_out": nrm(ks[14], (DEPTH, D_MIX, D_MODEL), D_MIX ** -0.5),
        "norm2_g": 1.0 + nrm(ks[15], (DEPTH, D_MODEL), 0.02),
        "router_w": nrm(ks[16], (DEPTH, D_MODEL, N_EXPERTS), D_MODEL ** -0.5),
        "router_b": nrm(ks[17], (DEPTH, N_EXPERTS), 0.01),
        "w_gu": nrm(ks[18], (DEPTH, N_EXPERTS, D_MODEL, 2 * D_FF), D_MODEL ** -0.5),
        "b_gu": nrm(ks[19], (DEPTH, N_EXPERTS, 2 * D_FF), 0.01),
        "w_down": nrm(ks[20], (DEPTH, N_EXPERTS, D_FF, D_MODEL), D_FF ** -0.5),
        "b_down": nrm(ks[21], (DEPTH, N_EXPERTS, D_MODEL), 0.01),
        "final_g": 1.0 + nrm(ks[22], (D_MODEL,), 0.02),
    }


def reference(x, rel_bias, norm1_g, w_in, conv_w, conv_b, gate_b, mlstm_norm_g,
              lam_q1, lam_k1, lam_q2, lam_k2, diff_norm_g, w_out, norm2_g,
              router_w, router_b, w_gu, b_gu, w_down, b_down, final_g):
    b_, s_, _ = x.shape
    f32 = jnp.float32
    h = x
    for l in range(DEPTH):
        u = rms_norm(h, norm1_g[l])
        proj = u @ w_in[l]
        c0 = 4 * M_WIDTH
        c1 = c0 + 2 * M_HEADS
        mqk = jax.nn.silu(causal_conv(proj[..., :2 * M_WIDTH], conv_w[l], conv_b[l]))
        mq = mqk[..., :M_WIDTH].reshape(b_, s_, M_HEADS, M_HEAD_DIM)
        mk = mqk[..., M_WIDTH:].reshape(b_, s_, M_HEADS, M_HEAD_DIM)
        mv = proj[..., 2 * M_WIDTH:3 * M_WIDTH].reshape(b_, s_, M_HEADS, M_HEAD_DIM)
        mo = proj[..., 3 * M_WIDTH:c0]
        mg = proj[..., c0:c1].astype(f32) + gate_b[l].astype(f32)
        m_h = mlstm_chunkwise(mq, mk, mv, mg[..., :M_HEADS], mg[..., M_HEADS:])
        m_h = rms_norm(m_h, mlstm_norm_g[l].reshape(M_HEADS, M_HEAD_DIM))
        m_out = (jax.nn.sigmoid(mo.astype(f32)) * m_h.reshape(b_, s_, M_WIDTH)).astype(x.dtype)
        a = proj[..., c1:]
        aq = a[..., :A_WIDTH].reshape(b_, s_, A_HEADS, 2, A_QKDIM)
        ak = a[..., A_WIDTH:2 * A_WIDTH].reshape(b_, s_, A_HEADS, 2, A_QKDIM)
        av = a[..., 2 * A_WIDTH:].reshape(b_, s_, A_HEADS, A_VDIM)
        lam_init = 0.8 - 0.6 * math.exp(-0.3 * l)
        lam = (jnp.exp(jnp.sum(lam_q1[l].astype(f32) * lam_k1[l].astype(f32)))
               - jnp.exp(jnp.sum(lam_q2[l].astype(f32) * lam_k2[l].astype(f32))) + lam_init)
        a_h = diff_attention(aq, ak, av, rel_bias, lam)
        a_out = (rms_norm(a_h, diff_norm_g[l]) * (1.0 - lam_init)).reshape(b_, s_, A_WIDTH).astype(x.dtype)
        h = h + jnp.concatenate([m_out, a_out], axis=-1) @ w_out[l]
        u2 = rms_norm(h, norm2_g[l]).reshape(b_ * s_, D_MODEL)
        h = h + moe(u2, router_w[l], router_b[l], w_gu[l], b_gu[l], w_down[l], b_down[l]).reshape(b_, s_, D_MODEL)
    return rms_norm(h, final_g)
```

```cpp
#include <hip/hip_runtime.h>
#include <cstdio>
#include <cstdint>

typedef unsigned short bf16_t;
typedef short bf16x8 __attribute__((ext_vector_type(8)));
typedef float f32x4 __attribute__((ext_vector_type(4)));
typedef unsigned u32x4 __attribute__((ext_vector_type(4)));
typedef unsigned u32x2 __attribute__((ext_vector_type(2)));

constexpr int NB = 4, SEQ = 8192, T = NB * SEQ, DM = 1024, DIN = 3592, NPJ = 3584;
constexpr int NCH = SEQ / 64;
constexpr int NE = 32, FF = 1024;
constexpr int PQ = 0, PK = 512, PV = 1024, PO = 1536, PAQ = 2048, PAK = 2560, PAV = 3072;
constexpr int PROWS = T * 4 + NE * 256;
constexpr float EPS = 1e-5f;
constexpr float LOG2E = 1.4426950408889634f;
constexpr float QSCALE = 0.125f * LOG2E;

constexpr size_t MiB = 1u << 20;
constexpr size_t WS_CTL = 0;
constexpr size_t WS_WIN = 2 * MiB;
constexpr size_t WS_WOUT = 10 * MiB;
constexpr size_t WS_GATES = 12 * MiB;
constexpr size_t WS_MISC = 14 * MiB;
constexpr size_t WS_WGU = 24 * MiB;
constexpr size_t WS_WDN = 152 * MiB;
constexpr size_t WS_XN = 216 * MiB;
constexpr size_t WS_PROJ = 280 * MiB;
constexpr size_t WS_MU = 504 * MiB;
constexpr size_t WS_MC = 568 * MiB;
constexpr size_t WS_AO = 632 * MiB;
constexpr size_t WS_MIX = 760 * MiB;
constexpr size_t WS_Y = 552 * MiB;
constexpr size_t WS_ACT = WS_PROJ;
constexpr size_t WS_U2 = WS_XN;
constexpr size_t WS_END = 824 * MiB;
constexpr size_t MS_LIST = WS_MISC;
constexpr size_t MS_PAIR = WS_MISC + 4 * MiB;
constexpr size_t MS_PE = MS_PAIR;
constexpr size_t MS_PP = MS_PAIR + (size_t)T * 4 * 4;
constexpr size_t MS_PG = MS_PP + (size_t)T * 4 * 4;
constexpr size_t MS_MSC = WS_MISC + 6 * MiB;
constexpr size_t MS_NU = WS_MISC + 7 * MiB;
constexpr size_t MS_NC = WS_MISC + 8 * MiB;
constexpr int CW_CNT = 64;

struct Params {
    const float *x, *rel_bias, *norm1_g, *w_in, *conv_w, *conv_b, *gate_b, *mlstm_norm_g, *lam_q1, *lam_k1, *lam_q2, *lam_k2,
        *diff_norm_g, *w_out, *norm2_g, *router_w, *router_b, *w_gu, *b_gu, *w_down, *b_down, *final_g;
    float* out; unsigned char* ws;
};

__device__ __forceinline__ float bf2f(bf16_t v) { return __uint_as_float((unsigned)v << 16); }
__device__ __forceinline__ unsigned f2bf(float f) { unsigned u = __float_as_uint(f); return (u + 0x7fffu + ((u >> 16) & 1u)) >> 16; }
__device__ __forceinline__ unsigned pk2(float lo, float hi) { return f2bf(lo) | (f2bf(hi) << 16); }
__device__ __forceinline__ float wave_sum(float v) {
#pragma unroll
    for (int o = 1; o < 64; o <<= 1) v += __shfl_xor(v, o);
    return v;
}
__device__ __forceinline__ float sigmoidf_(float x) { return 1.f / (1.f + __expf(-x)); }
__device__ __forceinline__ float log_sigmoid(float x) { return fminf(x, 0.f) - log1pf(__expf(-fabsf(x))); }
#define LDS_WAIT() asm volatile("s_waitcnt lgkmcnt(0)" ::: "memory")

__device__ __forceinline__ void tr_item(const float* W, int ldw, int n0, int k0, bf16_t* WT, int dstrow0, int Kd, float* scr, int lane) {
#pragma unroll 8
    for (int i = 0; i < 32; ++i) { const int kk = 2 * i + (lane >> 5); scr[kk * 33 + (lane & 31)] = W[(size_t)(k0 + kk) * ldw + n0 + (lane & 31)]; }
    LDS_WAIT();
    const int c = lane & 7;
#pragma unroll
    for (int j = 0; j < 4; ++j) { const int n = (lane >> 3) + 8 * j; const float* s = scr + (8 * c) * 33 + n;
        u32x4 o; o.x = pk2(s[0 * 33], s[1 * 33]); o.y = pk2(s[2 * 33], s[3 * 33]); o.z = pk2(s[4 * 33], s[5 * 33]); o.w = pk2(s[6 * 33], s[7 * 33]);
        *(u32x4*)(WT + (size_t)(dstrow0 + n) * Kd + k0 + 8 * c) = o; }
    LDS_WAIT();
}
constexpr int CV_I0 = 1024, CV_I1 = 768, CV_I2 = 512, CV_I3 = 32768, CV_I4 = 16384, CV_N = CV_I0 + CV_I1 + CV_I2 + CV_I3 + CV_I4;
__device__ __forceinline__ void convert_item(const Params& p, int it, float* scr, int lane) {
    bf16_t* win = (bf16_t*)(p.ws + WS_WIN); bf16_t* wout = (bf16_t*)(p.ws + WS_WOUT); bf16_t* wgu = (bf16_t*)(p.ws + WS_WGU); bf16_t* wdn = (bf16_t*)(p.ws + WS_WDN);
    int r = it;
    if (r < CV_I0) { const int kb = r / 64, nb = r % 64; tr_item(p.w_in, DIN, 32 * nb, 64 * kb, win, 32 * nb, DM, scr, lane); return; } r -= CV_I0;
    if (r < CV_I1) { const int kb = r / 48, nb = r % 48; tr_item(p.w_in, DIN, 2056 + 32 * nb, 64 * kb, win, 2048 + 32 * nb, DM, scr, lane); return; } r -= CV_I1;
    if (r < CV_I2) { const int kb = r / 32, nb = r % 32; tr_item(p.w_out, DM, 32 * nb, 64 * kb, wout, 32 * nb, DM, scr, lane); return; } r -= CV_I2;
    if (r < CV_I3) { const int e = r / 1024, q = r % 1024, kb = q / 64, nb = q % 64; const int n0 = 32 * nb;
        const int dst = (n0 < 1024) ? (256 * (n0 / 128) + (n0 % 128)) : (256 * ((n0 - 1024) / 128) + 128 + ((n0 - 1024) % 128));
        tr_item(p.w_gu + (size_t)e * DM * 2 * FF, 2 * FF, n0, 64 * kb, wgu + (size_t)e * 2 * FF * DM, dst, DM, scr, lane); return; } r -= CV_I3;
    { const int e = r / 512, q = r % 512, kb = q / 32, nb = q % 32;
        tr_item(p.w_down + (size_t)e * FF * DM, DM, 32 * nb, 64 * kb, wdn + (size_t)e * DM * FF, 32 * nb, FF, scr, lane); }
}
__global__ void __launch_bounds__(256) k_convert(Params p) {
    __shared__ float scr[4][64 * 33];
    const int wave = threadIdx.x >> 6, lane = threadIdx.x & 63;
    for (int it = blockIdx.x * 4 + wave; it < CV_N; it += gridDim.x * 4) convert_item(p, it, scr[wave], lane);
}

__global__ void __launch_bounds__(256) k_norm1(Params p) {
    __shared__ float gw[DM * 8];
    for (int i = threadIdx.x; i < DM * 8; i += 256) gw[i] = p.w_in[(size_t)(i >> 3) * DIN + 2048 + (i & 7)];
    __syncthreads();
    const int wave = threadIdx.x >> 6, lane = threadIdx.x & 63;
    bf16_t* XN = (bf16_t*)(p.ws + WS_XN); float* gates = (float*)(p.ws + WS_GATES);
    for (int row = blockIdx.x * 4 + wave; row < T; row += gridDim.x * 4) {
        const f32x4* xr = (const f32x4*)(p.x + (size_t)row * DM) + lane;
        f32x4 v[4]; float s = 0.f;
#pragma unroll
        for (int j = 0; j < 4; ++j) { v[j] = xr[64 * j]; s += (v[j].x * v[j].x + v[j].y * v[j].y) + (v[j].z * v[j].z + v[j].w * v[j].w); }
        const float rstd = rsqrtf(wave_sum(s) * (1.f / DM) + EPS);
        float ga[8];
#pragma unroll
        for (int q = 0; q < 8; ++q) ga[q] = 0.f;
        unsigned long long* o8 = (unsigned long long*)(XN + (size_t)row * DM) + lane;
#pragma unroll
        for (int j = 0; j < 4; ++j) { const f32x4 g = ((const f32x4*)p.norm1_g)[64 * j + lane]; f32x4 u = v[j] * rstd * g;
            o8[64 * j] = (unsigned long long)pk2(u.x, u.y) | ((unsigned long long)pk2(u.z, u.w) << 32);
            const int k0 = 256 * j + 4 * lane;
#pragma unroll
            for (int c = 0; c < 4; ++c) { const float uu = u[c]; const float* w = gw + (k0 + c) * 8;
#pragma unroll
                for (int q = 0; q < 8; ++q) ga[q] += uu * w[q]; } }
#pragma unroll
        for (int q = 0; q < 8; ++q) ga[q] = wave_sum(ga[q]);
        if (lane == 0) {
#pragma unroll
            for (int q = 0; q < 8; ++q) gates[(size_t)row * 8 + q] = ga[q] + p.gate_b[q]; }
    }
}

__device__ __forceinline__ void wave_gemm_32x32(f32x4 (&acc)[2][2], const bf16_t* a0, const bf16_t* a1, const bf16_t* b0, const bf16_t* b1, int K) {
    for (int k = 0; k < K; k += 32) {
        const bf16x8 A0 = *(const bf16x8*)(a0 + k), A1 = *(const bf16x8*)(a1 + k), B0 = *(const bf16x8*)(b0 + k), B1 = *(const bf16x8*)(b1 + k);
        acc[0][0] = __builtin_amdgcn_mfma_f32_16x16x32_bf16(A0, B0, acc[0][0], 0, 0, 0);
        acc[0][1] = __builtin_amdgcn_mfma_f32_16x16x32_bf16(A0, B1, acc[0][1], 0, 0, 0);
        acc[1][0] = __builtin_amdgcn_mfma_f32_16x16x32_bf16(A1, B0, acc[1][0], 0, 0, 0);
        acc[1][1] = __builtin_amdgcn_mfma_f32_16x16x32_bf16(A1, B1, acc[1][1], 0, 0, 0);
    }
}
#define ZERO_ACC(acc) do { _Pragma("unroll") for (int a_ = 0; a_ < 2; ++a_) _Pragma("unroll") for (int b_ = 0; b_ < 2; ++b_) acc[a_][b_] = (f32x4){0.f, 0.f, 0.f, 0.f}; } while (0)

__global__ void __launch_bounds__(256) k_proj(Params p) {
    const int wave = threadIdx.x >> 6, lane = threadIdx.x & 63, fr = lane & 15, fq = lane >> 4;
    const bf16_t* XN = (const bf16_t*)(p.ws + WS_XN); const bf16_t* W = (const bf16_t*)(p.ws + WS_WIN); bf16_t* PR = (bf16_t*)(p.ws + WS_PROJ);
    constexpr int NCT = NPJ / 32, NIT = (T / 32) * NCT;
    for (int it = blockIdx.x * 4 + wave; it < NIT; it += gridDim.x * 4) {
        const int rt = it / NCT, ct = it % NCT, r0 = rt * 32, c0 = ct * 32;
        f32x4 acc[2][2]; ZERO_ACC(acc);
        wave_gemm_32x32(acc, XN + (size_t)(r0 + fr) * DM + fq * 8, XN + (size_t)(r0 + 16 + fr) * DM + fq * 8, W + (size_t)(c0 + fr) * DM + fq * 8, W + (size_t)(c0 + 16 + fr) * DM + fq * 8, DM);
        const float sc = (c0 >= PAQ && c0 < PAK) ? QSCALE : 1.f;
#pragma unroll
        for (int mi = 0; mi < 2; ++mi)
#pragma unroll
            for (int ni = 0; ni < 2; ++ni)
#pragma unroll
                for (int j = 0; j < 4; ++j) PR[(size_t)(r0 + mi * 16 + fq * 4 + j) * NPJ + c0 + ni * 16 + fr] = (bf16_t)f2bf(acc[mi][ni][j] * sc);
    }
}

__global__ void __launch_bounds__(256) k_outproj(Params p) {
    const int wave = threadIdx.x >> 6, lane = threadIdx.x & 63, fr = lane & 15, fq = lane >> 4;
    const bf16_t* A = (const bf16_t*)(p.ws + WS_MIX); const bf16_t* W = (const bf16_t*)(p.ws + WS_WOUT);
    constexpr int NCT = DM / 32, NIT = (T / 32) * NCT;
    for (int it = blockIdx.x * 4 + wave; it < NIT; it += gridDim.x * 4) {
        const int rt = it / NCT, ct = it % NCT, r0 = rt * 32, c0 = ct * 32;
        f32x4 acc[2][2]; ZERO_ACC(acc);
        wave_gemm_32x32(acc, A + (size_t)(r0 + fr) * DM + fq * 8, A + (size_t)(r0 + 16 + fr) * DM + fq * 8, W + (size_t)(c0 + fr) * DM + fq * 8, W + (size_t)(c0 + 16 + fr) * DM + fq * 8, DM);
#pragma unroll
        for (int mi = 0; mi < 2; ++mi)
#pragma unroll
            for (int ni = 0; ni < 2; ++ni)
#pragma unroll
                for (int j = 0; j < 4; ++j) { const size_t o = (size_t)(r0 + mi * 16 + fq * 4 + j) * DM + c0 + ni * 16 + fr; p.out[o] = p.x[o] + acc[mi][ni][j]; }
    }
}

__device__ __forceinline__ void load_conv_tile(const Params& p, float* dst, int LD, int b, int c, int col0, int cch, float scale) {
    const bf16_t* PR = (const bf16_t*)(p.ws + WS_PROJ);
    for (int i = threadIdx.x; i < 64 * 128; i += blockDim.x) {
        const int s = i >> 7, d = i & 127; const int tl = c * 64 + s; float a = p.conv_b[cch + d];
#pragma unroll
        for (int j = 0; j < 4; ++j) { const int tt = tl - 3 + j; if (tt >= 0) a += p.conv_w[j * 1024 + cch + d] * bf2f(PR[(size_t)(b * SEQ + tt) * NPJ + col0 + d]); }
        dst[s * LD + d] = a * sigmoidf_(a) * scale;
    }
}
__device__ __forceinline__ void load_gates(const Params& p, float* li, float* bcum, int b, int h, int c) {
    const float* gates = (const float*)(p.ws + WS_GATES);
    if (threadIdx.x < 64) { const size_t t = (size_t)b * SEQ + c * 64 + threadIdx.x; li[threadIdx.x] = gates[t * 8 + h]; bcum[threadIdx.x] = log_sigmoid(gates[t * 8 + 4 + h]); }
    __syncthreads();
    if (threadIdx.x == 0) { float a = 0.f; for (int s = 0; s < 64; ++s) { a += bcum[s]; bcum[s] = a; } }
    __syncthreads();
}

__global__ void __launch_bounds__(256) k_mlstm_a(Params p) {
    extern __shared__ __attribute__((aligned(16))) unsigned char smem[];
    float* kk = (float*)smem; float* vv = kk + 64 * 129; float* li = vv + 64 * 128; float* bcum = li + 64; float* wgt = bcum + 64;
    const bf16_t* PR = (const bf16_t*)(p.ws + WS_PROJ);
    bf16_t* MU = (bf16_t*)(p.ws + WS_MU); float* NU = (float*)(p.ws + MS_NU); float* msc = (float*)(p.ws + MS_MSC);
    for (int item = blockIdx.x; item < 16 * NCH; item += gridDim.x) {
        const int bh = item / NCH, c = item % NCH, b = bh >> 2, h = bh & 3;
        __syncthreads();
        load_gates(p, li, bcum, b, h, c);
        load_conv_tile(p, kk, 129, b, c, PK + h * 128, 512 + h * 128, 0.08838834764831845f);
        for (int i = threadIdx.x; i < 64 * 128; i += 256) { const int s = i >> 7, e = i & 127; vv[i] = bf2f(PR[(size_t)(b * SEQ + c * 64 + s) * NPJ + PV + h * 128 + e]); }
        const float blast = bcum[63];
        float gmax = -INFINITY;
        for (int s = 0; s < 64; ++s) gmax = fmaxf(gmax, blast - bcum[s] + li[s]);
        __syncthreads();
        if (threadIdx.x < 64) wgt[threadIdx.x] = __expf(blast - bcum[threadIdx.x] + li[threadIdx.x] - gmax);
        __syncthreads();
        const int d = threadIdx.x >> 1, e0 = (threadIdx.x & 1) * 64;
        float acc[64];
#pragma unroll
        for (int e = 0; e < 64; ++e) acc[e] = 0.f;
        for (int s = 0; s < 64; ++s) { const float kd = wgt[s] * kk[s * 129 + d];
#pragma unroll
            for (int e = 0; e < 64; ++e) acc[e] += kd * vv[s * 128 + e0 + e]; }
        bf16_t* uo = MU + ((size_t)item * 128 + d) * 128 + e0;
#pragma unroll
        for (int e = 0; e < 64; e += 2) *(unsigned*)(uo + e) = pk2(acc[e], acc[e + 1]);
        if (threadIdx.x < 128) { float a = 0.f; for (int s = 0; s < 64; ++s) a += wgt[s] * kk[s * 129 + threadIdx.x]; NU[(size_t)item * 128 + threadIdx.x] = a; }
        if (threadIdx.x == 0) { msc[item] = blast; msc[2048 + item] = gmax; }
    }
}
__global__ void __launch_bounds__(256) k_mlstm_scan(Params p) {
    __shared__ float dec[NCH], ac[NCH];
    const bf16_t* MU = (const bf16_t*)(p.ws + WS_MU); bf16_t* MC = (bf16_t*)(p.ws + WS_MC);
    const float* NU = (const float*)(p.ws + MS_NU); float* NC = (float*)(p.ws + MS_NC); float* msc = (float*)(p.ws + MS_MSC);
    for (int item = blockIdx.x; item < 16 * 64; item += gridDim.x) {
        const int bh = item >> 6, eb = item & 63;
        __syncthreads();
        if (threadIdx.x == 0) { float m = 0.f;
            for (int c = 0; c < NCH; ++c) { const float bl = msc[bh * NCH + c], gm = msc[2048 + bh * NCH + c]; const float m1 = fmaxf(bl + m, gm);
                dec[c] = __expf(bl + m - m1); ac[c] = __expf(gm - m1); if (eb == 0) msc[4096 + bh * NCH + c] = m; m = m1; } }
        __syncthreads();
        const int idx = eb * 256 + threadIdx.x; float C = 0.f;
        for (int c = 0; c < NCH; ++c) { const size_t o = ((size_t)(bh * NCH + c)) * 16384 + idx; MC[o] = (bf16_t)f2bf(C); C = dec[c] * C + ac[c] * bf2f(MU[o]); }
        if (eb == 0 && threadIdx.x < 128) { float n = 0.f;
            for (int c = 0; c < NCH; ++c) { const size_t o = ((size_t)(bh * NCH + c)) * 128 + threadIdx.x; NC[o] = n; n = dec[c] * n + ac[c] * NU[o]; } }
    }
}
__global__ void __launch_bounds__(256) k_mlstm_c(Params p) {
    extern __shared__ __attribute__((aligned(16))) unsigned char smem[];
    float* qq = (float*)smem; float* kk = qq + 64 * 129; float* vv = kk + 64 * 129; float* W = vv + 64 * 128; float* li = W + 64 * 65; float* bcum = li + 64;
    float* mx = bcum + 64; float* den = mx + 64; float* nn = den + 64;
    const bf16_t* PR = (const bf16_t*)(p.ws + WS_PROJ); const bf16_t* MC = (const bf16_t*)(p.ws + WS_MC);
    const float* NC = (const float*)(p.ws + MS_NC); const float* msc = (const float*)(p.ws + MS_MSC); bf16_t* MIX = (bf16_t*)(p.ws + WS_MIX);
    for (int item = blockIdx.x; item < 16 * NCH; item += gridDim.x) {
        const int bh = item / NCH, c = item % NCH, b = bh >> 2, h = bh & 3;
        __syncthreads();
        load_gates(p, li, bcum, b, h, c);
        load_conv_tile(p, qq, 129, b, c, PQ + h * 128, h * 128, 1.f);
        load_conv_tile(p, kk, 129, b, c, PK + h * 128, 512 + h * 128, 0.08838834764831845f);
        for (int i = threadIdx.x; i < 64 * 128; i += 256) { const int s = i >> 7, e = i & 127; vv[i] = bf2f(PR[(size_t)(b * SEQ + c * 64 + s) * NPJ + PV + h * 128 + e]); }
        if (threadIdx.x < 128) nn[threadIdx.x] = NC[(size_t)item * 128 + threadIdx.x];
        const float mc = msc[4096 + item];
        if (threadIdx.x < 64) { const int t = threadIdx.x; float m = bcum[t] + mc; for (int s = 0; s <= t; ++s) m = fmaxf(m, bcum[t] - bcum[s] + li[s]); mx[t] = m; }
        __syncthreads();
        for (int i = threadIdx.x; i < 64 * 64; i += 256) { const int t = i >> 6, s = i & 63; float w = 0.f;
            if (s <= t) { float dot = 0.f; for (int d = 0; d < 128; ++d) dot += qq[t * 129 + d] * kk[s * 129 + d]; w = __expf(bcum[t] - bcum[s] + li[s] - mx[t]) * dot; }
            W[t * 65 + s] = w; }
        __syncthreads();
        const int t = threadIdx.x >> 2, e0 = (threadIdx.x & 3) * 32;
        const float sc = __expf(bcum[t] + mc - mx[t]);
        if ((threadIdx.x & 3) == 0) { float a = 0.f; for (int s = 0; s <= t; ++s) a += W[t * 65 + s]; float qn = 0.f; for (int d = 0; d < 128; ++d) qn += qq[t * 129 + d] * nn[d]; den[t] = a + sc * qn; }
        float acc[32];
#pragma unroll
        for (int e = 0; e < 32; ++e) acc[e] = 0.f;
        const bf16_t* Cb = MC + (size_t)item * 16384 + e0;
        for (int d = 0; d < 128; ++d) { const float qd = qq[t * 129 + d]; const bf16_t* cr = Cb + d * 128;
#pragma unroll
            for (int e = 0; e < 32; ++e) acc[e] += qd * bf2f(cr[e]); }
#pragma unroll
        for (int e = 0; e < 32; ++e) acc[e] *= sc;
        for (int s = 0; s <= t; ++s) { const float w = W[t * 65 + s];
#pragma unroll
            for (int e = 0; e < 32; ++e) acc[e] += w * vv[s * 128 + e0 + e]; }
        __syncthreads();
        const float dn = fmaxf(fabsf(den[t]), __expf(-mx[t])); float ss = 0.f;
#pragma unroll
        for (int e = 0; e < 32; ++e) { acc[e] /= dn; ss += acc[e] * acc[e]; }
        ss += __shfl_xor(ss, 1); ss += __shfl_xor(ss, 2);
        const float rstd = rsqrtf(ss * (1.f / 128.f) + EPS);
        const size_t row = (size_t)b * SEQ + c * 64 + t;
#pragma unroll
        for (int e = 0; e < 32; ++e) { const int ch = h * 128 + e0 + e; const float og = sigmoidf_(bf2f(PR[row * NPJ + PO + ch]));
            MIX[row * DM + ch] = (bf16_t)f2bf(acc[e] * rstd * p.mlstm_norm_g[ch] * og); }
    }
}

__device__ __forceinline__ int t5_bucket(int rel) {
    const int n = rel < 0 ? -rel : rel; int b;
    if (n < 8) b = n; else if (n < 12) b = 8; else if (n < 16) b = 9; else if (n < 23) b = 10; else if (n < 32) b = 11; else if (n < 46) b = 12; else if (n < 64) b = 13; else if (n < 91) b = 14; else b = 15;
    return b + (rel > 0 ? 16 : 0);
}
__global__ void __launch_bounds__(256) k_attn_naive(Params p) {
    __shared__ __attribute__((aligned(16))) float Ks[64 * 64];
    __shared__ __attribute__((aligned(16))) float Vs[64 * 128];
    __shared__ float btab[256];
    const bf16_t* PR = (const bf16_t*)(p.ws + WS_PROJ); float* AO = (float*)(p.ws + WS_AO);
    for (int item = blockIdx.x; item < NB * 4 * 2 * 32; item += gridDim.x) {
        const int qb = 31 - (item >> 5), r5 = item & 31, b = r5 >> 3, h = (r5 >> 1) & 3, m = r5 & 1;
        __syncthreads();
        btab[threadIdx.x] = p.rel_bias[t5_bucket((int)threadIdx.x - 192) * 4 + h] * LOG2E;
        const float c15 = p.rel_bias[15 * 4 + h] * LOG2E;
        const int q = qb * 256 + threadIdx.x, cq = q >> 6;
        float qv[64];
        { const bf16_t* qp = PR + (size_t)(b * SEQ + q) * NPJ + PAQ + h * 128 + m * 64;
#pragma unroll
            for (int d = 0; d < 64; d += 8) { const u32x4 w = *(const u32x4*)(qp + d);
                qv[d] = __uint_as_float(w.x << 16); qv[d + 1] = __uint_as_float(w.x & 0xffff0000u); qv[d + 2] = __uint_as_float(w.y << 16); qv[d + 3] = __uint_as_float(w.y & 0xffff0000u);
                qv[d + 4] = __uint_as_float(w.z << 16); qv[d + 5] = __uint_as_float(w.z & 0xffff0000u); qv[d + 6] = __uint_as_float(w.w << 16); qv[d + 7] = __uint_as_float(w.w & 0xffff0000u); } }
        float o[128];
#pragma unroll
        for (int e = 0; e < 128; ++e) o[e] = 0.f;
        float mrun = -INFINITY, l = 0.f;
        const int ntile = 4 * qb + 4;
        for (int j = 0; j < ntile; ++j) {
            __syncthreads();
            for (int i = threadIdx.x; i < 64 * 64; i += 256) { const int kk = i >> 6, d = i & 63; Ks[i] = bf2f(PR[(size_t)(b * SEQ + j * 64 + kk) * NPJ + PAK + h * 128 + m * 64 + d]); }
            for (int i = threadIdx.x; i < 64 * 128; i += 256) { const int kk = i >> 7, e = i & 127; Vs[i] = bf2f(PR[(size_t)(b * SEQ + j * 64 + kk) * NPJ + PAV + h * 128 + e]); }
            __syncthreads();
            if (j <= cq) {
                for (int kk = 0; kk < 64; ++kk) {
                    float s = 0.f;
#pragma unroll
                    for (int d = 0; d < 64; d += 4) { const f32x4 kv = *(const f32x4*)(Ks + kk * 64 + d); s += qv[d] * kv.x + qv[d + 1] * kv.y + qv[d + 2] * kv.z + qv[d + 3] * kv.w; }
                    const int rel = j * 64 + kk - q;
                    s += (rel < -192) ? c15 : btab[rel + 192];
                    if (s > mrun) { const float f = exp2f(mrun - s); l *= f;
#pragma unroll
                        for (int e = 0; e < 128; ++e) o[e] *= f;
                        mrun = s; }
                    const float pw = exp2f(s - mrun); l += pw;
#pragma unroll
                    for (int e = 0; e < 128; e += 4) { const f32x4 vv = *(const f32x4*)(Vs + kk * 128 + e); o[e] += pw * vv.x; o[e + 1] += pw * vv.y; o[e + 2] += pw * vv.z; o[e + 3] += pw * vv.w; }
                }
            }
        }
        const float inv = 1.f / l;
        float* op = AO + (((size_t)(b * SEQ + q) * 4 + h) * 2 + m) * 128;
#pragma unroll
        for (int e = 0; e < 128; e += 4) *(f32x4*)(op + e) = (f32x4){o[e] * inv, o[e + 1] * inv, o[e + 2] * inv, o[e + 3] * inv};
    }
}
__global__ void __launch_bounds__(256) k_attn_combine(Params p) {
    __shared__ float lam_s;
    if (threadIdx.x == 0) { float a = 0.f, c = 0.f; for (int i = 0; i < 64; ++i) { a += p.lam_q1[i] * p.lam_k1[i]; c += p.lam_q2[i] * p.lam_k2[i]; } lam_s = __expf(a) - __expf(c) + 0.2f; }
    __syncthreads();
    const float lam = lam_s;
    const float* AO = (const float*)(p.ws + WS_AO); bf16_t* MIX = (bf16_t*)(p.ws + WS_MIX);
    const int wave = threadIdx.x >> 6, lane = threadIdx.x & 63;
    for (int it = blockIdx.x * 4 + wave; it < T * 4; it += gridDim.x * 4) {
        const float* o1 = AO + (size_t)it * 256; const float* o2 = o1 + 128;
        const float a0 = o1[2 * lane] - lam * o2[2 * lane], a1 = o1[2 * lane + 1] - lam * o2[2 * lane + 1];
        const float rstd = rsqrtf(wave_sum(a0 * a0 + a1 * a1) * (1.f / 128.f) + EPS);
        const int t = it >> 2, h = it & 3;
        *(unsigned*)(MIX + (size_t)t * DM + 512 + h * 128 + 2 * lane) = pk2(a0 * rstd * p.diff_norm_g[2 * lane] * 0.8f, a1 * rstd * p.diff_norm_g[2 * lane + 1] * 0.8f);
    }
}

__global__ void __launch_bounds__(256) k_route(Params p) {
    __shared__ float urow[4][DM];
    const int wave = threadIdx.x >> 6, lane = threadIdx.x & 63;
    bf16_t* U2 = (bf16_t*)(p.ws + WS_U2); unsigned* ctl = (unsigned*)(p.ws + WS_CTL);
    int* list = (int*)(p.ws + MS_LIST); int* pe = (int*)(p.ws + MS_PE); int* pp = (int*)(p.ws + MS_PP); float* pg = (float*)(p.ws + MS_PG);
    for (int row = blockIdx.x * 4 + wave; row < T; row += gridDim.x * 4) {
        const f32x4* xr = (const f32x4*)(p.out + (size_t)row * DM) + lane;
        f32x4 v[4]; float s = 0.f;
#pragma unroll
        for (int j = 0; j < 4; ++j) { v[j] = xr[64 * j]; s += (v[j].x * v[j].x + v[j].y * v[j].y) + (v[j].z * v[j].z + v[j].w * v[j].w); }
        const float rstd = rsqrtf(wave_sum(s) * (1.f / DM) + EPS);
        unsigned long long* o8 = (unsigned long long*)(U2 + (size_t)row * DM) + lane;
#pragma unroll
        for (int j = 0; j < 4; ++j) { const f32x4 g = ((const f32x4*)p.norm2_g)[64 * j + lane]; const f32x4 u = v[j] * rstd * g;
            o8[64 * j] = (unsigned long long)pk2(u.x, u.y) | ((unsigned long long)pk2(u.z, u.w) << 32);
            *(f32x4*)(&urow[wave][256 * j + 4 * lane]) = u; }
        LDS_WAIT();
        const int e = lane & 31, half = lane >> 5; float acc = 0.f;
        for (int k = half * 512; k < half * 512 + 512; ++k) acc += urow[wave][k] * p.router_w[(size_t)k * NE + e];
        acc += __shfl_xor(acc, 32);
        float val = acc + p.router_b[e];
        float tv[4]; int ti[4];
#pragma unroll
        for (int r = 0; r < 4; ++r) { float bv = val; int bi = e;
#pragma unroll
            for (int o = 1; o < 32; o <<= 1) { const float ov = __shfl_xor(bv, o); const int oi = __shfl_xor(bi, o); if (ov > bv || (ov == bv && oi < bi)) { bv = ov; bi = oi; } }
            tv[r] = bv; ti[r] = bi; if (e == bi) val = -INFINITY; }
        const float e1 = __expf(tv[1] - tv[0]), e2 = __expf(tv[2] - tv[0]), e3 = __expf(tv[3] - tv[0]); const float inv = 1.f / (1.f + e1 + e2 + e3);
        if (lane < 4) { const int ee = lane == 0 ? ti[0] : lane == 1 ? ti[1] : lane == 2 ? ti[2] : ti[3]; const float gg = (lane == 0 ? 1.f : lane == 1 ? e1 : lane == 2 ? e2 : e3) * inv;
            const int pos = (int)atomicAdd(&ctl[CW_CNT + ee], 1u);
            list[(size_t)ee * T + pos] = row; pe[row * 4 + lane] = ee; pp[row * 4 + lane] = pos; pg[row * 4 + lane] = gg; }
        LDS_WAIT();
    }
}

__device__ __forceinline__ void expert_starts(const unsigned* ctl, int* ps, int* cn) {
    if (threadIdx.x == 0) { int a = 0; for (int e = 0; e < NE; ++e) { const int c = (int)ctl[CW_CNT + e]; cn[e] = c; ps[e] = a; a += (c + 255) & ~255; } ps[NE] = a; }
    __syncthreads();
}
__global__ void __launch_bounds__(256) k_moe1(Params p) {
    __shared__ int ps[NE + 1], cn[NE];
    const unsigned* ctl = (const unsigned*)(p.ws + WS_CTL);
    expert_starts(ctl, ps, cn);
    const int wave = threadIdx.x >> 6, lane = threadIdx.x & 63, fr = lane & 15, fq = lane >> 4;
    const bf16_t* U2 = (const bf16_t*)(p.ws + WS_U2); const bf16_t* WG = (const bf16_t*)(p.ws + WS_WGU); bf16_t* ACT = (bf16_t*)(p.ws + WS_ACT); const int* list = (const int*)(p.ws + MS_LIST);
    const int nrt = ps[NE] / 32, NIT = nrt * 32;
    for (int it = blockIdx.x * 4 + wave; it < NIT; it += gridDim.x * 4) {
        const int rt = it >> 5, ct = it & 31, R = rt * 32, c0 = ct * 32;
        int e = 0; while (ps[e + 1] <= R) ++e;
        const int lr = R - ps[e]; if (lr >= cn[e]) continue;
        const int i0 = min(lr + fr, cn[e] - 1), i1 = min(lr + 16 + fr, cn[e] - 1);
        const int t0 = list[(size_t)e * T + i0], t1 = list[(size_t)e * T + i1];
        const bf16_t* Wb = WG + (size_t)e * 2 * FF * DM + (size_t)(256 * (c0 / 128) + (c0 % 128)) * DM;
        f32x4 ag[2][2], au[2][2]; ZERO_ACC(ag); ZERO_ACC(au);
        wave_gemm_32x32(ag, U2 + (size_t)t0 * DM + fq * 8, U2 + (size_t)t1 * DM + fq * 8, Wb + (size_t)fr * DM + fq * 8, Wb + (size_t)(16 + fr) * DM + fq * 8, DM);
        wave_gemm_32x32(au, U2 + (size_t)t0 * DM + fq * 8, U2 + (size_t)t1 * DM + fq * 8, Wb + (size_t)(128 + fr) * DM + fq * 8, Wb + (size_t)(128 + 16 + fr) * DM + fq * 8, DM);
#pragma unroll
        for (int mi = 0; mi < 2; ++mi)
#pragma unroll
            for (int ni = 0; ni < 2; ++ni)
#pragma unroll
                for (int j = 0; j < 4; ++j) { const int col = c0 + ni * 16 + fr;
                    float g = ag[mi][ni][j] + p.b_gu[(size_t)e * 2 * FF + col], u = au[mi][ni][j] + p.b_gu[(size_t)e * 2 * FF + FF + col];
                    g = fminf(g, 7.f); u = fminf(fmaxf(u, -7.f), 7.f);
                    ACT[(size_t)(R + mi * 16 + fq * 4 + j) * FF + col] = (bf16_t)f2bf((u + 1.f) * g * sigmoidf_(1.702f * g)); }
    }
}
__global__ void __launch_bounds__(256) k_moe2(Params p) {
    __shared__ int ps[NE + 1], cn[NE];
    const unsigned* ctl = (const unsigned*)(p.ws + WS_CTL);
    expert_starts(ctl, ps, cn);
    const int wave = threadIdx.x >> 6, lane = threadIdx.x & 63, fr = lane & 15, fq = lane >> 4;
    const bf16_t* ACT = (const bf16_t*)(p.ws + WS_ACT); const bf16_t* WD = (const bf16_t*)(p.ws + WS_WDN); bf16_t* Y = (bf16_t*)(p.ws + WS_Y);
    const int nrt = ps[NE] / 32, NIT = nrt * 32;
    for (int it = blockIdx.x * 4 + wave; it < NIT; it += gridDim.x * 4) {
        const int rt = it >> 5, ct = it & 31, R = rt * 32, c0 = ct * 32;
        int e = 0; while (ps[e + 1] <= R) ++e;
        const int lr = R - ps[e]; if (lr >= cn[e]) continue;
        const bf16_t* Wb = WD + (size_t)e * DM * FF + (size_t)c0 * FF;
        f32x4 acc[2][2]; ZERO_ACC(acc);
        wave_gemm_32x32(acc, ACT + (size_t)(R + fr) * FF + fq * 8, ACT + (size_t)(R + 16 + fr) * FF + fq * 8, Wb + (size_t)fr * FF + fq * 8, Wb + (size_t)(16 + fr) * FF + fq * 8, FF);
#pragma unroll
        for (int mi = 0; mi < 2; ++mi)
#pragma unroll
            for (int ni = 0; ni < 2; ++ni)
#pragma unroll
                for (int j = 0; j < 4; ++j) { const int col = c0 + ni * 16 + fr;
                    Y[(size_t)(R + mi * 16 + fq * 4 + j) * DM + col] = (bf16_t)f2bf(acc[mi][ni][j] + p.b_down[(size_t)e * DM + col]); }
    }
}
__global__ void __launch_bounds__(256) k_final(Params p) {
    __shared__ int ps[NE + 1], cn[NE];
    const unsigned* ctl = (const unsigned*)(p.ws + WS_CTL);
    expert_starts(ctl, ps, cn);
    const int wave = threadIdx.x >> 6, lane = threadIdx.x & 63;
    const bf16_t* Y = (const bf16_t*)(p.ws + WS_Y); const int* pe = (const int*)(p.ws + MS_PE); const int* pp = (const int*)(p.ws + MS_PP); const float* pg = (const float*)(p.ws + MS_PG);
    for (int row = blockIdx.x * 4 + wave; row < T; row += gridDim.x * 4) {
        f32x4* xr = (f32x4*)(p.out + (size_t)row * DM) + lane;
        f32x4 v[4];
#pragma unroll
        for (int j = 0; j < 4; ++j) v[j] = xr[64 * j];
#pragma unroll
        for (int r = 0; r < 4; ++r) { const int e = pe[row * 4 + r]; const size_t yr = (size_t)(ps[e] + pp[row * 4 + r]); const float g = pg[row * 4 + r];
            const u32x2* yp = (const u32x2*)(Y + yr * DM) + lane;
#pragma unroll
            for (int j = 0; j < 4; ++j) { const u32x2 w = yp[64 * j];
                v[j].x += g * __uint_as_float(w.x << 16); v[j].y += g * __uint_as_float(w.x & 0xffff0000u); v[j].z += g * __uint_as_float(w.y << 16); v[j].w += g * __uint_as_float(w.y & 0xffff0000u); } }
        float s = 0.f;
#pragma unroll
        for (int j = 0; j < 4; ++j) s += (v[j].x * v[j].x + v[j].y * v[j].y) + (v[j].z * v[j].z + v[j].w * v[j].w);
        const float rstd = rsqrtf(wave_sum(s) * (1.f / DM) + EPS);
#pragma unroll
        for (int j = 0; j < 4; ++j) { const f32x4 g = ((const f32x4*)p.final_g)[64 * j + lane]; xr[64 * j] = v[j] * rstd * g; }
    }
}

extern "C" void kernel_launch(void* const* d_in, const int* in_sizes, int n_in, void* d_out, int out_size, void* d_ws, size_t ws_size, hipStream_t stream) {
    if (n_in != 22 || out_size != T * DM || ws_size < WS_END) { fprintf(stderr, "kernel_launch: unexpected shapes (n_in %d out %d ws %zu)\n", n_in, out_size, ws_size); return; }
    Params p{};
    const float** f = (const float**)&p;
    for (int i = 0; i < 22; ++i) f[i] = (const float*)d_in[i];
    p.out = (float*)d_out; p.ws = (unsigned char*)d_ws;
    static bool attr = false;
    if (!attr) { attr = true;
        hipFuncSetAttribute((const void*)k_mlstm_a, hipFuncAttributeMaxDynamicSharedMemorySize, 80 * 1024);
        hipFuncSetAttribute((const void*)k_mlstm_c, hipFuncAttributeMaxDynamicSharedMemorySize, 128 * 1024); }
    hipMemsetAsync((char*)d_ws + WS_CTL, 0, 1 * MiB, stream);
    k_convert<<<2048, 256, 0, stream>>>(p);
    k_norm1<<<1024, 256, 0, stream>>>(p);
    k_proj<<<2048, 256, 0, stream>>>(p);
    k_mlstm_a<<<2048, 256, 67 * 1024, stream>>>(p);
    k_mlstm_scan<<<1024, 256, 0, stream>>>(p);
    k_mlstm_c<<<2048, 256, 120 * 1024, stream>>>(p);
    k_attn_naive<<<1024, 256, 0, stream>>>(p);
    k_attn_combine<<<2048, 256, 0, stream>>>(p);
    k_outproj<<<2048, 256, 0, stream>>>(p);
    k_route<<<2048, 256, 0, stream>>>(p);
    k_moe1<<<2048, 256, 0, stream>>>(p);
    k_moe2<<<2048, 256, 0, stream>>>(p);
    k_final<<<2048, 256, 0, stream>>>(p);
}
```

```cpp
#include <hip/hip_runtime.h>
#include <cstdio>
#include <cstdint>

typedef unsigned short bf16_t;
typedef short bf16x8 __attribute__((ext_vector_type(8)));
typedef float f32x4 __attribute__((ext_vector_type(4)));
typedef unsigned u32x4 __attribute__((ext_vector_type(4)));
typedef unsigned u32x2 __attribute__((ext_vector_type(2)));

constexpr int NB = 4, SEQ = 8192, T = NB * SEQ, DM = 1024, DIN = 3592, NPJ = 3584;
constexpr int NCH = SEQ / 64;
constexpr int NE = 32, FF = 1024;
constexpr int PQ = 0, PK = 512, PV = 1024, PO = 1536, PAQ = 2048, PAK = 2560, PAV = 3072;
constexpr int PROWS = T * 4 + NE * 256;
constexpr float EPS = 1e-5f;
constexpr float LOG2E = 1.4426950408889634f;
constexpr float QSCALE = 0.125f * LOG2E;

constexpr size_t MiB = 1u << 20;
constexpr size_t WS_CTL = 0;
constexpr size_t WS_WIN = 2 * MiB;
constexpr size_t WS_WOUT = 10 * MiB;
constexpr size_t WS_GATES = 12 * MiB;
constexpr size_t WS_MISC = 14 * MiB;
constexpr size_t WS_WGU = 24 * MiB;
constexpr size_t WS_WDN = 152 * MiB;
constexpr size_t WS_XN = 216 * MiB;
constexpr size_t WS_PROJ = 280 * MiB;
constexpr size_t WS_MU = 504 * MiB;
constexpr size_t WS_MC = 568 * MiB;
constexpr size_t WS_AO = 632 * MiB;
constexpr size_t WS_MIX = 760 * MiB;
constexpr size_t WS_Y = 552 * MiB;
constexpr size_t WS_ACT = WS_PROJ;
constexpr size_t WS_U2 = WS_XN;
constexpr size_t WS_END = 824 * MiB;
constexpr size_t MS_LIST = WS_MISC;
constexpr size_t MS_PAIR = WS_MISC + 4 * MiB;
constexpr size_t MS_PE = MS_PAIR;
constexpr size_t MS_PP = MS_PAIR + (size_t)T * 4 * 4;
constexpr size_t MS_PG = MS_PP + (size_t)T * 4 * 4;
constexpr size_t MS_MSC = WS_MISC + 6 * MiB;
constexpr size_t MS_NU = WS_MISC + 7 * MiB;
constexpr size_t MS_NC = WS_MISC + 8 * MiB;
constexpr int CW_CNT = 64;

struct Params {
    const float *x, *rel_bias, *norm1_g, *w_in, *conv_w, *conv_b, *gate_b, *mlstm_norm_g, *lam_q1, *lam_k1, *lam_q2, *lam_k2,
        *diff_norm_g, *w_out, *norm2_g, *router_w, *router_b, *w_gu, *b_gu, *w_down, *b_down, *final_g;
    float* out; unsigned char* ws;
};

__device__ __forceinline__ float bf2f(bf16_t v) { return __uint_as_float((unsigned)v << 16); }
__device__ __forceinline__ unsigned f2bf(float f) { unsigned u = __float_as_uint(f); return (u + 0x7fffu + ((u >> 16) & 1u)) >> 16; }
__device__ __forceinline__ unsigned pk2(float lo, float hi) { return f2bf(lo) | (f2bf(hi) << 16); }
__device__ __forceinline__ float wave_sum(float v) {
#pragma unroll
    for (int o = 1; o < 64; o <<= 1) v += __shfl_xor(v, o);
    return v;
}
__device__ __forceinline__ float sigmoidf_(float x) { return 1.f / (1.f + __expf(-x)); }
__device__ __forceinline__ float log_sigmoid(float x) { return fminf(x, 0.f) - log1pf(__expf(-fabsf(x))); }
#define LDS_WAIT() asm volatile("s_waitcnt lgkmcnt(0)" ::: "memory")

__device__ __forceinline__ void tr_item(const float* W, int ldw, int n0, int k0, bf16_t* WT, int dstrow0, int Kd, float* scr, int lane) {
#pragma unroll 8
    for (int i = 0; i < 32; ++i) { const int kk = 2 * i + (lane >> 5); scr[kk * 33 + (lane & 31)] = W[(size_t)(k0 + kk) * ldw + n0 + (lane & 31)]; }
    LDS_WAIT();
    const int c = lane & 7;
#pragma unroll
    for (int j = 0; j < 4; ++j) { const int n = (lane >> 3) + 8 * j; const float* s = scr + (8 * c) * 33 + n;
        u32x4 o; o.x = pk2(s[0 * 33], s[1 * 33]); o.y = pk2(s[2 * 33], s[3 * 33]); o.z = pk2(s[4 * 33], s[5 * 33]); o.w = pk2(s[6 * 33], s[7 * 33]);
        *(u32x4*)(WT + (size_t)(dstrow0 + n) * Kd + k0 + 8 * c) = o; }
    LDS_WAIT();
}
constexpr int CV_I0 = 1024, CV_I1 = 768, CV_I2 = 512, CV_I3 = 32768, CV_I4 = 16384, CV_N = CV_I0 + CV_I1 + CV_I2 + CV_I3 + CV_I4;
__device__ __forceinline__ void convert_item(const Params& p, int it, float* scr, int lane) {
    bf16_t* win = (bf16_t*)(p.ws + WS_WIN); bf16_t* wout = (bf16_t*)(p.ws + WS_WOUT); bf16_t* wgu = (bf16_t*)(p.ws + WS_WGU); bf16_t* wdn = (bf16_t*)(p.ws + WS_WDN);
    int r = it;
    if (r < CV_I0) { const int kb = r / 64, nb = r % 64; tr_item(p.w_in, DIN, 32 * nb, 64 * kb, win, 32 * nb, DM, scr, lane); return; } r -= CV_I0;
    if (r < CV_I1) { const int kb = r / 48, nb = r % 48; tr_item(p.w_in, DIN, 2056 + 32 * nb, 64 * kb, win, 2048 + 32 * nb, DM, scr, lane); return; } r -= CV_I1;
    if (r < CV_I2) { const int kb = r / 32, nb = r % 32; tr_item(p.w_out, DM, 32 * nb, 64 * kb, wout, 32 * nb, DM, scr, lane); return; } r -= CV_I2;
    if (r < CV_I3) { const int e = r / 1024, q = r % 1024, kb = q / 64, nb = q % 64; const int n0 = 32 * nb;
        const int dst = (n0 < 1024) ? (256 * (n0 / 128) + (n0 % 128)) : (256 * ((n0 - 1024) / 128) + 128 + ((n0 - 1024) % 128));
        tr_item(p.w_gu + (size_t)e * DM * 2 * FF, 2 * FF, n0, 64 * kb, wgu + (size_t)e * 2 * FF * DM, dst, DM, scr, lane); return; } r -= CV_I3;
    { const int e = r / 512, q = r % 512, kb = q / 32, nb = q % 32;
        tr_item(p.w_down + (size_t)e * FF * DM, DM, 32 * nb, 64 * kb, wdn + (size_t)e * DM * FF, 32 * nb, FF, scr, lane); }
}
__global__ void __launch_bounds__(256) k_convert(Params p) {
    __shared__ float scr[4][64 * 33];
    const int wave = threadIdx.x >> 6, lane = threadIdx.x & 63;
    for (int it = blockIdx.x * 4 + wave; it < CV_N; it += gridDim.x * 4) convert_item(p, it, scr[wave], lane);
}

__global__ void __launch_bounds__(256) k_norm1(Params p) {
    __shared__ float gw[DM * 8];
    for (int i = threadIdx.x; i < DM * 8; i += 256) gw[i] = p.w_in[(size_t)(i >> 3) * DIN + 2048 + (i & 7)];
    __syncthreads();
    const int wave = threadIdx.x >> 6, lane = threadIdx.x & 63;
    bf16_t* XN = (bf16_t*)(p.ws + WS_XN); float* gates = (float*)(p.ws + WS_GATES);
    for (int row = blockIdx.x * 4 + wave; row < T; row += gridDim.x * 4) {
        const f32x4* xr = (const f32x4*)(p.x + (size_t)row * DM) + lane;
        f32x4 v[4]; float s = 0.f;
#pragma unroll
        for (int j = 0; j < 4; ++j) { v[j] = xr[64 * j]; s += (v[j].x * v[j].x + v[j].y * v[j].y) + (v[j].z * v[j].z + v[j].w * v[j].w); }
        const float rstd = rsqrtf(wave_sum(s) * (1.f / DM) + EPS);
        float ga[8];
#pragma unroll
        for (int q = 0; q < 8; ++q) ga[q] = 0.f;
        unsigned long long* o8 = (unsigned long long*)(XN + (size_t)row * DM) + lane;
#pragma unroll
        for (int j = 0; j < 4; ++j) { const f32x4 g = ((const f32x4*)p.norm1_g)[64 * j + lane]; f32x4 u = v[j] * rstd * g;
            o8[64 * j] = (unsigned long long)pk2(u.x, u.y) | ((unsigned long long)pk2(u.z, u.w) << 32);
            const int k0 = 256 * j + 4 * lane;
#pragma unroll
            for (int c = 0; c < 4; ++c) { const float uu = u[c]; const float* w = gw + (k0 + c) * 8;
#pragma unroll
                for (int q = 0; q < 8; ++q) ga[q] += uu * w[q]; } }
#pragma unroll
        for (int q = 0; q < 8; ++q) ga[q] = wave_sum(ga[q]);
        if (lane == 0) {
#pragma unroll
            for (int q = 0; q < 8; ++q) gates[(size_t)row * 8 + q] = ga[q] + p.gate_b[q]; }
    }
}

__device__ __forceinline__ void wave_gemm_32x32(f32x4 (&acc)[2][2], const bf16_t* a0, const bf16_t* a1, const bf16_t* b0, const bf16_t* b1, int K) {
    for (int k = 0; k < K; k += 32) {
        const bf16x8 A0 = *(const bf16x8*)(a0 + k), A1 = *(const bf16x8*)(a1 + k), B0 = *(const bf16x8*)(b0 + k), B1 = *(const bf16x8*)(b1 + k);
        acc[0][0] = __builtin_amdgcn_mfma_f32_16x16x32_bf16(A0, B0, acc[0][0], 0, 0, 0);
        acc[0][1] = __builtin_amdgcn_mfma_f32_16x16x32_bf16(A0, B1, acc[0][1], 0, 0, 0);
        acc[1][0] = __builtin_amdgcn_mfma_f32_16x16x32_bf16(A1, B0, acc[1][0], 0, 0, 0);
        acc[1][1] = __builtin_amdgcn_mfma_f32_16x16x32_bf16(A1, B1, acc[1][1], 0, 0, 0);
    }
}
#define ZERO_ACC(acc) do { _Pragma("unroll") for (int a_ = 0; a_ < 2; ++a_) _Pragma("unroll") for (int b_ = 0; b_ < 2; ++b_) acc[a_][b_] = (f32x4){0.f, 0.f, 0.f, 0.f}; } while (0)

__global__ void __launch_bounds__(256) k_proj(Params p) {
    const int wave = threadIdx.x >> 6, lane = threadIdx.x & 63, fr = lane & 15, fq = lane >> 4;
    const bf16_t* XN = (const bf16_t*)(p.ws + WS_XN); const bf16_t* W = (const bf16_t*)(p.ws + WS_WIN); bf16_t* PR = (bf16_t*)(p.ws + WS_PROJ);
    constexpr int NCT = NPJ / 32, NIT = (T / 32) * NCT;
    for (int it = blockIdx.x * 4 + wave; it < NIT; it += gridDim.x * 4) {
        const int rt = it / NCT, ct = it % NCT, r0 = rt * 32, c0 = ct * 32;
        f32x4 acc[2][2]; ZERO_ACC(acc);
        wave_gemm_32x32(acc, XN + (size_t)(r0 + fr) * DM + fq * 8, XN + (size_t)(r0 + 16 + fr) * DM + fq * 8, W + (size_t)(c0 + fr) * DM + fq * 8, W + (size_t)(c0 + 16 + fr) * DM + fq * 8, DM);
        const float sc = (c0 >= PAQ && c0 < PAK) ? QSCALE : 1.f;
#pragma unroll
        for (int mi = 0; mi < 2; ++mi)
#pragma unroll
            for (int ni = 0; ni < 2; ++ni)
#pragma unroll
                for (int j = 0; j < 4; ++j) PR[(size_t)(r0 + mi * 16 + fq * 4 + j) * NPJ + c0 + ni * 16 + fr] = (bf16_t)f2bf(acc[mi][ni][j] * sc);
    }
}

__global__ void __launch_bounds__(256) k_outproj(Params p) {
    const int wave = threadIdx.x >> 6, lane = threadIdx.x & 63, fr = lane & 15, fq = lane >> 4;
    const bf16_t* A = (const bf16_t*)(p.ws + WS_MIX); const bf16_t* W = (const bf16_t*)(p.ws + WS_WOUT);
    constexpr int NCT = DM / 32, NIT = (T / 32) * NCT;
    for (int it = blockIdx.x * 4 + wave; it < NIT; it += gridDim.x * 4) {
        const int rt = it / NCT, ct = it % NCT, r0 = rt * 32, c0 = ct * 32;
        f32x4 acc[2][2]; ZERO_ACC(acc);
        wave_gemm_32x32(acc, A + (size_t)(r0 + fr) * DM + fq * 8, A + (size_t)(r0 + 16 + fr) * DM + fq * 8, W + (size_t)(c0 + fr) * DM + fq * 8, W + (size_t)(c0 + 16 + fr) * DM + fq * 8, DM);
#pragma unroll
        for (int mi = 0; mi < 2; ++mi)
#pragma unroll
            for (int ni = 0; ni < 2; ++ni)
#pragma unroll
                for (int j = 0; j < 4; ++j) { const size_t o = (size_t)(r0 + mi * 16 + fq * 4 + j) * DM + c0 + ni * 16 + fr; p.out[o] = p.x[o] + acc[mi][ni][j]; }
    }
}

__device__ __forceinline__ void load_conv_tile(const Params& p, float* dst, int LD, int b, int c, int col0, int cch, float scale) {
    const bf16_t* PR = (const bf16_t*)(p.ws + WS_PROJ);
    for (int i = threadIdx.x; i < 64 * 128; i += blockDim.x) {
        const int s = i >> 7, d = i & 127; const int tl = c * 64 + s; float a = p.conv_b[cch + d];
#pragma unroll
        for (int j = 0; j < 4; ++j) { const int tt = tl - 3 + j; if (tt >= 0) a += p.conv_w[j * 1024 + cch + d] * bf2f(PR[(size_t)(b * SEQ + tt) * NPJ + col0 + d]); }
        dst[s * LD + d] = a * sigmoidf_(a) * scale;
    }
}
__device__ __forceinline__ void load_gates(const Params& p, float* li, float* bcum, int b, int h, int c) {
    const float* gates = (const float*)(p.ws + WS_GATES);
    if (threadIdx.x < 64) { const size_t t = (size_t)b * SEQ + c * 64 + threadIdx.x; li[threadIdx.x] = gates[t * 8 + h]; bcum[threadIdx.x] = log_sigmoid(gates[t * 8 + 4 + h]); }
    __syncthreads();
    if (threadIdx.x == 0) { float a = 0.f; for (int s = 0; s < 64; ++s) { a += bcum[s]; bcum[s] = a; } }
    __syncthreads();
}

__global__ void __launch_bounds__(256) k_mlstm_a(Params p) {
    extern __shared__ __attribute__((aligned(16))) unsigned char smem[];
    float* kk = (float*)smem; float* vv = kk + 64 * 129; float* li = vv + 64 * 128; float* bcum = li + 64; float* wgt = bcum + 64;
    const bf16_t* PR = (const bf16_t*)(p.ws + WS_PROJ);
    bf16_t* MU = (bf16_t*)(p.ws + WS_MU); float* NU = (float*)(p.ws + MS_NU); float* msc = (float*)(p.ws + MS_MSC);
    for (int item = blockIdx.x; item < 16 * NCH; item += gridDim.x) {
        const int bh = item / NCH, c = item % NCH, b = bh >> 2, h = bh & 3;
        __syncthreads();
        load_gates(p, li, bcum, b, h, c);
        load_conv_tile(p, kk, 129, b, c, PK + h * 128, 512 + h * 128, 0.08838834764831845f);
        for (int i = threadIdx.x; i < 64 * 128; i += 256) { const int s = i >> 7, e = i & 127; vv[i] = bf2f(PR[(size_t)(b * SEQ + c * 64 + s) * NPJ + PV + h * 128 + e]); }
        const float blast = bcum[63];
        float gmax = -INFINITY;
        for (int s = 0; s < 64; ++s) gmax = fmaxf(gmax, blast - bcum[s] + li[s]);
        __syncthreads();
        if (threadIdx.x < 64) wgt[threadIdx.x] = __expf(blast - bcum[threadIdx.x] + li[threadIdx.x] - gmax);
        __syncthreads();
        const int d = threadIdx.x >> 1, e0 = (threadIdx.x & 1) * 64;
        float acc[64];
#pragma unroll
        for (int e = 0; e < 64; ++e) acc[e] = 0.f;
        for (int s = 0; s < 64; ++s) { const float kd = wgt[s] * kk[s * 129 + d];
#pragma unroll
            for (int e = 0; e < 64; ++e) acc[e] += kd * vv[s * 128 + e0 + e]; }
        bf16_t* uo = MU + ((size_t)item * 128 + d) * 128 + e0;
#pragma unroll
        for (int e = 0; e < 64; e += 2) *(unsigned*)(uo + e) = pk2(acc[e], acc[e + 1]);
        if (threadIdx.x < 128) { float a = 0.f; for (int s = 0; s < 64; ++s) a += wgt[s] * kk[s * 129 + threadIdx.x]; NU[(size_t)item * 128 + threadIdx.x] = a; }
        if (threadIdx.x == 0) { msc[item] = blast; msc[2048 + item] = gmax; }
    }
}
__global__ void __launch_bounds__(256) k_mlstm_scan(Params p) {
    __shared__ float dec[NCH], ac[NCH];
    const bf16_t* MU = (const bf16_t*)(p.ws + WS_MU); bf16_t* MC = (bf16_t*)(p.ws + WS_MC);
    const float* NU = (const float*)(p.ws + MS_NU); float* NC = (float*)(p.ws + MS_NC); float* msc = (float*)(p.ws + MS_MSC);
    for (int item = blockIdx.x; item < 16 * 64; item += gridDim.x) {
        const int bh = item >> 6, eb = item & 63;
        __syncthreads();
        if (threadIdx.x == 0) { float m = 0.f;
            for (int c = 0; c < NCH; ++c) { const float bl = msc[bh * NCH + c], gm = msc[2048 + bh * NCH + c]; const float m1 = fmaxf(bl + m, gm);
                dec[c] = __expf(bl + m - m1); ac[c] = __expf(gm - m1); if (eb == 0) msc[4096 + bh * NCH + c] = m; m = m1; } }
        __syncthreads();
        const int idx = eb * 256 + threadIdx.x; float C = 0.f;
        for (int c = 0; c < NCH; ++c) { const size_t o = ((size_t)(bh * NCH + c)) * 16384 + idx; MC[o] = (bf16_t)f2bf(C); C = dec[c] * C + ac[c] * bf2f(MU[o]); }
        if (eb == 0 && threadIdx.x < 128) { float n = 0.f;
            for (int c = 0; c < NCH; ++c) { const size_t o = ((size_t)(bh * NCH + c)) * 128 + threadIdx.x; NC[o] = n; n = dec[c] * n + ac[c] * NU[o]; } }
    }
}
__global__ void __launch_bounds__(256) k_mlstm_c(Params p) {
    extern __shared__ __attribute__((aligned(16))) unsigned char smem[];
    float* qq = (float*)smem; float* kk = qq + 64 * 129; float* vv = kk + 64 * 129; float* W = vv + 64 * 128; float* li = W + 64 * 65; float* bcum = li + 64;
    float* mx = bcum + 64; float* den = mx + 64; float* nn = den + 64;
    const bf16_t* PR = (const bf16_t*)(p.ws + WS_PROJ); const bf16_t* MC = (const bf16_t*)(p.ws + WS_MC);
    const float* NC = (const float*)(p.ws + MS_NC); const float* msc = (const float*)(p.ws + MS_MSC); bf16_t* MIX = (bf16_t*)(p.ws + WS_MIX);
    for (int item = blockIdx.x; item < 16 * NCH; item += gridDim.x) {
        const int bh = item / NCH, c = item % NCH, b = bh >> 2, h = bh & 3;
        __syncthreads();
        load_gates(p, li, bcum, b, h, c);
        load_conv_tile(p, qq, 129, b, c, PQ + h * 128, h * 128, 1.f);
        load_conv_tile(p, kk, 129, b, c, PK + h * 128, 512 + h * 128, 0.08838834764831845f);
        for (int i = threadIdx.x; i < 64 * 128; i += 256) { const int s = i >> 7, e = i & 127; vv[i] = bf2f(PR[(size_t)(b * SEQ + c * 64 + s) * NPJ + PV + h * 128 + e]); }
        if (threadIdx.x < 128) nn[threadIdx.x] = NC[(size_t)item * 128 + threadIdx.x];
        const float mc = msc[4096 + item];
        if (threadIdx.x < 64) { const int t = threadIdx.x; float m = bcum[t] + mc; for (int s = 0; s <= t; ++s) m = fmaxf(m, bcum[t] - bcum[s] + li[s]); mx[t] = m; }
        __syncthreads();
        for (int i = threadIdx.x; i < 64 * 64; i += 256) { const int t = i >> 6, s = i & 63; float w = 0.f;
            if (s <= t) { float dot = 0.f; for (int d = 0; d < 128; ++d) dot += qq[t * 129 + d] * kk[s * 129 + d]; w = __expf(bcum[t] - bcum[s] + li[s] - mx[t]) * dot; }
            W[t * 65 + s] = w; }
        __syncthreads();
        const int t = threadIdx.x >> 2, e0 = (threadIdx.x & 3) * 32;
        const float sc = __expf(bcum[t] + mc - mx[t]);
        if ((threadIdx.x & 3) == 0) { float a = 0.f; for (int s = 0; s <= t; ++s) a += W[t * 65 + s]; float qn = 0.f; for (int d = 0; d < 128; ++d) qn += qq[t * 129 + d] * nn[d]; den[t] = a + sc * qn; }
        float acc[32];
#pragma unroll
        for (int e = 0; e < 32; ++e) acc[e] = 0.f;
        const bf16_t* Cb = MC + (size_t)item * 16384 + e0;
        for (int d = 0; d < 128; ++d) { const float qd = qq[t * 129 + d]; const bf16_t* cr = Cb + d * 128;
#pragma unroll
            for (int e = 0; e < 32; ++e) acc[e] += qd * bf2f(cr[e]); }
#pragma unroll
        for (int e = 0; e < 32; ++e) acc[e] *= sc;
        for (int s = 0; s <= t; ++s) { const float w = W[t * 65 + s];
#pragma unroll
            for (int e = 0; e < 32; ++e) acc[e] += w * vv[s * 128 + e0 + e]; }
        __syncthreads();
        const float dn = fmaxf(fabsf(den[t]), __expf(-mx[t])); float ss = 0.f;
#pragma unroll
        for (int e = 0; e < 32; ++e) { acc[e] /= dn; ss += acc[e] * acc[e]; }
        ss += __shfl_xor(ss, 1); ss += __shfl_xor(ss, 2);
        const float rstd = rsqrtf(ss * (1.f / 128.f) + EPS);
        const size_t row = (size_t)b * SEQ + c * 64 + t;
#pragma unroll
        for (int e = 0; e < 32; ++e) { const int ch = h * 128 + e0 + e; const float og = sigmoidf_(bf2f(PR[row * NPJ + PO + ch]));
            MIX[row * DM + ch] = (bf16_t)f2bf(acc[e] * rstd * p.mlstm_norm_g[ch] * og); }
    }
}

__device__ __forceinline__ int t5_bucket(int rel) {
    const int n = rel < 0 ? -rel : rel; int b;
    if (n < 8) b = n; else if (n < 12) b = 8; else if (n < 16) b = 9; else if (n < 23) b = 10; else if (n < 32) b = 11; else if (n < 46) b = 12; else if (n < 64) b = 13; else if (n < 91) b = 14; else b = 15;
    return b + (rel > 0 ? 16 : 0);
}
__global__ void __launch_bounds__(256) k_attn_naive(Params p) {
    __shared__ __attribute__((aligned(16))) float Ks[64 * 64];
    __shared__ __attribute__((aligned(16))) float Vs[64 * 128];
    __shared__ float btab[256];
    const bf16_t* PR = (const bf16_t*)(p.ws + WS_PROJ); float* AO = (float*)(p.ws + WS_AO);
    for (int item = blockIdx.x; item < NB * 4 * 2 * 32; item += gridDim.x) {
        const int qb = 31 - (item >> 5), r5 = item & 31, b = r5 >> 3, h = (r5 >> 1) & 3, m = r5 & 1;
        __syncthreads();
        btab[threadIdx.x] = p.rel_bias[t5_bucket((int)threadIdx.x - 192) * 4 + h] * LOG2E;
        const float c15 = p.rel_bias[15 * 4 + h] * LOG2E;
        const int q = qb * 256 + threadIdx.x, cq = q >> 6;
        float qv[64];
        { const bf16_t* qp = PR + (size_t)(b * SEQ + q) * NPJ + PAQ + h * 128 + m * 64;
#pragma unroll
            for (int d = 0; d < 64; d += 8) { const u32x4 w = *(const u32x4*)(qp + d);
                qv[d] = __uint_as_float(w.x << 16); qv[d + 1] = __uint_as_float(w.x & 0xffff0000u); qv[d + 2] = __uint_as_float(w.y << 16); qv[d + 3] = __uint_as_float(w.y & 0xffff0000u);
                qv[d + 4] = __uint_as_float(w.z << 16); qv[d + 5] = __uint_as_float(w.z & 0xffff0000u); qv[d + 6] = __uint_as_float(w.w << 16); qv[d + 7] = __uint_as_float(w.w & 0xffff0000u); } }
        float o[128];
#pragma unroll
        for (int e = 0; e < 128; ++e) o[e] = 0.f;
        float mrun = -INFINITY, l = 0.f;
        const int ntile = 4 * qb + 4;
        for (int j = 0; j < ntile; ++j) {
            __syncthreads();
            for (int i = threadIdx.x; i < 64 * 64; i += 256) { const int kk = i >> 6, d = i & 63; Ks[i] = bf2f(PR[(size_t)(b * SEQ + j * 64 + kk) * NPJ + PAK + h * 128 + m * 64 + d]); }
            for (int i = threadIdx.x; i < 64 * 128; i += 256) { const int kk = i >> 7, e = i & 127; Vs[i] = bf2f(PR[(size_t)(b * SEQ + j * 64 + kk) * NPJ + PAV + h * 128 + e]); }
            __syncthreads();
            if (j <= cq) {
                for (int kk = 0; kk < 64; ++kk) {
                    float s = 0.f;
#pragma unroll
                    for (int d = 0; d < 64; d += 4) { const f32x4 kv = *(const f32x4*)(Ks + kk * 64 + d); s += qv[d] * kv.x + qv[d + 1] * kv.y + qv[d + 2] * kv.z + qv[d + 3] * kv.w; }
                    const int rel = j * 64 + kk - q;
                    s += (rel < -192) ? c15 : btab[rel + 192];
                    if (s > mrun) { const float f = exp2f(mrun - s); l *= f;
#pragma unroll
                        for (int e = 0; e < 128; ++e) o[e] *= f;
                        mrun = s; }
                    const float pw = exp2f(s - mrun); l += pw;
#pragma unroll
                    for (int e = 0; e < 128; e += 4) { const f32x4 vv = *(const f32x4*)(Vs + kk * 128 + e); o[e] += pw * vv.x; o[e + 1] += pw * vv.y; o[e + 2] += pw * vv.z; o[e + 3] += pw * vv.w; }
                }
            }
        }
        const float inv = 1.f / l;
        float* op = AO + (((size_t)(b * SEQ + q) * 4 + h) * 2 + m) * 128;
#pragma unroll
        for (int e = 0; e < 128; e += 4) *(f32x4*)(op + e) = (f32x4){o[e] * inv, o[e + 1] * inv, o[e + 2] * inv, o[e + 3] * inv};
    }
}
__global__ void __launch_bounds__(256) k_attn_combine(Params p) {
    __shared__ float lam_s;
    if (threadIdx.x == 0) { float a = 0.f, c = 0.f; for (int i = 0; i < 64; ++i) { a += p.lam_q1[i] * p.lam_k1[i]; c += p.lam_q2[i] * p.lam_k2[i]; } lam_s = __expf(a) - __expf(c) + 0.2f; }
    __syncthreads();
    const float lam = lam_s;
    const float* AO = (const float*)(p.ws + WS_AO); bf16_t* MIX = (bf16_t*)(p.ws + WS_MIX);
    const int wave = threadIdx.x >> 6, lane = threadIdx.x & 63;
    for (int it = blockIdx.x * 4 + wave; it < T * 4; it += gridDim.x * 4) {
        const float* o1 = AO + (size_t)it * 256; const float* o2 = o1 + 128;
        const float a0 = o1[2 * lane] - lam * o2[2 * lane], a1 = o1[2 * lane + 1] - lam * o2[2 * lane + 1];
        const float rstd = rsqrtf(wave_sum(a0 * a0 + a1 * a1) * (1.f / 128.f) + EPS);
        const int t = it >> 2, h = it & 3;
        *(unsigned*)(MIX + (size_t)t * DM + 512 + h * 128 + 2 * lane) = pk2(a0 * rstd * p.diff_norm_g[2 * lane] * 0.8f, a1 * rstd * p.diff_norm_g[2 * lane + 1] * 0.8f);
    }
}

__global__ void __launch_bounds__(256) k_route(Params p) {
    __shared__ float urow[4][DM];
    const int wave = threadIdx.x >> 6, lane = threadIdx.x & 63;
    bf16_t* U2 = (bf16_t*)(p.ws + WS_U2); unsigned* ctl = (unsigned*)(p.ws + WS_CTL);
    int* list = (int*)(p.ws + MS_LIST); int* pe = (int*)(p.ws + MS_PE); int* pp = (int*)(p.ws + MS_PP); float* pg = (float*)(p.ws + MS_PG);
    for (int row = blockIdx.x * 4 + wave; row < T; row += gridDim.x * 4) {
        const f32x4* xr = (const f32x4*)(p.out + (size_t)row * DM) + lane;
        f32x4 v[4]; float s = 0.f;
#pragma unroll
        for (int j = 0; j < 4; ++j) { v[j] = xr[64 * j]; s += (v[j].x * v[j].x + v[j].y * v[j].y) + (v[j].z * v[j].z + v[j].w * v[j].w); }
        const float rstd = rsqrtf(wave_sum(s) * (1.f / DM) + EPS);
        unsigned long long* o8 = (unsigned long long*)(U2 + (size_t)row * DM) + lane;
#pragma unroll
        for (int j = 0; j < 4; ++j) { const f32x4 g = ((const f32x4*)p.norm2_g)[64 * j + lane]; const f32x4 u = v[j] * rstd * g;
            o8[64 * j] = (unsigned long long)pk2(u.x, u.y) | ((unsigned long long)pk2(u.z, u.w) << 32);
            *(f32x4*)(&urow[wave][256 * j + 4 * lane]) = u; }
        LDS_WAIT();
        const int e = lane & 31, half = lane >> 5; float acc = 0.f;
        for (int k = half * 512; k < half * 512 + 512; ++k) acc += urow[wave][k] * p.router_w[(size_t)k * NE + e];
        acc += __shfl_xor(acc, 32);
        float val = acc + p.router_b[e];
        float tv[4]; int ti[4];
#pragma unroll
        for (int r = 0; r < 4; ++r) { float bv = val; int bi = e;
#pragma unroll
            for (int o = 1; o < 32; o <<= 1) { const float ov = __shfl_xor(bv, o); const int oi = __shfl_xor(bi, o); if (ov > bv || (ov == bv && oi < bi)) { bv = ov; bi = oi; } }
            tv[r] = bv; ti[r] = bi; if (e == bi) val = -INFINITY; }
        const float e1 = __expf(tv[1] - tv[0]), e2 = __expf(tv[2] - tv[0]), e3 = __expf(tv[3] - tv[0]); const float inv = 1.f / (1.f + e1 + e2 + e3);
        if (lane < 4) { const int ee = lane == 0 ? ti[0] : lane == 1 ? ti[1] : lane == 2 ? ti[2] : ti[3]; const float gg = (lane == 0 ? 1.f : lane == 1 ? e1 : lane == 2 ? e2 : e3) * inv;
            const int pos = (int)atomicAdd(&ctl[CW_CNT + ee], 1u);
            list[(size_t)ee * T + pos] = row; pe[row * 4 + lane] = ee; pp[row * 4 + lane] = pos; pg[row * 4 + lane] = gg; }
        LDS_WAIT();
    }
}

__device__ __forceinline__ void expert_starts(const unsigned* ctl, int* ps, int* cn) {
    if (threadIdx.x == 0) { int a = 0; for (int e = 0; e < NE; ++e) { const int c = (int)ctl[CW_CNT + e]; cn[e] = c; ps[e] = a; a += (c + 255) & ~255; } ps[NE] = a; }
    __syncthreads();
}
__global__ void __launch_bounds__(256) k_moe1(Params p) {
    __shared__ int ps[NE + 1], cn[NE];
    const unsigned* ctl = (const unsigned*)(p.ws + WS_CTL);
    expert_starts(ctl, ps, cn);
    const int wave = threadIdx.x >> 6, lane = threadIdx.x & 63, fr = lane & 15, fq = lane >> 4;
    const bf16_t* U2 = (const bf16_t*)(p.ws + WS_U2); const bf16_t* WG = (const bf16_t*)(p.ws + WS_WGU); bf16_t* ACT = (bf16_t*)(p.ws + WS_ACT); const int* list = (const int*)(p.ws + MS_LIST);
    const int nrt = ps[NE] / 32, NIT = nrt * 32;
    for (int it = blockIdx.x * 4 + wave; it < NIT; it += gridDim.x * 4) {
        const int rt = it >> 5, ct = it & 31, R = rt * 32, c0 = ct * 32;
        int e = 0; while (ps[e + 1] <= R) ++e;
        const int lr = R - ps[e]; if (lr >= cn[e]) continue;
        const int i0 = min(lr + fr, cn[e] - 1), i1 = min(lr + 16 + fr, cn[e] - 1);
        const int t0 = list[(size_t)e * T + i0], t1 = list[(size_t)e * T + i1];
        const bf16_t* Wb = WG + (size_t)e * 2 * FF * DM + (size_t)(256 * (c0 / 128) + (c0 % 128)) * DM;
        f32x4 ag[2][2], au[2][2]; ZERO_ACC(ag); ZERO_ACC(au);
        wave_gemm_32x32(ag, U2 + (size_t)t0 * DM + fq * 8, U2 + (size_t)t1 * DM + fq * 8, Wb + (size_t)fr * DM + fq * 8, Wb + (size_t)(16 + fr) * DM + fq * 8, DM);
        wave_gemm_32x32(au, U2 + (size_t)t0 * DM + fq * 8, U2 + (size_t)t1 * DM + fq * 8, Wb + (size_t)(128 + fr) * DM + fq * 8, Wb + (size_t)(128 + 16 + fr) * DM + fq * 8, DM);
#pragma unroll
        for (int mi = 0; mi < 2; ++mi)
#pragma unroll
            for (int ni = 0; ni < 2; ++ni)
#pragma unroll
                for (int j = 0; j < 4; ++j) { const int col = c0 + ni * 16 + fr;
                    float g = ag[mi][ni][j] + p.b_gu[(size_t)e * 2 * FF + col], u = au[mi][ni][j] + p.b_gu[(size_t)e * 2 * FF + FF + col];
                    g = fminf(g, 7.f); u = fminf(fmaxf(u, -7.f), 7.f);
                    ACT[(size_t)(R + mi * 16 + fq * 4 + j) * FF + col] = (bf16_t)f2bf((u + 1.f) * g * sigmoidf_(1.702f * g)); }
    }
}
__global__ void __launch_bounds__(256) k_moe2(Params p) {
    __shared__ int ps[NE + 1], cn[NE];
    const unsigned* ctl = (const unsigned*)(p.ws + WS_CTL);
    expert_starts(ctl, ps, cn);
    const int wave = threadIdx.x >> 6, lane = threadIdx.x & 63, fr = lane & 15, fq = lane >> 4;
    const bf16_t* ACT = (const bf16_t*)(p.ws + WS_ACT); const bf16_t* WD = (const bf16_t*)(p.ws + WS_WDN); bf16_t* Y = (bf16_t*)(p.ws + WS_Y);
    const int nrt = ps[NE] / 32, NIT = nrt * 32;
    for (int it = blockIdx.x * 4 + wave; it < NIT; it += gridDim.x * 4) {
        const int rt = it >> 5, ct = it & 31, R = rt * 32, c0 = ct * 32;
        int e = 0; while (ps[e + 1] <= R) ++e;
        const int lr = R - ps[e]; if (lr >= cn[e]) continue;
        const bf16_t* Wb = WD + (size_t)e * DM * FF + (size_t)c0 * FF;
        f32x4 acc[2][2]; ZERO_ACC(acc);
        wave_gemm_32x32(acc, ACT + (size_t)(R + fr) * FF + fq * 8, ACT + (size_t)(R + 16 + fr) * FF + fq * 8, Wb + (size_t)fr * FF + fq * 8, Wb + (size_t)(16 + fr) * FF + fq * 8, FF);
#pragma unroll
        for (int mi = 0; mi < 2; ++mi)
#pragma unroll
            for (int ni = 0; ni < 2; ++ni)
#pragma unroll
                for (int j = 0; j < 4; ++j) { const int col = c0 + ni * 16 + fr;
                    Y[(size_t)(R + mi * 16 + fq * 4 + j) * DM + col] = (bf16_t)f2bf(acc[mi][ni][j] + p.b_down[(size_t)e * DM + col]); }
    }
}
__global__ void __launch_bounds__(256) k_final(Params p) {
    __shared__ int ps[NE + 1], cn[NE];
    const unsigned* ctl = (const unsigned*)(p.ws + WS_CTL);
    expert_starts(ctl, ps, cn);
    const int wave = threadIdx.x >> 6, lane = threadIdx.x & 63;
    const bf16_t* Y = (const bf16_t*)(p.ws + WS_Y); const int* pe = (const int*)(p.ws + MS_PE); const int* pp = (const int*)(p.ws + MS_PP); const float* pg = (const float*)(p.ws + MS_PG);
    for (int row = blockIdx.x * 4 + wave; row < T; row += gridDim.x * 4) {
        f32x4* xr = (f32x4*)(p.out + (size_t)row * DM) + lane;
        f32x4 v[4];
#pragma unroll
        for (int j = 0; j < 4; ++j) v[j] = xr[64 * j];
#pragma unroll
        for (int r = 0; r < 4; ++r) { const int e = pe[row * 4 + r]; const size_t yr = (size_t)(ps[e] + pp[row * 4 + r]); const float g = pg[row * 4 + r];
            const u32x2* yp = (const u32x2*)(Y + yr * DM) + lane;
#pragma unroll
            for (int j = 0; j < 4; ++j) { const u32x2 w = yp[64 * j];
                v[j].x += g * __uint_as_float(w.x << 16); v[j].y += g * __uint_as_float(w.x & 0xffff0000u); v[j].z += g * __uint_as_float(w.y << 16); v[j].w += g * __uint_as_float(w.y & 0xffff0000u); } }
        float s = 0.f;
#pragma unroll
        for (int j = 0; j < 4; ++j) s += (v[j].x * v[j].x + v[j].y * v[j].y) + (v[j].z * v[j].z + v[j].w * v[j].w);
        const float rstd = rsqrtf(wave_sum(s) * (1.f / DM) + EPS);
#pragma unroll
        for (int j = 0; j < 4; ++j) { const f32x4 g = ((const f32x4*)p.final_g)[64 * j + lane]; xr[64 * j] = v[j] * rstd * g; }
    }
}

#define LAS __attribute__((address_space(3)))
#define GAS __attribute__((address_space(1)))
typedef GAS unsigned gu32;
#define RLX_AGENT __ATOMIC_RELAXED, __HIP_MEMORY_SCOPE_AGENT
#define VM_WAIT() asm volatile("s_waitcnt vmcnt(0)" ::: "memory")
constexpr int NWAVES = 8, NTHR = 512;
constexpr int RING_BYTES = 131072;
constexpr int LDSCTL_OFF = RING_BYTES, MISC_OFF = LDSCTL_OFF + 320;
constexpr int TAB_OFF = RING_BYTES + 1024;
constexpr int TAB_UL = TAB_OFF, TAB_PS = TAB_OFF + 256, TAB_CN = TAB_OFF + 256 + 160, TAB_NU = TAB_OFF + 256 + 160 + 128, TAB_UC = TAB_OFF + 256 + 160 + 128 + 16;
constexpr int GTAB_OFF = TAB_OFF + 1024;
constexpr int LDS_BYTES = 155648;
static_assert(GTAB_OFF + 20 * 256 * 4 <= LDS_BYTES, "LDS map");
constexpr int CW_BAR = 4096;

namespace pg8 {
constexpr int BM = 256, BK = 64, HALF = 128, HTB = HALF * BK * 2, STAGE_BYTES = 8 * HTB, NXCD = 8, WGM = 8;
__host__ __device__ __forceinline__ int lds_byte(int r, int c) { const int st = (r >> 4) * 2 + (c >> 5), rr = r & 15, cc = c & 31, ob = rr * 64 + cc * 2; return st * 1024 + (ob ^ (((ob >> 9) & 1) << 5)); }
__host__ __device__ __forceinline__ void stage_rc(int b, int& R, int& C) { const int st = b / 1024, sb = b % 1024, swz = sb ^ (((sb >> 9) & 1) << 5); R = (st >> 1) * 16 + swz / 64; C = (st & 1) * 32 + (swz % 64) / 2; }
__host__ __device__ __forceinline__ int perm32(int rho) { const int n = rho >> 4, i = rho & 15; return 8 * (i >> 2) + 4 * n + (i & 3); }
__device__ __forceinline__ unsigned cvt_pk_bf16(float lo, float hi) { unsigned r; asm volatile("v_cvt_pk_bf16_f32 %0, %1, %2" : "=v"(r) : "v"(lo), "v"(hi)); return r; }

struct Unit { const char* a; const char* b; int pm, pn, e, slot; };

__device__ __forceinline__ int xcd_remap(int L, int nwg) { const int q = nwg / NXCD, r = nwg % NXCD, xcd = L % NXCD, off = L / NXCD; return (xcd < r ? xcd * (q + 1) : r * (q + 1) + (xcd - r) * q) + off; }

struct StaticOrder {
    const char* A; const char* Bt; int nM, nN, nwg, G, c; size_t tstep;
    __device__ void init(const void* A_, const void* Bt_, int M, int N, int K, int G_, int c_) { A = (const char*)A_; Bt = (const char*)Bt_; nM = M / BM; nN = N / BM; nwg = nM * nN; G = G_; c = c_; tstep = (size_t)BM * K * 2; }
    __device__ __forceinline__ bool next(int i, Unit& u) const {
        const long L = (long)i * G + c; if (L >= nwg) return false;
        const int wgid = xcd_remap((int)L, nwg);
        const int nig = WGM * nN, gid = wgid / nig, fm = gid * WGM, gsz = (nM - fm) < WGM ? (nM - fm) : WGM;
        u.pm = fm + ((wgid % nig) % gsz); u.pn = (wgid % nig) / gsz; u.e = 0; u.slot = 0;
        u.a = A + (size_t)u.pm * tstep; u.b = Bt + (size_t)u.pn * tstep; return true;
    }
};

template <class Epi, class Sched, bool GATHER>
__device__ __forceinline__ void gemm_phase(LAS unsigned char* lds, const int K, const Sched& S, const Epi& E, const LAS unsigned* gtab) {
    const int tid = threadIdx.x, wid = __builtin_amdgcn_readfirstlane(tid >> 6), lane = tid & 63, wr = wid >> 2, wc = wid & 3, fr = lane & 15, fq = lane >> 4;
    const int nt = K / BK;
    unsigned voffA[2][2], voffB[2]; int rowA[2];
#pragma unroll
    for (int i = 0; i < 2; ++i) { int R, C; stage_rc(tid * 16 + i * 8192, R, C); const int Rb = Epi::PERM ? ((R & ~31) + perm32(R & 31)) : R;
        rowA[i] = R;
        if (GATHER) { voffA[0][i] = (unsigned)C * 2u; voffA[1][i] = (unsigned)C * 2u; }
        else { voffA[0][i] = (unsigned)(R * K + C) * 2u; voffA[1][i] = (unsigned)((R + HALF) * K + C) * 2u; }
        voffB[i] = (unsigned)(Rb * K + C) * 2u; }
    const unsigned coff0 = voffA[0][0], coff1 = voffA[0][1];
    const size_t kstep = (size_t)(BK * 2);
    const size_t hstep = (size_t)HALF * K * 2;
    const unsigned ldsw = (unsigned)wid * 1024u;
    const int aoff = lds_byte(wr * 64 + fr, fq * 8), boff = lds_byte(wc * 32 + fr, fq * 8);
#define PG8_SA(b, h) (((b) * 2 + (h)) * HTB)
#define PG8_SB(b, h) ((4 + (b) * 2 + (h)) * HTB)
#define PG8_STAGE(bufoff, gbase, voff) do { _Pragma("unroll") for (int _i = 0; _i < 2; ++_i) \
        __builtin_amdgcn_global_load_lds((const unsigned*)((const char*)(gbase) + (voff)[_i]), (LAS unsigned*)(lds + (bufoff) + ldsw + _i * 8192), 16, 0, 0); } while (0)
#define PG8_LDA(dst, b, h) do { _Pragma("unroll") for (int m = 0; m < 4; ++m) _Pragma("unroll") for (int k = 0; k < 2; ++k) dst[m][k] = *(const LAS bf16x8*)(lds + PG8_SA(b, h) + aoff + m * 2048 + k * 1024); } while (0)
#define PG8_LDB(dst, b, h) do { _Pragma("unroll") for (int n = 0; n < 2; ++n) _Pragma("unroll") for (int k = 0; k < 2; ++k) dst[n][k] = *(const LAS bf16x8*)(lds + PG8_SB(b, h) + boff + n * 2048 + k * 1024); } while (0)
#define PG8_MMA(ai, bj, At, Bt) do { __builtin_amdgcn_s_setprio(1); _Pragma("unroll") for (int m = 0; m < 4; ++m) _Pragma("unroll") for (int n = 0; n < 2; ++n) _Pragma("unroll") for (int k = 0; k < 2; ++k) \
        acc[ai][bj][m][n] = __builtin_amdgcn_mfma_f32_16x16x32_bf16(Bt[n][k], At[m][k], acc[ai][bj][m][n], 0, 0, 0); __builtin_amdgcn_s_setprio(0); } while (0)
#define PG8_WAIT_V(n) asm volatile("s_waitcnt vmcnt(" #n ")" ::: "memory")
#define PG8_WAIT_L(n) asm volatile("s_waitcnt lgkmcnt(" #n ")" ::: "memory")
#define PG8_BAR __builtin_amdgcn_s_barrier()
#define PG8_SCHED __builtin_amdgcn_sched_barrier(0)
#define PG8_GATHER_OFFS(u) do { if (GATHER) { const LAS unsigned* _g = gtab + (u).slot * 256; \
        voffA[0][0] = _g[rowA[0]] + coff0; voffA[0][1] = _g[rowA[1]] + coff1; voffA[1][0] = _g[HALF + rowA[0]] + coff0; voffA[1][1] = _g[HALF + rowA[1]] + coff1; } } while (0)
    Unit cur, nxt; int ui = 0;
    if (!S.next(0, cur)) return;
    f32x4 acc[2][2][4][2];
#pragma unroll
    for (int a = 0; a < 2; ++a)
#pragma unroll
        for (int b = 0; b < 2; ++b)
#pragma unroll
            for (int m = 0; m < 4; ++m)
#pragma unroll
                for (int n = 0; n < 2; ++n) acc[a][b][m][n] = (f32x4){0.f, 0.f, 0.f, 0.f};
    bf16x8 At[4][2], B0[2][2], B1[2][2];
    const char* cA = cur.a; const char* cB = cur.b;
    PG8_GATHER_OFFS(cur);
    PG8_STAGE(PG8_SB(0, 0), cB, voffB); PG8_STAGE(PG8_SB(0, 1), cB + hstep, voffB); PG8_STAGE(PG8_SA(0, 0), cA, voffA[0]); PG8_STAGE(PG8_SA(0, 1), cA, voffA[1]);
    if (wr == 1) PG8_BAR;
    PG8_WAIT_V(2); PG8_BAR;
    PG8_STAGE(PG8_SB(1, 0), cB + kstep, voffB); PG8_STAGE(PG8_SA(1, 0), cA + kstep, voffA[0]); PG8_STAGE(PG8_SB(1, 1), cB + hstep + kstep, voffB);
    PG8_WAIT_V(6); PG8_BAR;
    for (;;) {
        const bool has_next = S.next(ui + 1, nxt);
        const char* nA = has_next ? nxt.a : cA; const char* nB = has_next ? nxt.b : cB;
        for (int t = 0; t < nt; t += 2) {
            const bool last = (t == nt - 2);
            const char* a1 = cA + (size_t)(t + 1) * kstep;
            const char* a2 = last ? nA : cA + (size_t)(t + 2) * kstep; const char* b2 = last ? nB : cB + (size_t)(t + 2) * kstep;
            const char* a3 = a2 + kstep; const char* b3 = b2 + kstep;
            PG8_LDB(B0, 0, 0); PG8_LDB(B1, 0, 1); PG8_SCHED; PG8_LDA(At, 0, 0); PG8_STAGE(PG8_SA(1, 1), a1, voffA[1]);
            if (GATHER) { if (last && has_next) PG8_GATHER_OFFS(nxt); }
            PG8_WAIT_V(8); PG8_WAIT_L(0); PG8_BAR; PG8_MMA(0, 0, At, B0); PG8_MMA(0, 1, At, B1); PG8_BAR; PG8_SCHED;
            PG8_LDA(At, 0, 1); PG8_STAGE(PG8_SB(0, 0), b2, voffB); PG8_STAGE(PG8_SB(0, 1), b2 + hstep, voffB); PG8_STAGE(PG8_SA(0, 0), a2, voffA[0]);
            PG8_WAIT_V(8); PG8_WAIT_L(0); PG8_BAR; PG8_MMA(1, 0, At, B0); PG8_MMA(1, 1, At, B1); PG8_BAR; PG8_SCHED;
            PG8_LDB(B0, 1, 0); PG8_LDB(B1, 1, 1); PG8_SCHED; PG8_LDA(At, 1, 0); PG8_STAGE(PG8_SA(0, 1), a2, voffA[1]);
            PG8_WAIT_V(8); PG8_WAIT_L(0); PG8_BAR; PG8_MMA(0, 0, At, B0); PG8_MMA(0, 1, At, B1); PG8_BAR; PG8_SCHED;
            PG8_LDA(At, 1, 1); PG8_STAGE(PG8_SB(1, 0), b3, voffB); PG8_STAGE(PG8_SB(1, 1), b3 + hstep, voffB); PG8_STAGE(PG8_SA(1, 0), a3, voffA[0]);
            PG8_WAIT_V(8); PG8_WAIT_L(0); PG8_BAR; PG8_MMA(1, 0, At, B0); PG8_MMA(1, 1, At, B1); PG8_BAR; PG8_SCHED;
        }
        if (wr == 0) PG8_BAR;
        E(acc, cur, wr, wc, fr, fq);
        if (!has_next) break;
#pragma unroll
        for (int a = 0; a < 2; ++a)
#pragma unroll
            for (int b = 0; b < 2; ++b)
#pragma unroll
                for (int m = 0; m < 4; ++m)
#pragma unroll
                    for (int n = 0; n < 2; ++n) acc[a][b][m][n] = (f32x4){0.f, 0.f, 0.f, 0.f};
        cur = nxt; cA = nA; cB = nB; ++ui;
        if (wr == 1) PG8_BAR;
    }
    PG8_WAIT_V(0);
    PG8_BAR;
#undef PG8_SA
#undef PG8_SB
#undef PG8_STAGE
#undef PG8_LDA
#undef PG8_LDB
#undef PG8_MMA
#undef PG8_WAIT_V
#undef PG8_WAIT_L
#undef PG8_BAR
#undef PG8_SCHED
#undef PG8_GATHER_OFFS
}

struct EpiProj {
    static constexpr bool PERM = true;
    bf16_t* O;
    __device__ __forceinline__ void operator()(const f32x4 (&acc)[2][2][4][2], const Unit& u, int wr, int wc, int fr, int fq) const {
        const int row0 = u.pm * BM + wr * 64 + fr, col0 = u.pn * BM + wc * 32 + 8 * fq;
        const float sc = (u.pn == 8 || u.pn == 9) ? QSCALE : 1.f;
#pragma unroll
        for (int ai = 0; ai < 2; ++ai)
#pragma unroll
            for (int m = 0; m < 4; ++m) { bf16_t* rowp = O + (size_t)(row0 + ai * HALF + m * 16) * NPJ + col0;
#pragma unroll
                for (int bj = 0; bj < 2; ++bj) { const f32x4 v0 = acc[ai][bj][m][0] * sc, v1 = acc[ai][bj][m][1] * sc;
                    u32x4 w; w.x = cvt_pk_bf16(v0[0], v0[1]); w.y = cvt_pk_bf16(v0[2], v0[3]); w.z = cvt_pk_bf16(v1[0], v1[1]); w.w = cvt_pk_bf16(v1[2], v1[3]);
                    *(u32x4*)(rowp + bj * HALF) = w; } }
    }
};
struct EpiOut {
    static constexpr bool PERM = false;
    const float* X; float* O;
    __device__ __forceinline__ void operator()(const f32x4 (&acc)[2][2][4][2], const Unit& u, int wr, int wc, int fr, int fq) const {
        const int row0 = u.pm * BM + wr * 64 + fr, col0 = u.pn * BM + wc * 32 + 4 * fq;
#pragma unroll
        for (int ai = 0; ai < 2; ++ai)
#pragma unroll
            for (int m = 0; m < 4; ++m) { const size_t off = (size_t)(row0 + ai * HALF + m * 16) * DM + col0;
#pragma unroll
                for (int bj = 0; bj < 2; ++bj)
#pragma unroll
                    for (int n = 0; n < 2; ++n) { const f32x4 xv = *(const f32x4*)(X + off + bj * HALF + n * 16); *(f32x4*)(O + off + bj * HALF + n * 16) = xv + acc[ai][bj][m][n]; } }
    }
};
struct EpiSwiglu {
    static constexpr bool PERM = true;
    bf16_t* O; const float* bgu;
    __device__ __forceinline__ void operator()(const f32x4 (&acc)[2][2][4][2], const Unit& u, int wr, int wc, int fr, int fq) const {
        const int row0 = u.pm * BM + wr * 64 + fr, col0 = u.pn * HALF + wc * 32 + 8 * fq;
        const float* bb = bgu + (size_t)u.e * 2 * FF + col0;
        const f32x4 bg0 = *(const f32x4*)(bb), bg1 = *(const f32x4*)(bb + 4), bu0 = *(const f32x4*)(bb + FF), bu1 = *(const f32x4*)(bb + FF + 4);
#pragma unroll
        for (int ai = 0; ai < 2; ++ai)
#pragma unroll
            for (int m = 0; m < 4; ++m) { bf16_t* rowp = O + (size_t)(row0 + ai * HALF + m * 16) * FF + col0;
                float r[8];
#pragma unroll
                for (int n = 0; n < 2; ++n) { const f32x4 gv = acc[ai][0][m][n] + (n ? bg1 : bg0), uv = acc[ai][1][m][n] + (n ? bu1 : bu0);
#pragma unroll
                    for (int j = 0; j < 4; ++j) { const float g = fminf(gv[j], 7.f), uu = fminf(fmaxf(uv[j], -7.f), 7.f);
                        r[n * 4 + j] = (uu + 1.f) * g * __builtin_amdgcn_rcpf(1.f + __builtin_amdgcn_exp2f(-1.702f * LOG2E * g)); } }
                u32x4 w; w.x = cvt_pk_bf16(r[0], r[1]); w.y = cvt_pk_bf16(r[2], r[3]); w.z = cvt_pk_bf16(r[4], r[5]); w.w = cvt_pk_bf16(r[6], r[7]);
                *(u32x4*)(rowp) = w; }
    }
};
struct EpiDown {
    static constexpr bool PERM = true;
    bf16_t* O; const float* bd;
    __device__ __forceinline__ void operator()(const f32x4 (&acc)[2][2][4][2], const Unit& u, int wr, int wc, int fr, int fq) const {
        const int row0 = u.pm * BM + wr * 64 + fr, col0 = u.pn * BM + wc * 32 + 8 * fq;
        const float* bb = bd + (size_t)u.e * DM + col0;
        f32x4 bv[2][2];
#pragma unroll
        for (int bj = 0; bj < 2; ++bj)
#pragma unroll
            for (int n = 0; n < 2; ++n) bv[bj][n] = *(const f32x4*)(bb + bj * HALF + 4 * n);
#pragma unroll
        for (int ai = 0; ai < 2; ++ai)
#pragma unroll
            for (int m = 0; m < 4; ++m) { bf16_t* rowp = O + (size_t)(row0 + ai * HALF + m * 16) * DM + col0;
#pragma unroll
                for (int bj = 0; bj < 2; ++bj) { const f32x4 v0 = acc[ai][bj][m][0] + bv[bj][0], v1 = acc[ai][bj][m][1] + bv[bj][1];
                    u32x4 w; w.x = cvt_pk_bf16(v0[0], v0[1]); w.y = cvt_pk_bf16(v0[2], v0[3]); w.z = cvt_pk_bf16(v1[0], v1[1]); w.w = cvt_pk_bf16(v1[2], v1[3]);
                    *(u32x4*)(rowp + bj * HALF) = w; } }
    }
};
}

#define XB_TMO      128
#define XB_XCNT(j)  (256  + 64 * (j))
#define XB_XSUB(j)  (1280 + 64 * (j))
#define XB_XGEN(j)  (2304 + 64 * (j))
#define XB_TOP      3328
#define XB_TOPGEN   3392
#define XCD_BAR_WORDS 3456
#define XB_SPIN_CAP (1u << 22)
__device__ __forceinline__ unsigned xb_ld(unsigned* p)              { return __hip_atomic_load(p, __ATOMIC_RELAXED, __HIP_MEMORY_SCOPE_AGENT); }
__device__ __forceinline__ unsigned xb_add(unsigned* p, unsigned v) { return __hip_atomic_fetch_add(p, v, __ATOMIC_RELAXED, __HIP_MEMORY_SCOPE_AGENT); }
__device__ __forceinline__ unsigned xb_xcc_id() { return (unsigned)__builtin_amdgcn_s_getreg((3 << 11) | 20) & 0xFu; }
#define XB_SPIN(cond, bar) do { unsigned _sp = 0; while (cond) { __builtin_amdgcn_s_sleep(1); \
    if ((++_sp & 255u) == 0u) { if (xb_ld(&(bar)[XB_TMO])) break; if (_sp > XB_SPIN_CAP) { atomicAdd(&(bar)[XB_TMO], 1u); break; } } } } while (0)
struct XcdBarrier { unsigned* bar; unsigned x; volatile LAS unsigned* st; };
__device__ __forceinline__ XcdBarrier xcd_barrier_post(unsigned* bar, volatile LAS unsigned* st) {
    XcdBarrier b; b.bar = bar; b.x = xb_xcc_id(); b.st = st;
    if (threadIdx.x == 0) (void)xb_add(&bar[XB_XCNT(b.x)], 1u);
    return b;
}
__device__ __forceinline__ void xcd_barrier_complete(unsigned* bar, unsigned x, unsigned& nloc, unsigned& nx) {
    const unsigned G = gridDim.x * gridDim.y * gridDim.z;
    unsigned sum, cnt, mine, sp = 0u;
    for (;;) {
        sum = 0u; cnt = 0u; mine = 0u;
#pragma unroll
        for (unsigned j = 0; j < 16; ++j) { const unsigned c = xb_ld(&bar[XB_XCNT(j)]); sum += c; cnt += (c > 0u) ? 1u : 0u; mine = (j == x) ? c : mine; }
        if (sum == G) break;
        __builtin_amdgcn_s_sleep(1);
        if ((++sp & 255u) == 0u) { if (xb_ld(&bar[XB_TMO])) break; if (sp > XB_SPIN_CAP) { atomicAdd(&bar[XB_TMO], 1u); break; } }
    }
    nloc = mine > 0u ? mine : 1u; nx = cnt > 0u ? cnt : 1u;
}
__device__ __forceinline__ void xcd_barrier(const XcdBarrier& b) {
    asm volatile("s_waitcnt vmcnt(0)" ::: "memory");
    __syncthreads();
    if (threadIdx.x == 0) {
        unsigned* bar = b.bar;
        __builtin_amdgcn_s_waitcnt(0);
        unsigned nloc = b.st[0], nx = b.st[1];
        if (nloc == 0u) { xcd_barrier_complete(bar, b.x, nloc, nx); b.st[0] = nloc; b.st[1] = nx; }
        const unsigned old = xb_add(&bar[XB_XSUB(b.x)], 1u);
        const unsigned gen = old / nloc;
        if (old + 1u == (gen + 1u) * nloc) {
            __builtin_amdgcn_fence(__ATOMIC_RELEASE, "agent");
            asm volatile("s_waitcnt vmcnt(0)" ::: "memory");
            const unsigned og = xb_add(&bar[XB_TOP], 1u);
            const unsigned tg = og / nx;
            if (og + 1u == (tg + 1u) * nx) xb_add(&bar[XB_TOPGEN], 1u);
            else XB_SPIN(xb_ld(&bar[XB_TOPGEN]) == tg, bar);
            __builtin_amdgcn_fence(__ATOMIC_ACQUIRE, "agent");
            xb_add(&bar[XB_XGEN(b.x)], 1u);
            asm volatile("s_waitcnt vmcnt(0)" ::: "memory");
        } else {
            XB_SPIN(xb_ld(&bar[XB_XGEN(b.x)]) == gen, bar);
            __builtin_amdgcn_fence(__ATOMIC_ACQUIRE, "agent");
            asm volatile("s_waitcnt vmcnt(0)" ::: "memory");
        }
    }
    __syncthreads();
}

template <int NN, bool GU>
struct MoeOrder {
    const LAS int* UL; const LAS int* PS; int n; const char* A; const char* B;
    __device__ __forceinline__ bool next(int i, pg8::Unit& u) const {
        if (i >= n) return false;
        const int w = __builtin_amdgcn_readfirstlane(UL[i]); const int e = w & 255, rt = (w >> 8) & 255, pn = w >> 16;
        const int ps = __builtin_amdgcn_readfirstlane(PS[e]);
        u.e = e; u.pn = pn; u.pm = (ps >> 8) + rt; u.slot = i;
        if (GU) { u.a = A; u.b = B + ((size_t)e * 2 * FF + (size_t)pn * 256) * DM * 2; }
        else { u.a = A + (size_t)u.pm * 256 * FF * 2; u.b = B + ((size_t)e * DM + (size_t)pn * 256) * FF * 2; }
        return true;
    }
};
template <int NN>
__device__ __forceinline__ int moe_build_units(LAS unsigned char* lds, const unsigned* ctl, int G, int c) {
    LAS int* UL = (LAS int*)(lds + TAB_UL); LAS int* PS = (LAS int*)(lds + TAB_PS); LAS int* CN = (LAS int*)(lds + TAB_CN); LAS int* NU = (LAS int*)(lds + TAB_NU); LAS int* UC = (LAS int*)(lds + TAB_UC);
    __syncthreads();
    if (threadIdx.x == 0) {
        int a = 0, uc = 0;
        for (int e = 0; e < NE; ++e) { const int cnt = (int)__hip_atomic_load(ctl + CW_CNT + e, RLX_AGENT); CN[e] = cnt; PS[e] = a; UC[e] = uc; const int nt = (cnt + 255) >> 8; a += nt << 8; uc += nt * NN; }
        PS[NE] = a; UC[NE] = uc;
        const int nwg = uc; int n = 0;
        for (int i = 0;; ++i) { const long L = (long)i * G + c; if (L >= nwg || n >= 20) break;
            const int wgid = pg8::xcd_remap((int)L, nwg);
            int e = 0; while (UC[e + 1] <= wgid) ++e;
            const int l = wgid - UC[e], nte = (CN[e] + 255) >> 8;
            const int nig = pg8::WGM * NN, gid = l / nig, fm = gid * pg8::WGM, gsz = (nte - fm) < pg8::WGM ? (nte - fm) : pg8::WGM;
            const int rt = fm + ((l % nig) % gsz), pn = (l % nig) / gsz;
            UL[n++] = e | (rt << 8) | (pn << 16); }
        NU[0] = n;
    }
    __syncthreads();
    return __builtin_amdgcn_readfirstlane(NU[0]);
}

namespace att {
using f32x16 = __attribute__((ext_vector_type(16))) float;
using s16x4 = __attribute__((ext_vector_type(4))) short;
constexpr int NW = 8, QBLK = 32, KVBLK = 64, LDP = NPJ, LDO = 1024;
constexpr int SHM_V = KVBLK * 128 * 2, SHM_K = KVBLK * 64 * 2;
constexpr int OFF_V = 0, OFF_K = 2 * SHM_V, OFF_WS = OFF_K + 2 * SHM_K, OFF_BT = OFF_WS + NW * 64 * 4, ATT_LDS = OFF_BT + 1024;
constexpr float THRL = 8.f;
#define KSWZ(row, colB) ((row) * 128 + ((colB) ^ ((((row) >> 1) & 7) << 4)))
#define SBAR() __builtin_amdgcn_sched_barrier(0)
__device__ __forceinline__ int crow(int r, int hi) { return (r & 3) + 8 * (r >> 2) + 4 * hi; }
__device__ __forceinline__ unsigned cvtpk(float lo, float hi) { unsigned r; asm volatile("v_cvt_pk_bf16_f32 %0, %1, %2" : "=v"(r) : "v"(lo), "v"(hi)); return r; }

__device__ __forceinline__ void partialSM(f32x16& p0, f32x16& p1, float& m_reg, float& alpha) {
  float pmax = p0[0];
#pragma unroll
  for (int r = 1; r < 16; ++r) pmax = fmaxf(pmax, p0[r]);
#pragma unroll
  for (int r = 0; r < 16; ++r) pmax = fmaxf(pmax, p1[r]);
  { auto rr = __builtin_amdgcn_permlane32_swap(__float_as_uint(pmax), __float_as_uint(pmax), false, false);
    pmax = fmaxf(__uint_as_float(rr[0]), __uint_as_float(rr[1])); }
  float mn;
  if (__builtin_expect(__all(pmax - m_reg <= THRL), 1)) { mn = m_reg; alpha = 1.f; }
  else { mn = fmaxf(m_reg, pmax); alpha = __builtin_amdgcn_exp2f(m_reg - mn); m_reg = mn; }
#pragma unroll
  for (int r = 0; r < 16; ++r) p0[r] = p0[r] - mn;
#pragma unroll
  for (int r = 0; r < 16; ++r) p1[r] = p1[r] - mn;
#pragma unroll
  for (int r = 0; r < 16; ++r) p0[r] = __builtin_amdgcn_exp2f(p0[r]);
}
__device__ __forceinline__ void finishSM(f32x16& p0, f32x16& p1, float alpha, float& l_reg, bf16x8& pa0, bf16x8& pa1, bf16x8& pa2, bf16x8& pa3) {
#pragma unroll
  for (int r = 0; r < 16; ++r) p1[r] = __builtin_amdgcn_exp2f(p1[r]);
  float ps = 0;
#pragma unroll
  for (int r = 0; r < 16; ++r) ps += p0[r];
#pragma unroll
  for (int r = 0; r < 16; ++r) ps += p1[r];
  { auto rr = __builtin_amdgcn_permlane32_swap(__float_as_uint(ps), __float_as_uint(ps), false, false);
    ps = __uint_as_float(rr[0]) + __uint_as_float(rr[1]); }
  l_reg = l_reg * alpha + ps;
#define PK4(P, BASE, OUT) do { unsigned a0 = cvtpk(P[BASE + 0], P[BASE + 1]), a1 = cvtpk(P[BASE + 2], P[BASE + 3]);   \
    unsigned b0 = cvtpk(P[BASE + 4], P[BASE + 5]), b1 = cvtpk(P[BASE + 6], P[BASE + 7]);                              \
    auto r0 = __builtin_amdgcn_permlane32_swap(a0, b0, false, false); auto r1 = __builtin_amdgcn_permlane32_swap(a1, b1, false, false); \
    u32x4 w = {r0[0], r1[0], r0[1], r1[1]}; OUT = *reinterpret_cast<bf16x8*>(&w); } while (0)
  PK4(p0, 0, pa0); PK4(p0, 8, pa1); PK4(p1, 0, pa2); PK4(p1, 8, pa3);
#undef PK4
}
__device__ __forceinline__ void qkt(f32x16& p0, f32x16& p1, const char* Ks, const bf16x8* qr, int r32, int hi) {
  p0 = f32x16{}; p1 = f32x16{};
#pragma unroll
  for (int d0 = 0; d0 < 4; ++d0) { const int cb = (d0 * 16 + hi * 8) * 2;
    const bf16x8 b0 = *reinterpret_cast<const bf16x8*>(Ks + KSWZ(r32, cb));
    const bf16x8 b1 = *reinterpret_cast<const bf16x8*>(Ks + KSWZ(32 + r32, cb));
    p0 = __builtin_amdgcn_mfma_f32_32x32x16_bf16(b0, qr[d0], p0, 0, 0, 0);
    p1 = __builtin_amdgcn_mfma_f32_32x32x16_bf16(b1, qr[d0], p1, 0, 0, 0); }
}
__device__ __forceinline__ int v_st(int k, int c) { const int kk = (k & ~0xC) | ((k & 4) << 1) | ((k & 8) >> 1); return ((kk >> 3) * 4 + (c >> 5)) * 512 + ((kk & 7) * 32 + (c & 31)) * 2; }
__device__ __forceinline__ int v_rd_base(int lane) { return ((lane & 3) << 3) | (((lane >> 2) & 3) << 6) | (((lane >> 4) & 1) << 5) | (((lane >> 5) & 1) << 8); }
constexpr int v_rd_off(int d0, int ks, int half) { return d0 * 512 + ks * 4096 + half * 2048; }
template <int OFF> __device__ __forceinline__ s16x4 tr_read(int vb) {
  s16x4 r; asm volatile("ds_read_b64_tr_b16 %0, %1 offset:%2" : "=&v"(r) : "v"(vb), "i"(OFF) : "memory"); return r;
}
template <int D0> __device__ __forceinline__ void pv_one(f32x16& od, int vb, bf16x8 pa0, bf16x8 pa1, bf16x8 pa2, bf16x8 pa3) {
  const s16x4 l0 = tr_read<v_rd_off(D0, 0, 0)>(vb), h0 = tr_read<v_rd_off(D0, 0, 1)>(vb), l1 = tr_read<v_rd_off(D0, 1, 0)>(vb), h1 = tr_read<v_rd_off(D0, 1, 1)>(vb);
  const s16x4 l2 = tr_read<v_rd_off(D0, 2, 0)>(vb), h2 = tr_read<v_rd_off(D0, 2, 1)>(vb), l3 = tr_read<v_rd_off(D0, 3, 0)>(vb), h3 = tr_read<v_rd_off(D0, 3, 1)>(vb);
  asm volatile("s_waitcnt lgkmcnt(0)" ::: "memory"); SBAR();
#define PK(L, H) (bf16x8){L[0], L[1], L[2], L[3], H[0], H[1], H[2], H[3]}
  od = __builtin_amdgcn_mfma_f32_32x32x16_bf16(pa0, PK(l0, h0), od, 0, 0, 0);
  od = __builtin_amdgcn_mfma_f32_32x32x16_bf16(pa1, PK(l1, h1), od, 0, 0, 0);
  od = __builtin_amdgcn_mfma_f32_32x32x16_bf16(pa2, PK(l2, h2), od, 0, 0, 0);
  od = __builtin_amdgcn_mfma_f32_32x32x16_bf16(pa3, PK(l3, h3), od, 0, 0, 0);
#undef PK
}
__device__ __forceinline__ void pv_d0(f32x16* o, int vb, bf16x8 pa0, bf16x8 pa1, bf16x8 pa2, bf16x8 pa3) {
  pv_one<0>(o[0], vb, pa0, pa1, pa2, pa3); pv_one<1>(o[1], vb, pa0, pa1, pa2, pa3); pv_one<2>(o[2], vb, pa0, pa1, pa2, pa3); pv_one<3>(o[3], vb, pa0, pa1, pa2, pa3);
}
__device__ __forceinline__ void bias_mask(f32x16& p0, f32x16& p1, int j, int cw, const float* bt, int qoff, int r32, int hi) {
  if (j > cw) {
#pragma unroll
    for (int r = 0; r < 16; ++r) { p0[r] = -INFINITY; p1[r] = -INFINITY; }
  } else if (j >= cw - 2) {
    const float* b = bt + (64 * (j - cw) + 192 - qoff - r32 + 4 * hi);
#pragma unroll
    for (int r = 0; r < 16; ++r) { p0[r] += b[(r & 3) + 8 * (r >> 2)]; p1[r] += b[32 + (r & 3) + 8 * (r >> 2)]; }
  }
}

__device__ __forceinline__ void attn_unit(const Params& p, int b, int h, int m, int qb, char* lds) {
  const bf16_t* PR = (const bf16_t*)(p.ws + WS_PROJ);
  const int tid = threadIdx.x, wid = tid >> 6, lane = tid & 63, r32 = lane & 31, hi = lane >> 5;
  char* V_lds = lds + OFF_V; char* K_lds = lds + OFF_K;
  float* ws = (float*)(lds + OFF_WS) + wid * 64; float* li_l = ws; float* al_l = ws + 32; float* bt = (float*)(lds + OFF_BT);
  __syncthreads();
  if (tid < 256) bt[tid] = (p.rel_bias[t5_bucket(tid - 192) * 4 + h] - p.rel_bias[15 * 4 + h]) * LOG2E;
  const bf16_t* Qb = PR + (size_t)(b * SEQ + qb * 256) * LDP + PAQ + h * 128 + m * 64;
  const bf16_t* Kh = PR + (size_t)(b * SEQ) * LDP + PAK + h * 128 + m * 64;
  const bf16_t* Vh = PR + (size_t)(b * SEQ) * LDP + PAV + h * 128;
  float* Ob = (float*)(p.ws + WS_AO) + (size_t)(b * SEQ + qb * 256) * LDO + (h * 2 + m) * 128;
  const int cw = 4 * qb + (wid >> 1), qoff = 32 * (wid & 1);
  float m_reg = -1e30f, l_reg = 0; f32x16 o[4] = {}; bf16x8 qr[4];
  const bf16_t* Qw = Qb + (size_t)(wid * QBLK + r32) * LDP + hi * 8;
#pragma unroll
  for (int d0 = 0; d0 < 4; ++d0) qr[d0] = *reinterpret_cast<const bf16x8*>(Qw + d0 * 16);
  const int sr = tid >> 4, sc = (tid & 15) * 8, vst0 = v_st(sr, sc), vst1 = v_st(32 + sr, sc);
  const int kr = tid >> 3, kc = (tid & 7) * 8, kst = KSWZ(kr, kc * 2);
  const int vb0 = (int)(uintptr_t)V_lds + v_rd_base(lane);
  struct { bf16x8 vs0, vs1, ks; } sr_[1];
#define SLOAD(i, k0) do { sr_[i].vs0 = *(const bf16x8*)(&Vh[(size_t)((k0) + sr) * LDP + sc]); sr_[i].vs1 = *(const bf16x8*)(&Vh[(size_t)((k0) + 32 + sr) * LDP + sc]); \
    sr_[i].ks = *(const bf16x8*)(&Kh[(size_t)((k0) + kr) * LDP + kc]); } while (0)
#define SWRITE(bb, i) do { *(bf16x8*)(V_lds + (bb) * SHM_V + vst0) = sr_[i].vs0; *(bf16x8*)(V_lds + (bb) * SHM_V + vst1) = sr_[i].vs1; \
    *(bf16x8*)(K_lds + (bb) * SHM_K + kst) = sr_[i].ks; } while (0)
#define SWAIT() asm volatile("s_waitcnt vmcnt(0)" ::: "memory")
#define RESC(a) do { if (__any((a) < 1.f)) { if (hi == 0) al_l[r32] = (a); asm volatile("s_waitcnt lgkmcnt(0)" ::: "memory"); \
    _Pragma("unroll") for (int d = 0; d < 4; ++d) _Pragma("unroll") for (int r = 0; r < 16; ++r) o[d][r] *= al_l[crow(r, hi)]; } } while (0)
  f32x16 pA0, pA1, pB0, pB1; float alA, alB; bf16x8 pa0, pa1, pa2, pa3; const int NT = 4 * qb + 4;
  constexpr int SE = 0, SO = 0;
  SLOAD(SE, 0); asm volatile("s_waitcnt vmcnt(0)" ::: "memory"); SWRITE(0, SE); __syncthreads();
  qkt(pA0, pA1, K_lds, qr, r32, hi); bias_mask(pA0, pA1, 0, cw, bt, qoff, r32, hi); partialSM(pA0, pA1, m_reg, alA);
  SLOAD(SO, KVBLK);
  SWAIT(); SWRITE(1, SO); __syncthreads();
  for (int j = 1; j + 1 < NT; j += 2) {
    SBAR(); qkt(pB0, pB1, K_lds + SHM_K, qr, r32, hi);
    finishSM(pA0, pA1, alA, l_reg, pa0, pa1, pa2, pa3); SBAR();
    SLOAD(SO, (j + 1) * KVBLK); SBAR();
    pv_d0(o, vb0, pa0, pa1, pa2, pa3); bias_mask(pB0, pB1, j, cw, bt, qoff, r32, hi); partialSM(pB0, pB1, m_reg, alB);
    __syncthreads(); SWAIT(); SWRITE(0, SE);
    RESC(alB); __syncthreads();
    SBAR(); qkt(pA0, pA1, K_lds, qr, r32, hi);
    finishSM(pB0, pB1, alB, l_reg, pa0, pa1, pa2, pa3); SBAR();
    SLOAD(SE, (j + 2) * KVBLK); SBAR();
    pv_d0(o, vb0 + SHM_V, pa0, pa1, pa2, pa3); bias_mask(pA0, pA1, j + 1, cw, bt, qoff, r32, hi); partialSM(pA0, pA1, m_reg, alA);
    __syncthreads(); SWAIT(); SWRITE(1, SO);
    RESC(alA); __syncthreads();
  }
  SBAR(); qkt(pB0, pB1, K_lds + SHM_K, qr, r32, hi);
  finishSM(pA0, pA1, alA, l_reg, pa0, pa1, pa2, pa3); SBAR();
  pv_d0(o, vb0, pa0, pa1, pa2, pa3); bias_mask(pB0, pB1, NT - 1, cw, bt, qoff, r32, hi); partialSM(pB0, pB1, m_reg, alB);
  __syncthreads(); RESC(alB);
  finishSM(pB0, pB1, alB, l_reg, pa0, pa1, pa2, pa3); SBAR();
  pv_d0(o, vb0 + SHM_V, pa0, pa1, pa2, pa3);
  if (hi == 0) li_l[r32] = l_reg; asm volatile("s_waitcnt lgkmcnt(0)" ::: "memory");
  float rli[16];
#pragma unroll
  for (int r = 0; r < 16; ++r) rli[r] = __builtin_amdgcn_rcpf(li_l[crow(r, hi)]);
  float* Ow = Ob + (size_t)(wid * QBLK) * LDO;
#pragma unroll
  for (int r = 0; r < 16; ++r) { const int orow = crow(r, hi);
#pragma unroll
    for (int d0 = 0; d0 < 4; ++d0) Ow[(size_t)orow * LDO + d0 * 32 + r32] = o[d0][r] * rli[r]; }
#undef SLOAD
#undef SWRITE
#undef SWAIT
#undef RESC
}
#undef SBAR
#undef KSWZ
}

namespace ml {
using att::f32x16; using att::s16x4; using att::crow; using att::v_st; using att::v_rd_base; using att::v_rd_off; using att::tr_read;
constexpr int ML_Q = 0, ML_K = 16384, ML_V = 32768, ML_KW = 49152, ML_W = 49152, ML_H = 65536, ML_G = 98304;
constexpr float KSCALE = 0.08838834764831845f;
#define QSWZ(row, colB) ((row) * 256 + ((colB) ^ (((row) & 7) << 4)))
#define WSWZ(row, colB) ((row) * 128 + ((colB) ^ ((((row) >> 1) & 7) << 4)))
#define PKF(L, H) (bf16x8){L[0], L[1], L[2], L[3], H[0], H[1], H[2], H[3]}
__device__ __forceinline__ float wave_incl_scan_add(float v, int lane) {
#pragma unroll
  for (int o = 1; o < 64; o <<= 1) { const float t = __shfl_up(v, o); if (lane >= o) v += t; }
  return v;
}
__device__ __forceinline__ float wave_incl_scan_max(float v, int lane) {
#pragma unroll
  for (int o = 1; o < 64; o <<= 1) { const float t = __shfl_up(v, o); if (lane >= o) v = fmaxf(v, t); }
  return v;
}
__device__ __forceinline__ float wave_max(float v) {
#pragma unroll
  for (int o = 1; o < 64; o <<= 1) v = fmaxf(v, __shfl_xor(v, o));
  return v;
}
__device__ __forceinline__ void conv16(const Params& p, float (&y)[16], int b, int c, int s, int col0, int cch, int d0) {
  const bf16_t* PR = (const bf16_t*)(p.ws + WS_PROJ);
  const int tl = c * 64 + s;
#pragma unroll
  for (int q = 0; q < 4; ++q) { const f32x4 bb = *(const f32x4*)(p.conv_b + cch + d0 + 4 * q); y[4 * q] = bb.x; y[4 * q + 1] = bb.y; y[4 * q + 2] = bb.z; y[4 * q + 3] = bb.w; }
#pragma unroll
  for (int j = 0; j < 4; ++j) { const int tt = tl - 3 + j;
    if (tt >= 0) { const bf16_t* rp = PR + (size_t)(b * SEQ + tt) * NPJ + col0 + d0; const u32x4 r0 = *(const u32x4*)rp, r1 = *(const u32x4*)(rp + 8);
      const unsigned rw[8] = {r0.x, r0.y, r0.z, r0.w, r1.x, r1.y, r1.z, r1.w};
#pragma unroll
      for (int q = 0; q < 4; ++q) { const f32x4 w = *(const f32x4*)(p.conv_w + j * 1024 + cch + d0 + 4 * q);
        y[4 * q] += w.x * __uint_as_float(rw[2 * q] << 16); y[4 * q + 1] += w.y * __uint_as_float(rw[2 * q] & 0xffff0000u);
        y[4 * q + 2] += w.z * __uint_as_float(rw[2 * q + 1] << 16); y[4 * q + 3] += w.w * __uint_as_float(rw[2 * q + 1] & 0xffff0000u); } } }
#pragma unroll
  for (int i = 0; i < 16; ++i) y[i] = y[i] * __builtin_amdgcn_rcpf(1.f + __builtin_amdgcn_exp2f(-LOG2E * y[i]));
}
__device__ __forceinline__ u32x4 pack8(const float* y) { u32x4 w; w.x = pg8::cvt_pk_bf16(y[0], y[1]); w.y = pg8::cvt_pk_bf16(y[2], y[3]); w.z = pg8::cvt_pk_bf16(y[4], y[5]); w.w = pg8::cvt_pk_bf16(y[6], y[7]); return w; }

__device__ __forceinline__ void mlstm_a_item(const Params& p, int item, char* lds) {
  const int tid = threadIdx.x, wid = tid >> 6, lane = tid & 63, r32 = lane & 31, hi = lane >> 5;
  const int bh = item / NCH, c = item % NCH, b = bh >> 2, h = bh & 3;
  const bf16_t* PR = (const bf16_t*)(p.ws + WS_PROJ); const float* gates = (const float*)(p.ws + WS_GATES);
  bf16_t* MU = (bf16_t*)(p.ws + WS_MU); float* NU = (float*)(p.ws + MS_NU); float* msc = (float*)(p.ws + MS_MSC);
  float* wgt = (float*)(lds + ML_G);
  __syncthreads();
  if (wid == 0) { const size_t t = (size_t)b * SEQ + c * 64 + lane; const float li = gates[t * 8 + h]; const float lf = log_sigmoid(gates[t * 8 + 4 + h]);
    const float bc = wave_incl_scan_add(lf, lane); const float blast = __shfl(bc, 63); const float g = blast - bc + li; const float gmax = wave_max(g);
    wgt[lane] = __expf(g - gmax); if (lane == 0) { msc[item] = blast; msc[2048 + item] = gmax; } }
  __syncthreads();
  { const int s = tid >> 3, d0 = (tid & 7) * 16; float y[16];
    conv16(p, y, b, c, s, PK + h * 128, 512 + h * 128, d0);
    const float w = wgt[s] * KSCALE;
#pragma unroll
    for (int i = 0; i < 16; ++i) y[i] *= w;
    *(u32x4*)(lds + ML_KW + v_st(s, d0)) = pack8(y); *(u32x4*)(lds + ML_KW + v_st(s, d0 + 8)) = pack8(y + 8);
    const bf16_t* vp = PR + (size_t)(b * SEQ + c * 64 + s) * NPJ + PV + h * 128 + d0;
    *(u32x4*)(lds + ML_V + v_st(s, d0)) = *(const u32x4*)vp; *(u32x4*)(lds + ML_V + v_st(s, d0 + 8)) = *(const u32x4*)(vp + 8); }
  __syncthreads();
  const int ei = wid >> 1, dj0 = 2 * (wid & 1);
  const int vbV = (int)(uintptr_t)(lds + ML_V) + v_rd_base(lane) + ei * 512, vbK = (int)(uintptr_t)(lds + ML_KW) + v_rd_base(lane) + dj0 * 512;
  f32x16 acc0 = {}, acc1 = {}, accn0 = {}, accn1 = {};
  const bf16x8 ones = {0x3F80, 0x3F80, 0x3F80, 0x3F80, 0x3F80, 0x3F80, 0x3F80, 0x3F80};
#define MLA_STEP(KS) do { const s16x4 al = tr_read<v_rd_off(0, KS, 0)>(vbV), ah = tr_read<v_rd_off(0, KS, 1)>(vbV); \
    const s16x4 b0l = tr_read<v_rd_off(0, KS, 0)>(vbK), b0h = tr_read<v_rd_off(0, KS, 1)>(vbK), b1l = tr_read<v_rd_off(1, KS, 0)>(vbK), b1h = tr_read<v_rd_off(1, KS, 1)>(vbK); \
    asm volatile("s_waitcnt lgkmcnt(0)" ::: "memory"); __builtin_amdgcn_sched_barrier(0); \
    acc0 = __builtin_amdgcn_mfma_f32_32x32x16_bf16(PKF(al, ah), PKF(b0l, b0h), acc0, 0, 0, 0); acc1 = __builtin_amdgcn_mfma_f32_32x32x16_bf16(PKF(al, ah), PKF(b1l, b1h), acc1, 0, 0, 0); \
    if (ei == 0) { accn0 = __builtin_amdgcn_mfma_f32_32x32x16_bf16(ones, PKF(b0l, b0h), accn0, 0, 0, 0); accn1 = __builtin_amdgcn_mfma_f32_32x32x16_bf16(ones, PKF(b1l, b1h), accn1, 0, 0, 0); } } while (0)
  MLA_STEP(0); MLA_STEP(1); MLA_STEP(2); MLA_STEP(3);
#undef MLA_STEP
  bf16_t* uo = MU + (size_t)item * 16384;
#pragma unroll
  for (int r = 0; r < 16; ++r) { const int e = 32 * ei + crow(r, hi);
    uo[e * 128 + 32 * dj0 + r32] = (bf16_t)f2bf(acc0[r]); uo[e * 128 + 32 * (dj0 + 1) + r32] = (bf16_t)f2bf(acc1[r]); }
  if (ei == 0 && hi == 0) { NU[(size_t)item * 128 + 32 * dj0 + r32] = accn0[0]; NU[(size_t)item * 128 + 32 * (dj0 + 1) + r32] = accn1[0]; }
}

__device__ __forceinline__ void mlstm_scan_item(const Params& p, int item, char* lds) {
  float* dec = (float*)(lds + ML_G); float* ac = dec + NCH;
  const unsigned* MU = (const unsigned*)(p.ws + WS_MU); unsigned* MC = (unsigned*)(p.ws + WS_MC);
  const float* NU = (const float*)(p.ws + MS_NU); float* NC = (float*)(p.ws + MS_NC); float* msc = (float*)(p.ws + MS_MSC);
  const int bh = item >> 4, eb = item & 15; const int lane = threadIdx.x & 63;
  __syncthreads();
  if (threadIdx.x < 64) { float Bc = 0.f, pm = 0.f, mcar = 0.f;
    for (int half = 0; half < 2; ++half) { const int c = half * 64 + lane;
      const float bl = msc[bh * NCH + c], gm = msc[2048 + bh * NCH + c];
      const float Bi = Bc + wave_incl_scan_add(bl, lane);
      const float px = fmaxf(pm, wave_incl_scan_max(gm - Bi, lane));
      const float m1 = Bi + px; float m0 = __shfl_up(m1, 1); if (lane == 0) m0 = mcar;
      dec[c] = __expf(bl + m0 - m1); ac[c] = __expf(gm - m1);
      if (eb == 0) msc[4096 + bh * NCH + c] = m0;
      Bc = __shfl(Bi, 63); pm = __shfl(px, 63); mcar = __shfl(m1, 63); } }
  __syncthreads();
  const int idx = eb * 512 + threadIdx.x;
  float C0 = 0.f, C1 = 0.f;
#pragma unroll 8
  for (int c = 0; c < NCH; ++c) { const size_t o = ((size_t)(bh * NCH + c)) * 8192 + idx; const unsigned u = MU[o];
    MC[o] = pk2(C0, C1); C0 = dec[c] * C0 + ac[c] * __uint_as_float(u << 16); C1 = dec[c] * C1 + ac[c] * __uint_as_float(u & 0xffff0000u); }
  if (eb == 0 && threadIdx.x < 128) { float n = 0.f;
    for (int c = 0; c < NCH; ++c) { const size_t o = ((size_t)(bh * NCH + c)) * 128 + threadIdx.x; NC[o] = n; n = dec[c] * n + ac[c] * NU[o]; } }
}

__device__ __forceinline__ void mlstm_c_item(const Params& p, int item, char* lds) {
  const int tid = threadIdx.x, wid = tid >> 6, lane = tid & 63, r32 = lane & 31, hi = lane >> 5;
  const int bh = item / NCH, c = item % NCH, b = bh >> 2, h = bh & 3;
  const bf16_t* PR = (const bf16_t*)(p.ws + WS_PROJ); const float* gates = (const float*)(p.ws + WS_GATES);
  const bf16_t* MC = (const bf16_t*)(p.ws + WS_MC); const float* NC = (const float*)(p.ws + MS_NC); const float* msc = (const float*)(p.ws + MS_MSC); bf16_t* MIX = (bf16_t*)(p.ws + WS_MIX);
  float* G = (float*)(lds + ML_G); float* bm = G; float* as_ = G + 64; float* mxv = G + 128; float* scv = G + 192; float* qn = G + 256;
  float* H = (float*)(lds + ML_H);
  __syncthreads();
  if (wid == 0) { const size_t t = (size_t)b * SEQ + c * 64 + lane; const float li = gates[t * 8 + h]; const float lf = log_sigmoid(gates[t * 8 + 4 + h]);
    const float bc = wave_incl_scan_add(lf, lane); const float a = li - bc; const float pm = wave_incl_scan_max(a, lane);
    const float mc = msc[4096 + item]; const float mx = bc + fmaxf(mc, pm);
    bm[lane] = bc - mx; as_[lane] = a; mxv[lane] = mx; scv[lane] = __expf(bc + mc - mx); }
  { const int s = tid >> 3, d0 = (tid & 7) * 16; float y[16];
    conv16(p, y, b, c, s, PQ + h * 128, h * 128, d0);
    float part = 0.f;
#pragma unroll
    for (int q = 0; q < 4; ++q) { const f32x4 nv = *(const f32x4*)(NC + (size_t)item * 128 + d0 + 4 * q); part += y[4 * q] * nv.x + y[4 * q + 1] * nv.y + y[4 * q + 2] * nv.z + y[4 * q + 3] * nv.w; }
    part += __shfl_xor(part, 1); part += __shfl_xor(part, 2); part += __shfl_xor(part, 4);
    if ((tid & 7) == 0) qn[s] = part;
    *(u32x4*)(lds + ML_Q + QSWZ(s, d0 * 2)) = pack8(y); *(u32x4*)(lds + ML_Q + QSWZ(s, d0 * 2 + 16)) = pack8(y + 8);
    conv16(p, y, b, c, s, PK + h * 128, 512 + h * 128, d0);
#pragma unroll
    for (int i = 0; i < 16; ++i) y[i] *= KSCALE;
    *(u32x4*)(lds + ML_K + QSWZ(s, d0 * 2)) = pack8(y); *(u32x4*)(lds + ML_K + QSWZ(s, d0 * 2 + 16)) = pack8(y + 8);
    const bf16_t* vp = PR + (size_t)(b * SEQ + c * 64 + s) * NPJ + PV + h * 128 + d0;
    *(u32x4*)(lds + ML_V + v_st(s, d0)) = *(const u32x4*)vp; *(u32x4*)(lds + ML_V + v_st(s, d0 + 8)) = *(const u32x4*)(vp + 8); }
  __syncthreads();
  if (wid < 4) {
    const int ti = wid >> 1, si = wid & 1; f32x16 acc = {};
    if (si <= ti) {
#pragma unroll
      for (int ks = 0; ks < 8; ++ks) { const int cb = (ks * 16 + hi * 8) * 2;
        const bf16x8 a = *(const bf16x8*)(lds + ML_Q + QSWZ(32 * ti + r32, cb)), bb = *(const bf16x8*)(lds + ML_K + QSWZ(32 * si + r32, cb));
        acc = __builtin_amdgcn_mfma_f32_32x32x16_bf16(a, bb, acc, 0, 0, 0); }
    }
    const int s = 32 * si + r32; const float av = as_[s];
#pragma unroll
    for (int r = 0; r < 16; ++r) { const int t = 32 * ti + crow(r, hi); const float w = (s <= t) ? __expf(bm[t] + av) * acc[r] : 0.f;
      *(bf16_t*)(lds + ML_W + WSWZ(t, s * 2)) = (bf16_t)f2bf(w); }
  }
  __syncthreads();
  { const int ti = wid >> 2, ej = wid & 3; f32x16 acc = {}, accd = {};
    const bf16_t* ct = MC + (size_t)item * 16384 + (size_t)(32 * ej + r32) * 128 + hi * 8;
#pragma unroll
    for (int ks = 0; ks < 8; ++ks) { const bf16x8 a = *(const bf16x8*)(lds + ML_Q + QSWZ(32 * ti + r32, (ks * 16 + hi * 8) * 2)); const bf16x8 bb = *(const bf16x8*)(ct + ks * 16);
      acc = __builtin_amdgcn_mfma_f32_32x32x16_bf16(a, bb, acc, 0, 0, 0); }
#pragma unroll
    for (int r = 0; r < 16; ++r) acc[r] *= scv[32 * ti + crow(r, hi)];
    const int vbV = (int)(uintptr_t)(lds + ML_V) + v_rd_base(lane) + ej * 512;
    const bf16x8 ones = {0x3F80, 0x3F80, 0x3F80, 0x3F80, 0x3F80, 0x3F80, 0x3F80, 0x3F80};
#define MLC_STEP(KS) do { const s16x4 bl = tr_read<v_rd_off(0, KS, 0)>(vbV), bh_ = tr_read<v_rd_off(0, KS, 1)>(vbV); \
      const bf16x8 a = *(const bf16x8*)(lds + ML_W + WSWZ(32 * ti + r32, (KS * 16 + hi * 8) * 2)); \
      asm volatile("s_waitcnt lgkmcnt(0)" ::: "memory"); __builtin_amdgcn_sched_barrier(0); \
      acc = __builtin_amdgcn_mfma_f32_32x32x16_bf16(a, PKF(bl, bh_), acc, 0, 0, 0); accd = __builtin_amdgcn_mfma_f32_32x32x16_bf16(a, ones, accd, 0, 0, 0); } while (0)
    MLC_STEP(0); MLC_STEP(1); MLC_STEP(2); MLC_STEP(3);
#undef MLC_STEP
#pragma unroll
    for (int r = 0; r < 16; ++r) { const int t = 32 * ti + crow(r, hi); const float den = accd[r] + scv[t] * qn[t]; const float dn = fmaxf(fabsf(den), __expf(-mxv[t]));
      H[t * 128 + 32 * ej + r32] = acc[r] / dn; }
  }
  __syncthreads();
  { const int t = tid >> 3, e0 = (tid & 7) * 16; float y[16]; float ss = 0.f;
#pragma unroll
    for (int q = 0; q < 4; ++q) { const f32x4 v = *(const f32x4*)(H + t * 128 + e0 + 4 * q); y[4 * q] = v.x; y[4 * q + 1] = v.y; y[4 * q + 2] = v.z; y[4 * q + 3] = v.w; ss += v.x * v.x + v.y * v.y + v.z * v.z + v.w * v.w; }
    ss += __shfl_xor(ss, 1); ss += __shfl_xor(ss, 2); ss += __shfl_xor(ss, 4);
    const float rstd = rsqrtf(ss * (1.f / 128.f) + EPS);
    const size_t row = (size_t)b * SEQ + c * 64 + t; const int ch = h * 128 + e0;
    const bf16_t* mo = PR + row * NPJ + PO + ch; const u32x4 m0 = *(const u32x4*)mo, m1 = *(const u32x4*)(mo + 8);
    const unsigned mw[8] = {m0.x, m0.y, m0.z, m0.w, m1.x, m1.y, m1.z, m1.w};
#pragma unroll
    for (int i = 0; i < 16; ++i) { const float mov = (i & 1) ? __uint_as_float(mw[i >> 1] & 0xffff0000u) : __uint_as_float(mw[i >> 1] << 16);
      y[i] = y[i] * rstd * p.mlstm_norm_g[ch + i] * __builtin_amdgcn_rcpf(1.f + __builtin_amdgcn_exp2f(-LOG2E * mov)); }
    bf16_t* op = MIX + row * DM + ch; *(u32x4*)op = pack8(y); *(u32x4*)(op + 8) = pack8(y + 8); }
}
#undef QSWZ
#undef WSWZ
#undef PKF
}

__device__ __forceinline__ void phase_combine(const Params& p, int vcu, int G, int wave, int lane) {
    const float lam = __expf(wave_sum(p.lam_q1[lane] * p.lam_k1[lane])) - __expf(wave_sum(p.lam_q2[lane] * p.lam_k2[lane])) + 0.2f;
    const float* AO = (const float*)(p.ws + WS_AO); bf16_t* MIX = (bf16_t*)(p.ws + WS_MIX);
    const float g0 = p.diff_norm_g[2 * lane] * 0.8f, g1 = p.diff_norm_g[2 * lane + 1] * 0.8f;
    for (int it = vcu * NWAVES + wave; it < T * 4; it += G * NWAVES) {
        const float* o1 = AO + (size_t)it * 256; const float* o2 = o1 + 128;
        const float a0 = o1[2 * lane] - lam * o2[2 * lane], a1 = o1[2 * lane + 1] - lam * o2[2 * lane + 1];
        const float rstd = rsqrtf(wave_sum(a0 * a0 + a1 * a1) * (1.f / 128.f) + EPS);
        const int t = it >> 2, h = it & 3;
        *(unsigned*)(MIX + (size_t)t * DM + 512 + h * 128 + 2 * lane) = pk2(a0 * rstd * g0, a1 * rstd * g1);
    }
}
__device__ __forceinline__ void phase_route(const Params& p, unsigned char* lds, int vcu, int G, int wave, int lane) {
    float* urow = (float*)lds + wave * DM;
    int* cnt = (int*)(lds + 32768); int* base = cnt + 32; int* cnt2 = cnt + 64; int* pel = cnt + 96;
    bf16_t* U2 = (bf16_t*)(p.ws + WS_U2); unsigned* ctl = (unsigned*)(p.ws + WS_CTL);
    int* list = (int*)(p.ws + MS_LIST); int* pe = (int*)(p.ws + MS_PE); int* pp = (int*)(p.ws + MS_PP); float* pg = (float*)(p.ws + MS_PG);
    const int RPW = T / G;
    __syncthreads();
    if (threadIdx.x < 96) cnt[threadIdx.x] = 0;
    __syncthreads();
    for (int k = wave; k < RPW; k += NWAVES) {
        const int row = vcu * RPW + k;
        const f32x4* xr = (const f32x4*)(p.out + (size_t)row * DM) + lane;
        f32x4 v[4]; float s = 0.f;
#pragma unroll
        for (int j = 0; j < 4; ++j) { v[j] = xr[64 * j]; s += (v[j].x * v[j].x + v[j].y * v[j].y) + (v[j].z * v[j].z + v[j].w * v[j].w); }
        const float rstd = rsqrtf(wave_sum(s) * (1.f / DM) + EPS);
        unsigned long long* o8 = (unsigned long long*)(U2 + (size_t)row * DM) + lane;
#pragma unroll
        for (int j = 0; j < 4; ++j) { const f32x4 g = ((const f32x4*)p.norm2_g)[64 * j + lane]; const f32x4 u = v[j] * rstd * g;
            o8[64 * j] = (unsigned long long)pk2(u.x, u.y) | ((unsigned long long)pk2(u.z, u.w) << 32);
            *(f32x4*)(&urow[256 * j + 4 * lane]) = u; }
        LDS_WAIT();
        const int e = lane & 31, half = lane >> 5; float acc = 0.f;
#pragma unroll 8
        for (int kk = half * 512; kk < half * 512 + 512; ++kk) acc += urow[kk] * p.router_w[(size_t)kk * NE + e];
        acc += __shfl_xor(acc, 32);
        float val = acc + p.router_b[e];
        float tv[4]; int ti[4];
#pragma unroll
        for (int r = 0; r < 4; ++r) { float bv = val; int bi = e;
#pragma unroll
            for (int o = 1; o < 32; o <<= 1) { const float ov = __shfl_xor(bv, o); const int oi = __shfl_xor(bi, o); if (ov > bv || (ov == bv && oi < bi)) { bv = ov; bi = oi; } }
            tv[r] = bv; ti[r] = bi; if (e == bi) val = -INFINITY; }
        const float e1 = __expf(tv[1] - tv[0]), e2 = __expf(tv[2] - tv[0]), e3 = __expf(tv[3] - tv[0]); const float inv = 1.f / (1.f + e1 + e2 + e3);
        if (lane < 4) { const int ee = lane == 0 ? ti[0] : lane == 1 ? ti[1] : lane == 2 ? ti[2] : ti[3]; const float gg = (lane == 0 ? 1.f : lane == 1 ? e1 : lane == 2 ? e2 : e3) * inv;
            atomicAdd(&cnt[ee], 1); pel[k * 4 + lane] = ee; pe[row * 4 + lane] = ee; pg[row * 4 + lane] = gg; }
        LDS_WAIT();
    }
    __syncthreads();
    if (threadIdx.x < 32) base[threadIdx.x] = (int)atomicAdd(&ctl[CW_CNT + threadIdx.x], (unsigned)cnt[threadIdx.x]);
    __syncthreads();
    for (int i = threadIdx.x; i < RPW * 4; i += NTHR) { const int row = vcu * RPW + (i >> 2); const int ee = pel[i]; const int pos = base[ee] + atomicAdd(&cnt2[ee], 1);
        pp[row * 4 + (i & 3)] = pos; list[(size_t)ee * T + pos] = row; }
    __syncthreads();
}
__device__ __forceinline__ void phase_final(const Params& p, unsigned char* lds, int vcu, int G, int wave, int lane) {
    int* ps = (int*)lds;
    const unsigned* ctl = (const unsigned*)(p.ws + WS_CTL);
    __syncthreads();
    if (threadIdx.x == 0) { int a = 0; for (int e = 0; e < NE; ++e) { const int c = (int)__hip_atomic_load(ctl + CW_CNT + e, RLX_AGENT); ps[e] = a; a += (c + 255) & ~255; } }
    __syncthreads();
    const bf16_t* Y = (const bf16_t*)(p.ws + WS_Y); const int* pe = (const int*)(p.ws + MS_PE); const int* pp = (const int*)(p.ws + MS_PP); const float* pg = (const float*)(p.ws + MS_PG);
    for (int row = vcu * NWAVES + wave; row < T; row += G * NWAVES) {
        f32x4* xr = (f32x4*)(p.out + (size_t)row * DM) + lane;
        f32x4 v[4];
#pragma unroll
        for (int j = 0; j < 4; ++j) v[j] = xr[64 * j];
#pragma unroll
        for (int r = 0; r < 4; ++r) { const int e = pe[row * 4 + r]; const size_t yr = (size_t)(ps[e] + pp[row * 4 + r]); const float g = pg[row * 4 + r];
            const u32x2* yp = (const u32x2*)(Y + yr * DM) + lane;
#pragma unroll
            for (int j = 0; j < 4; ++j) { const u32x2 w = yp[64 * j];
                v[j].x += g * __uint_as_float(w.x << 16); v[j].y += g * __uint_as_float(w.x & 0xffff0000u); v[j].z += g * __uint_as_float(w.y << 16); v[j].w += g * __uint_as_float(w.y & 0xffff0000u); } }
        float s = 0.f;
#pragma unroll
        for (int j = 0; j < 4; ++j) s += (v[j].x * v[j].x + v[j].y * v[j].y) + (v[j].z * v[j].z + v[j].w * v[j].w);
        const float rstd = rsqrtf(wave_sum(s) * (1.f / DM) + EPS);
#pragma unroll
        for (int j = 0; j < 4; ++j) { const f32x4 g = ((const f32x4*)p.final_g)[64 * j + lane]; xr[64 * j] = v[j] * rstd * g; }
    }
}

enum { PH_PRE = 0, PH_PROJ = 1, PH_MLA = 2, PH_ATTN = 3, PH_MLC = 4, PH_OUT = 5, PH_ROUTE = 6, PH_MOE1 = 7, PH_MOE2 = 8, PH_FINAL = 9, PH_N = 10 };
struct Args { Params p; int ph_lo, ph_hi, li, pad; };

__device__ __forceinline__ void phase_pre(const Params& p, unsigned char* lds, int vcu, int G, int wave, int lane) {
    { float* scr = (float*)(lds + wave * 8448);
      for (int it = vcu * NWAVES + wave; it < CV_N; it += G * NWAVES) convert_item(p, it, scr, lane); }
    __syncthreads();
    float* gw = (float*)lds;
    for (int i = threadIdx.x; i < DM * 8; i += NTHR) gw[i] = p.w_in[(size_t)(i >> 3) * DIN + 2048 + (i & 7)];
    __syncthreads();
    bf16_t* XN = (bf16_t*)(p.ws + WS_XN); float* gates = (float*)(p.ws + WS_GATES);
    for (int row = vcu * NWAVES + wave; row < T; row += G * NWAVES) {
        const f32x4* xr = (const f32x4*)(p.x + (size_t)row * DM) + lane;
        f32x4 v[4]; float s = 0.f;
#pragma unroll
        for (int j = 0; j < 4; ++j) { v[j] = xr[64 * j]; s += (v[j].x * v[j].x + v[j].y * v[j].y) + (v[j].z * v[j].z + v[j].w * v[j].w); }
        const float rstd = rsqrtf(wave_sum(s) * (1.f / DM) + EPS);
        float ga[8];
#pragma unroll
        for (int q = 0; q < 8; ++q) ga[q] = 0.f;
        unsigned long long* o8 = (unsigned long long*)(XN + (size_t)row * DM) + lane;
#pragma unroll
        for (int j = 0; j < 4; ++j) { const f32x4 g = ((const f32x4*)p.norm1_g)[64 * j + lane]; f32x4 u = v[j] * rstd * g;
            o8[64 * j] = (unsigned long long)pk2(u.x, u.y) | ((unsigned long long)pk2(u.z, u.w) << 32);
            const int k0 = 256 * j + 4 * lane;
#pragma unroll
            for (int c = 0; c < 4; ++c) { const float uu = u[c]; const float* w = gw + (k0 + c) * 8;
#pragma unroll
                for (int q = 0; q < 8; ++q) ga[q] += uu * w[q]; } }
#pragma unroll
        for (int q = 0; q < 8; ++q) ga[q] = wave_sum(ga[q]);
        if (lane == 0) {
#pragma unroll
            for (int q = 0; q < 8; ++q) gates[(size_t)row * 8 + q] = ga[q] + p.gate_b[q]; }
    }
    __syncthreads();
}

__global__ void __launch_bounds__(NTHR, 2) mega(Args args) {
    extern __shared__ __attribute__((aligned(16))) unsigned char lds_raw[];
    const Params& p = args.p;
    LAS unsigned char* lds = (LAS unsigned char*)lds_raw;
    const int tid = threadIdx.x, lane = tid & 63, wave = __builtin_amdgcn_readfirstlane(tid >> 6);
    const int G = gridDim.x, bx = blockIdx.x, vcu = (G % 8 == 0) ? (bx % 8) * (G / 8) + bx / 8 : bx;
    unsigned* ctl = (unsigned*)(p.ws + WS_CTL);
    for (int u = tid; u < (TAB_OFF - LDSCTL_OFF) / 4; u += NTHR) ((LAS unsigned*)(lds + LDSCTL_OFF))[u] = 0u;
    __syncthreads();
    volatile LAS unsigned* MISC = (volatile LAS unsigned*)(lds + MISC_OFF);
    XcdBarrier bar = xcd_barrier_post(ctl + CW_BAR + args.li * XCD_BAR_WORDS, MISC + 8);
    const int lo = args.ph_lo, hi = args.ph_hi;
#define IN(k) (lo <= (k) && (k) < hi)
#define SEAM(k) do { if (IN(k) && (k) + 1 < hi) xcd_barrier(bar); } while (0)

    if (IN(PH_PRE)) { phase_pre(p, lds_raw, vcu, G, wave, lane); }
    SEAM(PH_PRE);
    if (IN(PH_PROJ)) {
        pg8::StaticOrder S; S.init(p.ws + WS_XN, p.ws + WS_WIN, T, NPJ, DM, G, bx);
        pg8::EpiProj E{(bf16_t*)(p.ws + WS_PROJ)};
        pg8::gemm_phase<pg8::EpiProj, pg8::StaticOrder, false>(lds, DM, S, E, nullptr);
    }
    SEAM(PH_PROJ);
    if (IN(PH_MLA)) { for (int it = vcu; it < 16 * NCH; it += G) ml::mlstm_a_item(p, it, (char*)lds_raw); __syncthreads(); }
    SEAM(PH_MLA);
    if (IN(PH_ATTN)) {
        for (int it = vcu; it < 256; it += G) ml::mlstm_scan_item(p, it, (char*)lds_raw);
        for (int U = vcu; U < 1024; U += G) { const int i = U >> 8, v = U & 255, bhm = v >> 3, s = v & 7;
            const int qb = (i == 0) ? s : (i == 1) ? 15 - s : (i == 2) ? 16 + s : 31 - s;
            att::attn_unit(p, bhm >> 3, (bhm >> 1) & 3, bhm & 1, qb, (char*)lds_raw); }
        __syncthreads();
    }
    SEAM(PH_ATTN);
    if (IN(PH_MLC)) { for (int it = vcu; it < 16 * NCH; it += G) ml::mlstm_c_item(p, it, (char*)lds_raw); phase_combine(p, vcu, G, wave, lane); __syncthreads(); }
    SEAM(PH_MLC);
    if (IN(PH_OUT)) {
        pg8::StaticOrder S; S.init(p.ws + WS_MIX, p.ws + WS_WOUT, T, DM, DM, G, bx);
        pg8::EpiOut E{p.x, p.out};
        pg8::gemm_phase<pg8::EpiOut, pg8::StaticOrder, false>(lds, DM, S, E, nullptr);
    }
    SEAM(PH_OUT);
    if (IN(PH_ROUTE)) phase_route(p, lds_raw, vcu, G, wave, lane);
    SEAM(PH_ROUTE);
    if (IN(PH_MOE1)) {
        const int n = moe_build_units<8>(lds, ctl, G, bx);
        const LAS int* UL = (const LAS int*)(lds + TAB_UL); const LAS int* PS = (const LAS int*)(lds + TAB_PS); const LAS int* CN = (const LAS int*)(lds + TAB_CN);
        LAS unsigned* gtab = (LAS unsigned*)(lds + GTAB_OFF);
        const int* list = (const int*)(p.ws + MS_LIST);
        for (int i = tid; i < n * 256; i += NTHR) { const int w = UL[i >> 8], e = w & 255, rt = (w >> 8) & 255; const int idx = min(rt * 256 + (i & 255), CN[e] - 1);
            gtab[i] = (unsigned)list[(size_t)e * T + idx] * (unsigned)(DM * 2); }
        __syncthreads();
        MoeOrder<8, true> S{UL, PS, n, (const char*)(p.ws + WS_U2), (const char*)(p.ws + WS_WGU)};
        pg8::EpiSwiglu E{(bf16_t*)(p.ws + WS_ACT), p.b_gu};
        pg8::gemm_phase<pg8::EpiSwiglu, MoeOrder<8, true>, true>(lds, DM, S, E, gtab);
    }
    SEAM(PH_MOE1);
    if (IN(PH_MOE2)) {
        const int n = moe_build_units<4>(lds, ctl, G, bx);
        const LAS int* UL = (const LAS int*)(lds + TAB_UL); const LAS int* PS = (const LAS int*)(lds + TAB_PS);
        MoeOrder<4, false> S{UL, PS, n, (const char*)(p.ws + WS_ACT), (const char*)(p.ws + WS_WDN)};
        pg8::EpiDown E{(bf16_t*)(p.ws + WS_Y), p.b_down};
        pg8::gemm_phase<pg8::EpiDown, MoeOrder<4, false>, false>(lds, FF, S, E, nullptr);
    }
    SEAM(PH_MOE2);
    if (IN(PH_FINAL)) phase_final(p, lds_raw, vcu, G, wave, lane);
#undef IN
#undef SEAM
}

static void launch_mega(const Params& p, int lo, int hi, int li, hipStream_t stream) {
    Args a{}; a.p = p; a.ph_lo = lo; a.ph_hi = hi; a.li = li; a.pad = 0;
    hipLaunchKernelGGL(mega, dim3(256), dim3(NTHR), LDS_BYTES, stream, a);
}
extern "C" void kernel_launch(void* const* d_in, const int* in_sizes, int n_in, void* d_out, int out_size, void* d_ws, size_t ws_size, hipStream_t stream) {
    if (n_in != 22 || out_size != T * DM || ws_size < WS_END) { fprintf(stderr, "kernel_launch: unexpected shapes (n_in %d out %d ws %zu)\n", n_in, out_size, ws_size); return; }
    Params p{};
    const float** f = (const float**)&p;
    for (int i = 0; i < 22; ++i) f[i] = (const float*)d_in[i];
    p.out = (float*)d_out; p.ws = (unsigned char*)d_ws;
    static bool attr = false;
    if (!attr) { attr = true;
        (void)hipFuncSetAttribute((const void*)k_mlstm_a, hipFuncAttributeMaxDynamicSharedMemorySize, 80 * 1024);
        (void)hipFuncSetAttribute((const void*)k_mlstm_c, hipFuncAttributeMaxDynamicSharedMemorySize, 128 * 1024);
        (void)hipFuncSetAttribute((const void*)mega, hipFuncAttributeMaxDynamicSharedMemorySize, LDS_BYTES); }
    (void)hipMemsetAsync((char*)d_ws + WS_CTL, 0, 1 * MiB, stream);
    launch_mega(p, PH_PRE, PH_N, 0, stream);
}
```

```cpp
#define DUP_PHASE -1
#define TSEL -1
#define TMULT 1
#define PWAVE 0
#define PBLK 0
#include <hip/hip_runtime.h>
#include <cstdio>
#include <cstdint>

typedef unsigned short bf16_t;
typedef short bf16x8 __attribute__((ext_vector_type(8)));
typedef float f32x4 __attribute__((ext_vector_type(4)));
typedef unsigned u32x4 __attribute__((ext_vector_type(4)));
typedef unsigned u32x2 __attribute__((ext_vector_type(2)));

constexpr int NB = 4, SEQ = 8192, T = NB * SEQ, DM = 1024, DIN = 3592, NPJ = 3584;
constexpr int NCH = SEQ / 64;
constexpr int NE = 32, FF = 1024;
constexpr int PQ = 0, PK = 512, PV = 1024, PO = 1536, PAQ = 2048, PAK = 2560, PAV = 3072;
constexpr int PROWS = T * 4 + NE * 256;
constexpr float EPS = 1e-5f;
constexpr float LOG2E = 1.4426950408889634f;
constexpr float QSCALE = 0.125f * LOG2E;

constexpr size_t MiB = 1u << 20;
constexpr size_t WS_CTL = 0;
constexpr size_t WS_WIN = 2 * MiB;
constexpr size_t WS_WOUT = 10 * MiB;
constexpr size_t WS_GATES = 12 * MiB;
constexpr size_t WS_MISC = 14 * MiB;
constexpr size_t WS_WGU = 24 * MiB;
constexpr size_t WS_WDN = 152 * MiB;
constexpr size_t WS_XN = 216 * MiB;
constexpr size_t WS_PROJ = 280 * MiB;
constexpr size_t WS_MU = 504 * MiB;
constexpr size_t WS_MC = 568 * MiB;
constexpr size_t WS_AO = 632 * MiB;
constexpr size_t WS_MIX = 760 * MiB;
constexpr size_t WS_Y = 552 * MiB;
constexpr size_t WS_ACT = WS_PROJ;
constexpr size_t WS_U2 = WS_XN;
constexpr size_t WS_END = 824 * MiB;
constexpr size_t MS_LIST = WS_MISC;
constexpr size_t MS_PAIR = WS_MISC + 4 * MiB;
constexpr size_t MS_PE = MS_PAIR;
constexpr size_t MS_PP = MS_PAIR + (size_t)T * 4 * 4;
constexpr size_t MS_PG = MS_PP + (size_t)T * 4 * 4;
constexpr size_t MS_MSC = WS_MISC + 6 * MiB;
constexpr size_t MS_NU = WS_MISC + 7 * MiB;
constexpr size_t MS_NC = WS_MISC + 8 * MiB;
constexpr int CW_CNT = 64;

struct Params {
    const float *x, *rel_bias, *norm1_g, *w_in, *conv_w, *conv_b, *gate_b, *mlstm_norm_g, *lam_q1, *lam_k1, *lam_q2, *lam_k2,
        *diff_norm_g, *w_out, *norm2_g, *router_w, *router_b, *w_gu, *b_gu, *w_down, *b_down, *final_g;
    float* out; unsigned char* ws;
};

__device__ __forceinline__ float bf2f(bf16_t v) { return __uint_as_float((unsigned)v << 16); }
__device__ __forceinline__ unsigned f2bf(float f) { unsigned u = __float_as_uint(f); return (u + 0x7fffu + ((u >> 16) & 1u)) >> 16; }
__device__ __forceinline__ unsigned pk2(float lo, float hi) { return f2bf(lo) | (f2bf(hi) << 16); }
__device__ __forceinline__ float wave_sum(float v) {
#pragma unroll
    for (int o = 1; o < 64; o <<= 1) v += __shfl_xor(v, o);
    return v;
}
__device__ __forceinline__ float sigmoidf_(float x) { return 1.f / (1.f + __expf(-x)); }
__device__ __forceinline__ float log_sigmoid(float x) { return fminf(x, 0.f) - log1pf(__expf(-fabsf(x))); }
#define LDS_WAIT() asm volatile("s_waitcnt lgkmcnt(0)" ::: "memory")

__device__ __forceinline__ void tr_item(const float* W, int ldw, int n0, int k0, bf16_t* WT, int dstrow0, int Kd, float* scr, int lane) {
#pragma unroll 8
    for (int i = 0; i < 32; ++i) { const int kk = 2 * i + (lane >> 5); scr[kk * 33 + (lane & 31)] = W[(size_t)(k0 + kk) * ldw + n0 + (lane & 31)]; }
    LDS_WAIT();
    const int c = lane & 7;
#pragma unroll
    for (int j = 0; j < 4; ++j) { const int n = (lane >> 3) + 8 * j; const float* s = scr + (8 * c) * 33 + n;
        u32x4 o; o.x = pk2(s[0 * 33], s[1 * 33]); o.y = pk2(s[2 * 33], s[3 * 33]); o.z = pk2(s[4 * 33], s[5 * 33]); o.w = pk2(s[6 * 33], s[7 * 33]);
        *(u32x4*)(WT + (size_t)(dstrow0 + n) * Kd + k0 + 8 * c) = o; }
    LDS_WAIT();
}
constexpr int CV_I0 = 1024, CV_I1 = 768, CV_I2 = 512, CV_I3 = 32768, CV_I4 = 16384, CV_N = CV_I0 + CV_I1 + CV_I2 + CV_I3 + CV_I4;
__device__ __forceinline__ void convert_item(const Params& p, int it, float* scr, int lane) {
    bf16_t* win = (bf16_t*)(p.ws + WS_WIN); bf16_t* wout = (bf16_t*)(p.ws + WS_WOUT); bf16_t* wgu = (bf16_t*)(p.ws + WS_WGU); bf16_t* wdn = (bf16_t*)(p.ws + WS_WDN);
    int r = it;
    if (r < CV_I0) { const int kb = r / 64, nb = r % 64; tr_item(p.w_in, DIN, 32 * nb, 64 * kb, win, 32 * nb, DM, scr, lane); return; } r -= CV_I0;
    if (r < CV_I1) { const int kb = r / 48, nb = r % 48; tr_item(p.w_in, DIN, 2056 + 32 * nb, 64 * kb, win, 2048 + 32 * nb, DM, scr, lane); return; } r -= CV_I1;
    if (r < CV_I2) { const int kb = r / 32, nb = r % 32; tr_item(p.w_out, DM, 32 * nb, 64 * kb, wout, 32 * nb, DM, scr, lane); return; } r -= CV_I2;
    if (r < CV_I3) { const int e = r / 1024, q = r % 1024, kb = q / 64, nb = q % 64; const int n0 = 32 * nb;
        const int dst = (n0 < 1024) ? (256 * (n0 / 128) + (n0 % 128)) : (256 * ((n0 - 1024) / 128) + 128 + ((n0 - 1024) % 128));
        tr_item(p.w_gu + (size_t)e * DM * 2 * FF, 2 * FF, n0, 64 * kb, wgu + (size_t)e * 2 * FF * DM, dst, DM, scr, lane); return; } r -= CV_I3;
    { const int e = r / 512, q = r % 512, kb = q / 32, nb = q % 32;
        tr_item(p.w_down + (size_t)e * FF * DM, DM, 32 * nb, 64 * kb, wdn + (size_t)e * DM * FF, 32 * nb, FF, scr, lane); }
}
__global__ void __launch_bounds__(256) k_convert(Params p) {
    __shared__ float scr[4][64 * 33 * 2];
    const int wave = threadIdx.x >> 6, lane = threadIdx.x & 63;
    for (int it = blockIdx.x * 4 + wave; it < CV_N; it += gridDim.x * 4) convert_item(p, it, scr[wave], lane);
}

__global__ void __launch_bounds__(256) k_norm1(Params p) {
    __shared__ float gw[DM * 8];
    for (int i = threadIdx.x; i < DM * 8; i += 256) gw[i] = p.w_in[(size_t)(i >> 3) * DIN + 2048 + (i & 7)];
    __syncthreads();
    const int wave = threadIdx.x >> 6, lane = threadIdx.x & 63;
    bf16_t* XN = (bf16_t*)(p.ws + WS_XN); float* gates = (float*)(p.ws + WS_GATES);
    for (int row = blockIdx.x * 4 + wave; row < T; row += gridDim.x * 4) {
        const f32x4* xr = (const f32x4*)(p.x + (size_t)row * DM) + lane;
        f32x4 v[4]; float s = 0.f;
#pragma unroll
        for (int j = 0; j < 4; ++j) { v[j] = xr[64 * j]; s += (v[j].x * v[j].x + v[j].y * v[j].y) + (v[j].z * v[j].z + v[j].w * v[j].w); }
        const float rstd = rsqrtf(wave_sum(s) * (1.f / DM) + EPS);
        float ga[8];
#pragma unroll
        for (int q = 0; q < 8; ++q) ga[q] = 0.f;
        unsigned long long* o8 = (unsigned long long*)(XN + (size_t)row * DM) + lane;
#pragma unroll
        for (int j = 0; j < 4; ++j) { const f32x4 g = ((const f32x4*)p.norm1_g)[64 * j + lane]; f32x4 u = v[j] * rstd * g;
            o8[64 * j] = (unsigned long long)pk2(u.x, u.y) | ((unsigned long long)pk2(u.z, u.w) << 32);
            const int k0 = 256 * j + 4 * lane;
#pragma unroll
            for (int c = 0; c < 4; ++c) { const float uu = u[c]; const float* w = gw + (k0 + c) * 8;
#pragma unroll
                for (int q = 0; q < 8; ++q) ga[q] += uu * w[q]; } }
#pragma unroll
        for (int q = 0; q < 8; ++q) ga[q] = wave_sum(ga[q]);
        if (lane == 0) {
#pragma unroll
            for (int q = 0; q < 8; ++q) gates[(size_t)row * 8 + q] = ga[q] + p.gate_b[q]; }
    }
}

__device__ __forceinline__ void wave_gemm_32x32(f32x4 (&acc)[2][2], const bf16_t* a0, const bf16_t* a1, const bf16_t* b0, const bf16_t* b1, int K) {
    for (int k = 0; k < K; k += 32) {
        const bf16x8 A0 = *(const bf16x8*)(a0 + k), A1 = *(const bf16x8*)(a1 + k), B0 = *(const bf16x8*)(b0 + k), B1 = *(const bf16x8*)(b1 + k);
        acc[0][0] = __builtin_amdgcn_mfma_f32_16x16x32_bf16(A0, B0, acc[0][0], 0, 0, 0);
        acc[0][1] = __builtin_amdgcn_mfma_f32_16x16x32_bf16(A0, B1, acc[0][1], 0, 0, 0);
        acc[1][0] = __builtin_amdgcn_mfma_f32_16x16x32_bf16(A1, B0, acc[1][0], 0, 0, 0);
        acc[1][1] = __builtin_amdgcn_mfma_f32_16x16x32_bf16(A1, B1, acc[1][1], 0, 0, 0);
    }
}
#define ZERO_ACC(acc) do { _Pragma("unroll") for (int a_ = 0; a_ < 2; ++a_) _Pragma("unroll") for (int b_ = 0; b_ < 2; ++b_) acc[a_][b_] = (f32x4){0.f, 0.f, 0.f, 0.f}; } while (0)

__global__ void __launch_bounds__(256) k_proj(Params p) {
    const int wave = threadIdx.x >> 6, lane = threadIdx.x & 63, fr = lane & 15, fq = lane >> 4;
    const bf16_t* XN = (const bf16_t*)(p.ws + WS_XN); const bf16_t* W = (const bf16_t*)(p.ws + WS_WIN); bf16_t* PR = (bf16_t*)(p.ws + WS_PROJ);
    constexpr int NCT = NPJ / 32, NIT = (T / 32) * NCT;
    for (int it = blockIdx.x * 4 + wave; it < NIT; it += gridDim.x * 4) {
        const int rt = it / NCT, ct = it % NCT, r0 = rt * 32, c0 = ct * 32;
        f32x4 acc[2][2]; ZERO_ACC(acc);
        wave_gemm_32x32(acc, XN + (size_t)(r0 + fr) * DM + fq * 8, XN + (size_t)(r0 + 16 + fr) * DM + fq * 8, W + (size_t)(c0 + fr) * DM + fq * 8, W + (size_t)(c0 + 16 + fr) * DM + fq * 8, DM);
        const float sc = (c0 >= PAQ && c0 < PAK) ? QSCALE : 1.f;
#pragma unroll
        for (int mi = 0; mi < 2; ++mi)
#pragma unroll
            for (int ni = 0; ni < 2; ++ni)
#pragma unroll
                for (int j = 0; j < 4; ++j) PR[(size_t)(r0 + mi * 16 + fq * 4 + j) * NPJ + c0 + ni * 16 + fr] = (bf16_t)f2bf(acc[mi][ni][j] * sc);
    }
}

__global__ void __launch_bounds__(256) k_outproj(Params p) {
    const int wave = threadIdx.x >> 6, lane = threadIdx.x & 63, fr = lane & 15, fq = lane >> 4;
    const bf16_t* A = (const bf16_t*)(p.ws + WS_MIX); const bf16_t* W = (const bf16_t*)(p.ws + WS_WOUT);
    constexpr int NCT = DM / 32, NIT = (T / 32) * NCT;
    for (int it = blockIdx.x * 4 + wave; it < NIT; it += gridDim.x * 4) {
        const int rt = it / NCT, ct = it % NCT, r0 = rt * 32, c0 = ct * 32;
        f32x4 acc[2][2]; ZERO_ACC(acc);
        wave_gemm_32x32(acc, A + (size_t)(r0 + fr) * DM + fq * 8, A + (size_t)(r0 + 16 + fr) * DM + fq * 8, W + (size_t)(c0 + fr) * DM + fq * 8, W + (size_t)(c0 + 16 + fr) * DM + fq * 8, DM);
#pragma unroll
        for (int mi = 0; mi < 2; ++mi)
#pragma unroll
            for (int ni = 0; ni < 2; ++ni)
#pragma unroll
                for (int j = 0; j < 4; ++j) { const size_t o = (size_t)(r0 + mi * 16 + fq * 4 + j) * DM + c0 + ni * 16 + fr; p.out[o] = p.x[o] + acc[mi][ni][j]; }
    }
}

__device__ __forceinline__ void load_conv_tile(const Params& p, float* dst, int LD, int b, int c, int col0, int cch, float scale) {
    const bf16_t* PR = (const bf16_t*)(p.ws + WS_PROJ);
    for (int i = threadIdx.x; i < 64 * 128; i += blockDim.x) {
        const int s = i >> 7, d = i & 127; const int tl = c * 64 + s; float a = p.conv_b[cch + d];
#pragma unroll
        for (int j = 0; j < 4; ++j) { const int tt = tl - 3 + j; if (tt >= 0) a += p.conv_w[j * 1024 + cch + d] * bf2f(PR[(size_t)(b * SEQ + tt) * NPJ + col0 + d]); }
        dst[s * LD + d] = a * sigmoidf_(a) * scale;
    }
}
__device__ __forceinline__ void load_gates(const Params& p, float* li, float* bcum, int b, int h, int c) {
    const float* gates = (const float*)(p.ws + WS_GATES);
    if (threadIdx.x < 64) { const size_t t = (size_t)b * SEQ + c * 64 + threadIdx.x; li[threadIdx.x] = gates[t * 8 + h]; bcum[threadIdx.x] = log_sigmoid(gates[t * 8 + 4 + h]); }
    __syncthreads();
    if (threadIdx.x == 0) { float a = 0.f; for (int s = 0; s < 64; ++s) { a += bcum[s]; bcum[s] = a; } }
    __syncthreads();
}

__global__ void __launch_bounds__(256) k_mlstm_a(Params p) {
    extern __shared__ __attribute__((aligned(16))) unsigned char smem[];
    float* kk = (float*)smem; float* vv = kk + 64 * 129; float* li = vv + 64 * 128; float* bcum = li + 64; float* wgt = bcum + 64;
    const bf16_t* PR = (const bf16_t*)(p.ws + WS_PROJ);
    bf16_t* MU = (bf16_t*)(p.ws + WS_MU); float* NU = (float*)(p.ws + MS_NU); float* msc = (float*)(p.ws + MS_MSC);
    for (int item = blockIdx.x; item < 16 * NCH; item += gridDim.x) {
        const int bh = item / NCH, c = item % NCH, b = bh >> 2, h = bh & 3;
        __syncthreads();
        load_gates(p, li, bcum, b, h, c);
        load_conv_tile(p, kk, 129, b, c, PK + h * 128, 512 + h * 128, 0.08838834764831845f);
        for (int i = threadIdx.x; i < 64 * 128; i += 256) { const int s = i >> 7, e = i & 127; vv[i] = bf2f(PR[(size_t)(b * SEQ + c * 64 + s) * NPJ + PV + h * 128 + e]); }
        const float blast = bcum[63];
        float gmax = -INFINITY;
        for (int s = 0; s < 64; ++s) gmax = fmaxf(gmax, blast - bcum[s] + li[s]);
        __syncthreads();
        if (threadIdx.x < 64) wgt[threadIdx.x] = __expf(blast - bcum[threadIdx.x] + li[threadIdx.x] - gmax);
        __syncthreads();
        const int d = threadIdx.x >> 1, e0 = (threadIdx.x & 1) * 64;
        float acc[64];
#pragma unroll
        for (int e = 0; e < 64; ++e) acc[e] = 0.f;
        for (int s = 0; s < 64; ++s) { const float kd = wgt[s] * kk[s * 129 + d];
#pragma unroll
            for (int e = 0; e < 64; ++e) acc[e] += kd * vv[s * 128 + e0 + e]; }
        bf16_t* uo = MU + ((size_t)item * 128 + d) * 128 + e0;
#pragma unroll
        for (int e = 0; e < 64; e += 2) *(unsigned*)(uo + e) = pk2(acc[e], acc[e + 1]);
        if (threadIdx.x < 128) { float a = 0.f; for (int s = 0; s < 64; ++s) a += wgt[s] * kk[s * 129 + threadIdx.x]; NU[(size_t)item * 128 + threadIdx.x] = a; }
        if (threadIdx.x == 0) { msc[item] = blast; msc[2048 + item] = gmax; }
    }
}
__global__ void __launch_bounds__(256) k_mlstm_scan(Params p) {
    __shared__ float dec[NCH], ac[NCH];
    const bf16_t* MU = (const bf16_t*)(p.ws + WS_MU); bf16_t* MC = (bf16_t*)(p.ws + WS_MC);
    const float* NU = (const float*)(p.ws + MS_NU); float* NC = (float*)(p.ws + MS_NC); float* msc = (float*)(p.ws + MS_MSC);
    for (int item = blockIdx.x; item < 16 * 64; item += gridDim.x) {
        const int bh = item >> 6, eb = item & 63;
        __syncthreads();
        if (threadIdx.x == 0) { float m = 0.f;
            for (int c = 0; c < NCH; ++c) { const float bl = msc[bh * NCH + c], gm = msc[2048 + bh * NCH + c]; const float m1 = fmaxf(bl + m, gm);
                dec[c] = __expf(bl + m - m1); ac[c] = __expf(gm - m1); if (eb == 0) msc[4096 + bh * NCH + c] = m; m = m1; } }
        __syncthreads();
        const int idx = eb * 256 + threadIdx.x; float C = 0.f;
        for (int c = 0; c < NCH; ++c) { const size_t o = ((size_t)(bh * NCH + c)) * 16384 + idx; MC[o] = (bf16_t)f2bf(C); C = dec[c] * C + ac[c] * bf2f(MU[o]); }
        if (eb == 0 && threadIdx.x < 128) { float n = 0.f;
            for (int c = 0; c < NCH; ++c) { const size_t o = ((size_t)(bh * NCH + c)) * 128 + threadIdx.x; NC[o] = n; n = dec[c] * n + ac[c] * NU[o]; } }
    }
}
__global__ void __launch_bounds__(256) k_mlstm_c(Params p) {
    extern __shared__ __attribute__((aligned(16))) unsigned char smem[];
    float* qq = (float*)smem; float* kk = qq + 64 * 129; float* vv = kk + 64 * 129; float* W = vv + 64 * 128; float* li = W + 64 * 65; float* bcum = li + 64;
    float* mx = bcum + 64; float* den = mx + 64; float* nn = den + 64;
    const bf16_t* PR = (const bf16_t*)(p.ws + WS_PROJ); const bf16_t* MC = (const bf16_t*)(p.ws + WS_MC);
    const float* NC = (const float*)(p.ws + MS_NC); const float* msc = (const float*)(p.ws + MS_MSC); bf16_t* MIX = (bf16_t*)(p.ws + WS_MIX);
    for (int item = blockIdx.x; item < 16 * NCH; item += gridDim.x) {
        const int bh = item / NCH, c = item % NCH, b = bh >> 2, h = bh & 3;
        __syncthreads();
        load_gates(p, li, bcum, b, h, c);
        load_conv_tile(p, qq, 129, b, c, PQ + h * 128, h * 128, 1.f);
        load_conv_tile(p, kk, 129, b, c, PK + h * 128, 512 + h * 128, 0.08838834764831845f);
        for (int i = threadIdx.x; i < 64 * 128; i += 256) { const int s = i >> 7, e = i & 127; vv[i] = bf2f(PR[(size_t)(b * SEQ + c * 64 + s) * NPJ + PV + h * 128 + e]); }
        if (threadIdx.x < 128) nn[threadIdx.x] = NC[(size_t)item * 128 + threadIdx.x];
        const float mc = msc[4096 + item];
        if (threadIdx.x < 64) { const int t = threadIdx.x; float m = bcum[t] + mc; for (int s = 0; s <= t; ++s) m = fmaxf(m, bcum[t] - bcum[s] + li[s]); mx[t] = m; }
        __syncthreads();
        for (int i = threadIdx.x; i < 64 * 64; i += 256) { const int t = i >> 6, s = i & 63; float w = 0.f;
            if (s <= t) { float dot = 0.f; for (int d = 0; d < 128; ++d) dot += qq[t * 129 + d] * kk[s * 129 + d]; w = __expf(bcum[t] - bcum[s] + li[s] - mx[t]) * dot; }
            W[t * 65 + s] = w; }
        __syncthreads();
        const int t = threadIdx.x >> 2, e0 = (threadIdx.x & 3) * 32;
        const float sc = __expf(bcum[t] + mc - mx[t]);
        if ((threadIdx.x & 3) == 0) { float a = 0.f; for (int s = 0; s <= t; ++s) a += W[t * 65 + s]; float qn = 0.f; for (int d = 0; d < 128; ++d) qn += qq[t * 129 + d] * nn[d]; den[t] = a + sc * qn; }
        float acc[32];
#pragma unroll
        for (int e = 0; e < 32; ++e) acc[e] = 0.f;
        const bf16_t* Cb = MC + (size_t)item * 16384 + e0;
        for (int d = 0; d < 128; ++d) { const float qd = qq[t * 129 + d]; const bf16_t* cr = Cb + d * 128;
#pragma unroll
            for (int e = 0; e < 32; ++e) acc[e] += qd * bf2f(cr[e]); }
#pragma unroll
        for (int e = 0; e < 32; ++e) acc[e] *= sc;
        for (int s = 0; s <= t; ++s) { const float w = W[t * 65 + s];
#pragma unroll
            for (int e = 0; e < 32; ++e) acc[e] += w * vv[s * 128 + e0 + e]; }
        __syncthreads();
        const float dn = fmaxf(fabsf(den[t]), __expf(-mx[t])); float ss = 0.f;
#pragma unroll
        for (int e = 0; e < 32; ++e) { acc[e] /= dn; ss += acc[e] * acc[e]; }
        ss += __shfl_xor(ss, 1); ss += __shfl_xor(ss, 2);
        const float rstd = rsqrtf(ss * (1.f / 128.f) + EPS);
        const size_t row = (size_t)b * SEQ + c * 64 + t;
#pragma unroll
        for (int e = 0; e < 32; ++e) { const int ch = h * 128 + e0 + e; const float og = sigmoidf_(bf2f(PR[row * NPJ + PO + ch]));
            MIX[row * DM + ch] = (bf16_t)f2bf(acc[e] * rstd * p.mlstm_norm_g[ch] * og); }
    }
}

__device__ __forceinline__ int t5_bucket(int rel) {
    const int n = rel < 0 ? -rel : rel; int b;
    if (n < 8) b = n; else if (n < 12) b = 8; else if (n < 16) b = 9; else if (n < 23) b = 10; else if (n < 32) b = 11; else if (n < 46) b = 12; else if (n < 64) b = 13; else if (n < 91) b = 14; else b = 15;
    return b + (rel > 0 ? 16 : 0);
}
__global__ void __launch_bounds__(256) k_attn_naive(Params p) {
    __shared__ __attribute__((aligned(16))) float Ks[64 * 64];
    __shared__ __attribute__((aligned(16))) float Vs[64 * 128];
    __shared__ float btab[256];
    const bf16_t* PR = (const bf16_t*)(p.ws + WS_PROJ); float* AO = (float*)(p.ws + WS_AO);
    for (int item = blockIdx.x; item < NB * 4 * 2 * 32; item += gridDim.x) {
        const int qb = 31 - (item >> 5), r5 = item & 31, b = r5 >> 3, h = (r5 >> 1) & 3, m = r5 & 1;
        __syncthreads();
        btab[threadIdx.x] = p.rel_bias[t5_bucket((int)threadIdx.x - 192) * 4 + h] * LOG2E;
        const float c15 = p.rel_bias[15 * 4 + h] * LOG2E;
        const int q = qb * 256 + threadIdx.x, cq = q >> 6;
        float qv[64];
        { const bf16_t* qp = PR + (size_t)(b * SEQ + q) * NPJ + PAQ + h * 128 + m * 64;
#pragma unroll
            for (int d = 0; d < 64; d += 8) { const u32x4 w = *(const u32x4*)(qp + d);
                qv[d] = __uint_as_float(w.x << 16); qv[d + 1] = __uint_as_float(w.x & 0xffff0000u); qv[d + 2] = __uint_as_float(w.y << 16); qv[d + 3] = __uint_as_float(w.y & 0xffff0000u);
                qv[d + 4] = __uint_as_float(w.z << 16); qv[d + 5] = __uint_as_float(w.z & 0xffff0000u); qv[d + 6] = __uint_as_float(w.w << 16); qv[d + 7] = __uint_as_float(w.w & 0xffff0000u); } }
        float o[128];
#pragma unroll
        for (int e = 0; e < 128; ++e) o[e] = 0.f;
        float mrun = -INFINITY, l = 0.f;
        const int ntile = 4 * qb + 4;
        for (int j = 0; j < ntile; ++j) {
            __syncthreads();
            for (int i = threadIdx.x; i < 64 * 64; i += 256) { const int kk = i >> 6, d = i & 63; Ks[i] = bf2f(PR[(size_t)(b * SEQ + j * 64 + kk) * NPJ + PAK + h * 128 + m * 64 + d]); }
            for (int i = threadIdx.x; i < 64 * 128; i += 256) { const int kk = i >> 7, e = i & 127; Vs[i] = bf2f(PR[(size_t)(b * SEQ + j * 64 + kk) * NPJ + PAV + h * 128 + e]); }
            __syncthreads();
            if (j <= cq) {
                for (int kk = 0; kk < 64; ++kk) {
                    float s = 0.f;
#pragma unroll
                    for (int d = 0; d < 64; d += 4) { const f32x4 kv = *(const f32x4*)(Ks + kk * 64 + d); s += qv[d] * kv.x + qv[d + 1] * kv.y + qv[d + 2] * kv.z + qv[d + 3] * kv.w; }
                    const int rel = j * 64 + kk - q;
                    s += (rel < -192) ? c15 : btab[rel + 192];
                    if (s > mrun) { const float f = exp2f(mrun - s); l *= f;
#pragma unroll
                        for (int e = 0; e < 128; ++e) o[e] *= f;
                        mrun = s; }
                    const float pw = exp2f(s - mrun); l += pw;
#pragma unroll
                    for (int e = 0; e < 128; e += 4) { const f32x4 vv = *(const f32x4*)(Vs + kk * 128 + e); o[e] += pw * vv.x; o[e + 1] += pw * vv.y; o[e + 2] += pw * vv.z; o[e + 3] += pw * vv.w; }
                }
            }
        }
        const float inv = 1.f / l;
        float* op = AO + (((size_t)(b * SEQ + q) * 4 + h) * 2 + m) * 128;
#pragma unroll
        for (int e = 0; e < 128; e += 4) *(f32x4*)(op + e) = (f32x4){o[e] * inv, o[e + 1] * inv, o[e + 2] * inv, o[e + 3] * inv};
    }
}
__global__ void __launch_bounds__(256) k_attn_combine(Params p) {
    __shared__ float lam_s;
    if (threadIdx.x == 0) { float a = 0.f, c = 0.f; for (int i = 0; i < 64; ++i) { a += p.lam_q1[i] * p.lam_k1[i]; c += p.lam_q2[i] * p.lam_k2[i]; } lam_s = __expf(a) - __expf(c) + 0.2f; }
    __syncthreads();
    const float lam = lam_s;
    const float* AO = (const float*)(p.ws + WS_AO); bf16_t* MIX = (bf16_t*)(p.ws + WS_MIX);
    const int wave = threadIdx.x >> 6, lane = threadIdx.x & 63;
    for (int it = blockIdx.x * 4 + wave; it < T * 4; it += gridDim.x * 4) {
        const float* o1 = AO + (size_t)it * 256; const float* o2 = o1 + 128;
        const float a0 = o1[2 * lane] - lam * o2[2 * lane], a1 = o1[2 * lane + 1] - lam * o2[2 * lane + 1];
        const float rstd = rsqrtf(wave_sum(a0 * a0 + a1 * a1) * (1.f / 128.f) + EPS);
        const int t = it >> 2, h = it & 3;
        *(unsigned*)(MIX + (size_t)t * DM + 512 + h * 128 + 2 * lane) = pk2(a0 * rstd * p.diff_norm_g[2 * lane] * 0.8f, a1 * rstd * p.diff_norm_g[2 * lane + 1] * 0.8f);
    }
}

__global__ void __launch_bounds__(256) k_route(Params p) {
    __shared__ float urow[4][DM];
    const int wave = threadIdx.x >> 6, lane = threadIdx.x & 63;
    bf16_t* U2 = (bf16_t*)(p.ws + WS_U2); unsigned* ctl = (unsigned*)(p.ws + WS_CTL);
    int* list = (int*)(p.ws + MS_LIST); int* pe = (int*)(p.ws + MS_PE); int* pp = (int*)(p.ws + MS_PP); float* pg = (float*)(p.ws + MS_PG);
    for (int row = blockIdx.x * 4 + wave; row < T; row += gridDim.x * 4) {
        const f32x4* xr = (const f32x4*)(p.out + (size_t)row * DM) + lane;
        f32x4 v[4]; float s = 0.f;
#pragma unroll
        for (int j = 0; j < 4; ++j) { v[j] = xr[64 * j]; s += (v[j].x * v[j].x + v[j].y * v[j].y) + (v[j].z * v[j].z + v[j].w * v[j].w); }
        const float rstd = rsqrtf(wave_sum(s) * (1.f / DM) + EPS);
        unsigned long long* o8 = (unsigned long long*)(U2 + (size_t)row * DM) + lane;
#pragma unroll
        for (int j = 0; j < 4; ++j) { const f32x4 g = ((const f32x4*)p.norm2_g)[64 * j + lane]; const f32x4 u = v[j] * rstd * g;
            o8[64 * j] = (unsigned long long)pk2(u.x, u.y) | ((unsigned long long)pk2(u.z, u.w) << 32);
            *(f32x4*)(&urow[wave][256 * j + 4 * lane]) = u; }
        LDS_WAIT();
        const int e = lane & 31, half = lane >> 5; float acc = 0.f;
        for (int k = half * 512; k < half * 512 + 512; ++k) acc += urow[wave][k] * p.router_w[(size_t)k * NE + e];
        acc += __shfl_xor(acc, 32);
        float val = acc + p.router_b[e];
        float tv[4]; int ti[4];
#pragma unroll
        for (int r = 0; r < 4; ++r) { float bv = val; int bi = e;
#pragma unroll
            for (int o = 1; o < 32; o <<= 1) { const float ov = __shfl_xor(bv, o); const int oi = __shfl_xor(bi, o); if (ov > bv || (ov == bv && oi < bi)) { bv = ov; bi = oi; } }
            tv[r] = bv; ti[r] = bi; if (e == bi) val = -INFINITY; }
        const float e1 = __expf(tv[1] - tv[0]), e2 = __expf(tv[2] - tv[0]), e3 = __expf(tv[3] - tv[0]); const float inv = 1.f / (1.f + e1 + e2 + e3);
        if (lane < 4) { const int ee = lane == 0 ? ti[0] : lane == 1 ? ti[1] : lane == 2 ? ti[2] : ti[3]; const float gg = (lane == 0 ? 1.f : lane == 1 ? e1 : lane == 2 ? e2 : e3) * inv;
            const int pos = (int)atomicAdd(&ctl[CW_CNT + ee], 1u);
            list[(size_t)ee * T + pos] = row; pe[row * 4 + lane] = ee; pp[row * 4 + lane] = pos; pg[row * 4 + lane] = gg; }
        LDS_WAIT();
    }
}

__device__ __forceinline__ void expert_starts(const unsigned* ctl, int* ps, int* cn) {
    if (threadIdx.x == 0) { int a = 0; for (int e = 0; e < NE; ++e) { const int c = (int)ctl[CW_CNT + e]; cn[e] = c; ps[e] = a; a += (c + 255) & ~255; } ps[NE] = a; }
    __syncthreads();
}
__global__ void __launch_bounds__(256) k_moe1(Params p) {
    __shared__ int ps[NE + 1], cn[NE];
    const unsigned* ctl = (const unsigned*)(p.ws + WS_CTL);
    expert_starts(ctl, ps, cn);
    const int wave = threadIdx.x >> 6, lane = threadIdx.x & 63, fr = lane & 15, fq = lane >> 4;
    const bf16_t* U2 = (const bf16_t*)(p.ws + WS_U2); const bf16_t* WG = (const bf16_t*)(p.ws + WS_WGU); bf16_t* ACT = (bf16_t*)(p.ws + WS_ACT); const int* list = (const int*)(p.ws + MS_LIST);
    const int nrt = ps[NE] / 32, NIT = nrt * 32;
    for (int it = blockIdx.x * 4 + wave; it < NIT; it += gridDim.x * 4) {
        const int rt = it >> 5, ct = it & 31, R = rt * 32, c0 = ct * 32;
        int e = 0; while (ps[e + 1] <= R) ++e;
        const int lr = R - ps[e]; if (lr >= cn[e]) continue;
        const int i0 = min(lr + fr, cn[e] - 1), i1 = min(lr + 16 + fr, cn[e] - 1);
        const int t0 = list[(size_t)e * T + i0], t1 = list[(size_t)e * T + i1];
        const bf16_t* Wb = WG + (size_t)e * 2 * FF * DM + (size_t)(256 * (c0 / 128) + (c0 % 128)) * DM;
        f32x4 ag[2][2], au[2][2]; ZERO_ACC(ag); ZERO_ACC(au);
        wave_gemm_32x32(ag, U2 + (size_t)t0 * DM + fq * 8, U2 + (size_t)t1 * DM + fq * 8, Wb + (size_t)fr * DM + fq * 8, Wb + (size_t)(16 + fr) * DM + fq * 8, DM);
        wave_gemm_32x32(au, U2 + (size_t)t0 * DM + fq * 8, U2 + (size_t)t1 * DM + fq * 8, Wb + (size_t)(128 + fr) * DM + fq * 8, Wb + (size_t)(128 + 16 + fr) * DM + fq * 8, DM);
#pragma unroll
        for (int mi = 0; mi < 2; ++mi)
#pragma unroll
            for (int ni = 0; ni < 2; ++ni)
#pragma unroll
                for (int j = 0; j < 4; ++j) { const int col = c0 + ni * 16 + fr;
                    float g = ag[mi][ni][j] + p.b_gu[(size_t)e * 2 * FF + col], u = au[mi][ni][j] + p.b_gu[(size_t)e * 2 * FF + FF + col];
                    g = fminf(g, 7.f); u = fminf(fmaxf(u, -7.f), 7.f);
                    ACT[(size_t)(R + mi * 16 + fq * 4 + j) * FF + col] = (bf16_t)f2bf((u + 1.f) * g * sigmoidf_(1.702f * g)); }
    }
}
__global__ void __launch_bounds__(256) k_moe2(Params p) {
    __shared__ int ps[NE + 1], cn[NE];
    const unsigned* ctl = (const unsigned*)(p.ws + WS_CTL);
    expert_starts(ctl, ps, cn);
    const int wave = threadIdx.x >> 6, lane = threadIdx.x & 63, fr = lane & 15, fq = lane >> 4;
    const bf16_t* ACT = (const bf16_t*)(p.ws + WS_ACT); const bf16_t* WD = (const bf16_t*)(p.ws + WS_WDN); bf16_t* Y = (bf16_t*)(p.ws + WS_Y);
    const int nrt = ps[NE] / 32, NIT = nrt * 32;
    for (int it = blockIdx.x * 4 + wave; it < NIT; it += gridDim.x * 4) {
        const int rt = it >> 5, ct = it & 31, R = rt * 32, c0 = ct * 32;
        int e = 0; while (ps[e + 1] <= R) ++e;
        const int lr = R - ps[e]; if (lr >= cn[e]) continue;
        const bf16_t* Wb = WD + (size_t)e * DM * FF + (size_t)c0 * FF;
        f32x4 acc[2][2]; ZERO_ACC(acc);
        wave_gemm_32x32(acc, ACT + (size_t)(R + fr) * FF + fq * 8, ACT + (size_t)(R + 16 + fr) * FF + fq * 8, Wb + (size_t)fr * FF + fq * 8, Wb + (size_t)(16 + fr) * FF + fq * 8, FF);
#pragma unroll
        for (int mi = 0; mi < 2; ++mi)
#pragma unroll
            for (int ni = 0; ni < 2; ++ni)
#pragma unroll
                for (int j = 0; j < 4; ++j) { const int col = c0 + ni * 16 + fr;
                    Y[(size_t)(R + mi * 16 + fq * 4 + j) * DM + col] = (bf16_t)f2bf(acc[mi][ni][j] + p.b_down[(size_t)e * DM + col]); }
    }
}
__global__ void __launch_bounds__(256) k_final(Params p) {
    __shared__ int ps[NE + 1], cn[NE];
    const unsigned* ctl = (const unsigned*)(p.ws + WS_CTL);
    expert_starts(ctl, ps, cn);
    const int wave = threadIdx.x >> 6, lane = threadIdx.x & 63;
    const bf16_t* Y = (const bf16_t*)(p.ws + WS_Y); const int* pe = (const int*)(p.ws + MS_PE); const int* pp = (const int*)(p.ws + MS_PP); const float* pg = (const float*)(p.ws + MS_PG);
    for (int row = blockIdx.x * 4 + wave; row < T; row += gridDim.x * 4) {
        f32x4* xr = (f32x4*)(p.out + (size_t)row * DM) + lane;
        f32x4 v[4];
#pragma unroll
        for (int j = 0; j < 4; ++j) v[j] = xr[64 * j];
#pragma unroll
        for (int r = 0; r < 4; ++r) { const int e = pe[row * 4 + r]; const size_t yr = (size_t)(ps[e] + pp[row * 4 + r]); const float g = pg[row * 4 + r];
            const u32x2* yp = (const u32x2*)(Y + yr * DM) + lane;
#pragma unroll
            for (int j = 0; j < 4; ++j) { const u32x2 w = yp[64 * j];
                v[j].x += g * __uint_as_float(w.x << 16); v[j].y += g * __uint_as_float(w.x & 0xffff0000u); v[j].z += g * __uint_as_float(w.y << 16); v[j].w += g * __uint_as_float(w.y & 0xffff0000u); } }
        float s = 0.f;
#pragma unroll
        for (int j = 0; j < 4; ++j) s += (v[j].x * v[j].x + v[j].y * v[j].y) + (v[j].z * v[j].z + v[j].w * v[j].w);
        const float rstd = rsqrtf(wave_sum(s) * (1.f / DM) + EPS);
#pragma unroll
        for (int j = 0; j < 4; ++j) { const f32x4 g = ((const f32x4*)p.final_g)[64 * j + lane]; xr[64 * j] = v[j] * rstd * g; }
    }
}

#define LAS __attribute__((address_space(3)))
#define GAS __attribute__((address_space(1)))
typedef GAS unsigned gu32;
#define RLX_AGENT __ATOMIC_RELAXED, __HIP_MEMORY_SCOPE_AGENT
#define VM_WAIT() asm volatile("s_waitcnt vmcnt(0)" ::: "memory")
constexpr int NWAVES = 8, NTHR = 512;
constexpr int RING_BYTES = 131072;
constexpr int LDSCTL_OFF = RING_BYTES, MISC_OFF = LDSCTL_OFF + 320;
constexpr int TAB_OFF = RING_BYTES + 1024;
constexpr int TAB_UL = TAB_OFF, TAB_PS = TAB_OFF + 256, TAB_CN = TAB_OFF + 256 + 160, TAB_NU = TAB_OFF + 256 + 160 + 128, TAB_UC = TAB_OFF + 256 + 160 + 128 + 16;
constexpr int GTAB_OFF = TAB_OFF + 1024;
constexpr int LDS_BYTES = 163840;
static_assert(GTAB_OFF + 20 * 256 * 4 <= LDS_BYTES, "LDS map");
constexpr int CW_BAR = 4096;

namespace pg8 {
constexpr int BM = 256, BK = 64, HALF = 128, HTB = HALF * BK * 2, STAGE_BYTES = 8 * HTB, NXCD = 8, WGM = 8;
__host__ __device__ __forceinline__ int lds_byte(int r, int c) { const int st = (r >> 4) * 2 + (c >> 5), rr = r & 15, cc = c & 31, ob = rr * 64 + cc * 2; return st * 1024 + (ob ^ (((ob >> 9) & 1) << 5)); }
__host__ __device__ __forceinline__ void stage_rc(int b, int& R, int& C) { const int st = b / 1024, sb = b % 1024, swz = sb ^ (((sb >> 9) & 1) << 5); R = (st >> 1) * 16 + swz / 64; C = (st & 1) * 32 + (swz % 64) / 2; }
__host__ __device__ __forceinline__ int perm32(int rho) { const int n = rho >> 4, i = rho & 15; return 8 * (i >> 2) + 4 * n + (i & 3); }
__device__ __forceinline__ unsigned cvt_pk_bf16(float lo, float hi) { unsigned r; asm volatile("v_cvt_pk_bf16_f32 %0, %1, %2" : "=v"(r) : "v"(lo), "v"(hi)); return r; }

struct Unit { const char* a; const char* b; int pm, pn, e, slot; };

__device__ __forceinline__ int xcd_remap(int L, int nwg) { const int q = nwg / NXCD, r = nwg % NXCD, xcd = L % NXCD, off = L / NXCD; return (xcd < r ? xcd * (q + 1) : r * (q + 1) + (xcd - r) * q) + off; }

struct StaticOrder {
    const char* A; const char* Bt; int nM, nN, nwg, G, c; size_t tstep;
    __device__ void init(const void* A_, const void* Bt_, int M, int N, int K, int G_, int c_) { A = (const char*)A_; Bt = (const char*)Bt_; nM = M / BM; nN = N / BM; nwg = nM * nN; G = G_; c = c_; tstep = (size_t)BM * K * 2; }
    __device__ __forceinline__ bool next(int i, Unit& u) const {
        const long L = (long)i * G + c; if (L >= nwg) return false;
        const int wgid = xcd_remap((int)L, nwg);
        const int nig = WGM * nN, gid = wgid / nig, fm = gid * WGM, gsz = (nM - fm) < WGM ? (nM - fm) : WGM;
        u.pm = fm + ((wgid % nig) % gsz); u.pn = (wgid % nig) / gsz; u.e = 0; u.slot = 0;
        u.a = A + (size_t)u.pm * tstep; u.b = Bt + (size_t)u.pn * tstep; return true;
    }
};

template <class Epi, class Sched, bool GATHER>
__device__ __forceinline__ void gemm_phase(LAS unsigned char* lds, const int K, const Sched& S, const Epi& E, const LAS unsigned* gtab) {
    const int tid = threadIdx.x, wid = __builtin_amdgcn_readfirstlane(tid >> 6), lane = tid & 63, wr = wid >> 2, wc = wid & 3, fr = lane & 15, fq = lane >> 4;
    const int nt = K / BK;
    unsigned voffA[2][2], voffB[2]; int rowA[2];
#pragma unroll
    for (int i = 0; i < 2; ++i) { int R, C; stage_rc(tid * 16 + i * 8192, R, C); const int Rb = Epi::PERM ? ((R & ~31) + perm32(R & 31)) : R;
        rowA[i] = R;
        if (GATHER) { voffA[0][i] = (unsigned)C * 2u; voffA[1][i] = (unsigned)C * 2u; }
        else { voffA[0][i] = (unsigned)(R * K + C) * 2u; voffA[1][i] = (unsigned)((R + HALF) * K + C) * 2u; }
        voffB[i] = (unsigned)(Rb * K + C) * 2u; }
    const unsigned coff0 = voffA[0][0], coff1 = voffA[0][1];
    const size_t kstep = (size_t)(BK * 2);
    const size_t hstep = (size_t)HALF * K * 2;
    const unsigned ldsw = (unsigned)wid * 1024u;
    const int aoff = lds_byte(wr * 64 + fr, fq * 8), boff = lds_byte(wc * 32 + fr, fq * 8);
#define PG8_SA(b, h) (((b) * 2 + (h)) * HTB)
#define PG8_SB(b, h) ((4 + (b) * 2 + (h)) * HTB)
#define PG8_STAGE(bufoff, gbase, voff) do { _Pragma("unroll") for (int _i = 0; _i < 2; ++_i) \
        __builtin_amdgcn_global_load_lds((const unsigned*)((const char*)(gbase) + (voff)[_i]), (LAS unsigned*)(lds + (bufoff) + ldsw + _i * 8192), 16, 0, 0); } while (0)
#define PG8_LDA(dst, b, h) do { _Pragma("unroll") for (int m = 0; m < 4; ++m) _Pragma("unroll") for (int k = 0; k < 2; ++k) dst[m][k] = *(const LAS bf16x8*)(lds + PG8_SA(b, h) + aoff + m * 2048 + k * 1024); } while (0)
#define PG8_LDB(dst, b, h) do { _Pragma("unroll") for (int n = 0; n < 2; ++n) _Pragma("unroll") for (int k = 0; k < 2; ++k) dst[n][k] = *(const LAS bf16x8*)(lds + PG8_SB(b, h) + boff + n * 2048 + k * 1024); } while (0)
#define PG8_MMA(ai, bj, At, Bt) do { __builtin_amdgcn_s_setprio(1); _Pragma("unroll") for (int m = 0; m < 4; ++m) _Pragma("unroll") for (int n = 0; n < 2; ++n) _Pragma("unroll") for (int k = 0; k < 2; ++k) \
        acc[ai][bj][m][n] = __builtin_amdgcn_mfma_f32_16x16x32_bf16(Bt[n][k], At[m][k], acc[ai][bj][m][n], 0, 0, 0); __builtin_amdgcn_s_setprio(0); } while (0)
#define PG8_WAIT_V(n) asm volatile("s_waitcnt vmcnt(" #n ")" ::: "memory")
#define PG8_WAIT_L(n) asm volatile("s_waitcnt lgkmcnt(" #n ")" ::: "memory")
#define PG8_BAR __builtin_amdgcn_s_barrier()
#define PG8_SCHED __builtin_amdgcn_sched_barrier(0)
#define PG8_GATHER_OFFS(u) do { if (GATHER) { const LAS unsigned* _g = gtab + (u).slot * 256; \
        voffA[0][0] = _g[rowA[0]] + coff0; voffA[0][1] = _g[rowA[1]] + coff1; voffA[1][0] = _g[HALF + rowA[0]] + coff0; voffA[1][1] = _g[HALF + rowA[1]] + coff1; } } while (0)
    Unit cur, nxt; int ui = 0;
    if (!S.next(0, cur)) return;
    f32x4 acc[2][2][4][2];
#pragma unroll
    for (int a = 0; a < 2; ++a)
#pragma unroll
        for (int b = 0; b < 2; ++b)
#pragma unroll
            for (int m = 0; m < 4; ++m)
#pragma unroll
                for (int n = 0; n < 2; ++n) acc[a][b][m][n] = (f32x4){0.f, 0.f, 0.f, 0.f};
    bf16x8 At[4][2], B0[2][2], B1[2][2];
    const char* cA = cur.a; const char* cB = cur.b;
    PG8_GATHER_OFFS(cur);
    PG8_STAGE(PG8_SB(0, 0), cB, voffB); PG8_STAGE(PG8_SB(0, 1), cB + hstep, voffB); PG8_STAGE(PG8_SA(0, 0), cA, voffA[0]); PG8_STAGE(PG8_SA(0, 1), cA, voffA[1]);
    if (wr == 1) PG8_BAR;
    PG8_WAIT_V(2); PG8_BAR;
    PG8_STAGE(PG8_SB(1, 0), cB + kstep, voffB); PG8_STAGE(PG8_SA(1, 0), cA + kstep, voffA[0]); PG8_STAGE(PG8_SB(1, 1), cB + hstep + kstep, voffB);
    PG8_WAIT_V(6); PG8_BAR;
    for (;;) {
        const bool has_next = S.next(ui + 1, nxt);
        const char* nA = has_next ? nxt.a : cA; const char* nB = has_next ? nxt.b : cB;
        for (int t = 0; t < nt; t += 2) {
            const bool last = (t == nt - 2);
            const char* a1 = cA + (size_t)(t + 1) * kstep;
            const char* a2 = last ? nA : cA + (size_t)(t + 2) * kstep; const char* b2 = last ? nB : cB + (size_t)(t + 2) * kstep;
            const char* a3 = a2 + kstep; const char* b3 = b2 + kstep;
            PG8_LDB(B0, 0, 0); PG8_LDB(B1, 0, 1); PG8_SCHED; PG8_LDA(At, 0, 0); PG8_STAGE(PG8_SA(1, 1), a1, voffA[1]);
            if (GATHER) { if (last && has_next) PG8_GATHER_OFFS(nxt); }
            PG8_WAIT_V(8); PG8_WAIT_L(0); PG8_BAR; PG8_MMA(0, 0, At, B0); PG8_MMA(0, 1, At, B1); PG8_BAR; PG8_SCHED;
            PG8_LDA(At, 0, 1); PG8_STAGE(PG8_SB(0, 0), b2, voffB); PG8_STAGE(PG8_SB(0, 1), b2 + hstep, voffB); PG8_STAGE(PG8_SA(0, 0), a2, voffA[0]);
            PG8_WAIT_V(8); PG8_WAIT_L(0); PG8_BAR; PG8_MMA(1, 0, At, B0); PG8_MMA(1, 1, At, B1); PG8_BAR; PG8_SCHED;
            PG8_LDB(B0, 1, 0); PG8_LDB(B1, 1, 1); PG8_SCHED; PG8_LDA(At, 1, 0); PG8_STAGE(PG8_SA(0, 1), a2, voffA[1]);
            PG8_WAIT_V(8); PG8_WAIT_L(0); PG8_BAR; PG8_MMA(0, 0, At, B0); PG8_MMA(0, 1, At, B1); PG8_BAR; PG8_SCHED;
            PG8_LDA(At, 1, 1); PG8_STAGE(PG8_SB(1, 0), b3, voffB); PG8_STAGE(PG8_SB(1, 1), b3 + hstep, voffB); PG8_STAGE(PG8_SA(1, 0), a3, voffA[0]);
            PG8_WAIT_V(8); PG8_WAIT_L(0); PG8_BAR; PG8_MMA(1, 0, At, B0); PG8_MMA(1, 1, At, B1); PG8_BAR; PG8_SCHED;
        }
        if (wr == 0) PG8_BAR;
        E(acc, cur, wr, wc, fr, fq);
        if (!has_next) break;
#pragma unroll
        for (int a = 0; a < 2; ++a)
#pragma unroll
            for (int b = 0; b < 2; ++b)
#pragma unroll
                for (int m = 0; m < 4; ++m)
#pragma unroll
                    for (int n = 0; n < 2; ++n) acc[a][b][m][n] = (f32x4){0.f, 0.f, 0.f, 0.f};
        cur = nxt; cA = nA; cB = nB; ++ui;
        if (wr == 1) PG8_BAR;
    }
    PG8_WAIT_V(0);
    PG8_BAR;
#undef PG8_SA
#undef PG8_SB
#undef PG8_STAGE
#undef PG8_LDA
#undef PG8_LDB
#undef PG8_MMA
#undef PG8_WAIT_V
#undef PG8_WAIT_L
#undef PG8_BAR
#undef PG8_SCHED
#undef PG8_GATHER_OFFS
}

constexpr size_t SEC = (size_t)16 * SEQ * 128;
struct EpiProj {
    static constexpr bool PERM = true;
    bf16_t* O;
    __device__ __forceinline__ void operator()(const f32x4 (&acc)[2][2][4][2], const Unit& u, int wr, int wc, int fr, int fq) const {
        const int row0 = u.pm * BM + wr * 64 + fr;
        const int b = row0 / SEQ, t0 = row0 % SEQ;
        const float sc = (u.pn == 8 || u.pn == 9) ? QSCALE : 1.f;
#pragma unroll
        for (int bj = 0; bj < 2; ++bj) { const int c0 = u.pn * BM + bj * HALF + wc * 32 + 8 * fq, sec = c0 >> 9, cs = c0 & 511, h = cs >> 7;
            bf16_t* base; int pitch;
            if (sec == 4 || sec == 5) { base = O + (size_t)sec * SEC + ((size_t)((b * 4 + h) * 2 + ((cs >> 6) & 1)) * SEQ + t0) * 64 + (cs & 63); pitch = 64; }
            else { base = O + (size_t)sec * SEC + ((size_t)(b * 4 + h) * SEQ + t0) * 128 + (cs & 127); pitch = 128; }
#pragma unroll
            for (int ai = 0; ai < 2; ++ai)
#pragma unroll
                for (int m = 0; m < 4; ++m) { const f32x4 v0 = acc[ai][bj][m][0] * sc, v1 = acc[ai][bj][m][1] * sc;
                    u32x4 w; w.x = cvt_pk_bf16(v0[0], v0[1]); w.y = cvt_pk_bf16(v0[2], v0[3]); w.z = cvt_pk_bf16(v1[0], v1[1]); w.w = cvt_pk_bf16(v1[2], v1[3]);
                    *(u32x4*)(base + (size_t)(ai * HALF + m * 16) * pitch) = w; } }
    }
};
struct EpiOut {
    static constexpr bool PERM = false;
    const float* X; float* O;
    __device__ __forceinline__ void operator()(const f32x4 (&acc)[2][2][4][2], const Unit& u, int wr, int wc, int fr, int fq) const {
        const int row0 = u.pm * BM + wr * 64 + fr, col0 = u.pn * BM + wc * 32 + 4 * fq;
#pragma unroll
        for (int ai = 0; ai < 2; ++ai)
#pragma unroll
            for (int m = 0; m < 4; ++m) { const size_t off = (size_t)(row0 + ai * HALF + m * 16) * DM + col0;
#pragma unroll
                for (int bj = 0; bj < 2; ++bj)
#pragma unroll
                    for (int n = 0; n < 2; ++n) { const f32x4 xv = *(const f32x4*)(X + off + bj * HALF + n * 16); *(f32x4*)(O + off + bj * HALF + n * 16) = xv + acc[ai][bj][m][n]; } }
    }
};
struct EpiSwiglu {
    static constexpr bool PERM = true;
    bf16_t* O; const float* bgu;
    __device__ __forceinline__ void operator()(const f32x4 (&acc)[2][2][4][2], const Unit& u, int wr, int wc, int fr, int fq) const {
        const int row0 = u.pm * BM + wr * 64 + fr, col0 = u.pn * HALF + wc * 32 + 8 * fq;
        const float* bb = bgu + (size_t)u.e * 2 * FF + col0;
        const f32x4 bg0 = *(const f32x4*)(bb), bg1 = *(const f32x4*)(bb + 4), bu0 = *(const f32x4*)(bb + FF), bu1 = *(const f32x4*)(bb + FF + 4);
#pragma unroll
        for (int ai = 0; ai < 2; ++ai)
#pragma unroll
            for (int m = 0; m < 4; ++m) { bf16_t* rowp = O + (size_t)(row0 + ai * HALF + m * 16) * FF + col0;
                float r[8];
#pragma unroll
                for (int n = 0; n < 2; ++n) { const f32x4 gv = acc[ai][0][m][n] + (n ? bg1 : bg0), uv = acc[ai][1][m][n] + (n ? bu1 : bu0);
#pragma unroll
                    for (int j = 0; j < 4; ++j) { const float g = fminf(gv[j], 7.f), uu = fminf(fmaxf(uv[j], -7.f), 7.f);
                        r[n * 4 + j] = (uu + 1.f) * g * __builtin_amdgcn_rcpf(1.f + __builtin_amdgcn_exp2f(-1.702f * LOG2E * g)); } }
                u32x4 w; w.x = cvt_pk_bf16(r[0], r[1]); w.y = cvt_pk_bf16(r[2], r[3]); w.z = cvt_pk_bf16(r[4], r[5]); w.w = cvt_pk_bf16(r[6], r[7]);
                *(u32x4*)(rowp) = w; }
    }
};
struct EpiDown {
    static constexpr bool PERM = true;
    bf16_t* O; const float* bd;
    __device__ __forceinline__ void operator()(const f32x4 (&acc)[2][2][4][2], const Unit& u, int wr, int wc, int fr, int fq) const {
        const int row0 = u.pm * BM + wr * 64 + fr, col0 = u.pn * BM + wc * 32 + 8 * fq;
        const float* bb = bd + (size_t)u.e * DM + col0;
        f32x4 bv[2][2];
#pragma unroll
        for (int bj = 0; bj < 2; ++bj)
#pragma unroll
            for (int n = 0; n < 2; ++n) bv[bj][n] = *(const f32x4*)(bb + bj * HALF + 4 * n);
#pragma unroll
        for (int ai = 0; ai < 2; ++ai)
#pragma unroll
            for (int m = 0; m < 4; ++m) { bf16_t* rowp = O + (size_t)(row0 + ai * HALF + m * 16) * DM + col0;
#pragma unroll
                for (int bj = 0; bj < 2; ++bj) { const f32x4 v0 = acc[ai][bj][m][0] + bv[bj][0], v1 = acc[ai][bj][m][1] + bv[bj][1];
                    u32x4 w; w.x = cvt_pk_bf16(v0[0], v0[1]); w.y = cvt_pk_bf16(v0[2], v0[3]); w.z = cvt_pk_bf16(v1[0], v1[1]); w.w = cvt_pk_bf16(v1[2], v1[3]);
                    *(u32x4*)(rowp + bj * HALF) = w; } }
    }
};
}

#define XB_TMO      128
#define XB_XCNT(j)  (256  + 64 * (j))
#define XB_XSUB(j)  (1280 + 64 * (j))
#define XB_XGEN(j)  (2304 + 64 * (j))
#define XB_TOP      3328
#define XB_TOPGEN   3392
#define XCD_BAR_WORDS 3456
#define XB_SPIN_CAP (1u << 22)
__device__ __forceinline__ unsigned xb_ld(unsigned* p)              { return __hip_atomic_load(p, __ATOMIC_RELAXED, __HIP_MEMORY_SCOPE_AGENT); }
__device__ __forceinline__ unsigned xb_add(unsigned* p, unsigned v) { return __hip_atomic_fetch_add(p, v, __ATOMIC_RELAXED, __HIP_MEMORY_SCOPE_AGENT); }
__device__ __forceinline__ unsigned xb_xcc_id() { return (unsigned)__builtin_amdgcn_s_getreg((3 << 11) | 20) & 0xFu; }
#define XB_SPIN(cond, bar) do { unsigned _sp = 0; while (cond) { __builtin_amdgcn_s_sleep(1); \
    if ((++_sp & 255u) == 0u) { if (xb_ld(&(bar)[XB_TMO])) break; if (_sp > XB_SPIN_CAP) { atomicAdd(&(bar)[XB_TMO], 1u); break; } } } } while (0)
struct XcdBarrier { unsigned* bar; unsigned x; volatile LAS unsigned* st; };
__device__ __forceinline__ XcdBarrier xcd_barrier_post(unsigned* bar, volatile LAS unsigned* st) {
    XcdBarrier b; b.bar = bar; b.x = xb_xcc_id(); b.st = st;
    if (threadIdx.x == 0) (void)xb_add(&bar[XB_XCNT(b.x)], 1u);
    return b;
}
__device__ __forceinline__ void xcd_barrier_complete(unsigned* bar, unsigned x, unsigned& nloc, unsigned& nx) {
    const unsigned G = gridDim.x * gridDim.y * gridDim.z;
    unsigned sum, cnt, mine, sp = 0u;
    for (;;) {
        sum = 0u; cnt = 0u; mine = 0u;
#pragma unroll
        for (unsigned j = 0; j < 16; ++j) { const unsigned c = xb_ld(&bar[XB_XCNT(j)]); sum += c; cnt += (c > 0u) ? 1u : 0u; mine = (j == x) ? c : mine; }
        if (sum == G) break;
        __builtin_amdgcn_s_sleep(1);
        if ((++sp & 255u) == 0u) { if (xb_ld(&bar[XB_TMO])) break; if (sp > XB_SPIN_CAP) { atomicAdd(&bar[XB_TMO], 1u); break; } }
    }
    nloc = mine > 0u ? mine : 1u; nx = cnt > 0u ? cnt : 1u;
}
__device__ __forceinline__ void xcd_barrier(const XcdBarrier& b) {
    asm volatile("s_waitcnt vmcnt(0)" ::: "memory");
    __syncthreads();
    if (threadIdx.x == 0) {
        unsigned* bar = b.bar;
        __builtin_amdgcn_s_waitcnt(0);
        unsigned nloc = b.st[0], nx = b.st[1];
        if (nloc == 0u) { xcd_barrier_complete(bar, b.x, nloc, nx); b.st[0] = nloc; b.st[1] = nx; }
        const unsigned old = xb_add(&bar[XB_XSUB(b.x)], 1u);
        const unsigned gen = old / nloc;
        if (old + 1u == (gen + 1u) * nloc) {
            __builtin_amdgcn_fence(__ATOMIC_RELEASE, "agent");
            asm volatile("s_waitcnt vmcnt(0)" ::: "memory");
            const unsigned og = xb_add(&bar[XB_TOP], 1u);
            const unsigned tg = og / nx;
            if (og + 1u == (tg + 1u) * nx) xb_add(&bar[XB_TOPGEN], 1u);
            else XB_SPIN(xb_ld(&bar[XB_TOPGEN]) == tg, bar);
            __builtin_amdgcn_fence(__ATOMIC_ACQUIRE, "agent");
            xb_add(&bar[XB_XGEN(b.x)], 1u);
            asm volatile("s_waitcnt vmcnt(0)" ::: "memory");
        } else {
            XB_SPIN(xb_ld(&bar[XB_XGEN(b.x)]) == gen, bar);
            __builtin_amdgcn_fence(__ATOMIC_ACQUIRE, "agent");
            asm volatile("s_waitcnt vmcnt(0)" ::: "memory");
        }
    }
    __syncthreads();
}

template <int NN, bool GU>
struct MoeOrder {
    const LAS int* UL; const LAS int* PS; int n; const char* A; const char* B;
    __device__ __forceinline__ bool next(int i, pg8::Unit& u) const {
        if (i >= n) return false;
        const int w = __builtin_amdgcn_readfirstlane(UL[i]); const int e = w & 255, rt = (w >> 8) & 255, pn = w >> 16;
        const int ps = __builtin_amdgcn_readfirstlane(PS[e]);
        u.e = e; u.pn = pn; u.pm = (ps >> 8) + rt; u.slot = i;
        if (GU) { u.a = A; u.b = B + ((size_t)e * 2 * FF + (size_t)pn * 256) * DM * 2; }
        else { u.a = A + (size_t)u.pm * 256 * FF * 2; u.b = B + ((size_t)e * DM + (size_t)pn * 256) * FF * 2; }
        return true;
    }
};
template <int NN>
__device__ __forceinline__ int moe_build_units(LAS unsigned char* lds, const unsigned* ctl, int G, int c) {
    LAS int* UL = (LAS int*)(lds + TAB_UL); LAS int* PS = (LAS int*)(lds + TAB_PS); LAS int* CN = (LAS int*)(lds + TAB_CN); LAS int* NU = (LAS int*)(lds + TAB_NU); LAS int* UC = (LAS int*)(lds + TAB_UC);
    __syncthreads();
    if (threadIdx.x == 0) {
        int a = 0, uc = 0;
        for (int e = 0; e < NE; ++e) { const int cnt = (int)__hip_atomic_load(ctl + CW_CNT + e, RLX_AGENT); CN[e] = cnt; PS[e] = a; UC[e] = uc; const int nt = (cnt + 255) >> 8; a += nt << 8; uc += nt * NN; }
        PS[NE] = a; UC[NE] = uc;
        const int nwg = uc; int n = 0;
        for (int i = 0;; ++i) { const long L = (long)i * G + c; if (L >= nwg || n >= 20) break;
            const int wgid = pg8::xcd_remap((int)L, nwg);
            int e = 0; while (UC[e + 1] <= wgid) ++e;
            const int l = wgid - UC[e], nte = (CN[e] + 255) >> 8;
            const int nig = pg8::WGM * NN, gid = l / nig, fm = gid * pg8::WGM, gsz = (nte - fm) < pg8::WGM ? (nte - fm) : pg8::WGM;
            const int rt = fm + ((l % nig) % gsz), pn = (l % nig) / gsz;
            UL[n++] = e | (rt << 8) | (pn << 16); }
        NU[0] = n;
    }
    __syncthreads();
    return __builtin_amdgcn_readfirstlane(NU[0]);
}

namespace att {
using f32x16 = __attribute__((ext_vector_type(16))) float;
using s16x4 = __attribute__((ext_vector_type(4))) short;
constexpr int NW = 8, QBLK = 32, KVBLK = 64, LDQK = 64, LDV = 128;
constexpr int SHM_V = KVBLK * 128 * 2, SHM_K = KVBLK * 64 * 2;
constexpr int NSLOT = 3, OFF_V = 0, OFF_ST = NSLOT * SHM_V, OFF_K = 132096, OFF_WS = OFF_K + NSLOT * SHM_K, OFF_BT = OFF_WS + NW * 64 * 4, ATT_LDS_END = OFF_BT + 1024;
static_assert(OFF_ST + NW * 8192 <= 131072 && ATT_LDS_END <= 163840, "attention LDS map");
constexpr float THRL = 8.f;
#define KSWZ(row, colB) ((row) * 128 + ((colB) ^ ((((row) >> 1) & 7) << 4)))
#define SBAR() __builtin_amdgcn_sched_barrier(0)
__device__ __forceinline__ int crow(int r, int hi) { return (r & 3) + 8 * (r >> 2) + 4 * hi; }
__device__ __forceinline__ unsigned cvtpk(float lo, float hi) { unsigned r; asm volatile("v_cvt_pk_bf16_f32 %0, %1, %2" : "=v"(r) : "v"(lo), "v"(hi)); return r; }

__device__ __forceinline__ void partialSM(f32x16& p0, f32x16& p1, float& m_reg, float& alpha) {
  float pmax = p0[0];
#pragma unroll
  for (int r = 1; r < 16; ++r) pmax = fmaxf(pmax, p0[r]);
#pragma unroll
  for (int r = 0; r < 16; ++r) pmax = fmaxf(pmax, p1[r]);
  { auto rr = __builtin_amdgcn_permlane32_swap(__float_as_uint(pmax), __float_as_uint(pmax), false, false);
    pmax = fmaxf(__uint_as_float(rr[0]), __uint_as_float(rr[1])); }
  float mn;
  if (__builtin_expect(__all(pmax - m_reg <= THRL), 1)) { mn = m_reg; alpha = 1.f; }
  else { mn = fmaxf(m_reg, pmax); alpha = __builtin_amdgcn_exp2f(m_reg - mn); m_reg = mn; }
#pragma unroll
  for (int r = 0; r < 16; ++r) p0[r] = p0[r] - mn;
#pragma unroll
  for (int r = 0; r < 16; ++r) p1[r] = p1[r] - mn;
#pragma unroll
  for (int r = 0; r < 16; ++r) p0[r] = __builtin_amdgcn_exp2f(p0[r]);
}
__device__ __forceinline__ void finishSM(f32x16& p0, f32x16& p1, float alpha, float& l_reg, bf16x8& pa0, bf16x8& pa1, bf16x8& pa2, bf16x8& pa3) {
#pragma unroll
  for (int r = 0; r < 16; ++r) p1[r] = __builtin_amdgcn_exp2f(p1[r]);
  float ps = 0;
#pragma unroll
  for (int r = 0; r < 16; ++r) ps += p0[r];
#pragma unroll
  for (int r = 0; r < 16; ++r) ps += p1[r];
  { auto rr = __builtin_amdgcn_permlane32_swap(__float_as_uint(ps), __float_as_uint(ps), false, false);
    ps = __uint_as_float(rr[0]) + __uint_as_float(rr[1]); }
  l_reg = l_reg * alpha + ps;
#define PK4(P, BASE, OUT) do { unsigned a0 = cvtpk(P[BASE + 0], P[BASE + 1]), a1 = cvtpk(P[BASE + 2], P[BASE + 3]);   \
    unsigned b0 = cvtpk(P[BASE + 4], P[BASE + 5]), b1 = cvtpk(P[BASE + 6], P[BASE + 7]);                              \
    auto r0 = __builtin_amdgcn_permlane32_swap(a0, b0, false, false); auto r1 = __builtin_amdgcn_permlane32_swap(a1, b1, false, false); \
    u32x4 w = {r0[0], r1[0], r0[1], r1[1]}; OUT = *reinterpret_cast<bf16x8*>(&w); } while (0)
  PK4(p0, 0, pa0); PK4(p0, 8, pa1); PK4(p1, 0, pa2); PK4(p1, 8, pa3);
#undef PK4
}
__device__ __forceinline__ void qkt(f32x16& p0, f32x16& p1, const char* Ks, const bf16x8* qr, int r32, int hi) {
  p0 = f32x16{}; p1 = f32x16{};
#pragma unroll
  for (int d0 = 0; d0 < 4; ++d0) { const int cb = (d0 * 16 + hi * 8) * 2;
    const bf16x8 b0 = *reinterpret_cast<const bf16x8*>(Ks + KSWZ(r32, cb));
    const bf16x8 b1 = *reinterpret_cast<const bf16x8*>(Ks + KSWZ(32 + r32, cb));
    p0 = __builtin_amdgcn_mfma_f32_32x32x16_bf16(b0, qr[d0], p0, 0, 0, 0);
    p1 = __builtin_amdgcn_mfma_f32_32x32x16_bf16(b1, qr[d0], p1, 0, 0, 0); }
}
__device__ __forceinline__ int v_st(int k, int c) { const int kk = (k & ~0xC) | ((k & 4) << 1) | ((k & 8) >> 1); return ((kk >> 3) * 4 + (c >> 5)) * 512 + ((kk & 7) * 32 + (c & 31)) * 2; }
__device__ __forceinline__ int v_rd_base(int lane) { return ((lane & 3) << 3) | (((lane >> 2) & 3) << 6) | (((lane >> 4) & 1) << 5) | (((lane >> 5) & 1) << 8); }
constexpr int v_rd_off(int d0, int ks, int half) { return d0 * 512 + ks * 4096 + half * 2048; }
template <int OFF> __device__ __forceinline__ s16x4 tr_read(int vb) {
  s16x4 r; asm volatile("ds_read_b64_tr_b16 %0, %1 offset:%2" : "=&v"(r) : "v"(vb), "i"(OFF) : "memory"); return r;
}
typedef short v4i16_t __attribute__((ext_vector_type(4)));
template <int OFF> __device__ __forceinline__ s16x4 tr_rd(int vb) {
  return __builtin_bit_cast(s16x4, __builtin_amdgcn_ds_read_tr16_b64_v4i16((__attribute__((address_space(3))) v4i16_t*)(unsigned)(vb + OFF)));
}
template <int D0> __device__ __forceinline__ void pv_one(f32x16& od, int vb, bf16x8 pa0, bf16x8 pa1, bf16x8 pa2, bf16x8 pa3) {
  const s16x4 l0 = tr_rd<v_rd_off(D0, 0, 0)>(vb), h0 = tr_rd<v_rd_off(D0, 0, 1)>(vb), l1 = tr_rd<v_rd_off(D0, 1, 0)>(vb), h1 = tr_rd<v_rd_off(D0, 1, 1)>(vb);
  const s16x4 l2 = tr_rd<v_rd_off(D0, 2, 0)>(vb), h2 = tr_rd<v_rd_off(D0, 2, 1)>(vb), l3 = tr_rd<v_rd_off(D0, 3, 0)>(vb), h3 = tr_rd<v_rd_off(D0, 3, 1)>(vb);
#define PK(L, H) (bf16x8){L[0], L[1], L[2], L[3], H[0], H[1], H[2], H[3]}
  od = __builtin_amdgcn_mfma_f32_32x32x16_bf16(pa0, PK(l0, h0), od, 0, 0, 0);
  od = __builtin_amdgcn_mfma_f32_32x32x16_bf16(pa1, PK(l1, h1), od, 0, 0, 0);
  od = __builtin_amdgcn_mfma_f32_32x32x16_bf16(pa2, PK(l2, h2), od, 0, 0, 0);
  od = __builtin_amdgcn_mfma_f32_32x32x16_bf16(pa3, PK(l3, h3), od, 0, 0, 0);
#undef PK
}
#define PV_RD(D0, L0, H0, L1, H1, L2, H2, L3, H3) do { L0 = tr_rd<v_rd_off(D0, 0, 0)>(vb); H0 = tr_rd<v_rd_off(D0, 0, 1)>(vb); L1 = tr_rd<v_rd_off(D0, 1, 0)>(vb); H1 = tr_rd<v_rd_off(D0, 1, 1)>(vb); \
    L2 = tr_rd<v_rd_off(D0, 2, 0)>(vb); H2 = tr_rd<v_rd_off(D0, 2, 1)>(vb); L3 = tr_rd<v_rd_off(D0, 3, 0)>(vb); H3 = tr_rd<v_rd_off(D0, 3, 1)>(vb); } while (0)
#define PKV(L, H) (bf16x8){L[0], L[1], L[2], L[3], H[0], H[1], H[2], H[3]}
#define PV_MM(OD, L0, H0, L1, H1, L2, H2, L3, H3) do { OD = __builtin_amdgcn_mfma_f32_32x32x16_bf16(pa0, PKV(L0, H0), OD, 0, 0, 0); OD = __builtin_amdgcn_mfma_f32_32x32x16_bf16(pa1, PKV(L1, H1), OD, 0, 0, 0); \
    OD = __builtin_amdgcn_mfma_f32_32x32x16_bf16(pa2, PKV(L2, H2), OD, 0, 0, 0); OD = __builtin_amdgcn_mfma_f32_32x32x16_bf16(pa3, PKV(L3, H3), OD, 0, 0, 0); } while (0)
__device__ __forceinline__ void pv_d0(f32x16* o, int vb, bf16x8 pa0, bf16x8 pa1, bf16x8 pa2, bf16x8 pa3) {
  s16x4 a0, a1, a2, a3, a4, a5, a6, a7, b0, b1, b2, b3, b4, b5, b6, b7;
  PV_RD(0, a0, a1, a2, a3, a4, a5, a6, a7); PV_RD(1, b0, b1, b2, b3, b4, b5, b6, b7); SBAR();
  PV_MM(o[0], a0, a1, a2, a3, a4, a5, a6, a7); SBAR(); PV_RD(2, a0, a1, a2, a3, a4, a5, a6, a7); SBAR();
  PV_MM(o[1], b0, b1, b2, b3, b4, b5, b6, b7); SBAR(); PV_RD(3, b0, b1, b2, b3, b4, b5, b6, b7); SBAR();
  PV_MM(o[2], a0, a1, a2, a3, a4, a5, a6, a7); SBAR();
  PV_MM(o[3], b0, b1, b2, b3, b4, b5, b6, b7);
}
#undef PV_RD
#undef PV_MM
#undef PKV
__device__ __forceinline__ void bias_mask(f32x16& p0, f32x16& p1, int j, int cw, const float* bt, int qoff, int r32, int hi) {
  if (j > cw) {
#pragma unroll
    for (int r = 0; r < 16; ++r) { p0[r] = -INFINITY; p1[r] = -INFINITY; }
  } else if (j >= cw - 2) {
    const float* b = bt + (64 * (j - cw) + 192 - qoff - r32 + 4 * hi);
#pragma unroll
    for (int r = 0; r < 16; ++r) { p0[r] += b[(r & 3) + 8 * (r >> 2)]; p1[r] += b[32 + (r & 3) + 8 * (r >> 2)]; }
  }
}

__device__ __forceinline__ void glds16(const void* gsrc, unsigned lds_dst) { unsigned keep;
  asm volatile("s_mov_b32 %0, m0\n\ts_mov_b32 m0, %2\n\ts_nop 0\n\tglobal_load_lds_dwordx4 %1, off\n\ts_mov_b32 m0, %0" : "=&s"(keep) : "v"(gsrc), "s"(lds_dst) : "memory"); }
__device__ __forceinline__ void attn_unit(const Params& p, int b, int h, int m, int qb, float lam, char* lds, unsigned& g_tacc) {
  const bf16_t* PR = (const bf16_t*)(p.ws + WS_PROJ);
  int tid_ = threadIdx.x; asm volatile("" : "+v"(tid_));
  const int tid = tid_, wid = __builtin_amdgcn_readfirstlane(tid >> 6), lane = tid & 63, r32 = lane & 31, hi = lane >> 5;
  char* V_lds = lds + OFF_V; char* K_lds = lds + OFF_K;
  const unsigned ldsb = (unsigned)(uintptr_t)lds;
  float* ws = (float*)(lds + OFF_WS) + wid * 64; float* li_l = ws; float* al_l = ws + 32; float* bt = (float*)(lds + OFF_BT);
  bf16_t* stash = (bf16_t*)(lds + OFF_ST + wid * 8192);
  __syncthreads();
  if (m == 0 && tid < 256) bt[tid] = (p.rel_bias[t5_bucket(tid - 192) * 4 + h] - p.rel_bias[15 * 4 + h]) * LOG2E;
  const bf16_t* Qb = PR + 4 * pg8::SEC + ((size_t)((b * 4 + h) * 2 + m) * SEQ + qb * 256) * LDQK;
  const bf16_t* Kh = PR + 5 * pg8::SEC + (size_t)((b * 4 + h) * 2 + m) * SEQ * LDQK;
  const bf16_t* Vh = PR + 6 * pg8::SEC + (size_t)(b * 4 + h) * SEQ * LDV;
  const int cw = 4 * qb + (wid >> 1), qoff = 32 * (wid & 1);
  float l_reg = 0; f32x16 o[4] = {}; bf16x8 qr[4];
  const int krow = wid * 8 + (lane >> 3), kch = (lane & 7) ^ ((krow >> 1) & 7);
  const bf16_t* ksrc = Kh + (size_t)krow * LDQK + kch * 8;
  const bf16_t* vsrc0; const bf16_t* vsrc1;
  { const int sub0 = (wid * 2) * 2 + (lane >> 5), kk0 = (sub0 >> 2) * 8 + ((lane & 31) >> 2), k0_ = (kk0 & ~0xC) | ((kk0 & 4) << 1) | ((kk0 & 8) >> 1);
    vsrc0 = Vh + (size_t)k0_ * LDV + (sub0 & 3) * 32 + (lane & 3) * 8;
    const int sub1 = (wid * 2 + 1) * 2 + (lane >> 5), kk1 = (sub1 >> 2) * 8 + ((lane & 31) >> 2), k1_ = (kk1 & ~0xC) | ((kk1 & 4) << 1) | ((kk1 & 8) >> 1);
    vsrc1 = Vh + (size_t)k1_ * LDV + (sub1 & 3) * 32 + (lane & 3) * 8; }
#define DMA_K(tile, slot) glds16(ksrc + (size_t)(tile) * (KVBLK * LDQK), (unsigned)__builtin_amdgcn_readfirstlane((int)(ldsb + OFF_K + (slot) * SHM_K + wid * 1024)))
#define DMA_V(tile, slot) do { glds16(vsrc0 + (size_t)(tile) * (KVBLK * LDV), (unsigned)__builtin_amdgcn_readfirstlane((int)(ldsb + OFF_V + (slot) * SHM_V + wid * 2048))); \
    glds16(vsrc1 + (size_t)(tile) * (KVBLK * LDV), (unsigned)__builtin_amdgcn_readfirstlane((int)(ldsb + OFF_V + (slot) * SHM_V + wid * 2048 + 1024))); } while (0)
#define WAIT_BAR(N) asm volatile("s_waitcnt vmcnt(" #N ") lgkmcnt(0)\n\ts_barrier" ::: "memory")
  DMA_K(0, 0); DMA_V(0, 0); DMA_K(1, 1);
  const bf16_t* Qw = Qb + (size_t)(wid * QBLK + r32) * LDQK + hi * 8;
#pragma unroll
  for (int d0 = 0; d0 < 4; ++d0) qr[d0] = *reinterpret_cast<const bf16x8*>(Qw + d0 * 16);
  const int vb0 = (int)(uintptr_t)V_lds + v_rd_base(lane);
#define RESC(a) do { if (__any((a) < 1.f)) { if (hi == 0) al_l[r32] = (a); asm volatile("s_waitcnt lgkmcnt(0)" ::: "memory"); \
    _Pragma("unroll") for (int d = 0; d < 4; ++d) _Pragma("unroll") for (int r = 0; r < 16; ++r) o[d][r] *= al_l[crow(r, hi)]; } } while (0)
  f32x16 pA0, pA1, pB0, pB1; u32x4 pw0, pw1, pw2, pw3; const int NT = 4 * qb + 4;
  float mhat = 0.f; f32x16 negm = f32x16{}; asm volatile("" : "+v"(negm));
  bool resc = false;
  WAIT_BAR(0);
  DMA_K(2, 2); DMA_V(1, 1);
#define PIN(x) asm volatile("" : "+v"(x))
#define MX3(a, b, c) __builtin_fmaxf(__builtin_fmaxf((a), (b)), (c))
#define ROWMAX(C0, C1, rm) do { float a_ = MX3(C0[0], C0[1], C1[0]), b_ = MX3(C0[2], C0[3], C1[1]); a_ = MX3(a_, C1[2], C1[3]); \
    _Pragma("unroll") for (int r = 4; r < 16; r += 4) { a_ = MX3(a_, C0[r], C0[r + 1]); b_ = MX3(b_, C0[r + 2], C0[r + 3]); a_ = MX3(a_, C1[r], C1[r + 1]); b_ = MX3(b_, C1[r + 2], C1[r + 3]); } \
    rm = __builtin_fmaxf(a_, b_); { auto rr_ = __builtin_amdgcn_permlane32_swap(__float_as_uint(rm), __float_as_uint(rm), false, false); rm = __builtin_fmaxf(__uint_as_float(rr_[0]), __uint_as_float(rr_[1])); } } while (0)
#define RESCALE(C0, C1, dl) do { mhat += (dl); \
    _Pragma("unroll") for (int r = 0; r < 16; ++r) { C0[r] -= (dl); C1[r] -= (dl); } \
    _Pragma("unroll") for (int r = 0; r < 16; ++r) negm[r] = -mhat; PIN(negm); } while (0)
  { const char* Ks = K_lds;
#pragma unroll
    for (int d0 = 0; d0 < 4; ++d0) { const int cb = (d0 * 16 + hi * 8) * 2;
      const bf16x8 b0 = *reinterpret_cast<const bf16x8*>(Ks + KSWZ(r32, cb)), b1 = *reinterpret_cast<const bf16x8*>(Ks + KSWZ(32 + r32, cb));
      if (d0 == 0) { pA0 = __builtin_amdgcn_mfma_f32_32x32x16_bf16(b0, qr[0], negm, 0, 0, 0); pA1 = __builtin_amdgcn_mfma_f32_32x32x16_bf16(b1, qr[0], negm, 0, 0, 0); }
      else { pA0 = __builtin_amdgcn_mfma_f32_32x32x16_bf16(b0, qr[d0], pA0, 0, 0, 0); pA1 = __builtin_amdgcn_mfma_f32_32x32x16_bf16(b1, qr[d0], pA1, 0, 0, 0); } }
    bias_mask(pA0, pA1, 0, cw, bt, qoff, r32, hi);
    float rm; ROWMAX(pA0, pA1, rm); RESCALE(pA0, pA1, rm);
#pragma unroll
    for (int r = 0; r < 16; ++r) { pA0[r] = __builtin_amdgcn_exp2f(pA0[r]); pA1[r] = __builtin_amdgcn_exp2f(pA1[r]); } }
  int sk = 1, sv = 0;
  const bool lead = wid < 4;
#if TSEL >= 20 && TSEL < 30
  unsigned long long tq_;
#define TB() (tq_ = __builtin_amdgcn_s_memrealtime())
#define TE(k) do { if ((k) == TSEL - 20 && blockIdx.x == 0 && wid == PWAVE) g_tacc += (unsigned)(__builtin_amdgcn_s_memrealtime() - tq_); } while (0)
#else
#define TB() do {} while (0)
#define TE(k) do {} while (0)
#endif
#define WB_A(j) do { if ((j) + 2 >= NT) WAIT_BAR(0); else if (lead) WAIT_BAR(5); else WAIT_BAR(3); } while (0)
#define WB_B(j) do { if ((j) + 2 >= NT) WAIT_BAR(0); else if (lead) WAIT_BAR(4); else WAIT_BAR(3); } while (0)
#define KF(i) (*reinterpret_cast<const bf16x8*>(Kt_ + KSWZ(((i) & 1) * 32 + r32, ((((i) >> 1) * 16 + hi * 8) * 2))))
#define CVT(P, B) cvtpk(P[B], P[(B) + 1])
#define GAPA(MF, A0, A1, A2, A3, P, BA, BB, RO) do { MF; sacc += A0; sacc += A1; sacc += A2; sacc += A3; PIN(sacc); \
    { const unsigned ca_ = CVT(P, BA), cb_ = CVT(P, BB); auto rr_ = __builtin_amdgcn_permlane32_swap(ca_, cb_, false, false); RO##l = rr_[0]; RO##h = rr_[1]; } SBAR(); } while (0)
#define HALF_A(j, C0, C1, P0, P1, GQ) do { TB(); WB_A(j); TE(0); TB(); \
    { const int sp = (sk == 0) ? 2 : sk - 1; if ((j) + 2 < NT) DMA_K((j) + 2, sp); } \
    const char* Kt_ = K_lds + sk * SHM_K; unsigned r0l, r0h, r1l, r1h; float sacc = P0[0] + P0[1]; SBAR(); \
    if (GQ) { const bf16x8 kf0 = KF(0), kf1 = KF(1), kf2 = KF(2), kf3 = KF(3), kf4 = KF(4), kf5 = KF(5), kf6 = KF(6), kf7 = KF(7); SBAR(); \
      GAPA(C0 = __builtin_amdgcn_mfma_f32_32x32x16_bf16(kf0, qr[0], negm, 0, 0, 0), P0[2], P0[3], P0[4], P0[5], P0, 0, 4, r0); \
      GAPA(C1 = __builtin_amdgcn_mfma_f32_32x32x16_bf16(kf1, qr[0], negm, 0, 0, 0), P0[6], P0[7], P0[8], P0[9], P0, 2, 6, r1); \
      pw0 = (u32x4){r0l, r1l, r0h, r1h}; \
      GAPA(C0 = __builtin_amdgcn_mfma_f32_32x32x16_bf16(kf2, qr[1], C0, 0, 0, 0), P0[10], P0[11], P0[12], P0[13], P0, 8, 12, r0); \
      GAPA(C1 = __builtin_amdgcn_mfma_f32_32x32x16_bf16(kf3, qr[1], C1, 0, 0, 0), P0[14], P0[15], P1[0], P1[1], P0, 10, 14, r1); \
      pw1 = (u32x4){r0l, r1l, r0h, r1h}; \
      GAPA(C0 = __builtin_amdgcn_mfma_f32_32x32x16_bf16(kf4, qr[2], C0, 0, 0, 0), P1[2], P1[3], P1[4], P1[5], P1, 0, 4, r0); \
      GAPA(C1 = __builtin_amdgcn_mfma_f32_32x32x16_bf16(kf5, qr[2], C1, 0, 0, 0), P1[6], P1[7], P1[8], P1[9], P1, 2, 6, r1); \
      pw2 = (u32x4){r0l, r1l, r0h, r1h}; \
      GAPA(C0 = __builtin_amdgcn_mfma_f32_32x32x16_bf16(kf6, qr[3], C0, 0, 0, 0), P1[10], P1[11], P1[12], P1[13], P1, 8, 12, r0); \
      GAPA(C1 = __builtin_amdgcn_mfma_f32_32x32x16_bf16(kf7, qr[3], C1, 0, 0, 0), P1[14], P1[15], 0.f, 0.f, P1, 10, 14, r1); \
      pw3 = (u32x4){r0l, r1l, r0h, r1h}; \
    } else { \
      GAPA((void)0, P0[2], P0[3], P0[4], P0[5], P0, 0, 4, r0); GAPA((void)0, P0[6], P0[7], P0[8], P0[9], P0, 2, 6, r1); pw0 = (u32x4){r0l, r1l, r0h, r1h}; \
      GAPA((void)0, P0[10], P0[11], P0[12], P0[13], P0, 8, 12, r0); GAPA((void)0, P0[14], P0[15], P1[0], P1[1], P0, 10, 14, r1); pw1 = (u32x4){r0l, r1l, r0h, r1h}; \
      GAPA((void)0, P1[2], P1[3], P1[4], P1[5], P1, 0, 4, r0); GAPA((void)0, P1[6], P1[7], P1[8], P1[9], P1, 2, 6, r1); pw2 = (u32x4){r0l, r1l, r0h, r1h}; \
      GAPA((void)0, P1[10], P1[11], P1[12], P1[13], P1, 8, 12, r0); GAPA((void)0, P1[14], P1[15], 0.f, 0.f, P1, 10, 14, r1); pw3 = (u32x4){r0l, r1l, r0h, r1h}; \
    } \
    l_reg += sacc; resc = false; \
    if (GQ) { bias_mask(C0, C1, (j), cw, bt, qoff, r32, hi); float rm; ROWMAX(C0, C1, rm); \
      if (__builtin_expect(__any(rm > THRL), 0)) { const float dl = __builtin_fmaxf(rm, 0.f); RESCALE(C0, C1, dl); const float f = __builtin_amdgcn_exp2f(-dl); l_reg *= f; if (hi == 0) al_l[r32] = f; resc = true; } } \
    TE(1); } while (0)
#define PAF(k) __builtin_bit_cast(bf16x8, pw##k)
#define VFR(S, i) (bf16x8){S##l##i[0], S##l##i[1], S##l##i[2], S##l##i[3], S##h##i[0], S##h##i[1], S##h##i[2], S##h##i[3]}
#define VRD(S, D0, i) do { S##l##i = tr_rd<v_rd_off(D0, i, 0)>(vb_); S##h##i = tr_rd<v_rd_off(D0, i, 1)>(vb_); } while (0)
#define EX2(C, B) do { C[B] = __builtin_amdgcn_exp2f(C[B]); C[(B) + 1] = __builtin_amdgcn_exp2f(C[(B) + 1]); PIN(C); } while (0)
#define GAPB(OD, K, FR, EXS, RD) do { OD = __builtin_amdgcn_mfma_f32_32x32x16_bf16(PAF(K), FR, OD, 0, 0, 0); EXS; RD; SBAR(); } while (0)
#define HALF_B(j, C0, C1, GP) do { TB(); WB_B(j); TE(0); TB(); \
    { const int sn = (sk == 2) ? 0 : sk + 1; if ((j) + 1 < NT) DMA_V((j) + 1, sn); } \
    const int vb_ = vb0 + sv * SHM_V; s16x4 Fl0, Fh0, Fl1, Fh1, Fl2, Fh2, Fl3, Fh3, Gl0, Gh0, Gl1, Gh1, Gl2, Gh2, Gl3, Gh3; \
    VRD(F, 0, 0); VRD(F, 0, 1); VRD(F, 0, 2); VRD(F, 0, 3); SBAR(); \
    SBAR(); \
    GAPB(o[0], 0, VFR(F, 0), if (GP) EX2(C0, 0), VRD(G, 1, 0)); GAPB(o[0], 1, VFR(F, 1), if (GP) EX2(C0, 2), VRD(G, 1, 1)); \
    GAPB(o[0], 2, VFR(F, 2), if (GP) EX2(C0, 4), VRD(G, 1, 2)); GAPB(o[0], 3, VFR(F, 3), if (GP) EX2(C0, 6), VRD(G, 1, 3)); \
    GAPB(o[1], 0, VFR(G, 0), if (GP) EX2(C0, 8), VRD(F, 2, 0)); GAPB(o[1], 1, VFR(G, 1), if (GP) EX2(C0, 10), VRD(F, 2, 1)); \
    GAPB(o[1], 2, VFR(G, 2), if (GP) EX2(C0, 12), VRD(F, 2, 2)); GAPB(o[1], 3, VFR(G, 3), if (GP) EX2(C0, 14), VRD(F, 2, 3)); \
    GAPB(o[2], 0, VFR(F, 0), if (GP) EX2(C1, 0), VRD(G, 3, 0)); GAPB(o[2], 1, VFR(F, 1), if (GP) EX2(C1, 2), VRD(G, 3, 1)); \
    GAPB(o[2], 2, VFR(F, 2), if (GP) EX2(C1, 4), VRD(G, 3, 2)); GAPB(o[2], 3, VFR(F, 3), if (GP) EX2(C1, 6), VRD(G, 3, 3)); \
    GAPB(o[3], 0, VFR(G, 0), if (GP) EX2(C1, 8), (void)0); GAPB(o[3], 1, VFR(G, 1), if (GP) EX2(C1, 10), (void)0); \
    GAPB(o[3], 2, VFR(G, 2), if (GP) EX2(C1, 12), (void)0); GAPB(o[3], 3, VFR(G, 3), if (GP) EX2(C1, 14), (void)0); \
    if (resc) { asm volatile("s_waitcnt lgkmcnt(0)" ::: "memory"); \
      _Pragma("unroll") for (int d = 0; d < 4; ++d) _Pragma("unroll") for (int r = 0; r < 16; ++r) o[d][r] *= al_l[crow(r, hi)]; } \
    TE(2); sv = sk; sk = (sk == 2) ? 0 : sk + 1; } while (0)
  if (!lead) asm volatile("s_barrier" ::: "memory");
  for (int j = 1; j + 1 < NT; j += 2) {
    HALF_A(j, pB0, pB1, pA0, pA1, true); HALF_B(j, pB0, pB1, true);
    HALF_A(j + 1, pA0, pA1, pB0, pB1, true); HALF_B(j + 1, pA0, pA1, true);
  }
  HALF_A(NT - 1, pB0, pB1, pA0, pA1, true); HALF_B(NT - 1, pB0, pB1, true);
  HALF_A(NT, pA0, pA1, pB0, pB1, false); HALF_B(NT, pA0, pA1, false);
  if (lead) asm volatile("s_waitcnt lgkmcnt(0)\n\ts_barrier" ::: "memory");
  { auto rr_ = __builtin_amdgcn_permlane32_swap(__float_as_uint(l_reg), __float_as_uint(l_reg), false, false); l_reg = __uint_as_float(rr_[0]) + __uint_as_float(rr_[1]); }
#undef HALF_A
#undef HALF_B
#undef GAPA
#undef GAPB
#undef WB_A
#undef WB_B
#undef KF
#undef CVT
#undef PAF
#undef VFR
#undef VRD
#undef EX2
#undef PIN
#undef MX3
#undef ROWMAX
#undef RESCALE
#undef DMA_K
#undef DMA_V
#undef WAIT_BAR
  if (hi == 0) li_l[r32] = l_reg; asm volatile("s_waitcnt lgkmcnt(0)" ::: "memory");
  float rli[16];
#pragma unroll
  for (int r = 0; r < 16; ++r) rli[r] = __builtin_amdgcn_rcpf(li_l[crow(r, hi)]);
  int r32e = r32, hie = hi, lanee = lane; asm volatile("" : "+v"(r32e), "+v"(hie), "+v"(lanee));
  bf16_t* st = stash + r32e;
  if (m == 0) {
#pragma unroll
    for (int r = 0; r < 16; ++r) { const int orow = crow(r, hie);
#pragma unroll
      for (int d0 = 0; d0 < 4; ++d0) st[orow * 128 + d0 * 32] = (bf16_t)f2bf(o[d0][r] * rli[r]); }
  } else {
    float gv[4];
#pragma unroll
    for (int d0 = 0; d0 < 4; ++d0) gv[d0] = p.diff_norm_g[d0 * 32 + r32e] * 0.8f;
#pragma unroll
    for (int r = 0; r < 16; ++r) { const int orow = crow(r, hie); float s = 0.f; float av[4];
#pragma unroll
      for (int d0 = 0; d0 < 4; ++d0) { av[d0] = bf2f(st[orow * 128 + d0 * 32]) - lam * (o[d0][r] * rli[r]); s += av[d0] * av[d0]; }
#pragma unroll
      for (int of = 1; of < 32; of <<= 1) s += __shfl_xor(s, of);
      const float rs = rsqrtf(s * (1.f / 128.f) + EPS);
#pragma unroll
      for (int d0 = 0; d0 < 4; ++d0) st[orow * 128 + d0 * 32] = (bf16_t)f2bf(av[d0] * rs * gv[d0]); }
    asm volatile("s_waitcnt lgkmcnt(0)" ::: "memory");
    bf16_t* Mw = (bf16_t*)(p.ws + WS_MIX) + (size_t)(b * SEQ + qb * 256 + wid * QBLK + (lanee >> 4)) * DM + 512 + h * 128 + (lanee & 15) * 8;
    const bf16_t* sr2 = stash + (lanee >> 4) * 128 + (lanee & 15) * 8;
#pragma unroll
    for (int i = 0; i < 8; ++i) *(u32x4*)(Mw + (size_t)(i * 4) * DM) = *(const u32x4*)(sr2 + i * 4 * 128);
  }
#undef RESC
}
#undef SBAR
#undef KSWZ
}

namespace ml {
using att::f32x16; using att::s16x4; using att::crow; using att::v_st; using att::v_rd_base; using att::v_rd_off; using att::tr_read;
constexpr int ML_Q = 0, ML_K = 16384, ML_V = 32768, ML_KW = 49152, ML_W = 49152, ML_H = 65536, ML_G = 98304;
constexpr float KSCALE = 0.08838834764831845f;
#define QSWZ(row, colB) ((row) * 256 + ((colB) ^ (((row) & 7) << 4)))
#define WSWZ(row, colB) ((row) * 128 + ((colB) ^ ((((row) >> 1) & 7) << 4)))
#define PKF(L, H) (bf16x8){L[0], L[1], L[2], L[3], H[0], H[1], H[2], H[3]}
__device__ __forceinline__ float wave_incl_scan_add(float v, int lane) {
#pragma unroll
  for (int o = 1; o < 64; o <<= 1) { const float t = __shfl_up(v, o); if (lane >= o) v += t; }
  return v;
}
__device__ __forceinline__ float wave_incl_scan_max(float v, int lane) {
#pragma unroll
  for (int o = 1; o < 64; o <<= 1) { const float t = __shfl_up(v, o); if (lane >= o) v = fmaxf(v, t); }
  return v;
}
__device__ __forceinline__ float wave_max(float v) {
#pragma unroll
  for (int o = 1; o < 64; o <<= 1) v = fmaxf(v, __shfl_xor(v, o));
  return v;
}
struct Raw16 { u32x4 r[4][2]; };
__device__ __forceinline__ void raw16_load(const Params& p, Raw16& R, int b, int c, int s, int sec, int h, int d0) {
  const bf16_t* PR = (const bf16_t*)(p.ws + WS_PROJ) + (size_t)sec * pg8::SEC + (size_t)(b * 4 + h) * SEQ * 128;
  const int tl = c * 64 + s;
#pragma unroll
  for (int j = 0; j < 4; ++j) { const int tt = tl - 3 + j;
    if (tt >= 0) { const bf16_t* rp = PR + (size_t)tt * 128 + d0; R.r[j][0] = *(const u32x4*)rp; R.r[j][1] = *(const u32x4*)(rp + 8); }
    else { R.r[j][0] = (u32x4){0u, 0u, 0u, 0u}; R.r[j][1] = (u32x4){0u, 0u, 0u, 0u}; } }
}
__device__ __forceinline__ void conv16_compute(const Params& p, float (&y)[16], const Raw16& R, int cch, int d0) {
#pragma unroll
  for (int q = 0; q < 4; ++q) { const f32x4 bb = *(const f32x4*)(p.conv_b + cch + d0 + 4 * q); y[4 * q] = bb.x; y[4 * q + 1] = bb.y; y[4 * q + 2] = bb.z; y[4 * q + 3] = bb.w; }
#pragma unroll
  for (int j = 0; j < 4; ++j) { const unsigned rw[8] = {R.r[j][0].x, R.r[j][0].y, R.r[j][0].z, R.r[j][0].w, R.r[j][1].x, R.r[j][1].y, R.r[j][1].z, R.r[j][1].w};
#pragma unroll
    for (int q = 0; q < 4; ++q) { const f32x4 w = *(const f32x4*)(p.conv_w + j * 1024 + cch + d0 + 4 * q);
      y[4 * q] += w.x * __uint_as_float(rw[2 * q] << 16); y[4 * q + 1] += w.y * __uint_as_float(rw[2 * q] & 0xffff0000u);
      y[4 * q + 2] += w.z * __uint_as_float(rw[2 * q + 1] << 16); y[4 * q + 3] += w.w * __uint_as_float(rw[2 * q + 1] & 0xffff0000u); } }
#pragma unroll
  for (int i = 0; i < 16; ++i) y[i] = y[i] * __builtin_amdgcn_rcpf(1.f + __builtin_amdgcn_exp2f(-LOG2E * y[i]));
}
__device__ __forceinline__ void conv16(const Params& p, float (&y)[16], int b, int c, int s, int sec, int h, int cch, int d0) {
  Raw16 R; raw16_load(p, R, b, c, s, sec, h, d0); conv16_compute(p, y, R, cch, d0);
}
__device__ __forceinline__ u32x4 pack8(const float* y) { u32x4 w; w.x = pg8::cvt_pk_bf16(y[0], y[1]); w.y = pg8::cvt_pk_bf16(y[2], y[3]); w.z = pg8::cvt_pk_bf16(y[4], y[5]); w.w = pg8::cvt_pk_bf16(y[6], y[7]); return w; }

__device__ __forceinline__ void mlstm_a_item(const Params& p, int item, char* lds) {
  int tid_ = threadIdx.x; asm volatile("" : "+v"(tid_));
  const int tid = tid_, wid = __builtin_amdgcn_readfirstlane(tid >> 6), lane = tid & 63, r32 = lane & 31, hi = lane >> 5;
  const int bh = item / NCH, c = item % NCH, b = bh >> 2, h = bh & 3;
  const bf16_t* PR = (const bf16_t*)(p.ws + WS_PROJ); const float* gates = (const float*)(p.ws + WS_GATES);
  bf16_t* MU = (bf16_t*)(p.ws + WS_MU); float* NU = (float*)(p.ws + MS_NU); float* msc = (float*)(p.ws + MS_MSC);
  float* wgt = (float*)(lds + ML_G);
  __syncthreads();
  if (wid == 0) { const size_t t = (size_t)b * SEQ + c * 64 + lane; const float li = gates[t * 8 + h]; const float lf = log_sigmoid(gates[t * 8 + 4 + h]);
    const float bc = wave_incl_scan_add(lf, lane); const float blast = __shfl(bc, 63); const float g = blast - bc + li; const float gmax = wave_max(g);
    wgt[lane] = __expf(g - gmax); if (lane == 0) { msc[item] = blast; msc[2048 + item] = gmax; } }
  __syncthreads();
  { const int s = tid >> 3, d0 = (tid & 7) * 16; float y[16];
    conv16(p, y, b, c, s, 1, h, 512 + h * 128, d0);
    const float w = wgt[s] * KSCALE;
#pragma unroll
    for (int i = 0; i < 16; ++i) y[i] *= w;
    *(u32x4*)(lds + ML_KW + v_st(s, d0)) = pack8(y); *(u32x4*)(lds + ML_KW + v_st(s, d0 + 8)) = pack8(y + 8);
    const bf16_t* vp = PR + 2 * pg8::SEC + ((size_t)(b * 4 + h) * SEQ + c * 64 + s) * 128 + d0;
    *(u32x4*)(lds + ML_V + v_st(s, d0)) = *(const u32x4*)vp; *(u32x4*)(lds + ML_V + v_st(s, d0 + 8)) = *(const u32x4*)(vp + 8); }
  __syncthreads();
  const int ei = wid >> 1, dj0 = 2 * (wid & 1);
  const int vbV = (int)(uintptr_t)(lds + ML_V) + v_rd_base(lane) + ei * 512, vbK = (int)(uintptr_t)(lds + ML_KW) + v_rd_base(lane) + dj0 * 512;
  f32x16 acc0 = {}, acc1 = {}, accn0 = {}, accn1 = {};
  const bf16x8 ones = {0x3F80, 0x3F80, 0x3F80, 0x3F80, 0x3F80, 0x3F80, 0x3F80, 0x3F80};
#define MLA_STEP(KS) do { const s16x4 al = tr_read<v_rd_off(0, KS, 0)>(vbV), ah = tr_read<v_rd_off(0, KS, 1)>(vbV); \
    const s16x4 b0l = tr_read<v_rd_off(0, KS, 0)>(vbK), b0h = tr_read<v_rd_off(0, KS, 1)>(vbK), b1l = tr_read<v_rd_off(1, KS, 0)>(vbK), b1h = tr_read<v_rd_off(1, KS, 1)>(vbK); \
    asm volatile("s_waitcnt lgkmcnt(0)" ::: "memory"); __builtin_amdgcn_sched_barrier(0); \
    acc0 = __builtin_amdgcn_mfma_f32_32x32x16_bf16(PKF(al, ah), PKF(b0l, b0h), acc0, 0, 0, 0); acc1 = __builtin_amdgcn_mfma_f32_32x32x16_bf16(PKF(al, ah), PKF(b1l, b1h), acc1, 0, 0, 0); \
    if (ei == 0) { accn0 = __builtin_amdgcn_mfma_f32_32x32x16_bf16(ones, PKF(b0l, b0h), accn0, 0, 0, 0); accn1 = __builtin_amdgcn_mfma_f32_32x32x16_bf16(ones, PKF(b1l, b1h), accn1, 0, 0, 0); } } while (0)
  MLA_STEP(0); MLA_STEP(1); MLA_STEP(2); MLA_STEP(3);
#undef MLA_STEP
  bf16_t* uo = MU + (size_t)item * 16384;
#pragma unroll
  for (int r = 0; r < 16; ++r) { const int e = 32 * ei + crow(r, hi);
    uo[e * 128 + 32 * dj0 + r32] = (bf16_t)f2bf(acc0[r]); uo[e * 128 + 32 * (dj0 + 1) + r32] = (bf16_t)f2bf(acc1[r]); }
  if (ei == 0 && hi == 0) { NU[(size_t)item * 128 + 32 * dj0 + r32] = accn0[0]; NU[(size_t)item * 128 + 32 * (dj0 + 1) + r32] = accn1[0]; }
}

__device__ __forceinline__ void mlstm_scan_item(const Params& p, int item, char* lds) {
  float* dec = (float*)(lds + ML_G); float* ac = dec + NCH;
  const unsigned* MU = (const unsigned*)(p.ws + WS_MU); unsigned* MC = (unsigned*)(p.ws + WS_MC);
  const float* NU = (const float*)(p.ws + MS_NU); float* NC = (float*)(p.ws + MS_NC); float* msc = (float*)(p.ws + MS_MSC);
  const int bh = item >> 4, eb = item & 15; const int lane = threadIdx.x & 63;
  __syncthreads();
  if (threadIdx.x < 64) { float Bc = 0.f, pm = 0.f, mcar = 0.f;
    for (int half = 0; half < 2; ++half) { const int c = half * 64 + lane;
      const float bl = msc[bh * NCH + c], gm = msc[2048 + bh * NCH + c];
      const float Bi = Bc + wave_incl_scan_add(bl, lane);
      const float px = fmaxf(pm, wave_incl_scan_max(gm - Bi, lane));
      const float m1 = Bi + px; float m0 = __shfl_up(m1, 1); if (lane == 0) m0 = mcar;
      dec[c] = __expf(bl + m0 - m1); ac[c] = __expf(gm - m1);
      if (eb == 0) msc[4096 + bh * NCH + c] = m0;
      Bc = __shfl(Bi, 63); pm = __shfl(px, 63); mcar = __shfl(m1, 63); } }
  __syncthreads();
  const int idx = eb * 512 + threadIdx.x;
  const bool ndo = (eb == 0 && threadIdx.x < 128);
  float C0 = 0.f, C1 = 0.f, nst = 0.f;
#pragma unroll 16
  for (int c = 0; c < NCH; ++c) { const size_t o = ((size_t)(bh * NCH + c)) * 8192 + idx; const unsigned u = MU[o];
    const size_t on = ((size_t)(bh * NCH + c)) * 128 + (threadIdx.x & 127); const float nu = ndo ? NU[on] : 0.f;
    MC[o] = pk2(C0, C1); C0 = dec[c] * C0 + ac[c] * __uint_as_float(u << 16); C1 = dec[c] * C1 + ac[c] * __uint_as_float(u & 0xffff0000u);
    if (ndo) { NC[on] = nst; nst = dec[c] * nst + ac[c] * nu; } }
}

#if TSEL >= 40 && TSEL < 50
#define MTB() (mtq_ = __builtin_amdgcn_s_memrealtime())
#define MTE(k) do { if ((k) == TSEL - 40 && blockIdx.x == 0 && wid == PWAVE) g_tacc += (unsigned)(__builtin_amdgcn_s_memrealtime() - mtq_); } while (0)
#else
#define MTB() do {} while (0)
#define MTE(k) do {} while (0)
#endif
struct McRaw { Raw16 q, k; u32x4 v0, v1; float li, lf, mc; f32x4 nc[4]; };
__device__ __forceinline__ void mc_load(const Params& p, McRaw& R, int item, int tid) {
  const int bh = item / NCH, c = item % NCH, b = bh >> 2, h = bh & 3, s = tid >> 3, d0 = (tid & 7) * 16, lane = tid & 63;
  const bf16_t* PR = (const bf16_t*)(p.ws + WS_PROJ); const float* gates = (const float*)(p.ws + WS_GATES);
  const float* NC = (const float*)(p.ws + MS_NC); const float* msc = (const float*)(p.ws + MS_MSC);
  raw16_load(p, R.q, b, c, s, 0, h, d0); raw16_load(p, R.k, b, c, s, 1, h, d0);
  const bf16_t* vp = PR + 2 * pg8::SEC + ((size_t)(b * 4 + h) * SEQ + c * 64 + s) * 128 + d0; R.v0 = *(const u32x4*)vp; R.v1 = *(const u32x4*)(vp + 8);
  const size_t gt = (size_t)b * SEQ + c * 64 + lane; R.li = gates[gt * 8 + h]; R.lf = gates[gt * 8 + 4 + h]; R.mc = msc[4096 + item];
#pragma unroll
  for (int q = 0; q < 4; ++q) R.nc[q] = *(const f32x4*)(NC + (size_t)item * 128 + d0 + 4 * q);
}
#define LBAR() asm volatile("s_waitcnt lgkmcnt(0)\n\ts_barrier" ::: "memory")
__device__ __forceinline__ void mlstm_c_phase(const Params& p, int vcu, int G, char* lds, unsigned& g_tacc) {
  unsigned long long mtq_ = 0; (void)mtq_;
  const bf16_t* PR = (const bf16_t*)(p.ws + WS_PROJ); const bf16_t* MC = (const bf16_t*)(p.ws + WS_MC); bf16_t* MIX = (bf16_t*)(p.ws + WS_MIX);
  float* Gf = (float*)(lds + ML_G); float* bm = Gf; float* as_ = Gf + 64; float* mxv = Gf + 128; float* scv = Gf + 192; float* qn = Gf + 256;
  float* H = (float*)(lds + ML_H);
  McRaw P;
  if (vcu < 16 * NCH) mc_load(p, P, vcu, threadIdx.x);
  for (int item = vcu; item < 16 * NCH; item += G) {
    int tid_ = threadIdx.x; asm volatile("" : "+v"(tid_));
    const int tid = tid_, wid = __builtin_amdgcn_readfirstlane(tid >> 6), lane = tid & 63, r32 = lane & 31, hi = lane >> 5;
    const int bh = item / NCH, c = item % NCH, b = bh >> 2, h = bh & 3;
    const int s_ = tid >> 3, d0_ = (tid & 7) * 16;
    MTB();
    bf16x8 ctf[8];
    { const bf16_t* ct = MC + (size_t)item * 16384 + (size_t)(32 * (wid & 3) + r32) * 128 + hi * 8;
#pragma unroll
      for (int ks = 0; ks < 8; ++ks) ctf[ks] = *(const bf16x8*)(ct + ks * 16); }
    LBAR(); MTE(4); MTB();
    if (wid == 0) { const float li = P.li; const float lf = log_sigmoid(P.lf);
      const float bc = wave_incl_scan_add(lf, lane); const float a = li - bc; const float pm = wave_incl_scan_max(a, lane);
      const float mc = P.mc; const float mx = bc + fmaxf(mc, pm);
      bm[lane] = bc - mx; as_[lane] = a; mxv[lane] = mx; scv[lane] = __expf(bc + mc - mx); }
    MTE(5); MTB();
    { const int s = s_, d0 = d0_; float y[16];
      conv16_compute(p, y, P.q, h * 128, d0); asm volatile("" : "+v"(y[0])); MTE(6); MTB();
      float part = 0.f;
#pragma unroll
      for (int q = 0; q < 4; ++q) { const f32x4 nv = P.nc[q]; part += y[4 * q] * nv.x + y[4 * q + 1] * nv.y + y[4 * q + 2] * nv.z + y[4 * q + 3] * nv.w; }
      part += __shfl_xor(part, 1); part += __shfl_xor(part, 2); part += __shfl_xor(part, 4);
      if ((tid & 7) == 0) qn[s] = part;
      *(u32x4*)(lds + ML_Q + QSWZ(s, d0 * 2)) = pack8(y); *(u32x4*)(lds + ML_Q + QSWZ(s, d0 * 2 + 16)) = pack8(y + 8);
      conv16_compute(p, y, P.k, 512 + h * 128, d0);
#pragma unroll
      for (int i = 0; i < 16; ++i) y[i] *= KSCALE;
      *(u32x4*)(lds + ML_K + QSWZ(s, d0 * 2)) = pack8(y); *(u32x4*)(lds + ML_K + QSWZ(s, d0 * 2 + 16)) = pack8(y + 8);
      *(u32x4*)(lds + ML_V + v_st(s, d0)) = P.v0; *(u32x4*)(lds + ML_V + v_st(s, d0 + 8)) = P.v1; }
    MTE(7); MTB(); LBAR(); MTE(0); MTB();
    if (item + G < 16 * NCH) mc_load(p, P, item + G, tid);
    const bf16_t* mo_ = PR + 3 * pg8::SEC + ((size_t)(b * 4 + h) * SEQ + c * 64 + s_) * 128 + d0_; const u32x4 mo0 = *(const u32x4*)mo_, mo1 = *(const u32x4*)(mo_ + 8);
    if (wid < 4) {
      const int ti = wid >> 1, si = wid & 1; f32x16 acc = {};
      if (si <= ti) {
#pragma unroll
        for (int ks = 0; ks < 8; ++ks) { const int cb = (ks * 16 + hi * 8) * 2;
          const bf16x8 a = *(const bf16x8*)(lds + ML_Q + QSWZ(32 * ti + r32, cb)), bb = *(const bf16x8*)(lds + ML_K + QSWZ(32 * si + r32, cb));
          acc = __builtin_amdgcn_mfma_f32_32x32x16_bf16(a, bb, acc, 0, 0, 0); }
      }
      const int s = 32 * si + r32; const float av = as_[s];
#pragma unroll
      for (int r = 0; r < 16; ++r) { const int t = 32 * ti + crow(r, hi); const float w = (s <= t) ? __expf(bm[t] + av) * acc[r] : 0.f;
        *(bf16_t*)(lds + ML_W + WSWZ(t, s * 2)) = (bf16_t)f2bf(w); }
    }
    LBAR(); MTE(1); MTB();
    { const int ti = wid >> 2, ej = wid & 3; f32x16 acc = {}, accd = {};
#pragma unroll
      for (int ks = 0; ks < 8; ++ks) { const bf16x8 a = *(const bf16x8*)(lds + ML_Q + QSWZ(32 * ti + r32, (ks * 16 + hi * 8) * 2)); const bf16x8 bb = ctf[ks];
        acc = __builtin_amdgcn_mfma_f32_32x32x16_bf16(a, bb, acc, 0, 0, 0); }
#pragma unroll
      for (int r = 0; r < 16; ++r) acc[r] *= scv[32 * ti + crow(r, hi)];
      const int vbV = (int)(uintptr_t)(lds + ML_V) + v_rd_base(lane) + ej * 512;
      const bf16x8 ones = {0x3F80, 0x3F80, 0x3F80, 0x3F80, 0x3F80, 0x3F80, 0x3F80, 0x3F80};
#define MLC_STEP(KS) do { const s16x4 bl = tr_read<v_rd_off(0, KS, 0)>(vbV), bh_ = tr_read<v_rd_off(0, KS, 1)>(vbV); \
        const bf16x8 a = *(const bf16x8*)(lds + ML_W + WSWZ(32 * ti + r32, (KS * 16 + hi * 8) * 2)); \
        asm volatile("s_waitcnt lgkmcnt(0)" ::: "memory"); __builtin_amdgcn_sched_barrier(0); \
        acc = __builtin_amdgcn_mfma_f32_32x32x16_bf16(a, PKF(bl, bh_), acc, 0, 0, 0); accd = __builtin_amdgcn_mfma_f32_32x32x16_bf16(a, ones, accd, 0, 0, 0); } while (0)
      MLC_STEP(0); MLC_STEP(1); MLC_STEP(2); MLC_STEP(3);
#undef MLC_STEP
#pragma unroll
      for (int r = 0; r < 16; ++r) { const int t = 32 * ti + crow(r, hi); const float den = accd[r] + scv[t] * qn[t]; const float dn = fmaxf(fabsf(den), __expf(-mxv[t]));
        H[t * 128 + 32 * ej + r32] = acc[r] * __builtin_amdgcn_rcpf(dn); }
    }
    LBAR(); MTE(2); MTB();
    { const int t = s_, e0 = d0_; float y[16]; float ss = 0.f;
#pragma unroll
      for (int q = 0; q < 4; ++q) { const f32x4 v = *(const f32x4*)(H + t * 128 + e0 + 4 * q); y[4 * q] = v.x; y[4 * q + 1] = v.y; y[4 * q + 2] = v.z; y[4 * q + 3] = v.w; ss += v.x * v.x + v.y * v.y + v.z * v.z + v.w * v.w; }
      ss += __shfl_xor(ss, 1); ss += __shfl_xor(ss, 2); ss += __shfl_xor(ss, 4);
      const float rstd = rsqrtf(ss * (1.f / 128.f) + EPS);
      const size_t row = (size_t)b * SEQ + c * 64 + t; const int ch = h * 128 + e0;
      const unsigned mw[8] = {mo0.x, mo0.y, mo0.z, mo0.w, mo1.x, mo1.y, mo1.z, mo1.w};
      float gn[16];
#pragma unroll
      for (int q = 0; q < 4; ++q) { const f32x4 gq = *(const f32x4*)(p.mlstm_norm_g + ch + 4 * q); gn[4 * q] = gq.x; gn[4 * q + 1] = gq.y; gn[4 * q + 2] = gq.z; gn[4 * q + 3] = gq.w; }
#pragma unroll
      for (int i = 0; i < 16; ++i) { const float mov = (i & 1) ? __uint_as_float(mw[i >> 1] & 0xffff0000u) : __uint_as_float(mw[i >> 1] << 16);
        y[i] = y[i] * rstd * gn[i] * __builtin_amdgcn_rcpf(1.f + __builtin_amdgcn_exp2f(-LOG2E * mov)); }
      bf16_t* op = MIX + row * DM + ch; *(u32x4*)op = pack8(y); *(u32x4*)(op + 8) = pack8(y + 8); }
    MTE(3);
  }
}
#undef LBAR
#undef QSWZ
#undef WSWZ
#undef PKF
}

__device__ __forceinline__ void phase_combine(const Params& p, int vcu, int G, int wave, int lane) {
    const float lam = __expf(wave_sum(p.lam_q1[lane] * p.lam_k1[lane])) - __expf(wave_sum(p.lam_q2[lane] * p.lam_k2[lane])) + 0.2f;
    const float* AO = (const float*)(p.ws + WS_AO); bf16_t* MIX = (bf16_t*)(p.ws + WS_MIX);
    const float g0 = p.diff_norm_g[2 * lane] * 0.8f, g1 = p.diff_norm_g[2 * lane + 1] * 0.8f;
    for (int it = vcu * NWAVES + wave; it < T * 4; it += G * NWAVES) {
        const float* o1 = AO + (size_t)it * 256; const float* o2 = o1 + 128;
        const float a0 = o1[2 * lane] - lam * o2[2 * lane], a1 = o1[2 * lane + 1] - lam * o2[2 * lane + 1];
        const float rstd = rsqrtf(wave_sum(a0 * a0 + a1 * a1) * (1.f / 128.f) + EPS);
        const int t = it >> 2, h = it & 3;
        *(unsigned*)(MIX + (size_t)t * DM + 512 + h * 128 + 2 * lane) = pk2(a0 * rstd * g0, a1 * rstd * g1);
    }
}
__device__ __forceinline__ void phase_route(const Params& p, unsigned char* lds, int vcu, int G, int wave, int lane) {
    float* urow = (float*)lds; float* part = (float*)(lds + 32768);
    int* cnt = (int*)(lds + 40960); int* base = cnt + 32; int* cnt2 = cnt + 64; int* pel = cnt + 96;
    bf16_t* U2 = (bf16_t*)(p.ws + WS_U2); unsigned* ctl = (unsigned*)(p.ws + WS_CTL);
    int* list = (int*)(p.ws + MS_LIST); int* pe = (int*)(p.ws + MS_PE); int* pp = (int*)(p.ws + MS_PP); float* pg = (float*)(p.ws + MS_PG);
    const int RPW = T / G;
    const int e = lane & 31, half = lane >> 5;
    __syncthreads();
    if (threadIdx.x < 96) cnt[threadIdx.x] = 0;
    float rw[64];
#pragma unroll
    for (int kk = 0; kk < 64; ++kk) rw[kk] = p.router_w[(size_t)(128 * wave + 64 * half + kk) * NE + e];
    const float rb = p.router_b[e];
    f32x4 v[4];
    { const f32x4* xr = (const f32x4*)(p.out + (size_t)(vcu * RPW + wave) * DM) + lane;
#pragma unroll
      for (int j = 0; j < 4; ++j) v[j] = xr[64 * j]; }
    for (int bt = 0; bt < RPW / 8; ++bt) {
        const int row = vcu * RPW + bt * 8 + wave;
        float s = 0.f;
#pragma unroll
        for (int j = 0; j < 4; ++j) s += (v[j].x * v[j].x + v[j].y * v[j].y) + (v[j].z * v[j].z + v[j].w * v[j].w);
        const float rstd = rsqrtf(wave_sum(s) * (1.f / DM) + EPS);
        unsigned long long* o8 = (unsigned long long*)(U2 + (size_t)row * DM) + lane;
#pragma unroll
        for (int j = 0; j < 4; ++j) { const f32x4 g = ((const f32x4*)p.norm2_g)[64 * j + lane]; const f32x4 u = v[j] * rstd * g;
            o8[64 * j] = (unsigned long long)pk2(u.x, u.y) | ((unsigned long long)pk2(u.z, u.w) << 32);
            *(f32x4*)(&urow[wave * DM + 256 * j + 4 * lane]) = u; }
        if (bt + 1 < RPW / 8) { const f32x4* xr = (const f32x4*)(p.out + (size_t)(row + 8) * DM) + lane;
#pragma unroll
          for (int j = 0; j < 4; ++j) v[j] = xr[64 * j]; }
        __syncthreads();
#pragma unroll 2
        for (int r = 0; r < 8; ++r) { const float* ur = urow + r * DM + 128 * wave + 64 * half; float acc = 0.f;
#pragma unroll
            for (int kk = 0; kk < 64; kk += 4) { const f32x4 uu = *(const f32x4*)(ur + kk); acc += uu.x * rw[kk] + uu.y * rw[kk + 1] + uu.z * rw[kk + 2] + uu.w * rw[kk + 3]; }
            acc += __shfl_xor(acc, 32);
            if (half == 0) part[(r * 8 + wave) * 32 + e] = acc; }
        __syncthreads();
        { float val = rb;
#pragma unroll
          for (int w = 0; w < 8; ++w) val += part[(wave * 8 + w) * 32 + e];
          float tv[4]; int ti[4];
#pragma unroll
          for (int r = 0; r < 4; ++r) { float bv = val; int bi = e;
#pragma unroll
              for (int o = 1; o < 32; o <<= 1) { const float ov = __shfl_xor(bv, o); const int oi = __shfl_xor(bi, o); if (ov > bv || (ov == bv && oi < bi)) { bv = ov; bi = oi; } }
              tv[r] = bv; ti[r] = bi; if (e == bi) val = -INFINITY; }
          const float e1 = __expf(tv[1] - tv[0]), e2 = __expf(tv[2] - tv[0]), e3 = __expf(tv[3] - tv[0]); const float inv = 1.f / (1.f + e1 + e2 + e3);
          if (lane < 4) { const int ee = lane == 0 ? ti[0] : lane == 1 ? ti[1] : lane == 2 ? ti[2] : ti[3]; const float gg = (lane == 0 ? 1.f : lane == 1 ? e1 : lane == 2 ? e2 : e3) * inv;
              atomicAdd(&cnt[ee], 1); pel[(bt * 8 + wave) * 4 + lane] = ee; pe[row * 4 + lane] = ee; pg[row * 4 + lane] = gg; } }
    }
    __syncthreads();
    if (threadIdx.x < 32) base[threadIdx.x] = (int)atomicAdd(&ctl[CW_CNT + threadIdx.x], (unsigned)cnt[threadIdx.x]);
    __syncthreads();
    for (int i = threadIdx.x; i < RPW * 4; i += NTHR) { const int row = vcu * RPW + (i >> 2); const int ee = pel[i]; const int pos = base[ee] + atomicAdd(&cnt2[ee], 1);
        pp[row * 4 + (i & 3)] = pos; list[(size_t)ee * T + pos] = row; }
    __syncthreads();
}
__device__ __forceinline__ void phase_final(const Params& p, unsigned char* lds, int vcu, int G, int wave, int lane) {
    int* ps = (int*)lds;
    const unsigned* ctl = (const unsigned*)(p.ws + WS_CTL);
    __syncthreads();
    if (threadIdx.x == 0) { int a = 0; for (int e = 0; e < NE; ++e) { const int c = (int)__hip_atomic_load(ctl + CW_CNT + e, RLX_AGENT); ps[e] = a; a += (c + 255) & ~255; } }
    __syncthreads();
    const bf16_t* Y = (const bf16_t*)(p.ws + WS_Y); const int* pe = (const int*)(p.ws + MS_PE); const int* pp = (const int*)(p.ws + MS_PP); const float* pg = (const float*)(p.ws + MS_PG);
    const int gw = vcu * NWAVES + wave, NGW = G * NWAVES, nrow = (T - gw + NGW - 1) / NGW;
    int yrow = 0; float yg = 0.f;
    { const int k = lane >> 2, r = lane & 3; if (k < nrow) { const int row = gw + k * NGW; const int e = pe[row * 4 + r]; yrow = ps[e] + pp[row * 4 + r]; yg = pg[row * 4 + r]; } }
    f32x4 v[4]; u32x2 yv[4][4];
#define FIN_LOAD(k) do { const int row_ = gw + (k) * NGW; const f32x4* xr_ = (const f32x4*)(p.out + (size_t)row_ * DM) + lane; \
        _Pragma("unroll") for (int j = 0; j < 4; ++j) v[j] = xr_[64 * j]; \
        _Pragma("unroll") for (int r = 0; r < 4; ++r) { const int yr_ = __shfl(yrow, (k) * 4 + r); const u32x2* yp_ = (const u32x2*)(Y + (size_t)yr_ * DM) + lane; \
            _Pragma("unroll") for (int j = 0; j < 4; ++j) yv[r][j] = yp_[64 * j]; } } while (0)
    if (nrow > 0) FIN_LOAD(0);
    for (int k = 0; k < nrow; ++k) {
        const int row = gw + k * NGW;
        f32x4 a[4];
#pragma unroll
        for (int j = 0; j < 4; ++j) a[j] = v[j];
#pragma unroll
        for (int r = 0; r < 4; ++r) { const float g = __shfl(yg, k * 4 + r);
#pragma unroll
            for (int j = 0; j < 4; ++j) { const u32x2 w = yv[r][j];
                a[j].x += g * __uint_as_float(w.x << 16); a[j].y += g * __uint_as_float(w.x & 0xffff0000u); a[j].z += g * __uint_as_float(w.y << 16); a[j].w += g * __uint_as_float(w.y & 0xffff0000u); } }
        if (k + 1 < nrow) FIN_LOAD(k + 1);
        float s = 0.f;
#pragma unroll
        for (int j = 0; j < 4; ++j) s += (a[j].x * a[j].x + a[j].y * a[j].y) + (a[j].z * a[j].z + a[j].w * a[j].w);
        const float rstd = rsqrtf(wave_sum(s) * (1.f / DM) + EPS);
        f32x4* xo = (f32x4*)(p.out + (size_t)row * DM) + lane;
#pragma unroll
        for (int j = 0; j < 4; ++j) { const f32x4 g = ((const f32x4*)p.final_g)[64 * j + lane]; xo[64 * j] = a[j] * rstd * g; }
    }
#undef FIN_LOAD
}

enum { PH_PRE = 0, PH_PROJ = 1, PH_MLA = 2, PH_ATTN = 3, PH_MLC = 4, PH_OUT = 5, PH_ROUTE = 6, PH_MOE1 = 7, PH_MOE2 = 8, PH_FINAL = 9, PH_N = 10 };
struct Args { Params p; int ph_lo, ph_hi, li, pad; };

__device__ __forceinline__ void phase_pre(const Params& p, unsigned char* lds, int vcu, int G, int wave, int lane) {
    { float* scr = (float*)(lds + wave * 8448);
      for (int it = vcu * NWAVES + wave; it < CV_N; it += G * NWAVES) convert_item(p, it, scr, lane); }
    __syncthreads();
#if TSEL == 50
    if (blockIdx.x == PBLK && threadIdx.x == 0) ((volatile LAS unsigned*)((LAS unsigned char*)lds + LDSCTL_OFF))[40] = (unsigned)__builtin_amdgcn_s_memrealtime() - ((volatile LAS unsigned*)((LAS unsigned char*)lds + LDSCTL_OFF))[0];
#endif
    float* gw = (float*)lds;
    for (int i = threadIdx.x; i < DM * 8; i += NTHR) gw[i] = p.w_in[(size_t)(i >> 3) * DIN + 2048 + (i & 7)];
    __syncthreads();
    bf16_t* XN = (bf16_t*)(p.ws + WS_XN); float* gates = (float*)(p.ws + WS_GATES);
    f32x4 v[4];
    { const int row0 = vcu * NWAVES + wave; if (row0 < T) { const f32x4* xr = (const f32x4*)(p.x + (size_t)row0 * DM) + lane;
#pragma unroll
        for (int j = 0; j < 4; ++j) v[j] = xr[64 * j]; } }
    for (int row = vcu * NWAVES + wave; row < T; row += G * NWAVES) {
        f32x4 c[4]; float s = 0.f;
#pragma unroll
        for (int j = 0; j < 4; ++j) { c[j] = v[j]; s += (c[j].x * c[j].x + c[j].y * c[j].y) + (c[j].z * c[j].z + c[j].w * c[j].w); }
        if (row + G * NWAVES < T) { const f32x4* xn = (const f32x4*)(p.x + (size_t)(row + G * NWAVES) * DM) + lane;
#pragma unroll
            for (int j = 0; j < 4; ++j) v[j] = xn[64 * j]; }
        const float rstd = rsqrtf(wave_sum(s) * (1.f / DM) + EPS);
        float ga[8];
#pragma unroll
        for (int q = 0; q < 8; ++q) ga[q] = 0.f;
        unsigned long long* o8 = (unsigned long long*)(XN + (size_t)row * DM) + lane;
#pragma unroll
        for (int j = 0; j < 4; ++j) { const f32x4 g = ((const f32x4*)p.norm1_g)[64 * j + lane]; f32x4 u = c[j] * rstd * g;
            o8[64 * j] = (unsigned long long)pk2(u.x, u.y) | ((unsigned long long)pk2(u.z, u.w) << 32);
            const int k0 = 256 * j + 4 * lane;
#pragma unroll
            for (int cc = 0; cc < 4; ++cc) { const float uu = u[cc]; const float* w = gw + (k0 + cc) * 8;
#pragma unroll
                for (int q = 0; q < 8; ++q) ga[q] += uu * w[q]; } }
        float h4[4], h2[2], h1;
        { const bool up = (lane & 32) != 0;
#pragma unroll
          for (int q = 0; q < 4; ++q) { const float mine = up ? ga[4 + q] : ga[q], theirs = up ? ga[q] : ga[4 + q]; h4[q] = mine + __shfl_xor(theirs, 32); } }
        { const bool up = (lane & 16) != 0;
#pragma unroll
          for (int q = 0; q < 2; ++q) { const float mine = up ? h4[2 + q] : h4[q], theirs = up ? h4[q] : h4[2 + q]; h2[q] = mine + __shfl_xor(theirs, 16); } }
        { const bool up = (lane & 8) != 0; const float mine = up ? h2[1] : h2[0], theirs = up ? h2[0] : h2[1]; h1 = mine + __shfl_xor(theirs, 8); }
        h1 += __shfl_xor(h1, 4); h1 += __shfl_xor(h1, 2); h1 += __shfl_xor(h1, 1);
        if ((lane & 7) == 0) { const int q = ((lane >> 5) & 1) * 4 + ((lane >> 4) & 1) * 2 + ((lane >> 3) & 1); gates[(size_t)row * 8 + q] = h1 + p.gate_b[q]; }
    }
#if TSEL == 51
    if (blockIdx.x == PBLK && threadIdx.x == 0) ((volatile LAS unsigned*)((LAS unsigned char*)lds + LDSCTL_OFF))[40] = (unsigned)__builtin_amdgcn_s_memrealtime() - ((volatile LAS unsigned*)((LAS unsigned char*)lds + LDSCTL_OFF))[0];
#endif
    __syncthreads();
}

__global__ void __launch_bounds__(NTHR, 2) mega(Args args) {
    extern __shared__ __attribute__((aligned(16))) unsigned char lds_raw[];
    const Params& p = args.p;
    LAS unsigned char* lds = (LAS unsigned char*)lds_raw;
    const int tid = threadIdx.x, lane = tid & 63, wave = __builtin_amdgcn_readfirstlane(tid >> 6);
    const int G = gridDim.x, bx = blockIdx.x, vcu = (G % 8 == 0) ? (bx % 8) * (G / 8) + bx / 8 : bx;
    unsigned* ctl = (unsigned*)(p.ws + WS_CTL);
    for (int u = tid; u < (TAB_OFF - LDSCTL_OFF) / 4; u += NTHR) ((LAS unsigned*)(lds + LDSCTL_OFF))[u] = 0u;
    __syncthreads();
    volatile LAS unsigned* MISC = (volatile LAS unsigned*)(lds + MISC_OFF);
    XcdBarrier bar = xcd_barrier_post(ctl + CW_BAR + args.li * XCD_BAR_WORDS, MISC + 8);
    const int lo = args.ph_lo, hi = args.ph_hi;
#define IN(k) (lo <= (k) && (k) < hi)
#ifndef DUP_PHASE
#define DUP_PHASE -1
#endif
#define REP(k) for (int rep_ = 0; rep_ < ((k) == DUP_PHASE ? 2 : 1); ++rep_)
#ifndef TSEL
#define TSEL -1
#endif
#define STAMP(k) do { if (TSEL >= 0 && (TSEL < 20 || TSEL == 50 || TSEL == 51) && bx == PBLK && tid == 0) { const unsigned long long t_ = __builtin_amdgcn_s_memrealtime(); ((volatile LAS unsigned*)(lds + LDSCTL_OFF))[2 * (k)] = (unsigned)t_; } } while (0)
#define SEAM(k) do { if (IN(k) && (k) + 1 < hi) xcd_barrier(bar); STAMP((k) + 1); } while (0)
    STAMP(0);

    if (IN(PH_PRE)) REP(PH_PRE) { phase_pre(p, lds_raw, vcu, G, wave, lane); }
    SEAM(PH_PRE);
    if (IN(PH_PROJ)) REP(PH_PROJ) {
        pg8::StaticOrder S; S.init(p.ws + WS_XN, p.ws + WS_WIN, T, NPJ, DM, G, bx);
        pg8::EpiProj E{(bf16_t*)(p.ws + WS_PROJ)};
        pg8::gemm_phase<pg8::EpiProj, pg8::StaticOrder, false>(lds, DM, S, E, nullptr);
    }
    SEAM(PH_PROJ);
    if (IN(PH_MLA)) REP(PH_MLA) { for (int it = vcu; it < 16 * NCH; it += G) ml::mlstm_a_item(p, it, (char*)lds_raw); __syncthreads(); }
    SEAM(PH_MLA);
    if (IN(PH_ATTN)) {
        for (int it = vcu; it < 256; it += G) ml::mlstm_scan_item(p, it, (char*)lds_raw);
        unsigned g_tacc = 0; const unsigned long long mt0_ = (TSEL == 30) ? __builtin_amdgcn_s_memtime() : 0ull;
        const float lam = __expf(wave_sum(p.lam_q1[lane] * p.lam_k1[lane])) - __expf(wave_sum(p.lam_q2[lane] * p.lam_k2[lane])) + 0.2f;
        for (int U = vcu; U < (DUP_PHASE == PH_ATTN ? 1024 : 512); U += G) { const int i = (U >> 8) & 1, v = U & 255, bh = v >> 4, s = v & 15;
            const int qb = (i == 0) ? s : 31 - s;
#pragma nounroll
            for (int m = 0; m < 2; ++m) att::attn_unit(p, bh >> 2, bh & 3, m, qb, lam, (char*)lds_raw, g_tacc); }
        if (TSEL == 30) g_tacc = (unsigned)((__builtin_amdgcn_s_memtime() - mt0_) >> 4);
        if (TSEL >= 20 && bx == 0 && lane == 0 && wave == PWAVE) ((volatile LAS unsigned*)(lds + LDSCTL_OFF))[40] = g_tacc;
        __syncthreads();
    }
    SEAM(PH_ATTN);
    if (IN(PH_MLC)) REP(PH_MLC) { unsigned g_tacc = 0; ml::mlstm_c_phase(p, vcu, G, (char*)lds_raw, g_tacc);
        if (TSEL >= 40 && TSEL < 50 && bx == 0 && lane == 0 && wave == PWAVE) ((volatile LAS unsigned*)(lds + LDSCTL_OFF))[40] = g_tacc;
        __syncthreads(); }
    SEAM(PH_MLC);
    if (IN(PH_OUT)) REP(PH_OUT) {
        pg8::StaticOrder S; S.init(p.ws + WS_MIX, p.ws + WS_WOUT, T, DM, DM, G, bx);
        pg8::EpiOut E{p.x, p.out};
        pg8::gemm_phase<pg8::EpiOut, pg8::StaticOrder, false>(lds, DM, S, E, nullptr);
    }
    SEAM(PH_OUT);
    if (IN(PH_ROUTE)) phase_route(p, lds_raw, vcu, G, wave, lane);
    SEAM(PH_ROUTE);
    if (IN(PH_MOE1)) REP(PH_MOE1) {
        const int n = moe_build_units<8>(lds, ctl, G, bx);
        const LAS int* UL = (const LAS int*)(lds + TAB_UL); const LAS int* PS = (const LAS int*)(lds + TAB_PS); const LAS int* CN = (const LAS int*)(lds + TAB_CN);
        LAS unsigned* gtab = (LAS unsigned*)(lds + GTAB_OFF);
        const int* list = (const int*)(p.ws + MS_LIST);
        for (int i = tid; i < n * 256; i += NTHR) { const int w = UL[i >> 8], e = w & 255, rt = (w >> 8) & 255; const int idx = min(rt * 256 + (i & 255), CN[e] - 1);
            gtab[i] = (unsigned)list[(size_t)e * T + idx] * (unsigned)(DM * 2); }
        __syncthreads();
        MoeOrder<8, true> S{UL, PS, n, (const char*)(p.ws + WS_U2), (const char*)(p.ws + WS_WGU)};
        pg8::EpiSwiglu E{(bf16_t*)(p.ws + WS_ACT), p.b_gu};
        pg8::gemm_phase<pg8::EpiSwiglu, MoeOrder<8, true>, true>(lds, DM, S, E, gtab);
    }
    SEAM(PH_MOE1);
    if (IN(PH_MOE2)) REP(PH_MOE2) {
        const int n = moe_build_units<4>(lds, ctl, G, bx);
        const LAS int* UL = (const LAS int*)(lds + TAB_UL); const LAS int* PS = (const LAS int*)(lds + TAB_PS);
        MoeOrder<4, false> S{UL, PS, n, (const char*)(p.ws + WS_ACT), (const char*)(p.ws + WS_WDN)};
        pg8::EpiDown E{(bf16_t*)(p.ws + WS_Y), p.b_down};
        pg8::gemm_phase<pg8::EpiDown, MoeOrder<4, false>, false>(lds, FF, S, E, nullptr);
    }
    SEAM(PH_MOE2);
    if (IN(PH_FINAL)) phase_final(p, lds_raw, vcu, G, wave, lane);
    if (TSEL >= 0) { __syncthreads(); STAMP(PH_N);
        if (bx == PBLK && tid == 0) { volatile LAS unsigned* st_ = (volatile LAS unsigned*)(lds + LDSCTL_OFF); const unsigned d_ = (TSEL >= 20 ? st_[40] : (st_[2 * (TSEL + 1)] - st_[2 * TSEL])) * TMULT;
            const unsigned long long t0_ = __builtin_amdgcn_s_memrealtime(); while ((unsigned)(__builtin_amdgcn_s_memrealtime() - t0_) < d_) __builtin_amdgcn_s_sleep(8); } }
#undef IN
#undef SEAM
}

static void launch_mega(const Params& p, int lo, int hi, int li, hipStream_t stream) {
    Args a{}; a.p = p; a.ph_lo = lo; a.ph_hi = hi; a.li = li; a.pad = 0;
    hipLaunchKernelGGL(mega, dim3(256), dim3(NTHR), LDS_BYTES, stream, a);
}
extern "C" void kernel_launch(void* const* d_in, const int* in_sizes, int n_in, void* d_out, int out_size, void* d_ws, size_t ws_size, hipStream_t stream) {
    if (n_in != 22 || out_size != T * DM || ws_size < WS_END) { fprintf(stderr, "kernel_launch: unexpected shapes (n_in %d out %d ws %zu)\n", n_in, out_size, ws_size); return; }
    Params p{};
    const float** f = (const float**)&p;
    for (int i = 0; i < 22; ++i) f[i] = (const float*)d_in[i];
    p.out = (float*)d_out; p.ws = (unsigned char*)d_ws;
    static bool attr = false;
    if (!attr) { attr = true;
        (void)hipFuncSetAttribute((const void*)k_mlstm_a, hipFuncAttributeMaxDynamicSharedMemorySize, 80 * 1024);
        (void)hipFuncSetAttribute((const void*)k_mlstm_c, hipFuncAttributeMaxDynamicSharedMemorySize, 128 * 1024);
        (void)hipFuncSetAttribute((const void*)mega, hipFuncAttributeMaxDynamicSharedMemorySize, LDS_BYTES); }
    (void)hipMemsetAsync((char*)d_ws + WS_CTL, 0, 1 * MiB, stream);
    launch_mega(p, PH_PRE, PH_N, 0, stream);
}
```

```cpp
#define DUP_PHASE -1
#define TSEL -1
#define TMULT 1
#define PWAVE 0
#define PBLK 0
#include <hip/hip_runtime.h>
#include <cstdio>
#include <cstdint>

typedef unsigned short bf16_t;
typedef short bf16x8 __attribute__((ext_vector_type(8)));
typedef float f32x4 __attribute__((ext_vector_type(4)));
typedef unsigned u32x4 __attribute__((ext_vector_type(4)));
typedef unsigned u32x2 __attribute__((ext_vector_type(2)));

constexpr int NB = 4, SEQ = 8192, T = NB * SEQ, DM = 1024, DIN = 3592, NPJ = 3584;
constexpr int NCH = SEQ / 64;
constexpr int NE = 32, FF = 1024;
constexpr int PQ = 0, PK = 512, PV = 1024, PO = 1536, PAQ = 2048, PAK = 2560, PAV = 3072;
constexpr int PROWS = T * 4 + NE * 256;
constexpr float EPS = 1e-5f;
constexpr float LOG2E = 1.4426950408889634f;
constexpr float QSCALE = 0.125f * LOG2E;

constexpr size_t MiB = 1u << 20;
constexpr size_t WS_CTL = 0;
constexpr size_t WS_WIN = 2 * MiB;
constexpr size_t WS_WOUT = 10 * MiB;
constexpr size_t WS_GATES = 12 * MiB;
constexpr size_t WS_MISC = 14 * MiB;
constexpr size_t WS_WGU = 24 * MiB;
constexpr size_t WS_WDN = 152 * MiB;
constexpr size_t WS_XN = 216 * MiB;
constexpr size_t WS_PROJ = 280 * MiB;
constexpr size_t WS_MU = 504 * MiB;
constexpr size_t WS_MC = 568 * MiB;
constexpr size_t WS_AO = 632 * MiB;
constexpr size_t WS_MIX = 760 * MiB;
constexpr size_t WS_Y = 552 * MiB;
constexpr size_t WS_ACT = WS_PROJ;
constexpr size_t WS_U2 = WS_XN;
constexpr size_t WS_END = 824 * MiB;
constexpr size_t MS_LIST = WS_MISC;
constexpr size_t MS_PAIR = WS_MISC + 4 * MiB;
constexpr size_t MS_PE = MS_PAIR;
constexpr size_t MS_PP = MS_PAIR + (size_t)T * 4 * 4;
constexpr size_t MS_PG = MS_PP + (size_t)T * 4 * 4;
constexpr size_t MS_MSC = WS_MISC + 6 * MiB;
constexpr size_t MS_NU = WS_MISC + 7 * MiB;
constexpr size_t MS_NC = WS_MISC + 8 * MiB;
constexpr int CW_CNT = 64;

struct Params {
    const float *x, *rel_bias, *norm1_g, *w_in, *conv_w, *conv_b, *gate_b, *mlstm_norm_g, *lam_q1, *lam_k1, *lam_q2, *lam_k2,
        *diff_norm_g, *w_out, *norm2_g, *router_w, *router_b, *w_gu, *b_gu, *w_down, *b_down, *final_g;
    float* out; unsigned char* ws;
};

__device__ __forceinline__ float bf2f(bf16_t v) { return __uint_as_float((unsigned)v << 16); }
__device__ __forceinline__ unsigned f2bf(float f) { unsigned u = __float_as_uint(f); return (u + 0x7fffu + ((u >> 16) & 1u)) >> 16; }
__device__ __forceinline__ unsigned pk2(float lo, float hi) { return f2bf(lo) | (f2bf(hi) << 16); }
__device__ __forceinline__ float wave_sum(float v) {
#pragma unroll
    for (int o = 1; o < 64; o <<= 1) v += __shfl_xor(v, o);
    return v;
}
__device__ __forceinline__ float sigmoidf_(float x) { return 1.f / (1.f + __expf(-x)); }
__device__ __forceinline__ float log_sigmoid(float x) { return fminf(x, 0.f) - log1pf(__expf(-fabsf(x))); }
#define LDS_WAIT() asm volatile("s_waitcnt lgkmcnt(0)" ::: "memory")

__device__ __forceinline__ void tr_item(const float* W, int ldw, int n0, int k0, bf16_t* WT, int dstrow0, int Kd, float* scr, int lane) {
#pragma unroll 8
    for (int i = 0; i < 32; ++i) { const int kk = 2 * i + (lane >> 5); scr[kk * 33 + (lane & 31)] = W[(size_t)(k0 + kk) * ldw + n0 + (lane & 31)]; }
    LDS_WAIT();
    const int c = lane & 7;
#pragma unroll
    for (int j = 0; j < 4; ++j) { const int n = (lane >> 3) + 8 * j; const float* s = scr + (8 * c) * 33 + n;
        u32x4 o; o.x = pk2(s[0 * 33], s[1 * 33]); o.y = pk2(s[2 * 33], s[3 * 33]); o.z = pk2(s[4 * 33], s[5 * 33]); o.w = pk2(s[6 * 33], s[7 * 33]);
        *(u32x4*)(WT + (size_t)(dstrow0 + n) * Kd + k0 + 8 * c) = o; }
    LDS_WAIT();
}
__device__ __forceinline__ void tr_item8(const float* W, int ldw, int n0, int k0, unsigned char* WT, int dstrow0, int Kd, float scale, float* scr, int lane) {
#pragma unroll 8
    for (int i = 0; i < 32; ++i) { const int kk = 2 * i + (lane >> 5); scr[kk * 33 + (lane & 31)] = W[(size_t)(k0 + kk) * ldw + n0 + (lane & 31)] * scale; }
    LDS_WAIT();
    const int c = lane & 3;
#pragma unroll
    for (int j = 0; j < 2; ++j) { const int n = (lane >> 2) + 16 * j; const float* s = scr + (16 * c) * 33 + n;
        u32x4 o;
        { int w = __builtin_amdgcn_cvt_pk_fp8_f32(s[0 * 33], s[1 * 33], 0, false); o.x = (unsigned)__builtin_amdgcn_cvt_pk_fp8_f32(s[2 * 33], s[3 * 33], w, true); }
        { int w = __builtin_amdgcn_cvt_pk_fp8_f32(s[4 * 33], s[5 * 33], 0, false); o.y = (unsigned)__builtin_amdgcn_cvt_pk_fp8_f32(s[6 * 33], s[7 * 33], w, true); }
        { int w = __builtin_amdgcn_cvt_pk_fp8_f32(s[8 * 33], s[9 * 33], 0, false); o.z = (unsigned)__builtin_amdgcn_cvt_pk_fp8_f32(s[10 * 33], s[11 * 33], w, true); }
        { int w = __builtin_amdgcn_cvt_pk_fp8_f32(s[12 * 33], s[13 * 33], 0, false); o.w = (unsigned)__builtin_amdgcn_cvt_pk_fp8_f32(s[14 * 33], s[15 * 33], w, true); }
        *(u32x4*)(WT + (size_t)(dstrow0 + n) * Kd + k0 + 16 * c) = o; }
    LDS_WAIT();
}
constexpr float W8_SCALE = 512.f, U8_SCALE = 16.f;
constexpr int CV_I0 = 1024, CV_I1 = 768, CV_I2 = 512, CV_I3 = 32768, CV_I4 = 16384, CV_N = CV_I0 + CV_I1 + CV_I2 + CV_I3 + CV_I4;
__device__ __forceinline__ void convert_item(const Params& p, int it, float* scr, int lane) {
    bf16_t* win = (bf16_t*)(p.ws + WS_WIN); bf16_t* wout = (bf16_t*)(p.ws + WS_WOUT); unsigned char* wgu = (unsigned char*)(p.ws + WS_WGU); unsigned char* wdn = (unsigned char*)(p.ws + WS_WDN);
    int r = it;
    if (r < CV_I0) { const int kb = r / 64, nb = r % 64; tr_item(p.w_in, DIN, 32 * nb, 64 * kb, win, 32 * nb, DM, scr, lane); return; } r -= CV_I0;
    if (r < CV_I1) { const int kb = r / 48, nb = r % 48; tr_item(p.w_in, DIN, 2056 + 32 * nb, 64 * kb, win, 2048 + 32 * nb, DM, scr, lane); return; } r -= CV_I1;
    if (r < CV_I2) { const int kb = r / 32, nb = r % 32; tr_item(p.w_out, DM, 32 * nb, 64 * kb, wout, 32 * nb, DM, scr, lane); return; } r -= CV_I2;
    if (r < CV_I3) { const int e = r / 1024, q = r % 1024, kb = q / 64, nb = q % 64; const int n0 = 32 * nb;
        const int dst = (n0 < 1024) ? (256 * (n0 / 128) + (n0 % 128)) : (256 * ((n0 - 1024) / 128) + 128 + ((n0 - 1024) % 128));
        tr_item8(p.w_gu + (size_t)e * DM * 2 * FF, 2 * FF, n0, 64 * kb, wgu + (size_t)e * 2 * FF * DM, dst, DM, W8_SCALE, scr, lane); return; } r -= CV_I3;
    { const int e = r / 512, q = r % 512, kb = q / 32, nb = q % 32;
        tr_item8(p.w_down + (size_t)e * FF * DM, DM, 32 * nb, 64 * kb, wdn + (size_t)e * DM * FF, 32 * nb, FF, W8_SCALE, scr, lane); }
}
__global__ void __launch_bounds__(256) k_convert(Params p) {
    __shared__ float scr[4][64 * 33 * 2];
    const int wave = threadIdx.x >> 6, lane = threadIdx.x & 63;
    for (int it = blockIdx.x * 4 + wave; it < CV_N; it += gridDim.x * 4) convert_item(p, it, scr[wave], lane);
}

__global__ void __launch_bounds__(256) k_norm1(Params p) {
    __shared__ float gw[DM * 8];
    for (int i = threadIdx.x; i < DM * 8; i += 256) gw[i] = p.w_in[(size_t)(i >> 3) * DIN + 2048 + (i & 7)];
    __syncthreads();
    const int wave = threadIdx.x >> 6, lane = threadIdx.x & 63;
    bf16_t* XN = (bf16_t*)(p.ws + WS_XN); float* gates = (float*)(p.ws + WS_GATES);
    for (int row = blockIdx.x * 4 + wave; row < T; row += gridDim.x * 4) {
        const f32x4* xr = (const f32x4*)(p.x + (size_t)row * DM) + lane;
        f32x4 v[4]; float s = 0.f;
#pragma unroll
        for (int j = 0; j < 4; ++j) { v[j] = xr[64 * j]; s += (v[j].x * v[j].x + v[j].y * v[j].y) + (v[j].z * v[j].z + v[j].w * v[j].w); }
        const float rstd = rsqrtf(wave_sum(s) * (1.f / DM) + EPS);
        float ga[8];
#pragma unroll
        for (int q = 0; q < 8; ++q) ga[q] = 0.f;
        unsigned long long* o8 = (unsigned long long*)(XN + (size_t)row * DM) + lane;
#pragma unroll
        for (int j = 0; j < 4; ++j) { const f32x4 g = ((const f32x4*)p.norm1_g)[64 * j + lane]; f32x4 u = v[j] * rstd * g;
            o8[64 * j] = (unsigned long long)pk2(u.x, u.y) | ((unsigned long long)pk2(u.z, u.w) << 32);
            const int k0 = 256 * j + 4 * lane;
#pragma unroll
            for (int c = 0; c < 4; ++c) { const float uu = u[c]; const float* w = gw + (k0 + c) * 8;
#pragma unroll
                for (int q = 0; q < 8; ++q) ga[q] += uu * w[q]; } }
#pragma unroll
        for (int q = 0; q < 8; ++q) ga[q] = wave_sum(ga[q]);
        if (lane == 0) {
#pragma unroll
            for (int q = 0; q < 8; ++q) gates[(size_t)row * 8 + q] = ga[q] + p.gate_b[q]; }
    }
}

__device__ __forceinline__ void wave_gemm_32x32(f32x4 (&acc)[2][2], const bf16_t* a0, const bf16_t* a1, const bf16_t* b0, const bf16_t* b1, int K) {
    for (int k = 0; k < K; k += 32) {
        const bf16x8 A0 = *(const bf16x8*)(a0 + k), A1 = *(const bf16x8*)(a1 + k), B0 = *(const bf16x8*)(b0 + k), B1 = *(const bf16x8*)(b1 + k);
        acc[0][0] = __builtin_amdgcn_mfma_f32_16x16x32_bf16(A0, B0, acc[0][0], 0, 0, 0);
        acc[0][1] = __builtin_amdgcn_mfma_f32_16x16x32_bf16(A0, B1, acc[0][1], 0, 0, 0);
        acc[1][0] = __builtin_amdgcn_mfma_f32_16x16x32_bf16(A1, B0, acc[1][0], 0, 0, 0);
        acc[1][1] = __builtin_amdgcn_mfma_f32_16x16x32_bf16(A1, B1, acc[1][1], 0, 0, 0);
    }
}
#define ZERO_ACC(acc) do { _Pragma("unroll") for (int a_ = 0; a_ < 2; ++a_) _Pragma("unroll") for (int b_ = 0; b_ < 2; ++b_) acc[a_][b_] = (f32x4){0.f, 0.f, 0.f, 0.f}; } while (0)

__global__ void __launch_bounds__(256) k_proj(Params p) {
    const int wave = threadIdx.x >> 6, lane = threadIdx.x & 63, fr = lane & 15, fq = lane >> 4;
    const bf16_t* XN = (const bf16_t*)(p.ws + WS_XN); const bf16_t* W = (const bf16_t*)(p.ws + WS_WIN); bf16_t* PR = (bf16_t*)(p.ws + WS_PROJ);
    constexpr int NCT = NPJ / 32, NIT = (T / 32) * NCT;
    for (int it = blockIdx.x * 4 + wave; it < NIT; it += gridDim.x * 4) {
        const int rt = it / NCT, ct = it % NCT, r0 = rt * 32, c0 = ct * 32;
        f32x4 acc[2][2]; ZERO_ACC(acc);
        wave_gemm_32x32(acc, XN + (size_t)(r0 + fr) * DM + fq * 8, XN + (size_t)(r0 + 16 + fr) * DM + fq * 8, W + (size_t)(c0 + fr) * DM + fq * 8, W + (size_t)(c0 + 16 + fr) * DM + fq * 8, DM);
        const float sc = (c0 >= PAQ && c0 < PAK) ? QSCALE : 1.f;
#pragma unroll
        for (int mi = 0; mi < 2; ++mi)
#pragma unroll
            for (int ni = 0; ni < 2; ++ni)
#pragma unroll
                for (int j = 0; j < 4; ++j) PR[(size_t)(r0 + mi * 16 + fq * 4 + j) * NPJ + c0 + ni * 16 + fr] = (bf16_t)f2bf(acc[mi][ni][j] * sc);
    }
}

__global__ void __launch_bounds__(256) k_outproj(Params p) {
    const int wave = threadIdx.x >> 6, lane = threadIdx.x & 63, fr = lane & 15, fq = lane >> 4;
    const bf16_t* A = (const bf16_t*)(p.ws + WS_MIX); const bf16_t* W = (const bf16_t*)(p.ws + WS_WOUT);
    constexpr int NCT = DM / 32, NIT = (T / 32) * NCT;
    for (int it = blockIdx.x * 4 + wave; it < NIT; it += gridDim.x * 4) {
        const int rt = it / NCT, ct = it % NCT, r0 = rt * 32, c0 = ct * 32;
        f32x4 acc[2][2]; ZERO_ACC(acc);
        wave_gemm_32x32(acc, A + (size_t)(r0 + fr) * DM + fq * 8, A + (size_t)(r0 + 16 + fr) * DM + fq * 8, W + (size_t)(c0 + fr) * DM + fq * 8, W + (size_t)(c0 + 16 + fr) * DM + fq * 8, DM);
#pragma unroll
        for (int mi = 0; mi < 2; ++mi)
#pragma unroll
            for (int ni = 0; ni < 2; ++ni)
#pragma unroll
                for (int j = 0; j < 4; ++j) { const size_t o = (size_t)(r0 + mi * 16 + fq * 4 + j) * DM + c0 + ni * 16 + fr; p.out[o] = p.x[o] + acc[mi][ni][j]; }
    }
}

__device__ __forceinline__ void load_conv_tile(const Params& p, float* dst, int LD, int b, int c, int col0, int cch, float scale) {
    const bf16_t* PR = (const bf16_t*)(p.ws + WS_PROJ);
    for (int i = threadIdx.x; i < 64 * 128; i += blockDim.x) {
        const int s = i >> 7, d = i & 127; const int tl = c * 64 + s; float a = p.conv_b[cch + d];
#pragma unroll
        for (int j = 0; j < 4; ++j) { const int tt = tl - 3 + j; if (tt >= 0) a += p.conv_w[j * 1024 + cch + d] * bf2f(PR[(size_t)(b * SEQ + tt) * NPJ + col0 + d]); }
        dst[s * LD + d] = a * sigmoidf_(a) * scale;
    }
}
__device__ __forceinline__ void load_gates(const Params& p, float* li, float* bcum, int b, int h, int c) {
    const float* gates = (const float*)(p.ws + WS_GATES);
    if (threadIdx.x < 64) { const size_t t = (size_t)b * SEQ + c * 64 + threadIdx.x; li[threadIdx.x] = gates[t * 8 + h]; bcum[threadIdx.x] = log_sigmoid(gates[t * 8 + 4 + h]); }
    __syncthreads();
    if (threadIdx.x == 0) { float a = 0.f; for (int s = 0; s < 64; ++s) { a += bcum[s]; bcum[s] = a; } }
    __syncthreads();
}

__global__ void __launch_bounds__(256) k_mlstm_a(Params p) {
    extern __shared__ __attribute__((aligned(16))) unsigned char smem[];
    float* kk = (float*)smem; float* vv = kk + 64 * 129; float* li = vv + 64 * 128; float* bcum = li + 64; float* wgt = bcum + 64;
    const bf16_t* PR = (const bf16_t*)(p.ws + WS_PROJ);
    bf16_t* MU = (bf16_t*)(p.ws + WS_MU); float* NU = (float*)(p.ws + MS_NU); float* msc = (float*)(p.ws + MS_MSC);
    for (int item = blockIdx.x; item < 16 * NCH; item += gridDim.x) {
        const int bh = item / NCH, c = item % NCH, b = bh >> 2, h = bh & 3;
        __syncthreads();
        load_gates(p, li, bcum, b, h, c);
        load_conv_tile(p, kk, 129, b, c, PK + h * 128, 512 + h * 128, 0.08838834764831845f);
        for (int i = threadIdx.x; i < 64 * 128; i += 256) { const int s = i >> 7, e = i & 127; vv[i] = bf2f(PR[(size_t)(b * SEQ + c * 64 + s) * NPJ + PV + h * 128 + e]); }
        const float blast = bcum[63];
        float gmax = -INFINITY;
        for (int s = 0; s < 64; ++s) gmax = fmaxf(gmax, blast - bcum[s] + li[s]);
        __syncthreads();
        if (threadIdx.x < 64) wgt[threadIdx.x] = __expf(blast - bcum[threadIdx.x] + li[threadIdx.x] - gmax);
        __syncthreads();
        const int d = threadIdx.x >> 1, e0 = (threadIdx.x & 1) * 64;
        float acc[64];
#pragma unroll
        for (int e = 0; e < 64; ++e) acc[e] = 0.f;
        for (int s = 0; s < 64; ++s) { const float kd = wgt[s] * kk[s * 129 + d];
#pragma unroll
            for (int e = 0; e < 64; ++e) acc[e] += kd * vv[s * 128 + e0 + e]; }
        bf16_t* uo = MU + ((size_t)item * 128 + d) * 128 + e0;
#pragma unroll
        for (int e = 0; e < 64; e += 2) *(unsigned*)(uo + e) = pk2(acc[e], acc[e + 1]);
        if (threadIdx.x < 128) { float a = 0.f; for (int s = 0; s < 64; ++s) a += wgt[s] * kk[s * 129 + threadIdx.x]; NU[(size_t)item * 128 + threadIdx.x] = a; }
        if (threadIdx.x == 0) { msc[item] = blast; msc[2048 + item] = gmax; }
    }
}
__global__ void __launch_bounds__(256) k_mlstm_scan(Params p) {
    __shared__ float dec[NCH], ac[NCH];
    const bf16_t* MU = (const bf16_t*)(p.ws + WS_MU); bf16_t* MC = (bf16_t*)(p.ws + WS_MC);
    const float* NU = (const float*)(p.ws + MS_NU); float* NC = (float*)(p.ws + MS_NC); float* msc = (float*)(p.ws + MS_MSC);
    for (int item = blockIdx.x; item < 16 * 64; item += gridDim.x) {
        const int bh = item >> 6, eb = item & 63;
        __syncthreads();
        if (threadIdx.x == 0) { float m = 0.f;
            for (int c = 0; c < NCH; ++c) { const float bl = msc[bh * NCH + c], gm = msc[2048 + bh * NCH + c]; const float m1 = fmaxf(bl + m, gm);
                dec[c] = __expf(bl + m - m1); ac[c] = __expf(gm - m1); if (eb == 0) msc[4096 + bh * NCH + c] = m; m = m1; } }
        __syncthreads();
        const int idx = eb * 256 + threadIdx.x; float C = 0.f;
        for (int c = 0; c < NCH; ++c) { const size_t o = ((size_t)(bh * NCH + c)) * 16384 + idx; MC[o] = (bf16_t)f2bf(C); C = dec[c] * C + ac[c] * bf2f(MU[o]); }
        if (eb == 0 && threadIdx.x < 128) { float n = 0.f;
            for (int c = 0; c < NCH; ++c) { const size_t o = ((size_t)(bh * NCH + c)) * 128 + threadIdx.x; NC[o] = n; n = dec[c] * n + ac[c] * NU[o]; } }
    }
}
__global__ void __launch_bounds__(256) k_mlstm_c(Params p) {
    extern __shared__ __attribute__((aligned(16))) unsigned char smem[];
    float* qq = (float*)smem; float* kk = qq + 64 * 129; float* vv = kk + 64 * 129; float* W = vv + 64 * 128; float* li = W + 64 * 65; float* bcum = li + 64;
    float* mx = bcum + 64; float* den = mx + 64; float* nn = den + 64;
    const bf16_t* PR = (const bf16_t*)(p.ws + WS_PROJ); const bf16_t* MC = (const bf16_t*)(p.ws + WS_MC);
    const float* NC = (const float*)(p.ws + MS_NC); const float* msc = (const float*)(p.ws + MS_MSC); bf16_t* MIX = (bf16_t*)(p.ws + WS_MIX);
    for (int item = blockIdx.x; item < 16 * NCH; item += gridDim.x) {
        const int bh = item / NCH, c = item % NCH, b = bh >> 2, h = bh & 3;
        __syncthreads();
        load_gates(p, li, bcum, b, h, c);
        load_conv_tile(p, qq, 129, b, c, PQ + h * 128, h * 128, 1.f);
        load_conv_tile(p, kk, 129, b, c, PK + h * 128, 512 + h * 128, 0.08838834764831845f);
        for (int i = threadIdx.x; i < 64 * 128; i += 256) { const int s = i >> 7, e = i & 127; vv[i] = bf2f(PR[(size_t)(b * SEQ + c * 64 + s) * NPJ + PV + h * 128 + e]); }
        if (threadIdx.x < 128) nn[threadIdx.x] = NC[(size_t)item * 128 + threadIdx.x];
        const float mc = msc[4096 + item];
        if (threadIdx.x < 64) { const int t = threadIdx.x; float m = bcum[t] + mc; for (int s = 0; s <= t; ++s) m = fmaxf(m, bcum[t] - bcum[s] + li[s]); mx[t] = m; }
        __syncthreads();
        for (int i = threadIdx.x; i < 64 * 64; i += 256) { const int t = i >> 6, s = i & 63; float w = 0.f;
            if (s <= t) { float dot = 0.f; for (int d = 0; d < 128; ++d) dot += qq[t * 129 + d] * kk[s * 129 + d]; w = __expf(bcum[t] - bcum[s] + li[s] - mx[t]) * dot; }
            W[t * 65 + s] = w; }
        __syncthreads();
        const int t = threadIdx.x >> 2, e0 = (threadIdx.x & 3) * 32;
        const float sc = __expf(bcum[t] + mc - mx[t]);
        if ((threadIdx.x & 3) == 0) { float a = 0.f; for (int s = 0; s <= t; ++s) a += W[t * 65 + s]; float qn = 0.f; for (int d = 0; d < 128; ++d) qn += qq[t * 129 + d] * nn[d]; den[t] = a + sc * qn; }
        float acc[32];
#pragma unroll
        for (int e = 0; e < 32; ++e) acc[e] = 0.f;
        const bf16_t* Cb = MC + (size_t)item * 16384 + e0;
        for (int d = 0; d < 128; ++d) { const float qd = qq[t * 129 + d]; const bf16_t* cr = Cb + d * 128;
#pragma unroll
            for (int e = 0; e < 32; ++e) acc[e] += qd * bf2f(cr[e]); }
#pragma unroll
        for (int e = 0; e < 32; ++e) acc[e] *= sc;
        for (int s = 0; s <= t; ++s) { const float w = W[t * 65 + s];
#pragma unroll
            for (int e = 0; e < 32; ++e) acc[e] += w * vv[s * 128 + e0 + e]; }
        __syncthreads();
        const float dn = fmaxf(fabsf(den[t]), __expf(-mx[t])); float ss = 0.f;
#pragma unroll
        for (int e = 0; e < 32; ++e) { acc[e] /= dn; ss += acc[e] * acc[e]; }
        ss += __shfl_xor(ss, 1); ss += __shfl_xor(ss, 2);
        const float rstd = rsqrtf(ss * (1.f / 128.f) + EPS);
        const size_t row = (size_t)b * SEQ + c * 64 + t;
#pragma unroll
        for (int e = 0; e < 32; ++e) { const int ch = h * 128 + e0 + e; const float og = sigmoidf_(bf2f(PR[row * NPJ + PO + ch]));
            MIX[row * DM + ch] = (bf16_t)f2bf(acc[e] * rstd * p.mlstm_norm_g[ch] * og); }
    }
}

__device__ __forceinline__ int t5_bucket(int rel) {
    const int n = rel < 0 ? -rel : rel; int b;
    if (n < 8) b = n; else if (n < 12) b = 8; else if (n < 16) b = 9; else if (n < 23) b = 10; else if (n < 32) b = 11; else if (n < 46) b = 12; else if (n < 64) b = 13; else if (n < 91) b = 14; else b = 15;
    return b + (rel > 0 ? 16 : 0);
}
__global__ void __launch_bounds__(256) k_attn_naive(Params p) {
    __shared__ __attribute__((aligned(16))) float Ks[64 * 64];
    __shared__ __attribute__((aligned(16))) float Vs[64 * 128];
    __shared__ float btab[256];
    const bf16_t* PR = (const bf16_t*)(p.ws + WS_PROJ); float* AO = (float*)(p.ws + WS_AO);
    for (int item = blockIdx.x; item < NB * 4 * 2 * 32; item += gridDim.x) {
        const int qb = 31 - (item >> 5), r5 = item & 31, b = r5 >> 3, h = (r5 >> 1) & 3, m = r5 & 1;
        __syncthreads();
        btab[threadIdx.x] = p.rel_bias[t5_bucket((int)threadIdx.x - 192) * 4 + h] * LOG2E;
        const float c15 = p.rel_bias[15 * 4 + h] * LOG2E;
        const int q = qb * 256 + threadIdx.x, cq = q >> 6;
        float qv[64];
        { const bf16_t* qp = PR + (size_t)(b * SEQ + q) * NPJ + PAQ + h * 128 + m * 64;
#pragma unroll
            for (int d = 0; d < 64; d += 8) { const u32x4 w = *(const u32x4*)(qp + d);
                qv[d] = __uint_as_float(w.x << 16); qv[d + 1] = __uint_as_float(w.x & 0xffff0000u); qv[d + 2] = __uint_as_float(w.y << 16); qv[d + 3] = __uint_as_float(w.y & 0xffff0000u);
                qv[d + 4] = __uint_as_float(w.z << 16); qv[d + 5] = __uint_as_float(w.z & 0xffff0000u); qv[d + 6] = __uint_as_float(w.w << 16); qv[d + 7] = __uint_as_float(w.w & 0xffff0000u); } }
        float o[128];
#pragma unroll
        for (int e = 0; e < 128; ++e) o[e] = 0.f;
        float mrun = -INFINITY, l = 0.f;
        const int ntile = 4 * qb + 4;
        for (int j = 0; j < ntile; ++j) {
            __syncthreads();
            for (int i = threadIdx.x; i < 64 * 64; i += 256) { const int kk = i >> 6, d = i & 63; Ks[i] = bf2f(PR[(size_t)(b * SEQ + j * 64 + kk) * NPJ + PAK + h * 128 + m * 64 + d]); }
            for (int i = threadIdx.x; i < 64 * 128; i += 256) { const int kk = i >> 7, e = i & 127; Vs[i] = bf2f(PR[(size_t)(b * SEQ + j * 64 + kk) * NPJ + PAV + h * 128 + e]); }
            __syncthreads();
            if (j <= cq) {
                for (int kk = 0; kk < 64; ++kk) {
                    float s = 0.f;
#pragma unroll
                    for (int d = 0; d < 64; d += 4) { const f32x4 kv = *(const f32x4*)(Ks + kk * 64 + d); s += qv[d] * kv.x + qv[d + 1] * kv.y + qv[d + 2] * kv.z + qv[d + 3] * kv.w; }
                    const int rel = j * 64 + kk - q;
                    s += (rel < -192) ? c15 : btab[rel + 192];
                    if (s > mrun) { const float f = exp2f(mrun - s); l *= f;
#pragma unroll
                        for (int e = 0; e < 128; ++e) o[e] *= f;
                        mrun = s; }
                    const float pw = exp2f(s - mrun); l += pw;
#pragma unroll
                    for (int e = 0; e < 128; e += 4) { const f32x4 vv = *(const f32x4*)(Vs + kk * 128 + e); o[e] += pw * vv.x; o[e + 1] += pw * vv.y; o[e + 2] += pw * vv.z; o[e + 3] += pw * vv.w; }
                }
            }
        }
        const float inv = 1.f / l;
        float* op = AO + (((size_t)(b * SEQ + q) * 4 + h) * 2 + m) * 128;
#pragma unroll
        for (int e = 0; e < 128; e += 4) *(f32x4*)(op + e) = (f32x4){o[e] * inv, o[e + 1] * inv, o[e + 2] * inv, o[e + 3] * inv};
    }
}
__global__ void __launch_bounds__(256) k_attn_combine(Params p) {
    __shared__ float lam_s;
    if (threadIdx.x == 0) { float a = 0.f, c = 0.f; for (int i = 0; i < 64; ++i) { a += p.lam_q1[i] * p.lam_k1[i]; c += p.lam_q2[i] * p.lam_k2[i]; } lam_s = __expf(a) - __expf(c) + 0.2f; }
    __syncthreads();
    const float lam = lam_s;
    const float* AO = (const float*)(p.ws + WS_AO); bf16_t* MIX = (bf16_t*)(p.ws + WS_MIX);
    const int wave = threadIdx.x >> 6, lane = threadIdx.x & 63;
    for (int it = blockIdx.x * 4 + wave; it < T * 4; it += gridDim.x * 4) {
        const float* o1 = AO + (size_t)it * 256; const float* o2 = o1 + 128;
        const float a0 = o1[2 * lane] - lam * o2[2 * lane], a1 = o1[2 * lane + 1] - lam * o2[2 * lane + 1];
        const float rstd = rsqrtf(wave_sum(a0 * a0 + a1 * a1) * (1.f / 128.f) + EPS);
        const int t = it >> 2, h = it & 3;
        *(unsigned*)(MIX + (size_t)t * DM + 512 + h * 128 + 2 * lane) = pk2(a0 * rstd * p.diff_norm_g[2 * lane] * 0.8f, a1 * rstd * p.diff_norm_g[2 * lane + 1] * 0.8f);
    }
}

__global__ void __launch_bounds__(256) k_route(Params p) {
    __shared__ float urow[4][DM];
    const int wave = threadIdx.x >> 6, lane = threadIdx.x & 63;
    bf16_t* U2 = (bf16_t*)(p.ws + WS_U2); unsigned* ctl = (unsigned*)(p.ws + WS_CTL);
    int* list = (int*)(p.ws + MS_LIST); int* pe = (int*)(p.ws + MS_PE); int* pp = (int*)(p.ws + MS_PP); float* pg = (float*)(p.ws + MS_PG);
    for (int row = blockIdx.x * 4 + wave; row < T; row += gridDim.x * 4) {
        const f32x4* xr = (const f32x4*)(p.out + (size_t)row * DM) + lane;
        f32x4 v[4]; float s = 0.f;
#pragma unroll
        for (int j = 0; j < 4; ++j) { v[j] = xr[64 * j]; s += (v[j].x * v[j].x + v[j].y * v[j].y) + (v[j].z * v[j].z + v[j].w * v[j].w); }
        const float rstd = rsqrtf(wave_sum(s) * (1.f / DM) + EPS);
        unsigned long long* o8 = (unsigned long long*)(U2 + (size_t)row * DM) + lane;
#pragma unroll
        for (int j = 0; j < 4; ++j) { const f32x4 g = ((const f32x4*)p.norm2_g)[64 * j + lane]; const f32x4 u = v[j] * rstd * g;
            o8[64 * j] = (unsigned long long)pk2(u.x, u.y) | ((unsigned long long)pk2(u.z, u.w) << 32);
            *(f32x4*)(&urow[wave][256 * j + 4 * lane]) = u; }
        LDS_WAIT();
        const int e = lane & 31, half = lane >> 5; float acc = 0.f;
        for (int k = half * 512; k < half * 512 + 512; ++k) acc += urow[wave][k] * p.router_w[(size_t)k * NE + e];
        acc += __shfl_xor(acc, 32);
        float val = acc + p.router_b[e];
        float tv[4]; int ti[4];
#pragma unroll
        for (int r = 0; r < 4; ++r) { float bv = val; int bi = e;
#pragma unroll
            for (int o = 1; o < 32; o <<= 1) { const float ov = __shfl_xor(bv, o); const int oi = __shfl_xor(bi, o); if (ov > bv || (ov == bv && oi < bi)) { bv = ov; bi = oi; } }
            tv[r] = bv; ti[r] = bi; if (e == bi) val = -INFINITY; }
        const float e1 = __expf(tv[1] - tv[0]), e2 = __expf(tv[2] - tv[0]), e3 = __expf(tv[3] - tv[0]); const float inv = 1.f / (1.f + e1 + e2 + e3);
        if (lane < 4) { const int ee = lane == 0 ? ti[0] : lane == 1 ? ti[1] : lane == 2 ? ti[2] : ti[3]; const float gg = (lane == 0 ? 1.f : lane == 1 ? e1 : lane == 2 ? e2 : e3) * inv;
            const int pos = (int)atomicAdd(&ctl[CW_CNT + ee], 1u);
            list[(size_t)ee * T + pos] = row; pe[row * 4 + lane] = ee; pp[row * 4 + lane] = pos; pg[row * 4 + lane] = gg; }
        LDS_WAIT();
    }
}

__device__ __forceinline__ void expert_starts(const unsigned* ctl, int* ps, int* cn) {
    if (threadIdx.x == 0) { int a = 0; for (int e = 0; e < NE; ++e) { const int c = (int)ctl[CW_CNT + e]; cn[e] = c; ps[e] = a; a += (c + 255) & ~255; } ps[NE] = a; }
    __syncthreads();
}
__global__ void __launch_bounds__(256) k_moe1(Params p) {
    __shared__ int ps[NE + 1], cn[NE];
    const unsigned* ctl = (const unsigned*)(p.ws + WS_CTL);
    expert_starts(ctl, ps, cn);
    const int wave = threadIdx.x >> 6, lane = threadIdx.x & 63, fr = lane & 15, fq = lane >> 4;
    const bf16_t* U2 = (const bf16_t*)(p.ws + WS_U2); const bf16_t* WG = (const bf16_t*)(p.ws + WS_WGU); bf16_t* ACT = (bf16_t*)(p.ws + WS_ACT); const int* list = (const int*)(p.ws + MS_LIST);
    const int nrt = ps[NE] / 32, NIT = nrt * 32;
    for (int it = blockIdx.x * 4 + wave; it < NIT; it += gridDim.x * 4) {
        const int rt = it >> 5, ct = it & 31, R = rt * 32, c0 = ct * 32;
        int e = 0; while (ps[e + 1] <= R) ++e;
        const int lr = R - ps[e]; if (lr >= cn[e]) continue;
        const int i0 = min(lr + fr, cn[e] - 1), i1 = min(lr + 16 + fr, cn[e] - 1);
        const int t0 = list[(size_t)e * T + i0], t1 = list[(size_t)e * T + i1];
        const bf16_t* Wb = WG + (size_t)e * 2 * FF * DM + (size_t)(256 * (c0 / 128) + (c0 % 128)) * DM;
        f32x4 ag[2][2], au[2][2]; ZERO_ACC(ag); ZERO_ACC(au);
        wave_gemm_32x32(ag, U2 + (size_t)t0 * DM + fq * 8, U2 + (size_t)t1 * DM + fq * 8, Wb + (size_t)fr * DM + fq * 8, Wb + (size_t)(16 + fr) * DM + fq * 8, DM);
        wave_gemm_32x32(au, U2 + (size_t)t0 * DM + fq * 8, U2 + (size_t)t1 * DM + fq * 8, Wb + (size_t)(128 + fr) * DM + fq * 8, Wb + (size_t)(128 + 16 + fr) * DM + fq * 8, DM);
#pragma unroll
        for (int mi = 0; mi < 2; ++mi)
#pragma unroll
            for (int ni = 0; ni < 2; ++ni)
#pragma unroll
                for (int j = 0; j < 4; ++j) { const int col = c0 + ni * 16 + fr;
                    float g = ag[mi][ni][j] + p.b_gu[(size_t)e * 2 * FF + col], u = au[mi][ni][j] + p.b_gu[(size_t)e * 2 * FF + FF + col];
                    g = fminf(g, 7.f); u = fminf(fmaxf(u, -7.f), 7.f);
                    ACT[(size_t)(R + mi * 16 + fq * 4 + j) * FF + col] = (bf16_t)f2bf((u + 1.f) * g * sigmoidf_(1.702f * g)); }
    }
}
__global__ void __launch_bounds__(256) k_moe2(Params p) {
    __shared__ int ps[NE + 1], cn[NE];
    const unsigned* ctl = (const unsigned*)(p.ws + WS_CTL);
    expert_starts(ctl, ps, cn);
    const int wave = threadIdx.x >> 6, lane = threadIdx.x & 63, fr = lane & 15, fq = lane >> 4;
    const bf16_t* ACT = (const bf16_t*)(p.ws + WS_ACT); const bf16_t* WD = (const bf16_t*)(p.ws + WS_WDN); bf16_t* Y = (bf16_t*)(p.ws + WS_Y);
    const int nrt = ps[NE] / 32, NIT = nrt * 32;
    for (int it = blockIdx.x * 4 + wave; it < NIT; it += gridDim.x * 4) {
        const int rt = it >> 5, ct = it & 31, R = rt * 32, c0 = ct * 32;
        int e = 0; while (ps[e + 1] <= R) ++e;
        const int lr = R - ps[e]; if (lr >= cn[e]) continue;
        const bf16_t* Wb = WD + (size_t)e * DM * FF + (size_t)c0 * FF;
        f32x4 acc[2][2]; ZERO_ACC(acc);
        wave_gemm_32x32(acc, ACT + (size_t)(R + fr) * FF + fq * 8, ACT + (size_t)(R + 16 + fr) * FF + fq * 8, Wb + (size_t)fr * FF + fq * 8, Wb + (size_t)(16 + fr) * FF + fq * 8, FF);
#pragma unroll
        for (int mi = 0; mi < 2; ++mi)
#pragma unroll
            for (int ni = 0; ni < 2; ++ni)
#pragma unroll
                for (int j = 0; j < 4; ++j) { const int col = c0 + ni * 16 + fr;
                    Y[(size_t)(R + mi * 16 + fq * 4 + j) * DM + col] = (bf16_t)f2bf(acc[mi][ni][j] + p.b_down[(size_t)e * DM + col]); }
    }
}
__global__ void __launch_bounds__(256) k_final(Params p) {
    __shared__ int ps[NE + 1], cn[NE];
    const unsigned* ctl = (const unsigned*)(p.ws + WS_CTL);
    expert_starts(ctl, ps, cn);
    const int wave = threadIdx.x >> 6, lane = threadIdx.x & 63;
    const bf16_t* Y = (const bf16_t*)(p.ws + WS_Y); const int* pe = (const int*)(p.ws + MS_PE); const int* pp = (const int*)(p.ws + MS_PP); const float* pg = (const float*)(p.ws + MS_PG);
    for (int row = blockIdx.x * 4 + wave; row < T; row += gridDim.x * 4) {
        f32x4* xr = (f32x4*)(p.out + (size_t)row * DM) + lane;
        f32x4 v[4];
#pragma unroll
        for (int j = 0; j < 4; ++j) v[j] = xr[64 * j];
#pragma unroll
        for (int r = 0; r < 4; ++r) { const int e = pe[row * 4 + r]; const size_t yr = (size_t)(ps[e] + pp[row * 4 + r]); const float g = pg[row * 4 + r];
            const u32x2* yp = (const u32x2*)(Y + yr * DM) + lane;
#pragma unroll
            for (int j = 0; j < 4; ++j) { const u32x2 w = yp[64 * j];
                v[j].x += g * __uint_as_float(w.x << 16); v[j].y += g * __uint_as_float(w.x & 0xffff0000u); v[j].z += g * __uint_as_float(w.y << 16); v[j].w += g * __uint_as_float(w.y & 0xffff0000u); } }
        float s = 0.f;
#pragma unroll
        for (int j = 0; j < 4; ++j) s += (v[j].x * v[j].x + v[j].y * v[j].y) + (v[j].z * v[j].z + v[j].w * v[j].w);
        const float rstd = rsqrtf(wave_sum(s) * (1.f / DM) + EPS);
#pragma unroll
        for (int j = 0; j < 4; ++j) { const f32x4 g = ((const f32x4*)p.final_g)[64 * j + lane]; xr[64 * j] = v[j] * rstd * g; }
    }
}

#define LAS __attribute__((address_space(3)))
#define GAS __attribute__((address_space(1)))
typedef GAS unsigned gu32;
#define RLX_AGENT __ATOMIC_RELAXED, __HIP_MEMORY_SCOPE_AGENT
#define VM_WAIT() asm volatile("s_waitcnt vmcnt(0)" ::: "memory")
constexpr int NWAVES = 8, NTHR = 512;
constexpr int RING_BYTES = 131072;
constexpr int LDSCTL_OFF = RING_BYTES, MISC_OFF = LDSCTL_OFF + 320;
constexpr int TAB_OFF = RING_BYTES + 1024;
constexpr int TAB_UL = TAB_OFF, TAB_PS = TAB_OFF + 256, TAB_CN = TAB_OFF + 256 + 160, TAB_NU = TAB_OFF + 256 + 160 + 128, TAB_UC = TAB_OFF + 256 + 160 + 128 + 16;
constexpr int GTAB_OFF = TAB_OFF + 1024;
constexpr int LDS_BYTES = 163840;
static_assert(GTAB_OFF + 20 * 256 * 4 <= LDS_BYTES, "LDS map");
constexpr int CW_BAR = 4096;

namespace pg8 {
constexpr int BM = 256, BK = 64, HALF = 128, HTB = HALF * BK * 2, STAGE_BYTES = 8 * HTB, NXCD = 8, WGM = 8;
__host__ __device__ __forceinline__ int lds_byte(int r, int c) { const int st = (r >> 4) * 2 + (c >> 5), rr = r & 15, cc = c & 31, ob = rr * 64 + cc * 2; return st * 1024 + (ob ^ (((ob >> 9) & 1) << 5)); }
__host__ __device__ __forceinline__ void stage_rc(int b, int& R, int& C) { const int st = b / 1024, sb = b % 1024, swz = sb ^ (((sb >> 9) & 1) << 5); R = (st >> 1) * 16 + swz / 64; C = (st & 1) * 32 + (swz % 64) / 2; }
__host__ __device__ __forceinline__ int perm32(int rho) { const int n = rho >> 4, i = rho & 15; return 8 * (i >> 2) + 4 * n + (i & 3); }
__device__ __forceinline__ unsigned cvt_pk_bf16(float lo, float hi) { unsigned r; asm volatile("v_cvt_pk_bf16_f32 %0, %1, %2" : "=v"(r) : "v"(lo), "v"(hi)); return r; }

struct Unit { const char* a; const char* b; int pm, pn, e, slot; };

__device__ __forceinline__ int xcd_remap(int L, int nwg) { const int q = nwg / NXCD, r = nwg % NXCD, xcd = L % NXCD, off = L / NXCD; return (xcd < r ? xcd * (q + 1) : r * (q + 1) + (xcd - r) * q) + off; }

struct StaticOrder {
    const char* A; const char* Bt; int nM, nN, nwg, G, c; size_t tstep;
    __device__ void init(const void* A_, const void* Bt_, int M, int N, int K, int G_, int c_) { A = (const char*)A_; Bt = (const char*)Bt_; nM = M / BM; nN = N / BM; nwg = nM * nN; G = G_; c = c_; tstep = (size_t)BM * K * 2; }
    __device__ __forceinline__ bool next(int i, Unit& u) const {
        const long L = (long)i * G + c; if (L >= nwg) return false;
        const int wgid = xcd_remap((int)L, nwg);
        const int nig = WGM * nN, gid = wgid / nig, fm = gid * WGM, gsz = (nM - fm) < WGM ? (nM - fm) : WGM;
        u.pm = fm + ((wgid % nig) % gsz); u.pn = (wgid % nig) / gsz; u.e = 0; u.slot = 0;
        u.a = A + (size_t)u.pm * tstep; u.b = Bt + (size_t)u.pn * tstep; return true;
    }
};

template <class Epi, class Sched, bool GATHER, bool F8 = false, int sA = 0x7f7f7f7f, int sB = 0x7f7f7f7f>
__device__ __forceinline__ void gemm_phase(LAS unsigned char* lds, const int rowbytes, const Sched& S, const Epi& E, const LAS unsigned* gtab) {
    int tid_ = threadIdx.x; asm volatile("" : "+v"(tid_));
    const int tid = tid_, wid = __builtin_amdgcn_readfirstlane(tid >> 6), lane = tid & 63, wr = wid >> 2, wc = wid & 3, fr = lane & 15, fq = lane >> 4;
    int nt = rowbytes / 128; asm volatile("" : "+s"(nt));
    int R0, C0; stage_rc(tid * 16, R0, C0); const int Rb0 = Epi::PERM ? ((R0 & ~31) + perm32(R0 & 31)) : R0;
    const unsigned vA0 = (unsigned)(R0 * rowbytes + C0 * 2), vB0 = (unsigned)(Rb0 * rowbytes + C0 * 2), coff = (unsigned)(C0 * 2);
    unsigned vAg[2][2] = {{0u, 0u}, {0u, 0u}};
    const size_t pstep = (size_t)64 * rowbytes;
    const size_t kstep = (size_t)(BK * 2);
    const size_t hstep = (size_t)HALF * rowbytes;
    const unsigned ldsw = (unsigned)wid * 1024u;
    const int aoff = lds_byte(wr * 64 + fr, fq * 8), boff = lds_byte(wc * 32 + fr, fq * 8);
#define PG8_SA(b, h) (((b) * 2 + (h)) * HTB)
#define PG8_SB(b, h) ((4 + (b) * 2 + (h)) * HTB)
#define PG8_STAGE_B(bufoff, gbase) do { _Pragma("unroll") for (int _i = 0; _i < 2; ++_i) \
        __builtin_amdgcn_global_load_lds((const unsigned*)((const char*)(gbase) + _i * pstep + vB0), (LAS unsigned*)(lds + (bufoff) + ldsw + _i * 8192), 16, 0, 0); } while (0)
#define PG8_STAGE_A(bufoff, gbase, h) do { _Pragma("unroll") for (int _i = 0; _i < 2; ++_i) { \
        if (GATHER) __builtin_amdgcn_global_load_lds((const unsigned*)((const char*)(gbase) + vAg[h][_i]), (LAS unsigned*)(lds + (bufoff) + ldsw + _i * 8192), 16, 0, 0); \
        else __builtin_amdgcn_global_load_lds((const unsigned*)((const char*)(gbase) + (h) * hstep + _i * pstep + vA0), (LAS unsigned*)(lds + (bufoff) + ldsw + _i * 8192), 16, 0, 0); } } while (0)
#define PG8_LD8(p_) __builtin_shufflevector(*(const LAS v4i_*)(p_), *(const LAS v4i_*)((p_) + 1024), 0, 1, 2, 3, 4, 5, 6, 7)
#define PG8_LDA(dst, b, h) do { _Pragma("unroll") for (int m = 0; m < 4; ++m) dst[m] = PG8_LD8(lds + PG8_SA(b, h) + aoff + m * 2048); } while (0)
#define PG8_LDB(dst, b, h) do { _Pragma("unroll") for (int n = 0; n < 2; ++n) dst[n] = PG8_LD8(lds + PG8_SB(b, h) + boff + n * 2048); } while (0)
#define PG8_LO(x) __builtin_bit_cast(bf16x8, __builtin_shufflevector(x, x, 0, 1, 2, 3))
#define PG8_HI(x) __builtin_bit_cast(bf16x8, __builtin_shufflevector(x, x, 4, 5, 6, 7))
#define PG8_MMA(ai, bj, At, Bt) do { __builtin_amdgcn_s_setprio(1); _Pragma("unroll") for (int m = 0; m < 4; ++m) _Pragma("unroll") for (int n = 0; n < 2; ++n) { \
        if constexpr (F8) acc[ai][bj][m][n] = __builtin_amdgcn_mfma_scale_f32_16x16x128_f8f6f4(Bt[n], At[m], acc[ai][bj][m][n], 0, 0, 0, sB, 0, sA); \
        else { acc[ai][bj][m][n] = __builtin_amdgcn_mfma_f32_16x16x32_bf16(PG8_LO(Bt[n]), PG8_LO(At[m]), acc[ai][bj][m][n], 0, 0, 0); \
               acc[ai][bj][m][n] = __builtin_amdgcn_mfma_f32_16x16x32_bf16(PG8_HI(Bt[n]), PG8_HI(At[m]), acc[ai][bj][m][n], 0, 0, 0); } } \
        __builtin_amdgcn_s_setprio(0); } while (0)
#define PG8_WAIT_V(n) asm volatile("s_waitcnt vmcnt(" #n ")" ::: "memory")
#define PG8_WAIT_L(n) asm volatile("s_waitcnt lgkmcnt(" #n ")" ::: "memory")
#define PG8_BAR __builtin_amdgcn_s_barrier()
#define PG8_SCHED __builtin_amdgcn_sched_barrier(0)
#define PG8_GATHER_OFFS(u) do { if (GATHER) { const LAS unsigned* _g = gtab + (u).slot * 256 + R0; \
        vAg[0][0] = _g[0] + coff; vAg[0][1] = _g[64] + coff; vAg[1][0] = _g[HALF] + coff; vAg[1][1] = _g[HALF + 64] + coff; } } while (0)
    Unit cur, nxt; int ui = 0;
    if (!S.next(0, cur)) return;
    f32x4 acc[2][2][4][2];
#pragma unroll
    for (int a = 0; a < 2; ++a)
#pragma unroll
        for (int b = 0; b < 2; ++b)
#pragma unroll
            for (int m = 0; m < 4; ++m)
#pragma unroll
                for (int n = 0; n < 2; ++n) acc[a][b][m][n] = (f32x4){0.f, 0.f, 0.f, 0.f};
    typedef int v4i_ __attribute__((ext_vector_type(4))); typedef int v8i_ __attribute__((ext_vector_type(8)));
    v8i_ At[4], B0[2], B1[2];
    const char* cA = cur.a; const char* cB = cur.b;
    PG8_GATHER_OFFS(cur);
    PG8_STAGE_B(PG8_SB(0, 0), cB); PG8_STAGE_B(PG8_SB(0, 1), cB + hstep); PG8_STAGE_A(PG8_SA(0, 0), cA, 0); PG8_STAGE_A(PG8_SA(0, 1), cA, 1);
    if (wr == 1) PG8_BAR;
    PG8_WAIT_V(2); PG8_BAR;
    PG8_STAGE_B(PG8_SB(1, 0), cB + kstep); PG8_STAGE_A(PG8_SA(1, 0), cA + kstep, 0); PG8_STAGE_B(PG8_SB(1, 1), cB + hstep + kstep);
    PG8_WAIT_V(6); PG8_BAR;
    for (;;) {
        const bool has_next = S.next(ui + 1, nxt);
        const char* nA = has_next ? nxt.a : cA; const char* nB = has_next ? nxt.b : cB;
#pragma nounroll
        for (int t = 0; t < nt; t += 2) {
            const bool last = (t == nt - 2);
            const char* a1 = cA + (size_t)(t + 1) * kstep;
            const char* a2 = last ? nA : cA + (size_t)(t + 2) * kstep; const char* b2 = last ? nB : cB + (size_t)(t + 2) * kstep;
            const char* a3 = a2 + kstep; const char* b3 = b2 + kstep;
            PG8_LDB(B0, 0, 0); PG8_LDB(B1, 0, 1); PG8_SCHED; PG8_LDA(At, 0, 0); PG8_STAGE_A(PG8_SA(1, 1), a1, 1);
            if (GATHER) { if (last && has_next) PG8_GATHER_OFFS(nxt); }
            PG8_WAIT_V(8); PG8_WAIT_L(0); PG8_BAR; PG8_MMA(0, 0, At, B0); PG8_MMA(0, 1, At, B1); PG8_BAR; PG8_SCHED;
            PG8_LDA(At, 0, 1); PG8_STAGE_B(PG8_SB(0, 0), b2); PG8_STAGE_B(PG8_SB(0, 1), b2 + hstep); PG8_STAGE_A(PG8_SA(0, 0), a2, 0);
            PG8_WAIT_V(8); PG8_WAIT_L(0); PG8_BAR; PG8_MMA(1, 0, At, B0); PG8_MMA(1, 1, At, B1); PG8_BAR; PG8_SCHED;
            PG8_LDB(B0, 1, 0); PG8_LDB(B1, 1, 1); PG8_SCHED; PG8_LDA(At, 1, 0); PG8_STAGE_A(PG8_SA(0, 1), a2, 1);
            PG8_WAIT_V(8); PG8_WAIT_L(0); PG8_BAR; PG8_MMA(0, 0, At, B0); PG8_MMA(0, 1, At, B1); PG8_BAR; PG8_SCHED;
            PG8_LDA(At, 1, 1); PG8_STAGE_B(PG8_SB(1, 0), b3); PG8_STAGE_B(PG8_SB(1, 1), b3 + hstep); PG8_STAGE_A(PG8_SA(1, 0), a3, 0);
            PG8_WAIT_V(8); PG8_WAIT_L(0); PG8_BAR; PG8_MMA(1, 0, At, B0); PG8_MMA(1, 1, At, B1); PG8_BAR; PG8_SCHED;
        }
        if (wr == 0) PG8_BAR;
        E(acc, cur, wr, wc, fr, fq);
        if (!has_next) break;
#pragma unroll
        for (int a = 0; a < 2; ++a)
#pragma unroll
            for (int b = 0; b < 2; ++b)
#pragma unroll
                for (int m = 0; m < 4; ++m)
#pragma unroll
                    for (int n = 0; n < 2; ++n) acc[a][b][m][n] = (f32x4){0.f, 0.f, 0.f, 0.f};
        cur = nxt; cA = nA; cB = nB; ++ui;
        if (wr == 1) PG8_BAR;
    }
    PG8_WAIT_V(0);
    PG8_BAR;
#undef PG8_SA
#undef PG8_SB
#undef PG8_STAGE_A
#undef PG8_STAGE_B
#undef PG8_LDA
#undef PG8_LDB
#undef PG8_LD8
#undef PG8_LO
#undef PG8_HI
#undef PG8_MMA
#undef PG8_WAIT_V
#undef PG8_WAIT_L
#undef PG8_BAR
#undef PG8_SCHED
#undef PG8_GATHER_OFFS
}

constexpr size_t SEC = (size_t)16 * SEQ * 128;
struct EpiProj {
    static constexpr bool PERM = true;
    bf16_t* O;
    __device__ __forceinline__ void operator()(const f32x4 (&acc)[2][2][4][2], const Unit& u, int wr, int wc, int fr, int fq) const {
        const int row0 = u.pm * BM + wr * 64 + fr;
        const int b = row0 / SEQ, t0 = row0 % SEQ;
        const float sc = (u.pn == 8 || u.pn == 9) ? QSCALE : 1.f;
#pragma unroll
        for (int bj = 0; bj < 2; ++bj) { const int c0 = u.pn * BM + bj * HALF + wc * 32 + 8 * fq, sec = c0 >> 9, cs = c0 & 511, h = cs >> 7;
            bf16_t* base; int pitch;
            if (sec == 4 || sec == 5) { base = O + (size_t)sec * SEC + ((size_t)((b * 4 + h) * 2 + ((cs >> 6) & 1)) * SEQ + t0) * 64 + (cs & 63); pitch = 64; }
            else { base = O + (size_t)sec * SEC + ((size_t)(b * 4 + h) * SEQ + t0) * 128 + (cs & 127); pitch = 128; }
#pragma unroll
            for (int ai = 0; ai < 2; ++ai)
#pragma unroll
                for (int m = 0; m < 4; ++m) { const f32x4 v0 = acc[ai][bj][m][0] * sc, v1 = acc[ai][bj][m][1] * sc;
                    u32x4 w; w.x = cvt_pk_bf16(v0[0], v0[1]); w.y = cvt_pk_bf16(v0[2], v0[3]); w.z = cvt_pk_bf16(v1[0], v1[1]); w.w = cvt_pk_bf16(v1[2], v1[3]);
                    *(u32x4*)(base + (size_t)(ai * HALF + m * 16) * pitch) = w; } }
    }
};
struct EpiOut {
    static constexpr bool PERM = false;
    const float* X; float* O;
    __device__ __forceinline__ void operator()(const f32x4 (&acc)[2][2][4][2], const Unit& u, int wr, int wc, int fr, int fq) const {
        const int row0 = u.pm * BM + wr * 64 + fr, col0 = u.pn * BM + wc * 32 + 4 * fq;
#pragma unroll
        for (int ai = 0; ai < 2; ++ai)
#pragma unroll
            for (int m = 0; m < 4; ++m) { const size_t off = (size_t)(row0 + ai * HALF + m * 16) * DM + col0;
#pragma unroll
                for (int bj = 0; bj < 2; ++bj)
#pragma unroll
                    for (int n = 0; n < 2; ++n) { const f32x4 xv = *(const f32x4*)(X + off + bj * HALF + n * 16); *(f32x4*)(O + off + bj * HALF + n * 16) = xv + acc[ai][bj][m][n]; } }
    }
};
__device__ __forceinline__ unsigned pk4_fp8(float a, float b, float c, float d) { int w = __builtin_amdgcn_cvt_pk_fp8_f32(a, b, 0, false); w = __builtin_amdgcn_cvt_pk_fp8_f32(c, d, w, true); return (unsigned)w; }
constexpr float ACT_SCALE = 4.f;
struct EpiSwiglu {
    static constexpr bool PERM = true;
    unsigned char* O; const float* bgu;
    __device__ __forceinline__ void operator()(const f32x4 (&acc)[2][2][4][2], const Unit& u, int wr, int wc, int fr, int fq) const {
        const int row0 = u.pm * BM + wr * 64 + fr, col0 = u.pn * HALF + wc * 32 + 8 * fq;
        const float* bb = bgu + (size_t)u.e * 2 * FF + col0;
        const f32x4 bg0 = *(const f32x4*)(bb), bg1 = *(const f32x4*)(bb + 4), bu0 = *(const f32x4*)(bb + FF), bu1 = *(const f32x4*)(bb + FF + 4);
#pragma unroll
        for (int ai = 0; ai < 2; ++ai)
#pragma unroll
            for (int m = 0; m < 4; ++m) { unsigned char* rowp = O + (size_t)(row0 + ai * HALF + m * 16) * FF + col0;
                float r[8];
#pragma unroll
                for (int n = 0; n < 2; ++n) { const f32x4 gv = acc[ai][0][m][n] + (n ? bg1 : bg0), uv = acc[ai][1][m][n] + (n ? bu1 : bu0);
#pragma unroll
                    for (int j = 0; j < 4; ++j) { const float g = fminf(gv[j], 7.f), uu = fminf(fmaxf(uv[j], -7.f), 7.f);
                        r[n * 4 + j] = ACT_SCALE * (uu + 1.f) * g * __builtin_amdgcn_rcpf(1.f + __builtin_amdgcn_exp2f(-1.702f * LOG2E * g)); } }
                u32x2 w; w.x = pk4_fp8(r[0], r[1], r[2], r[3]); w.y = pk4_fp8(r[4], r[5], r[6], r[7]);
                *(u32x2*)(rowp) = w; }
    }
};
struct EpiDown {
    static constexpr bool PERM = true;
    bf16_t* O; const float* bd;
    __device__ __forceinline__ void operator()(const f32x4 (&acc)[2][2][4][2], const Unit& u, int wr, int wc, int fr, int fq) const {
        const int row0 = u.pm * BM + wr * 64 + fr, col0 = u.pn * BM + wc * 32 + 8 * fq;
        const float* bb = bd + (size_t)u.e * DM + col0;
#pragma unroll
        for (int bj = 0; bj < 2; ++bj) { const f32x4 bv0 = *(const f32x4*)(bb + bj * HALF), bv1 = *(const f32x4*)(bb + bj * HALF + 4);
#pragma unroll
            for (int ai = 0; ai < 2; ++ai)
#pragma unroll
                for (int m = 0; m < 4; ++m) { bf16_t* rowp = O + (size_t)(row0 + ai * HALF + m * 16) * DM + col0 + bj * HALF;
                    const f32x4 v0 = acc[ai][bj][m][0] + bv0, v1 = acc[ai][bj][m][1] + bv1;
                    u32x4 w; w.x = cvt_pk_bf16(v0[0], v0[1]); w.y = cvt_pk_bf16(v0[2], v0[3]); w.z = cvt_pk_bf16(v1[0], v1[1]); w.w = cvt_pk_bf16(v1[2], v1[3]);
                    *(u32x4*)(rowp) = w; } }
    }
};
}

#define XB_TMO      128
#define XB_XCNT(j)  (256  + 64 * (j))
#define XB_XSUB(j)  (1280 + 64 * (j))
#define XB_XGEN(j)  (2304 + 64 * (j))
#define XB_TOP      3328
#define XB_TOPGEN   3392
#define XCD_BAR_WORDS 3456
#define XB_SPIN_CAP (1u << 22)
__device__ __forceinline__ unsigned xb_ld(unsigned* p)              { return __hip_atomic_load(p, __ATOMIC_RELAXED, __HIP_MEMORY_SCOPE_AGENT); }
__device__ __forceinline__ unsigned xb_add(unsigned* p, unsigned v) { return __hip_atomic_fetch_add(p, v, __ATOMIC_RELAXED, __HIP_MEMORY_SCOPE_AGENT); }
__device__ __forceinline__ unsigned xb_xcc_id() { return (unsigned)__builtin_amdgcn_s_getreg((3 << 11) | 20) & 0xFu; }
#define XB_SPIN(cond, bar) do { unsigned _sp = 0; while (cond) { __builtin_amdgcn_s_sleep(1); \
    if ((++_sp & 255u) == 0u) { if (xb_ld(&(bar)[XB_TMO])) break; if (_sp > XB_SPIN_CAP) { atomicAdd(&(bar)[XB_TMO], 1u); break; } } } } while (0)
struct XcdBarrier { unsigned* bar; unsigned x; volatile LAS unsigned* st; };
__device__ __forceinline__ XcdBarrier xcd_barrier_post(unsigned* bar, volatile LAS unsigned* st) {
    XcdBarrier b; b.bar = bar; b.x = xb_xcc_id(); b.st = st;
    if (threadIdx.x == 0) (void)xb_add(&bar[XB_XCNT(b.x)], 1u);
    return b;
}
__device__ __forceinline__ void xcd_barrier_complete(unsigned* bar, unsigned x, unsigned& nloc, unsigned& nx) {
    const unsigned G = gridDim.x * gridDim.y * gridDim.z;
    unsigned sum, cnt, mine, sp = 0u;
    for (;;) {
        sum = 0u; cnt = 0u; mine = 0u;
#pragma unroll
        for (unsigned j = 0; j < 16; ++j) { const unsigned c = xb_ld(&bar[XB_XCNT(j)]); sum += c; cnt += (c > 0u) ? 1u : 0u; mine = (j == x) ? c : mine; }
        if (sum == G) break;
        __builtin_amdgcn_s_sleep(1);
        if ((++sp & 255u) == 0u) { if (xb_ld(&bar[XB_TMO])) break; if (sp > XB_SPIN_CAP) { atomicAdd(&bar[XB_TMO], 1u); break; } }
    }
    nloc = mine > 0u ? mine : 1u; nx = cnt > 0u ? cnt : 1u;
}
__device__ __forceinline__ void xcd_barrier(const XcdBarrier& b) {
    asm volatile("s_waitcnt vmcnt(0)" ::: "memory");
    __syncthreads();
    if (threadIdx.x == 0) {
        unsigned* bar = b.bar;
        __builtin_amdgcn_s_waitcnt(0);
        unsigned nloc = b.st[0], nx = b.st[1];
        if (nloc == 0u) { xcd_barrier_complete(bar, b.x, nloc, nx); b.st[0] = nloc; b.st[1] = nx; }
        const unsigned old = xb_add(&bar[XB_XSUB(b.x)], 1u);
        const unsigned gen = old / nloc;
        if (old + 1u == (gen + 1u) * nloc) {
            __builtin_amdgcn_fence(__ATOMIC_RELEASE, "agent");
            asm volatile("s_waitcnt vmcnt(0)" ::: "memory");
            const unsigned og = xb_add(&bar[XB_TOP], 1u);
            const unsigned tg = og / nx;
            if (og + 1u == (tg + 1u) * nx) xb_add(&bar[XB_TOPGEN], 1u);
            else XB_SPIN(xb_ld(&bar[XB_TOPGEN]) == tg, bar);
            __builtin_amdgcn_fence(__ATOMIC_ACQUIRE, "agent");
            xb_add(&bar[XB_XGEN(b.x)], 1u);
            asm volatile("s_waitcnt vmcnt(0)" ::: "memory");
        } else {
            XB_SPIN(xb_ld(&bar[XB_XGEN(b.x)]) == gen, bar);
            __builtin_amdgcn_fence(__ATOMIC_ACQUIRE, "agent");
            asm volatile("s_waitcnt vmcnt(0)" ::: "memory");
        }
    }
    __syncthreads();
}

template <int NN, bool GU, int EB>
struct MoeOrder {
    const LAS int* UL; const LAS int* PS; int n; const char* A; const char* B;
    __device__ __forceinline__ bool next(int i, pg8::Unit& u) const {
        if (i >= n) return false;
        const int w = __builtin_amdgcn_readfirstlane(UL[i]); const int e = w & 255, rt = (w >> 8) & 255, pn = w >> 16;
        const int ps = __builtin_amdgcn_readfirstlane(PS[e]);
        u.e = e; u.pn = pn; u.pm = (ps >> 8) + rt; u.slot = i;
        if (GU) { u.a = A; u.b = B + ((size_t)e * 2 * FF + (size_t)pn * 256) * DM * EB; }
        else { u.a = A + (size_t)u.pm * 256 * FF * EB; u.b = B + ((size_t)e * DM + (size_t)pn * 256) * FF * EB; }
        return true;
    }
};
template <int NN>
__device__ __forceinline__ int moe_build_units(LAS unsigned char* lds, const unsigned* ctl, int G, int c) {
    LAS int* UL = (LAS int*)(lds + TAB_UL); LAS int* PS = (LAS int*)(lds + TAB_PS); LAS int* CN = (LAS int*)(lds + TAB_CN); LAS int* NU = (LAS int*)(lds + TAB_NU); LAS int* UC = (LAS int*)(lds + TAB_UC);
    __syncthreads();
    if (threadIdx.x == 0) {
        int a = 0, uc = 0;
        for (int e = 0; e < NE; ++e) { const int cnt = (int)__hip_atomic_load(ctl + CW_CNT + e, RLX_AGENT); CN[e] = cnt; PS[e] = a; UC[e] = uc; const int nt = (cnt + 255) >> 8; a += nt << 8; uc += nt * NN; }
        PS[NE] = a; UC[NE] = uc;
        const int nwg = uc; int n = 0;
        for (int i = 0;; ++i) { const long L = (long)i * G + c; if (L >= nwg || n >= 20) break;
            const int wgid = pg8::xcd_remap((int)L, nwg);
            int e = 0; while (UC[e + 1] <= wgid) ++e;
            const int l = wgid - UC[e], nte = (CN[e] + 255) >> 8;
            const int nig = pg8::WGM * NN, gid = l / nig, fm = gid * pg8::WGM, gsz = (nte - fm) < pg8::WGM ? (nte - fm) : pg8::WGM;
            const int rt = fm + ((l % nig) % gsz), pn = (l % nig) / gsz;
            UL[n++] = e | (rt << 8) | (pn << 16); }
        NU[0] = n;
    }
    __syncthreads();
    return __builtin_amdgcn_readfirstlane(NU[0]);
}

namespace att {
using f32x16 = __attribute__((ext_vector_type(16))) float;
using s16x4 = __attribute__((ext_vector_type(4))) short;
constexpr int NW = 8, QBLK = 32, KVBLK = 64, LDQK = 64, LDV = 128;
constexpr int SHM_V = KVBLK * 128 * 2, SHM_K = KVBLK * 64 * 2;
constexpr int NSLOT = 3, OFF_V = 0, OFF_ST = NSLOT * SHM_V, OFF_K = 132096, OFF_WS = OFF_K + NSLOT * SHM_K, OFF_BT = OFF_WS + NW * 64 * 4, ATT_LDS_END = OFF_BT + 1024;
static_assert(OFF_ST + NW * 8192 <= 131072 && ATT_LDS_END <= 163840, "attention LDS map");
constexpr float THRL = 8.f;
#define KSWZ(row, colB) ((row) * 128 + ((colB) ^ ((((row) >> 1) & 7) << 4)))
#define SBAR() __builtin_amdgcn_sched_barrier(0)
__device__ __forceinline__ int crow(int r, int hi) { return (r & 3) + 8 * (r >> 2) + 4 * hi; }
__device__ __forceinline__ unsigned cvtpk(float lo, float hi) { unsigned r; asm volatile("v_cvt_pk_bf16_f32 %0, %1, %2" : "=v"(r) : "v"(lo), "v"(hi)); return r; }

__device__ __forceinline__ void partialSM(f32x16& p0, f32x16& p1, float& m_reg, float& alpha) {
  float pmax = p0[0];
#pragma unroll
  for (int r = 1; r < 16; ++r) pmax = fmaxf(pmax, p0[r]);
#pragma unroll
  for (int r = 0; r < 16; ++r) pmax = fmaxf(pmax, p1[r]);
  { auto rr = __builtin_amdgcn_permlane32_swap(__float_as_uint(pmax), __float_as_uint(pmax), false, false);
    pmax = fmaxf(__uint_as_float(rr[0]), __uint_as_float(rr[1])); }
  float mn;
  if (__builtin_expect(__all(pmax - m_reg <= THRL), 1)) { mn = m_reg; alpha = 1.f; }
  else { mn = fmaxf(m_reg, pmax); alpha = __builtin_amdgcn_exp2f(m_reg - mn); m_reg = mn; }
#pragma unroll
  for (int r = 0; r < 16; ++r) p0[r] = p0[r] - mn;
#pragma unroll
  for (int r = 0; r < 16; ++r) p1[r] = p1[r] - mn;
#pragma unroll
  for (int r = 0; r < 16; ++r) p0[r] = __builtin_amdgcn_exp2f(p0[r]);
}
__device__ __forceinline__ void finishSM(f32x16& p0, f32x16& p1, float alpha, float& l_reg, bf16x8& pa0, bf16x8& pa1, bf16x8& pa2, bf16x8& pa3) {
#pragma unroll
  for (int r = 0; r < 16; ++r) p1[r] = __builtin_amdgcn_exp2f(p1[r]);
  float ps = 0;
#pragma unroll
  for (int r = 0; r < 16; ++r) ps += p0[r];
#pragma unroll
  for (int r = 0; r < 16; ++r) ps += p1[r];
  { auto rr = __builtin_amdgcn_permlane32_swap(__float_as_uint(ps), __float_as_uint(ps), false, false);
    ps = __uint_as_float(rr[0]) + __uint_as_float(rr[1]); }
  l_reg = l_reg * alpha + ps;
#define PK4(P, BASE, OUT) do { unsigned a0 = cvtpk(P[BASE + 0], P[BASE + 1]), a1 = cvtpk(P[BASE + 2], P[BASE + 3]);   \
    unsigned b0 = cvtpk(P[BASE + 4], P[BASE + 5]), b1 = cvtpk(P[BASE + 6], P[BASE + 7]);                              \
    auto r0 = __builtin_amdgcn_permlane32_swap(a0, b0, false, false); auto r1 = __builtin_amdgcn_permlane32_swap(a1, b1, false, false); \
    u32x4 w = {r0[0], r1[0], r0[1], r1[1]}; OUT = *reinterpret_cast<bf16x8*>(&w); } while (0)
  PK4(p0, 0, pa0); PK4(p0, 8, pa1); PK4(p1, 0, pa2); PK4(p1, 8, pa3);
#undef PK4
}
__device__ __forceinline__ void qkt(f32x16& p0, f32x16& p1, const char* Ks, const bf16x8* qr, int r32, int hi) {
  p0 = f32x16{}; p1 = f32x16{};
#pragma unroll
  for (int d0 = 0; d0 < 4; ++d0) { const int cb = (d0 * 16 + hi * 8) * 2;
    const bf16x8 b0 = *reinterpret_cast<const bf16x8*>(Ks + KSWZ(r32, cb));
    const bf16x8 b1 = *reinterpret_cast<const bf16x8*>(Ks + KSWZ(32 + r32, cb));
    p0 = __builtin_amdgcn_mfma_f32_32x32x16_bf16(b0, qr[d0], p0, 0, 0, 0);
    p1 = __builtin_amdgcn_mfma_f32_32x32x16_bf16(b1, qr[d0], p1, 0, 0, 0); }
}
__device__ __forceinline__ int v_st(int k, int c) { const int kk = (k & ~0xC) | ((k & 4) << 1) | ((k & 8) >> 1); return ((kk >> 3) * 4 + (c >> 5)) * 512 + ((kk & 7) * 32 + (c & 31)) * 2; }
__device__ __forceinline__ int v_rd_base(int lane) { return ((lane & 3) << 3) | (((lane >> 2) & 3) << 6) | (((lane >> 4) & 1) << 5) | (((lane >> 5) & 1) << 8); }
constexpr int v_rd_off(int d0, int ks, int half) { return d0 * 512 + ks * 4096 + half * 2048; }
template <int OFF> __device__ __forceinline__ s16x4 tr_read(int vb) {
  s16x4 r; asm volatile("ds_read_b64_tr_b16 %0, %1 offset:%2" : "=&v"(r) : "v"(vb), "i"(OFF) : "memory"); return r;
}
typedef short v4i16_t __attribute__((ext_vector_type(4)));
template <int OFF> __device__ __forceinline__ s16x4 tr_rd(int vb) {
  return __builtin_bit_cast(s16x4, __builtin_amdgcn_ds_read_tr16_b64_v4i16((__attribute__((address_space(3))) v4i16_t*)(unsigned)(vb + OFF)));
}
template <int D0> __device__ __forceinline__ void pv_one(f32x16& od, int vb, bf16x8 pa0, bf16x8 pa1, bf16x8 pa2, bf16x8 pa3) {
  const s16x4 l0 = tr_rd<v_rd_off(D0, 0, 0)>(vb), h0 = tr_rd<v_rd_off(D0, 0, 1)>(vb), l1 = tr_rd<v_rd_off(D0, 1, 0)>(vb), h1 = tr_rd<v_rd_off(D0, 1, 1)>(vb);
  const s16x4 l2 = tr_rd<v_rd_off(D0, 2, 0)>(vb), h2 = tr_rd<v_rd_off(D0, 2, 1)>(vb), l3 = tr_rd<v_rd_off(D0, 3, 0)>(vb), h3 = tr_rd<v_rd_off(D0, 3, 1)>(vb);
#define PK(L, H) (bf16x8){L[0], L[1], L[2], L[3], H[0], H[1], H[2], H[3]}
  od = __builtin_amdgcn_mfma_f32_32x32x16_bf16(pa0, PK(l0, h0), od, 0, 0, 0);
  od = __builtin_amdgcn_mfma_f32_32x32x16_bf16(pa1, PK(l1, h1), od, 0, 0, 0);
  od = __builtin_amdgcn_mfma_f32_32x32x16_bf16(pa2, PK(l2, h2), od, 0, 0, 0);
  od = __builtin_amdgcn_mfma_f32_32x32x16_bf16(pa3, PK(l3, h3), od, 0, 0, 0);
#undef PK
}
#define PV_RD(D0, L0, H0, L1, H1, L2, H2, L3, H3) do { L0 = tr_rd<v_rd_off(D0, 0, 0)>(vb); H0 = tr_rd<v_rd_off(D0, 0, 1)>(vb); L1 = tr_rd<v_rd_off(D0, 1, 0)>(vb); H1 = tr_rd<v_rd_off(D0, 1, 1)>(vb); \
    L2 = tr_rd<v_rd_off(D0, 2, 0)>(vb); H2 = tr_rd<v_rd_off(D0, 2, 1)>(vb); L3 = tr_rd<v_rd_off(D0, 3, 0)>(vb); H3 = tr_rd<v_rd_off(D0, 3, 1)>(vb); } while (0)
#define PKV(L, H) (bf16x8){L[0], L[1], L[2], L[3], H[0], H[1], H[2], H[3]}
#define PV_MM(OD, L0, H0, L1, H1, L2, H2, L3, H3) do { OD = __builtin_amdgcn_mfma_f32_32x32x16_bf16(pa0, PKV(L0, H0), OD, 0, 0, 0); OD = __builtin_amdgcn_mfma_f32_32x32x16_bf16(pa1, PKV(L1, H1), OD, 0, 0, 0); \
    OD = __builtin_amdgcn_mfma_f32_32x32x16_bf16(pa2, PKV(L2, H2), OD, 0, 0, 0); OD = __builtin_amdgcn_mfma_f32_32x32x16_bf16(pa3, PKV(L3, H3), OD, 0, 0, 0); } while (0)
__device__ __forceinline__ void pv_d0(f32x16* o, int vb, bf16x8 pa0, bf16x8 pa1, bf16x8 pa2, bf16x8 pa3) {
  s16x4 a0, a1, a2, a3, a4, a5, a6, a7, b0, b1, b2, b3, b4, b5, b6, b7;
  PV_RD(0, a0, a1, a2, a3, a4, a5, a6, a7); PV_RD(1, b0, b1, b2, b3, b4, b5, b6, b7); SBAR();
  PV_MM(o[0], a0, a1, a2, a3, a4, a5, a6, a7); SBAR(); PV_RD(2, a0, a1, a2, a3, a4, a5, a6, a7); SBAR();
  PV_MM(o[1], b0, b1, b2, b3, b4, b5, b6, b7); SBAR(); PV_RD(3, b0, b1, b2, b3, b4, b5, b6, b7); SBAR();
  PV_MM(o[2], a0, a1, a2, a3, a4, a5, a6, a7); SBAR();
  PV_MM(o[3], b0, b1, b2, b3, b4, b5, b6, b7);
}
#undef PV_RD
#undef PV_MM
#undef PKV
__device__ __forceinline__ void bias_mask(f32x16& p0, f32x16& p1, int j, int cw, const float* bt, int qoff, int r32, int hi) {
  if (j > cw) {
#pragma unroll
    for (int r = 0; r < 16; ++r) { p0[r] = -INFINITY; p1[r] = -INFINITY; }
  } else if (j >= cw - 2) {
    const float* b = bt + (64 * (j - cw) + 192 - qoff - r32 + 4 * hi);
#pragma unroll
    for (int r = 0; r < 16; ++r) { p0[r] += b[(r & 3) + 8 * (r >> 2)]; p1[r] += b[32 + (r & 3) + 8 * (r >> 2)]; }
  }
}

__device__ __forceinline__ void glds16(const void* gsrc, unsigned lds_dst) { unsigned keep;
  asm volatile("s_mov_b32 %0, m0\n\ts_mov_b32 m0, %2\n\ts_nop 0\n\tglobal_load_lds_dwordx4 %1, off\n\ts_mov_b32 m0, %0" : "=&s"(keep) : "v"(gsrc), "s"(lds_dst) : "memory"); }
__device__ __forceinline__ void attn_unit(const Params& p, int b, int h, int m, int qb, float lam, char* lds, unsigned& g_tacc) {
  const bf16_t* PR = (const bf16_t*)(p.ws + WS_PROJ);
  int tid_ = threadIdx.x; asm volatile("" : "+v"(tid_));
  const int tid = tid_, wid = __builtin_amdgcn_readfirstlane(tid >> 6), lane = tid & 63, r32 = lane & 31, hi = lane >> 5;
  char* V_lds = lds + OFF_V; char* K_lds = lds + OFF_K;
  const unsigned ldsb = (unsigned)(uintptr_t)lds;
  float* ws = (float*)(lds + OFF_WS) + wid * 64; float* li_l = ws; float* al_l = ws + 32; float* bt = (float*)(lds + OFF_BT);
  bf16_t* stash = (bf16_t*)(lds + OFF_ST + wid * 8192);
  __syncthreads();
  if (m == 0 && tid < 256) bt[tid] = (p.rel_bias[t5_bucket(tid - 192) * 4 + h] - p.rel_bias[15 * 4 + h]) * LOG2E;
  const bf16_t* Qb = PR + 4 * pg8::SEC + ((size_t)((b * 4 + h) * 2 + m) * SEQ + qb * 256) * LDQK;
  const bf16_t* Kh = PR + 5 * pg8::SEC + (size_t)((b * 4 + h) * 2 + m) * SEQ * LDQK;
  const bf16_t* Vh = PR + 6 * pg8::SEC + (size_t)(b * 4 + h) * SEQ * LDV;
  const int cw = 4 * qb + (wid >> 1), qoff = 32 * (wid & 1);
  float l_reg = 0; f32x16 o[4] = {}; bf16x8 qr[4];
  const int krow = wid * 8 + (lane >> 3), kch = (lane & 7) ^ ((krow >> 1) & 7);
  const bf16_t* ksrc = Kh + (size_t)krow * LDQK + kch * 8;
  const bf16_t* vsrc0; const bf16_t* vsrc1;
  { const int sub0 = (wid * 2) * 2 + (lane >> 5), kk0 = (sub0 >> 2) * 8 + ((lane & 31) >> 2), k0_ = (kk0 & ~0xC) | ((kk0 & 4) << 1) | ((kk0 & 8) >> 1);
    vsrc0 = Vh + (size_t)k0_ * LDV + (sub0 & 3) * 32 + (lane & 3) * 8;
    const int sub1 = (wid * 2 + 1) * 2 + (lane >> 5), kk1 = (sub1 >> 2) * 8 + ((lane & 31) >> 2), k1_ = (kk1 & ~0xC) | ((kk1 & 4) << 1) | ((kk1 & 8) >> 1);
    vsrc1 = Vh + (size_t)k1_ * LDV + (sub1 & 3) * 32 + (lane & 3) * 8; }
#define DMA_K(tile, slot) glds16(ksrc + (size_t)(tile) * (KVBLK * LDQK), (unsigned)__builtin_amdgcn_readfirstlane((int)(ldsb + OFF_K + (slot) * SHM_K + wid * 1024)))
#define DMA_V(tile, slot) do { glds16(vsrc0 + (size_t)(tile) * (KVBLK * LDV), (unsigned)__builtin_amdgcn_readfirstlane((int)(ldsb + OFF_V + (slot) * SHM_V + wid * 2048))); \
    glds16(vsrc1 + (size_t)(tile) * (KVBLK * LDV), (unsigned)__builtin_amdgcn_readfirstlane((int)(ldsb + OFF_V + (slot) * SHM_V + wid * 2048 + 1024))); } while (0)
#define WAIT_BAR(N) asm volatile("s_waitcnt vmcnt(" #N ") lgkmcnt(0)\n\ts_barrier" ::: "memory")
  DMA_K(0, 0); DMA_V(0, 0); DMA_K(1, 1);
  const bf16_t* Qw = Qb + (size_t)(wid * QBLK + r32) * LDQK + hi * 8;
#pragma unroll
  for (int d0 = 0; d0 < 4; ++d0) qr[d0] = *reinterpret_cast<const bf16x8*>(Qw + d0 * 16);
  const int vb0 = (int)(uintptr_t)V_lds + v_rd_base(lane);
#define RESC(a) do { if (__any((a) < 1.f)) { if (hi == 0) al_l[r32] = (a); asm volatile("s_waitcnt lgkmcnt(0)" ::: "memory"); \
    _Pragma("unroll") for (int d = 0; d < 4; ++d) _Pragma("unroll") for (int r = 0; r < 16; ++r) o[d][r] *= al_l[crow(r, hi)]; } } while (0)
  f32x16 pA0, pA1, pB0, pB1; u32x4 pw0, pw1, pw2, pw3; const int NT = 4 * qb + 4;
  float mhat = 0.f; f32x16 negm = f32x16{}; asm volatile("" : "+v"(negm));
  bool resc = false;
  WAIT_BAR(0);
  DMA_K(2, 2); DMA_V(1, 1);
#define PIN(x) asm volatile("" : "+v"(x))
#define MX3(a, b, c) __builtin_fmaxf(__builtin_fmaxf((a), (b)), (c))
#define ROWMAX(C0, C1, rm) do { float a_ = MX3(C0[0], C0[1], C1[0]), b_ = MX3(C0[2], C0[3], C1[1]); a_ = MX3(a_, C1[2], C1[3]); \
    _Pragma("unroll") for (int r = 4; r < 16; r += 4) { a_ = MX3(a_, C0[r], C0[r + 1]); b_ = MX3(b_, C0[r + 2], C0[r + 3]); a_ = MX3(a_, C1[r], C1[r + 1]); b_ = MX3(b_, C1[r + 2], C1[r + 3]); } \
    rm = __builtin_fmaxf(a_, b_); { auto rr_ = __builtin_amdgcn_permlane32_swap(__float_as_uint(rm), __float_as_uint(rm), false, false); rm = __builtin_fmaxf(__uint_as_float(rr_[0]), __uint_as_float(rr_[1])); } } while (0)
#define RESCALE(C0, C1, dl) do { mhat += (dl); \
    _Pragma("unroll") for (int r = 0; r < 16; ++r) { C0[r] -= (dl); C1[r] -= (dl); } \
    _Pragma("unroll") for (int r = 0; r < 16; ++r) negm[r] = -mhat; PIN(negm); } while (0)
  { const char* Ks = K_lds;
#pragma unroll
    for (int d0 = 0; d0 < 4; ++d0) { const int cb = (d0 * 16 + hi * 8) * 2;
      const bf16x8 b0 = *reinterpret_cast<const bf16x8*>(Ks + KSWZ(r32, cb)), b1 = *reinterpret_cast<const bf16x8*>(Ks + KSWZ(32 + r32, cb));
      if (d0 == 0) { pA0 = __builtin_amdgcn_mfma_f32_32x32x16_bf16(b0, qr[0], negm, 0, 0, 0); pA1 = __builtin_amdgcn_mfma_f32_32x32x16_bf16(b1, qr[0], negm, 0, 0, 0); }
      else { pA0 = __builtin_amdgcn_mfma_f32_32x32x16_bf16(b0, qr[d0], pA0, 0, 0, 0); pA1 = __builtin_amdgcn_mfma_f32_32x32x16_bf16(b1, qr[d0], pA1, 0, 0, 0); } }
    bias_mask(pA0, pA1, 0, cw, bt, qoff, r32, hi);
    float rm; ROWMAX(pA0, pA1, rm); RESCALE(pA0, pA1, rm);
#pragma unroll
    for (int r = 0; r < 16; ++r) { pA0[r] = __builtin_amdgcn_exp2f(pA0[r]); pA1[r] = __builtin_amdgcn_exp2f(pA1[r]); } }
  int sk = 1, sv = 0;
  const bool lead = wid < 4;
#if TSEL >= 20 && TSEL < 30
  unsigned long long tq_;
#define TB() (tq_ = __builtin_amdgcn_s_memrealtime())
#define TE(k) do { if ((k) == TSEL - 20 && blockIdx.x == 0 && wid == PWAVE) g_tacc += (unsigned)(__builtin_amdgcn_s_memrealtime() - tq_); } while (0)
#else
#define TB() do {} while (0)
#define TE(k) do {} while (0)
#endif
#define WB_A(j) do { if ((j) + 2 >= NT) WAIT_BAR(0); else if (lead) WAIT_BAR(5); else WAIT_BAR(3); } while (0)
#define WB_B(j) do { if ((j) + 2 >= NT) WAIT_BAR(0); else if (lead) WAIT_BAR(4); else WAIT_BAR(3); } while (0)
#define KF(i) (*reinterpret_cast<const bf16x8*>(Kt_ + KSWZ(((i) & 1) * 32 + r32, ((((i) >> 1) * 16 + hi * 8) * 2))))
#define CVT(P, B) cvtpk(P[B], P[(B) + 1])
#define GAPA(MF, A0, A1, A2, A3, P, BA, BB, RO) do { MF; sacc += A0; sacc += A1; sacc += A2; sacc += A3; PIN(sacc); \
    { const unsigned ca_ = CVT(P, BA), cb_ = CVT(P, BB); auto rr_ = __builtin_amdgcn_permlane32_swap(ca_, cb_, false, false); RO##l = rr_[0]; RO##h = rr_[1]; } SBAR(); } while (0)
#define HALF_A(j, C0, C1, P0, P1, GQ) do { TB(); WB_A(j); TE(0); TB(); \
    { const int sp = (sk == 0) ? 2 : sk - 1; if ((j) + 2 < NT) DMA_K((j) + 2, sp); } \
    const char* Kt_ = K_lds + sk * SHM_K; unsigned r0l, r0h, r1l, r1h; float sacc = P0[0] + P0[1]; SBAR(); \
    if (GQ) { const bf16x8 kf0 = KF(0), kf1 = KF(1), kf2 = KF(2), kf3 = KF(3), kf4 = KF(4), kf5 = KF(5), kf6 = KF(6), kf7 = KF(7); SBAR(); \
      GAPA(C0 = __builtin_amdgcn_mfma_f32_32x32x16_bf16(kf0, qr[0], negm, 0, 0, 0), P0[2], P0[3], P0[4], P0[5], P0, 0, 4, r0); \
      GAPA(C1 = __builtin_amdgcn_mfma_f32_32x32x16_bf16(kf1, qr[0], negm, 0, 0, 0), P0[6], P0[7], P0[8], P0[9], P0, 2, 6, r1); \
      pw0 = (u32x4){r0l, r1l, r0h, r1h}; \
      GAPA(C0 = __builtin_amdgcn_mfma_f32_32x32x16_bf16(kf2, qr[1], C0, 0, 0, 0), P0[10], P0[11], P0[12], P0[13], P0, 8, 12, r0); \
      GAPA(C1 = __builtin_amdgcn_mfma_f32_32x32x16_bf16(kf3, qr[1], C1, 0, 0, 0), P0[14], P0[15], P1[0], P1[1], P0, 10, 14, r1); \
      pw1 = (u32x4){r0l, r1l, r0h, r1h}; \
      GAPA(C0 = __builtin_amdgcn_mfma_f32_32x32x16_bf16(kf4, qr[2], C0, 0, 0, 0), P1[2], P1[3], P1[4], P1[5], P1, 0, 4, r0); \
      GAPA(C1 = __builtin_amdgcn_mfma_f32_32x32x16_bf16(kf5, qr[2], C1, 0, 0, 0), P1[6], P1[7], P1[8], P1[9], P1, 2, 6, r1); \
      pw2 = (u32x4){r0l, r1l, r0h, r1h}; \
      GAPA(C0 = __builtin_amdgcn_mfma_f32_32x32x16_bf16(kf6, qr[3], C0, 0, 0, 0), P1[10], P1[11], P1[12], P1[13], P1, 8, 12, r0); \
      GAPA(C1 = __builtin_amdgcn_mfma_f32_32x32x16_bf16(kf7, qr[3], C1, 0, 0, 0), P1[14], P1[15], 0.f, 0.f, P1, 10, 14, r1); \
      pw3 = (u32x4){r0l, r1l, r0h, r1h}; \
    } else { \
      GAPA((void)0, P0[2], P0[3], P0[4], P0[5], P0, 0, 4, r0); GAPA((void)0, P0[6], P0[7], P0[8], P0[9], P0, 2, 6, r1); pw0 = (u32x4){r0l, r1l, r0h, r1h}; \
      GAPA((void)0, P0[10], P0[11], P0[12], P0[13], P0, 8, 12, r0); GAPA((void)0, P0[14], P0[15], P1[0], P1[1], P0, 10, 14, r1); pw1 = (u32x4){r0l, r1l, r0h, r1h}; \
      GAPA((void)0, P1[2], P1[3], P1[4], P1[5], P1, 0, 4, r0); GAPA((void)0, P1[6], P1[7], P1[8], P1[9], P1, 2, 6, r1); pw2 = (u32x4){r0l, r1l, r0h, r1h}; \
      GAPA((void)0, P1[10], P1[11], P1[12], P1[13], P1, 8, 12, r0); GAPA((void)0, P1[14], P1[15], 0.f, 0.f, P1, 10, 14, r1); pw3 = (u32x4){r0l, r1l, r0h, r1h}; \
    } \
    l_reg += sacc; resc = false; \
    if (GQ) { bias_mask(C0, C1, (j), cw, bt, qoff, r32, hi); float rm; ROWMAX(C0, C1, rm); \
      if (__builtin_expect(__any(rm > THRL), 0)) { const float dl = __builtin_fmaxf(rm, 0.f); RESCALE(C0, C1, dl); const float f = __builtin_amdgcn_exp2f(-dl); l_reg *= f; if (hi == 0) al_l[r32] = f; resc = true; } } \
    TE(1); } while (0)
#define PAF(k) __builtin_bit_cast(bf16x8, pw##k)
#define VFR(S, i) (bf16x8){S##l##i[0], S##l##i[1], S##l##i[2], S##l##i[3], S##h##i[0], S##h##i[1], S##h##i[2], S##h##i[3]}
#define VRD(S, D0, i) do { S##l##i = tr_rd<v_rd_off(D0, i, 0)>(vb_); S##h##i = tr_rd<v_rd_off(D0, i, 1)>(vb_); } while (0)
#define EX2(C, B) do { C[B] = __builtin_amdgcn_exp2f(C[B]); C[(B) + 1] = __builtin_amdgcn_exp2f(C[(B) + 1]); PIN(C); } while (0)
#define GAPB(OD, K, FR, EXS, RD) do { OD = __builtin_amdgcn_mfma_f32_32x32x16_bf16(PAF(K), FR, OD, 0, 0, 0); EXS; RD; SBAR(); } while (0)
#define HALF_B(j, C0, C1, GP) do { TB(); WB_B(j); TE(0); TB(); \
    { const int sn = (sk == 2) ? 0 : sk + 1; if ((j) + 1 < NT) DMA_V((j) + 1, sn); } \
    const int vb_ = vb0 + sv * SHM_V; s16x4 Fl0, Fh0, Fl1, Fh1, Fl2, Fh2, Fl3, Fh3, Gl0, Gh0, Gl1, Gh1, Gl2, Gh2, Gl3, Gh3; \
    VRD(F, 0, 0); VRD(F, 0, 1); VRD(F, 0, 2); VRD(F, 0, 3); SBAR(); \
    SBAR(); \
    GAPB(o[0], 0, VFR(F, 0), if (GP) EX2(C0, 0), VRD(G, 1, 0)); GAPB(o[0], 1, VFR(F, 1), if (GP) EX2(C0, 2), VRD(G, 1, 1)); \
    GAPB(o[0], 2, VFR(F, 2), if (GP) EX2(C0, 4), VRD(G, 1, 2)); GAPB(o[0], 3, VFR(F, 3), if (GP) EX2(C0, 6), VRD(G, 1, 3)); \
    GAPB(o[1], 0, VFR(G, 0), if (GP) EX2(C0, 8), VRD(F, 2, 0)); GAPB(o[1], 1, VFR(G, 1), if (GP) EX2(C0, 10), VRD(F, 2, 1)); \
    GAPB(o[1], 2, VFR(G, 2), if (GP) EX2(C0, 12), VRD(F, 2, 2)); GAPB(o[1], 3, VFR(G, 3), if (GP) EX2(C0, 14), VRD(F, 2, 3)); \
    GAPB(o[2], 0, VFR(F, 0), if (GP) EX2(C1, 0), VRD(G, 3, 0)); GAPB(o[2], 1, VFR(F, 1), if (GP) EX2(C1, 2), VRD(G, 3, 1)); \
    GAPB(o[2], 2, VFR(F, 2), if (GP) EX2(C1, 4), VRD(G, 3, 2)); GAPB(o[2], 3, VFR(F, 3), if (GP) EX2(C1, 6), VRD(G, 3, 3)); \
    GAPB(o[3], 0, VFR(G, 0), if (GP) EX2(C1, 8), (void)0); GAPB(o[3], 1, VFR(G, 1), if (GP) EX2(C1, 10), (void)0); \
    GAPB(o[3], 2, VFR(G, 2), if (GP) EX2(C1, 12), (void)0); GAPB(o[3], 3, VFR(G, 3), if (GP) EX2(C1, 14), (void)0); \
    if (resc) { asm volatile("s_waitcnt lgkmcnt(0)" ::: "memory"); \
      _Pragma("unroll") for (int d = 0; d < 4; ++d) _Pragma("unroll") for (int r = 0; r < 16; ++r) o[d][r] *= al_l[crow(r, hi)]; } \
    TE(2); sv = sk; sk = (sk == 2) ? 0 : sk + 1; } while (0)
  if (!lead) asm volatile("s_barrier" ::: "memory");
  for (int j = 1; j + 1 < NT; j += 2) {
    HALF_A(j, pB0, pB1, pA0, pA1, true); HALF_B(j, pB0, pB1, true);
    HALF_A(j + 1, pA0, pA1, pB0, pB1, true); HALF_B(j + 1, pA0, pA1, true);
  }
  HALF_A(NT - 1, pB0, pB1, pA0, pA1, true); HALF_B(NT - 1, pB0, pB1, true);
  HALF_A(NT, pA0, pA1, pB0, pB1, false); HALF_B(NT, pA0, pA1, false);
  if (lead) asm volatile("s_waitcnt lgkmcnt(0)\n\ts_barrier" ::: "memory");
  { auto rr_ = __builtin_amdgcn_permlane32_swap(__float_as_uint(l_reg), __float_as_uint(l_reg), false, false); l_reg = __uint_as_float(rr_[0]) + __uint_as_float(rr_[1]); }
#undef HALF_A
#undef HALF_B
#undef GAPA
#undef GAPB
#undef WB_A
#undef WB_B
#undef KF
#undef CVT
#undef PAF
#undef VFR
#undef VRD
#undef EX2
#undef PIN
#undef MX3
#undef ROWMAX
#undef RESCALE
#undef DMA_K
#undef DMA_V
#undef WAIT_BAR
  if (hi == 0) li_l[r32] = l_reg; asm volatile("s_waitcnt lgkmcnt(0)" ::: "memory");
  float rli[16];
#pragma unroll
  for (int r = 0; r < 16; ++r) rli[r] = __builtin_amdgcn_rcpf(li_l[crow(r, hi)]);
  int r32e = r32, hie = hi, lanee = lane; asm volatile("" : "+v"(r32e), "+v"(hie), "+v"(lanee));
  bf16_t* st = stash + r32e;
  if (m == 0) {
#pragma unroll
    for (int r = 0; r < 16; ++r) { const int orow = crow(r, hie);
#pragma unroll
      for (int d0 = 0; d0 < 4; ++d0) st[orow * 128 + d0 * 32] = (bf16_t)f2bf(o[d0][r] * rli[r]); }
  } else {
    float gv[4];
#pragma unroll
    for (int d0 = 0; d0 < 4; ++d0) gv[d0] = p.diff_norm_g[d0 * 32 + r32e] * 0.8f;
#pragma unroll
    for (int r = 0; r < 16; ++r) { const int orow = crow(r, hie); float s = 0.f; float av[4];
#pragma unroll
      for (int d0 = 0; d0 < 4; ++d0) { av[d0] = bf2f(st[orow * 128 + d0 * 32]) - lam * (o[d0][r] * rli[r]); s += av[d0] * av[d0]; }
#pragma unroll
      for (int of = 1; of < 32; of <<= 1) s += __shfl_xor(s, of);
      const float rs = rsqrtf(s * (1.f / 128.f) + EPS);
#pragma unroll
      for (int d0 = 0; d0 < 4; ++d0) st[orow * 128 + d0 * 32] = (bf16_t)f2bf(av[d0] * rs * gv[d0]); }
    asm volatile("s_waitcnt lgkmcnt(0)" ::: "memory");
    bf16_t* Mw = (bf16_t*)(p.ws + WS_MIX) + (size_t)(b * SEQ + qb * 256 + wid * QBLK + (lanee >> 4)) * DM + 512 + h * 128 + (lanee & 15) * 8;
    const bf16_t* sr2 = stash + (lanee >> 4) * 128 + (lanee & 15) * 8;
#pragma unroll
    for (int i = 0; i < 8; ++i) *(u32x4*)(Mw + (size_t)(i * 4) * DM) = *(const u32x4*)(sr2 + i * 4 * 128);
  }
#undef RESC
}
#undef SBAR
#undef KSWZ
}

namespace ml {
using att::f32x16; using att::s16x4; using att::crow; using att::v_st; using att::v_rd_base; using att::v_rd_off; using att::tr_read;
constexpr int ML_Q = 0, ML_K = 16384, ML_V = 32768, ML_KW = 49152, ML_W = 49152, ML_H = 65536, ML_G = 98304;
constexpr float KSCALE = 0.08838834764831845f;
#define QSWZ(row, colB) ((row) * 256 + ((colB) ^ (((row) & 7) << 4)))
#define WSWZ(row, colB) ((row) * 128 + ((colB) ^ ((((row) >> 1) & 7) << 4)))
#define PKF(L, H) (bf16x8){L[0], L[1], L[2], L[3], H[0], H[1], H[2], H[3]}
__device__ __forceinline__ float wave_incl_scan_add(float v, int lane) {
#pragma unroll
  for (int o = 1; o < 64; o <<= 1) { const float t = __shfl_up(v, o); if (lane >= o) v += t; }
  return v;
}
__device__ __forceinline__ float wave_incl_scan_max(float v, int lane) {
#pragma unroll
  for (int o = 1; o < 64; o <<= 1) { const float t = __shfl_up(v, o); if (lane >= o) v = fmaxf(v, t); }
  return v;
}
__device__ __forceinline__ float wave_max(float v) {
#pragma unroll
  for (int o = 1; o < 64; o <<= 1) v = fmaxf(v, __shfl_xor(v, o));
  return v;
}
struct Raw16 { u32x4 r[4][2]; };
__device__ __forceinline__ void raw16_load(const Params& p, Raw16& R, int b, int c, int s, int sec, int h, int d0) {
  const bf16_t* PR = (const bf16_t*)(p.ws + WS_PROJ) + (size_t)sec * pg8::SEC + (size_t)(b * 4 + h) * SEQ * 128;
  const int tl = c * 64 + s;
#pragma unroll
  for (int j = 0; j < 4; ++j) { const int tt = tl - 3 + j;
    if (tt >= 0) { const bf16_t* rp = PR + (size_t)tt * 128 + d0; R.r[j][0] = *(const u32x4*)rp; R.r[j][1] = *(const u32x4*)(rp + 8); }
    else { R.r[j][0] = (u32x4){0u, 0u, 0u, 0u}; R.r[j][1] = (u32x4){0u, 0u, 0u, 0u}; } }
}
__device__ __forceinline__ void conv16_compute(const Params& p, float (&y)[16], const Raw16& R, int cch, int d0) {
#pragma unroll
  for (int q = 0; q < 4; ++q) { const f32x4 bb = *(const f32x4*)(p.conv_b + cch + d0 + 4 * q); y[4 * q] = bb.x; y[4 * q + 1] = bb.y; y[4 * q + 2] = bb.z; y[4 * q + 3] = bb.w; }
#pragma unroll
  for (int j = 0; j < 4; ++j) { const unsigned rw[8] = {R.r[j][0].x, R.r[j][0].y, R.r[j][0].z, R.r[j][0].w, R.r[j][1].x, R.r[j][1].y, R.r[j][1].z, R.r[j][1].w};
#pragma unroll
    for (int q = 0; q < 4; ++q) { const f32x4 w = *(const f32x4*)(p.conv_w + j * 1024 + cch + d0 + 4 * q);
      y[4 * q] += w.x * __uint_as_float(rw[2 * q] << 16); y[4 * q + 1] += w.y * __uint_as_float(rw[2 * q] & 0xffff0000u);
      y[4 * q + 2] += w.z * __uint_as_float(rw[2 * q + 1] << 16); y[4 * q + 3] += w.w * __uint_as_float(rw[2 * q + 1] & 0xffff0000u); } }
#pragma unroll
  for (int i = 0; i < 16; ++i) y[i] = y[i] * __builtin_amdgcn_rcpf(1.f + __builtin_amdgcn_exp2f(-LOG2E * y[i]));
}
__device__ __forceinline__ void conv16(const Params& p, float (&y)[16], int b, int c, int s, int sec, int h, int cch, int d0) {
  Raw16 R; raw16_load(p, R, b, c, s, sec, h, d0); conv16_compute(p, y, R, cch, d0);
}
__device__ __forceinline__ u32x4 pack8(const float* y) { u32x4 w; w.x = pg8::cvt_pk_bf16(y[0], y[1]); w.y = pg8::cvt_pk_bf16(y[2], y[3]); w.z = pg8::cvt_pk_bf16(y[4], y[5]); w.w = pg8::cvt_pk_bf16(y[6], y[7]); return w; }

__device__ __forceinline__ void mlstm_a_item(const Params& p, int item, char* lds) {
  int tid_ = threadIdx.x; asm volatile("" : "+v"(tid_));
  const int tid = tid_, wid = __builtin_amdgcn_readfirstlane(tid >> 6), lane = tid & 63, r32 = lane & 31, hi = lane >> 5;
  const int bh = item / NCH, c = item % NCH, b = bh >> 2, h = bh & 3;
  const bf16_t* PR = (const bf16_t*)(p.ws + WS_PROJ); const float* gates = (const float*)(p.ws + WS_GATES);
  bf16_t* MU = (bf16_t*)(p.ws + WS_MU); float* NU = (float*)(p.ws + MS_NU); float* msc = (float*)(p.ws + MS_MSC);
  float* wgt = (float*)(lds + ML_G);
  __syncthreads();
  if (wid == 0) { const size_t t = (size_t)b * SEQ + c * 64 + lane; const float li = gates[t * 8 + h]; const float lf = log_sigmoid(gates[t * 8 + 4 + h]);
    const float bc = wave_incl_scan_add(lf, lane); const float blast = __shfl(bc, 63); const float g = blast - bc + li; const float gmax = wave_max(g);
    wgt[lane] = __expf(g - gmax); if (lane == 0) { msc[item] = blast; msc[2048 + item] = gmax; } }
  __syncthreads();
  { const int s = tid >> 3, d0 = (tid & 7) * 16; float y[16];
    conv16(p, y, b, c, s, 1, h, 512 + h * 128, d0);
    const float w = wgt[s] * KSCALE;
#pragma unroll
    for (int i = 0; i < 16; ++i) y[i] *= w;
    *(u32x4*)(lds + ML_KW + v_st(s, d0)) = pack8(y); *(u32x4*)(lds + ML_KW + v_st(s, d0 + 8)) = pack8(y + 8);
    const bf16_t* vp = PR + 2 * pg8::SEC + ((size_t)(b * 4 + h) * SEQ + c * 64 + s) * 128 + d0;
    *(u32x4*)(lds + ML_V + v_st(s, d0)) = *(const u32x4*)vp; *(u32x4*)(lds + ML_V + v_st(s, d0 + 8)) = *(const u32x4*)(vp + 8); }
  __syncthreads();
  const int ei = wid >> 1, dj0 = 2 * (wid & 1);
  const int vbV = (int)(uintptr_t)(lds + ML_V) + v_rd_base(lane) + ei * 512, vbK = (int)(uintptr_t)(lds + ML_KW) + v_rd_base(lane) + dj0 * 512;
  f32x16 acc0 = {}, acc1 = {}, accn0 = {}, accn1 = {};
  const bf16x8 ones = {0x3F80, 0x3F80, 0x3F80, 0x3F80, 0x3F80, 0x3F80, 0x3F80, 0x3F80};
#define MLA_STEP(KS) do { const s16x4 al = tr_read<v_rd_off(0, KS, 0)>(vbV), ah = tr_read<v_rd_off(0, KS, 1)>(vbV); \
    const s16x4 b0l = tr_read<v_rd_off(0, KS, 0)>(vbK), b0h = tr_read<v_rd_off(0, KS, 1)>(vbK), b1l = tr_read<v_rd_off(1, KS, 0)>(vbK), b1h = tr_read<v_rd_off(1, KS, 1)>(vbK); \
    asm volatile("s_waitcnt lgkmcnt(0)" ::: "memory"); __builtin_amdgcn_sched_barrier(0); \
    acc0 = __builtin_amdgcn_mfma_f32_32x32x16_bf16(PKF(al, ah), PKF(b0l, b0h), acc0, 0, 0, 0); acc1 = __builtin_amdgcn_mfma_f32_32x32x16_bf16(PKF(al, ah), PKF(b1l, b1h), acc1, 0, 0, 0); \
    if (ei == 0) { accn0 = __builtin_amdgcn_mfma_f32_32x32x16_bf16(ones, PKF(b0l, b0h), accn0, 0, 0, 0); accn1 = __builtin_amdgcn_mfma_f32_32x32x16_bf16(ones, PKF(b1l, b1h), accn1, 0, 0, 0); } } while (0)
  MLA_STEP(0); MLA_STEP(1); MLA_STEP(2); MLA_STEP(3);
#undef MLA_STEP
  bf16_t* uo = MU + (size_t)item * 16384;
#pragma unroll
  for (int r = 0; r < 16; ++r) { const int e = 32 * ei + crow(r, hi);
    uo[e * 128 + 32 * dj0 + r32] = (bf16_t)f2bf(acc0[r]); uo[e * 128 + 32 * (dj0 + 1) + r32] = (bf16_t)f2bf(acc1[r]); }
  if (ei == 0 && hi == 0) { NU[(size_t)item * 128 + 32 * dj0 + r32] = accn0[0]; NU[(size_t)item * 128 + 32 * (dj0 + 1) + r32] = accn1[0]; }
}

__device__ __forceinline__ void mlstm_scan_item(const Params& p, int item, char* lds) {
  float* dec = (float*)(lds + ML_G); float* ac = dec + NCH;
  const unsigned* MU = (const unsigned*)(p.ws + WS_MU); unsigned* MC = (unsigned*)(p.ws + WS_MC);
  const float* NU = (const float*)(p.ws + MS_NU); float* NC = (float*)(p.ws + MS_NC); float* msc = (float*)(p.ws + MS_MSC);
  const int bh = item >> 4, eb = item & 15; const int lane = threadIdx.x & 63;
  __syncthreads();
  if (threadIdx.x < 64) { float Bc = 0.f, pm = 0.f, mcar = 0.f;
    for (int half = 0; half < 2; ++half) { const int c = half * 64 + lane;
      const float bl = msc[bh * NCH + c], gm = msc[2048 + bh * NCH + c];
      const float Bi = Bc + wave_incl_scan_add(bl, lane);
      const float px = fmaxf(pm, wave_incl_scan_max(gm - Bi, lane));
      const float m1 = Bi + px; float m0 = __shfl_up(m1, 1); if (lane == 0) m0 = mcar;
      dec[c] = __expf(bl + m0 - m1); ac[c] = __expf(gm - m1);
      if (eb == 0) msc[4096 + bh * NCH + c] = m0;
      Bc = __shfl(Bi, 63); pm = __shfl(px, 63); mcar = __shfl(m1, 63); } }
  __syncthreads();
  const int idx = eb * 512 + threadIdx.x;
  const bool ndo = (eb == 0 && threadIdx.x < 128);
  float C0 = 0.f, C1 = 0.f, nst = 0.f;
#pragma unroll 16
  for (int c = 0; c < NCH; ++c) { const size_t o = ((size_t)(bh * NCH + c)) * 8192 + idx; const unsigned u = MU[o];
    const size_t on = ((size_t)(bh * NCH + c)) * 128 + (threadIdx.x & 127); const float nu = ndo ? NU[on] : 0.f;
    MC[o] = pk2(C0, C1); C0 = dec[c] * C0 + ac[c] * __uint_as_float(u << 16); C1 = dec[c] * C1 + ac[c] * __uint_as_float(u & 0xffff0000u);
    if (ndo) { NC[on] = nst; nst = dec[c] * nst + ac[c] * nu; } }
}

#if TSEL >= 40 && TSEL < 50
#define MTB() (mtq_ = __builtin_amdgcn_s_memrealtime())
#define MTE(k) do { if ((k) == TSEL - 40 && blockIdx.x == 0 && wid == PWAVE) g_tacc += (unsigned)(__builtin_amdgcn_s_memrealtime() - mtq_); } while (0)
#else
#define MTB() do {} while (0)
#define MTE(k) do {} while (0)
#endif
struct McRaw { Raw16 q, k; u32x4 v0, v1; float li, lf, mc; f32x4 nc[4]; };
__device__ __forceinline__ void mc_load(const Params& p, McRaw& R, int item, int tid) {
  const int bh = item / NCH, c = item % NCH, b = bh >> 2, h = bh & 3, s = tid >> 3, d0 = (tid & 7) * 16, lane = tid & 63;
  const bf16_t* PR = (const bf16_t*)(p.ws + WS_PROJ); const float* gates = (const float*)(p.ws + WS_GATES);
  const float* NC = (const float*)(p.ws + MS_NC); const float* msc = (const float*)(p.ws + MS_MSC);
  raw16_load(p, R.q, b, c, s, 0, h, d0); raw16_load(p, R.k, b, c, s, 1, h, d0);
  const bf16_t* vp = PR + 2 * pg8::SEC + ((size_t)(b * 4 + h) * SEQ + c * 64 + s) * 128 + d0; R.v0 = *(const u32x4*)vp; R.v1 = *(const u32x4*)(vp + 8);
  const size_t gt = (size_t)b * SEQ + c * 64 + lane; R.li = gates[gt * 8 + h]; R.lf = gates[gt * 8 + 4 + h]; R.mc = msc[4096 + item];
#pragma unroll
  for (int q = 0; q < 4; ++q) R.nc[q] = *(const f32x4*)(NC + (size_t)item * 128 + d0 + 4 * q);
}
#define LBAR() asm volatile("s_waitcnt lgkmcnt(0)\n\ts_barrier" ::: "memory")
__device__ __forceinline__ void mlstm_c_phase(const Params& p, int vcu, int G, char* lds, unsigned& g_tacc) {
  unsigned long long mtq_ = 0; (void)mtq_;
  const bf16_t* PR = (const bf16_t*)(p.ws + WS_PROJ); const bf16_t* MC = (const bf16_t*)(p.ws + WS_MC); bf16_t* MIX = (bf16_t*)(p.ws + WS_MIX);
  float* Gf = (float*)(lds + ML_G); float* bm = Gf; float* as_ = Gf + 64; float* mxv = Gf + 128; float* scv = Gf + 192; float* qn = Gf + 256;
  float* H = (float*)(lds + ML_H);
  McRaw P;
  if (vcu < 16 * NCH) mc_load(p, P, vcu, threadIdx.x);
  for (int item = vcu; item < 16 * NCH; item += G) {
    int tid_ = threadIdx.x; asm volatile("" : "+v"(tid_));
    const int tid = tid_, wid = __builtin_amdgcn_readfirstlane(tid >> 6), lane = tid & 63, r32 = lane & 31, hi = lane >> 5;
    const int bh = item / NCH, c = item % NCH, b = bh >> 2, h = bh & 3;
    const int s_ = tid >> 3, d0_ = (tid & 7) * 16;
    MTB();
    bf16x8 ctf[8];
    { const bf16_t* ct = MC + (size_t)item * 16384 + (size_t)(32 * (wid & 3) + r32) * 128 + hi * 8;
#pragma unroll
      for (int ks = 0; ks < 8; ++ks) ctf[ks] = *(const bf16x8*)(ct + ks * 16); }
    LBAR(); MTE(4); MTB();
    if (wid == 0) { const float li = P.li; const float lf = log_sigmoid(P.lf);
      const float bc = wave_incl_scan_add(lf, lane); const float a = li - bc; const float pm = wave_incl_scan_max(a, lane);
      const float mc = P.mc; const float mx = bc + fmaxf(mc, pm);
      bm[lane] = bc - mx; as_[lane] = a; mxv[lane] = mx; scv[lane] = __expf(bc + mc - mx); }
    MTE(5); MTB();
    { const int s = s_, d0 = d0_; float y[16];
      conv16_compute(p, y, P.q, h * 128, d0); asm volatile("" : "+v"(y[0])); MTE(6); MTB();
      float part = 0.f;
#pragma unroll
      for (int q = 0; q < 4; ++q) { const f32x4 nv = P.nc[q]; part += y[4 * q] * nv.x + y[4 * q + 1] * nv.y + y[4 * q + 2] * nv.z + y[4 * q + 3] * nv.w; }
      part += __shfl_xor(part, 1); part += __shfl_xor(part, 2); part += __shfl_xor(part, 4);
      if ((tid & 7) == 0) qn[s] = part;
      *(u32x4*)(lds + ML_Q + QSWZ(s, d0 * 2)) = pack8(y); *(u32x4*)(lds + ML_Q + QSWZ(s, d0 * 2 + 16)) = pack8(y + 8);
      conv16_compute(p, y, P.k, 512 + h * 128, d0);
#pragma unroll
      for (int i = 0; i < 16; ++i) y[i] *= KSCALE;
      *(u32x4*)(lds + ML_K + QSWZ(s, d0 * 2)) = pack8(y); *(u32x4*)(lds + ML_K + QSWZ(s, d0 * 2 + 16)) = pack8(y + 8);
      *(u32x4*)(lds + ML_V + v_st(s, d0)) = P.v0; *(u32x4*)(lds + ML_V + v_st(s, d0 + 8)) = P.v1; }
    MTE(7); MTB(); LBAR(); MTE(0); MTB();
    if (item + G < 16 * NCH) mc_load(p, P, item + G, tid);
    const bf16_t* mo_ = PR + 3 * pg8::SEC + ((size_t)(b * 4 + h) * SEQ + c * 64 + s_) * 128 + d0_; const u32x4 mo0 = *(const u32x4*)mo_, mo1 = *(const u32x4*)(mo_ + 8);
    if (wid < 4) {
      const int ti = wid >> 1, si = wid & 1; f32x16 acc = {};
      if (si <= ti) {
#pragma unroll
        for (int ks = 0; ks < 8; ++ks) { const int cb = (ks * 16 + hi * 8) * 2;
          const bf16x8 a = *(const bf16x8*)(lds + ML_Q + QSWZ(32 * ti + r32, cb)), bb = *(const bf16x8*)(lds + ML_K + QSWZ(32 * si + r32, cb));
          acc = __builtin_amdgcn_mfma_f32_32x32x16_bf16(a, bb, acc, 0, 0, 0); }
      }
      const int s = 32 * si + r32; const float av = as_[s];
#pragma unroll
      for (int r = 0; r < 16; ++r) { const int t = 32 * ti + crow(r, hi); const float w = (s <= t) ? __expf(bm[t] + av) * acc[r] : 0.f;
        *(bf16_t*)(lds + ML_W + WSWZ(t, s * 2)) = (bf16_t)f2bf(w); }
    }
    LBAR(); MTE(1); MTB();
    { const int ti = wid >> 2, ej = wid & 3; f32x16 acc = {}, accd = {};
#pragma unroll
      for (int ks = 0; ks < 8; ++ks) { const bf16x8 a = *(const bf16x8*)(lds + ML_Q + QSWZ(32 * ti + r32, (ks * 16 + hi * 8) * 2)); const bf16x8 bb = ctf[ks];
        acc = __builtin_amdgcn_mfma_f32_32x32x16_bf16(a, bb, acc, 0, 0, 0); }
#pragma unroll
      for (int r = 0; r < 16; ++r) acc[r] *= scv[32 * ti + crow(r, hi)];
      const int vbV = (int)(uintptr_t)(lds + ML_V) + v_rd_base(lane) + ej * 512;
      const bf16x8 ones = {0x3F80, 0x3F80, 0x3F80, 0x3F80, 0x3F80, 0x3F80, 0x3F80, 0x3F80};
#define MLC_STEP(KS) do { const s16x4 bl = tr_read<v_rd_off(0, KS, 0)>(vbV), bh_ = tr_read<v_rd_off(0, KS, 1)>(vbV); \
        const bf16x8 a = *(const bf16x8*)(lds + ML_W + WSWZ(32 * ti + r32, (KS * 16 + hi * 8) * 2)); \
        asm volatile("s_waitcnt lgkmcnt(0)" ::: "memory"); __builtin_amdgcn_sched_barrier(0); \
        acc = __builtin_amdgcn_mfma_f32_32x32x16_bf16(a, PKF(bl, bh_), acc, 0, 0, 0); accd = __builtin_amdgcn_mfma_f32_32x32x16_bf16(a, ones, accd, 0, 0, 0); } while (0)
      MLC_STEP(0); MLC_STEP(1); MLC_STEP(2); MLC_STEP(3);
#undef MLC_STEP
#pragma unroll
      for (int r = 0; r < 16; ++r) { const int t = 32 * ti + crow(r, hi); const float den = accd[r] + scv[t] * qn[t]; const float dn = fmaxf(fabsf(den), __expf(-mxv[t]));
        H[t * 128 + 32 * ej + r32] = acc[r] * __builtin_amdgcn_rcpf(dn); }
    }
    LBAR(); MTE(2); MTB();
    { const int t = s_, e0 = d0_; float y[16]; float ss = 0.f;
#pragma unroll
      for (int q = 0; q < 4; ++q) { const f32x4 v = *(const f32x4*)(H + t * 128 + e0 + 4 * q); y[4 * q] = v.x; y[4 * q + 1] = v.y; y[4 * q + 2] = v.z; y[4 * q + 3] = v.w; ss += v.x * v.x + v.y * v.y + v.z * v.z + v.w * v.w; }
      ss += __shfl_xor(ss, 1); ss += __shfl_xor(ss, 2); ss += __shfl_xor(ss, 4);
      const float rstd = rsqrtf(ss * (1.f / 128.f) + EPS);
      const size_t row = (size_t)b * SEQ + c * 64 + t; const int ch = h * 128 + e0;
      const unsigned mw[8] = {mo0.x, mo0.y, mo0.z, mo0.w, mo1.x, mo1.y, mo1.z, mo1.w};
      float gn[16];
#pragma unroll
      for (int q = 0; q < 4; ++q) { const f32x4 gq = *(const f32x4*)(p.mlstm_norm_g + ch + 4 * q); gn[4 * q] = gq.x; gn[4 * q + 1] = gq.y; gn[4 * q + 2] = gq.z; gn[4 * q + 3] = gq.w; }
#pragma unroll
      for (int i = 0; i < 16; ++i) { const float mov = (i & 1) ? __uint_as_float(mw[i >> 1] & 0xffff0000u) : __uint_as_float(mw[i >> 1] << 16);
        y[i] = y[i] * rstd * gn[i] * __builtin_amdgcn_rcpf(1.f + __builtin_amdgcn_exp2f(-LOG2E * mov)); }
      bf16_t* op = MIX + row * DM + ch; *(u32x4*)op = pack8(y); *(u32x4*)(op + 8) = pack8(y + 8); }
    MTE(3);
  }
}
#undef LBAR
#undef QSWZ
#undef WSWZ
#undef PKF
}

__device__ __forceinline__ void phase_combine(const Params& p, int vcu, int G, int wave, int lane) {
    const float lam = __expf(wave_sum(p.lam_q1[lane] * p.lam_k1[lane])) - __expf(wave_sum(p.lam_q2[lane] * p.lam_k2[lane])) + 0.2f;
    const float* AO = (const float*)(p.ws + WS_AO); bf16_t* MIX = (bf16_t*)(p.ws + WS_MIX);
    const float g0 = p.diff_norm_g[2 * lane] * 0.8f, g1 = p.diff_norm_g[2 * lane + 1] * 0.8f;
    for (int it = vcu * NWAVES + wave; it < T * 4; it += G * NWAVES) {
        const float* o1 = AO + (size_t)it * 256; const float* o2 = o1 + 128;
        const float a0 = o1[2 * lane] - lam * o2[2 * lane], a1 = o1[2 * lane + 1] - lam * o2[2 * lane + 1];
        const float rstd = rsqrtf(wave_sum(a0 * a0 + a1 * a1) * (1.f / 128.f) + EPS);
        const int t = it >> 2, h = it & 3;
        *(unsigned*)(MIX + (size_t)t * DM + 512 + h * 128 + 2 * lane) = pk2(a0 * rstd * g0, a1 * rstd * g1);
    }
}
__device__ __forceinline__ void phase_route(const Params& p, unsigned char* lds, int vcu, int G, int wave, int lane) {
    float* urow = (float*)lds; float* part = (float*)(lds + 32768);
    int* cnt = (int*)(lds + 40960); int* base = cnt + 32; int* cnt2 = cnt + 64; int* pel = cnt + 96;
    unsigned char* U2 = (unsigned char*)(p.ws + WS_U2); unsigned* ctl = (unsigned*)(p.ws + WS_CTL);
    int* list = (int*)(p.ws + MS_LIST); int* pe = (int*)(p.ws + MS_PE); int* pp = (int*)(p.ws + MS_PP); float* pg = (float*)(p.ws + MS_PG);
    const int RPW = T / G;
    const int e = lane & 31, half = lane >> 5;
    __syncthreads();
    if (threadIdx.x < 96) cnt[threadIdx.x] = 0;
    float rw[64];
#pragma unroll
    for (int kk = 0; kk < 64; ++kk) rw[kk] = p.router_w[(size_t)(128 * wave + 64 * half + kk) * NE + e];
    const float rb = p.router_b[e];
    f32x4 v[4];
    { const f32x4* xr = (const f32x4*)(p.out + (size_t)(vcu * RPW + wave) * DM) + lane;
#pragma unroll
      for (int j = 0; j < 4; ++j) v[j] = xr[64 * j]; }
    for (int bt = 0; bt < RPW / 8; ++bt) {
        const int row = vcu * RPW + bt * 8 + wave;
        float s = 0.f;
#pragma unroll
        for (int j = 0; j < 4; ++j) s += (v[j].x * v[j].x + v[j].y * v[j].y) + (v[j].z * v[j].z + v[j].w * v[j].w);
        const float rstd = rsqrtf(wave_sum(s) * (1.f / DM) + EPS);
        unsigned* o4 = (unsigned*)(U2 + (size_t)row * DM) + lane;
#pragma unroll
        for (int j = 0; j < 4; ++j) { const f32x4 g = ((const f32x4*)p.norm2_g)[64 * j + lane]; const f32x4 u = v[j] * rstd * g;
            o4[64 * j] = pg8::pk4_fp8(u.x * U8_SCALE, u.y * U8_SCALE, u.z * U8_SCALE, u.w * U8_SCALE);
            *(f32x4*)(&urow[wave * DM + 256 * j + 4 * lane]) = u; }
        if (bt + 1 < RPW / 8) { const f32x4* xr = (const f32x4*)(p.out + (size_t)(row + 8) * DM) + lane;
#pragma unroll
          for (int j = 0; j < 4; ++j) v[j] = xr[64 * j]; }
        __syncthreads();
#pragma unroll 2
        for (int r = 0; r < 8; ++r) { const float* ur = urow + r * DM + 128 * wave + 64 * half; float acc = 0.f;
#pragma unroll
            for (int kk = 0; kk < 64; kk += 4) { const f32x4 uu = *(const f32x4*)(ur + kk); acc += uu.x * rw[kk] + uu.y * rw[kk + 1] + uu.z * rw[kk + 2] + uu.w * rw[kk + 3]; }
            acc += __shfl_xor(acc, 32);
            if (half == 0) part[(r * 8 + wave) * 32 + e] = acc; }
        __syncthreads();
        { float val = rb;
#pragma unroll
          for (int w = 0; w < 8; ++w) val += part[(wave * 8 + w) * 32 + e];
          float tv[4]; int ti[4];
#pragma unroll
          for (int r = 0; r < 4; ++r) { float bv = val; int bi = e;
#pragma unroll
              for (int o = 1; o < 32; o <<= 1) { const float ov = __shfl_xor(bv, o); const int oi = __shfl_xor(bi, o); if (ov > bv || (ov == bv && oi < bi)) { bv = ov; bi = oi; } }
              tv[r] = bv; ti[r] = bi; if (e == bi) val = -INFINITY; }
          const float e1 = __expf(tv[1] - tv[0]), e2 = __expf(tv[2] - tv[0]), e3 = __expf(tv[3] - tv[0]); const float inv = 1.f / (1.f + e1 + e2 + e3);
          if (lane < 4) { const int ee = lane == 0 ? ti[0] : lane == 1 ? ti[1] : lane == 2 ? ti[2] : ti[3]; const float gg = (lane == 0 ? 1.f : lane == 1 ? e1 : lane == 2 ? e2 : e3) * inv;
              atomicAdd(&cnt[ee], 1); pel[(bt * 8 + wave) * 4 + lane] = ee; pe[row * 4 + lane] = ee; pg[row * 4 + lane] = gg; } }
    }
    __syncthreads();
    if (threadIdx.x < 32) base[threadIdx.x] = (int)atomicAdd(&ctl[CW_CNT + threadIdx.x], (unsigned)cnt[threadIdx.x]);
    __syncthreads();
    for (int i = threadIdx.x; i < RPW * 4; i += NTHR) { const int row = vcu * RPW + (i >> 2); const int ee = pel[i]; const int pos = base[ee] + atomicAdd(&cnt2[ee], 1);
        pp[row * 4 + (i & 3)] = pos; list[(size_t)ee * T + pos] = row; }
    __syncthreads();
}
__device__ __forceinline__ void phase_final(const Params& p, unsigned char* lds, int vcu, int G, int wave, int lane) {
    int* ps = (int*)lds;
    const unsigned* ctl = (const unsigned*)(p.ws + WS_CTL);
    __syncthreads();
    if (threadIdx.x == 0) { int a = 0; for (int e = 0; e < NE; ++e) { const int c = (int)__hip_atomic_load(ctl + CW_CNT + e, RLX_AGENT); ps[e] = a; a += (c + 255) & ~255; } }
    __syncthreads();
    const bf16_t* Y = (const bf16_t*)(p.ws + WS_Y); const int* pe = (const int*)(p.ws + MS_PE); const int* pp = (const int*)(p.ws + MS_PP); const float* pg = (const float*)(p.ws + MS_PG);
    const int gw = vcu * NWAVES + wave, NGW = G * NWAVES, nrow = (T - gw + NGW - 1) / NGW;
    int yrow = 0; float yg = 0.f;
    { const int k = lane >> 2, r = lane & 3; if (k < nrow) { const int row = gw + k * NGW; const int e = pe[row * 4 + r]; yrow = ps[e] + pp[row * 4 + r]; yg = pg[row * 4 + r]; } }
    f32x4 v[4]; u32x2 yv[4][4];
#define FIN_LOAD(k) do { const int row_ = gw + (k) * NGW; const f32x4* xr_ = (const f32x4*)(p.out + (size_t)row_ * DM) + lane; \
        _Pragma("unroll") for (int j = 0; j < 4; ++j) v[j] = xr_[64 * j]; \
        _Pragma("unroll") for (int r = 0; r < 4; ++r) { const int yr_ = __shfl(yrow, (k) * 4 + r); const u32x2* yp_ = (const u32x2*)(Y + (size_t)yr_ * DM) + lane; \
            _Pragma("unroll") for (int j = 0; j < 4; ++j) yv[r][j] = yp_[64 * j]; } } while (0)
    if (nrow > 0) FIN_LOAD(0);
    for (int k = 0; k < nrow; ++k) {
        const int row = gw + k * NGW;
        f32x4 a[4];
#pragma unroll
        for (int j = 0; j < 4; ++j) a[j] = v[j];
#pragma unroll
        for (int r = 0; r < 4; ++r) { const float g = __shfl(yg, k * 4 + r);
#pragma unroll
            for (int j = 0; j < 4; ++j) { const u32x2 w = yv[r][j];
                a[j].x += g * __uint_as_float(w.x << 16); a[j].y += g * __uint_as_float(w.x & 0xffff0000u); a[j].z += g * __uint_as_float(w.y << 16); a[j].w += g * __uint_as_float(w.y & 0xffff0000u); } }
        if (k + 1 < nrow) FIN_LOAD(k + 1);
        float s = 0.f;
#pragma unroll
        for (int j = 0; j < 4; ++j) s += (a[j].x * a[j].x + a[j].y * a[j].y) + (a[j].z * a[j].z + a[j].w * a[j].w);
        const float rstd = rsqrtf(wave_sum(s) * (1.f / DM) + EPS);
        f32x4* xo = (f32x4*)(p.out + (size_t)row * DM) + lane;
#pragma unroll
        for (int j = 0; j < 4; ++j) { const f32x4 g = ((const f32x4*)p.final_g)[64 * j + lane]; xo[64 * j] = a[j] * rstd * g; }
    }
#undef FIN_LOAD
}

enum { PH_PRE = 0, PH_PROJ = 1, PH_MLA = 2, PH_ATTN = 3, PH_MLC = 4, PH_OUT = 5, PH_ROUTE = 6, PH_MOE1 = 7, PH_MOE2 = 8, PH_FINAL = 9, PH_N = 10 };
struct Args { Params p; int ph_lo, ph_hi, li, pad; };

__device__ __forceinline__ void phase_pre(const Params& p, unsigned char* lds, int vcu, int G, int wave, int lane) {
    { float* scr = (float*)(lds + wave * 8448);
      for (int it = vcu * NWAVES + wave; it < CV_N; it += G * NWAVES) convert_item(p, it, scr, lane); }
    __syncthreads();
#if TSEL == 50
    if (blockIdx.x == PBLK && threadIdx.x == 0) ((volatile LAS unsigned*)((LAS unsigned char*)lds + LDSCTL_OFF))[40] = (unsigned)__builtin_amdgcn_s_memrealtime() - ((volatile LAS unsigned*)((LAS unsigned char*)lds + LDSCTL_OFF))[0];
#endif
    float* gw = (float*)lds;
    for (int i = threadIdx.x; i < DM * 8; i += NTHR) gw[i] = p.w_in[(size_t)(i >> 3) * DIN + 2048 + (i & 7)];
    __syncthreads();
    bf16_t* XN = (bf16_t*)(p.ws + WS_XN); float* gates = (float*)(p.ws + WS_GATES);
    f32x4 v[4];
    { const int row0 = vcu * NWAVES + wave; if (row0 < T) { const f32x4* xr = (const f32x4*)(p.x + (size_t)row0 * DM) + lane;
#pragma unroll
        for (int j = 0; j < 4; ++j) v[j] = xr[64 * j]; } }
    for (int row = vcu * NWAVES + wave; row < T; row += G * NWAVES) {
        f32x4 c[4]; float s = 0.f;
#pragma unroll
        for (int j = 0; j < 4; ++j) { c[j] = v[j]; s += (c[j].x * c[j].x + c[j].y * c[j].y) + (c[j].z * c[j].z + c[j].w * c[j].w); }
        if (row + G * NWAVES < T) { const f32x4* xn = (const f32x4*)(p.x + (size_t)(row + G * NWAVES) * DM) + lane;
#pragma unroll
            for (int j = 0; j < 4; ++j) v[j] = xn[64 * j]; }
        const float rstd = rsqrtf(wave_sum(s) * (1.f / DM) + EPS);
        float ga[8];
#pragma unroll
        for (int q = 0; q < 8; ++q) ga[q] = 0.f;
        unsigned long long* o8 = (unsigned long long*)(XN + (size_t)row * DM) + lane;
#pragma unroll
        for (int j = 0; j < 4; ++j) { const f32x4 g = ((const f32x4*)p.norm1_g)[64 * j + lane]; f32x4 u = c[j] * rstd * g;
            o8[64 * j] = (unsigned long long)pk2(u.x, u.y) | ((unsigned long long)pk2(u.z, u.w) << 32);
            const int k0 = 256 * j + 4 * lane;
#pragma unroll
            for (int cc = 0; cc < 4; ++cc) { const float uu = u[cc]; const float* w = gw + (k0 + cc) * 8;
#pragma unroll
                for (int q = 0; q < 8; ++q) ga[q] += uu * w[q]; } }
        float h4[4], h2[2], h1;
        { const bool up = (lane & 32) != 0;
#pragma unroll
          for (int q = 0; q < 4; ++q) { const float mine = up ? ga[4 + q] : ga[q], theirs = up ? ga[q] : ga[4 + q]; h4[q] = mine + __shfl_xor(theirs, 32); } }
        { const bool up = (lane & 16) != 0;
#pragma unroll
          for (int q = 0; q < 2; ++q) { const float mine = up ? h4[2 + q] : h4[q], theirs = up ? h4[q] : h4[2 + q]; h2[q] = mine + __shfl_xor(theirs, 16); } }
        { const bool up = (lane & 8) != 0; const float mine = up ? h2[1] : h2[0], theirs = up ? h2[0] : h2[1]; h1 = mine + __shfl_xor(theirs, 8); }
        h1 += __shfl_xor(h1, 4); h1 += __shfl_xor(h1, 2); h1 += __shfl_xor(h1, 1);
        if ((lane & 7) == 0) { const int q = ((lane >> 5) & 1) * 4 + ((lane >> 4) & 1) * 2 + ((lane >> 3) & 1); gates[(size_t)row * 8 + q] = h1 + p.gate_b[q]; }
    }
#if TSEL == 51
    if (blockIdx.x == PBLK && threadIdx.x == 0) ((volatile LAS unsigned*)((LAS unsigned char*)lds + LDSCTL_OFF))[40] = (unsigned)__builtin_amdgcn_s_memrealtime() - ((volatile LAS unsigned*)((LAS unsigned char*)lds + LDSCTL_OFF))[0];
#endif
    __syncthreads();
}

__global__ void __launch_bounds__(NTHR, 2) mega(Args args) {
    extern __shared__ __attribute__((aligned(16))) unsigned char lds_raw[];
    const Params& p = args.p;
    LAS unsigned char* lds = (LAS unsigned char*)lds_raw;
    const int tid = threadIdx.x, lane = tid & 63, wave = __builtin_amdgcn_readfirstlane(tid >> 6);
    const int G = gridDim.x, bx = blockIdx.x, vcu = (G % 8 == 0) ? (bx % 8) * (G / 8) + bx / 8 : bx;
    unsigned* ctl = (unsigned*)(p.ws + WS_CTL);
    for (int u = tid; u < (TAB_OFF - LDSCTL_OFF) / 4; u += NTHR) ((LAS unsigned*)(lds + LDSCTL_OFF))[u] = 0u;
    __syncthreads();
    volatile LAS unsigned* MISC = (volatile LAS unsigned*)(lds + MISC_OFF);
    XcdBarrier bar = xcd_barrier_post(ctl + CW_BAR + args.li * XCD_BAR_WORDS, MISC + 8);
    const int lo = args.ph_lo, hi = args.ph_hi;
#define IN(k) (lo <= (k) && (k) < hi)
#ifndef DUP_PHASE
#define DUP_PHASE -1
#endif
#define REP(k) for (int rep_ = 0; rep_ < ((k) == DUP_PHASE ? 2 : 1); ++rep_)
#ifndef TSEL
#define TSEL -1
#endif
#define STAMP(k) do { if (TSEL >= 0 && (TSEL < 20 || TSEL == 50 || TSEL == 51) && bx == PBLK && tid == 0) { const unsigned long long t_ = __builtin_amdgcn_s_memrealtime(); ((volatile LAS unsigned*)(lds + LDSCTL_OFF))[2 * (k)] = (unsigned)t_; } } while (0)
#define SEAM(k) do { if (IN(k) && (k) + 1 < hi) xcd_barrier(bar); STAMP((k) + 1); } while (0)
    STAMP(0);

    if (IN(PH_PRE)) REP(PH_PRE) { phase_pre(p, lds_raw, vcu, G, wave, lane); }
    SEAM(PH_PRE);
    if (IN(PH_PROJ)) REP(PH_PROJ) {
        pg8::StaticOrder S; S.init(p.ws + WS_XN, p.ws + WS_WIN, T, NPJ, DM, G, bx);
        pg8::EpiProj E{(bf16_t*)(p.ws + WS_PROJ)};
        pg8::gemm_phase<pg8::EpiProj, pg8::StaticOrder, false>(lds, DM * 2, S, E, nullptr);
    }
    SEAM(PH_PROJ);
    if (IN(PH_MLA)) REP(PH_MLA) { for (int it = vcu; it < 16 * NCH; it += G) ml::mlstm_a_item(p, it, (char*)lds_raw); __syncthreads(); }
    SEAM(PH_MLA);
    if (IN(PH_ATTN)) {
        for (int it = vcu; it < 256; it += G) ml::mlstm_scan_item(p, it, (char*)lds_raw);
        unsigned g_tacc = 0; const unsigned long long mt0_ = (TSEL == 30) ? __builtin_amdgcn_s_memtime() : 0ull;
        const float lam = __expf(wave_sum(p.lam_q1[lane] * p.lam_k1[lane])) - __expf(wave_sum(p.lam_q2[lane] * p.lam_k2[lane])) + 0.2f;
        for (int U = vcu; U < (DUP_PHASE == PH_ATTN ? 1024 : 512); U += G) { const int i = (U >> 8) & 1, v = U & 255, bh = v >> 4, s = v & 15;
            const int qb = (i == 0) ? s : 31 - s;
#pragma nounroll
            for (int m = 0; m < 2; ++m) att::attn_unit(p, bh >> 2, bh & 3, m, qb, lam, (char*)lds_raw, g_tacc); }
        if (TSEL == 30) g_tacc = (unsigned)((__builtin_amdgcn_s_memtime() - mt0_) >> 4);
        if (TSEL >= 20 && bx == 0 && lane == 0 && wave == PWAVE) ((volatile LAS unsigned*)(lds + LDSCTL_OFF))[40] = g_tacc;
        __syncthreads();
    }
    SEAM(PH_ATTN);
    if (IN(PH_MLC)) REP(PH_MLC) { unsigned g_tacc = 0; ml::mlstm_c_phase(p, vcu, G, (char*)lds_raw, g_tacc);
        if (TSEL >= 40 && TSEL < 50 && bx == 0 && lane == 0 && wave == PWAVE) ((volatile LAS unsigned*)(lds + LDSCTL_OFF))[40] = g_tacc;
        __syncthreads(); }
    SEAM(PH_MLC);
    if (IN(PH_OUT)) REP(PH_OUT) {
        pg8::StaticOrder S; S.init(p.ws + WS_MIX, p.ws + WS_WOUT, T, DM, DM, G, bx);
        pg8::EpiOut E{p.x, p.out};
        pg8::gemm_phase<pg8::EpiOut, pg8::StaticOrder, false>(lds, DM * 2, S, E, nullptr);
    }
    SEAM(PH_OUT);
    if (IN(PH_ROUTE)) phase_route(p, lds_raw, vcu, G, wave, lane);
    SEAM(PH_ROUTE);
    if (IN(PH_MOE1)) REP(PH_MOE1) {
        const int n = moe_build_units<8>(lds, ctl, G, bx);
        const LAS int* UL = (const LAS int*)(lds + TAB_UL); const LAS int* PS = (const LAS int*)(lds + TAB_PS); const LAS int* CN = (const LAS int*)(lds + TAB_CN);
        LAS unsigned* gtab = (LAS unsigned*)(lds + GTAB_OFF);
        const int* list = (const int*)(p.ws + MS_LIST);
        for (int i = tid; i < n * 256; i += NTHR) { const int w = UL[i >> 8], e = w & 255, rt = (w >> 8) & 255; const int idx = min(rt * 256 + (i & 255), CN[e] - 1);
            gtab[i] = (unsigned)list[(size_t)e * T + idx] * (unsigned)DM; }
        __syncthreads();
        MoeOrder<8, true, 1> S{UL, PS, n, (const char*)(p.ws + WS_U2), (const char*)(p.ws + WS_WGU)};
        pg8::EpiSwiglu E{(unsigned char*)(p.ws + WS_ACT), p.b_gu};
        pg8::gemm_phase<pg8::EpiSwiglu, MoeOrder<8, true, 1>, true, true, 0x7b7b7b7b  , 0x76767676  >(lds, DM, S, E, gtab);
    }
    SEAM(PH_MOE1);
    if (IN(PH_MOE2)) REP(PH_MOE2) {
        const int n = moe_build_units<4>(lds, ctl, G, bx);
        const LAS int* UL = (const LAS int*)(lds + TAB_UL); const LAS int* PS = (const LAS int*)(lds + TAB_PS);
        MoeOrder<4, false, 1> S{UL, PS, n, (const char*)(p.ws + WS_ACT), (const char*)(p.ws + WS_WDN)};
        pg8::EpiDown E{(bf16_t*)(p.ws + WS_Y), p.b_down};
        pg8::gemm_phase<pg8::EpiDown, MoeOrder<4, false, 1>, false, true, 0x7d7d7d7d  , 0x76767676  >(lds, FF, S, E, nullptr);
    }
    SEAM(PH_MOE2);
    if (IN(PH_FINAL)) phase_final(p, lds_raw, vcu, G, wave, lane);
    if (TSEL >= 0) { __syncthreads(); STAMP(PH_N);
        if (bx == PBLK && tid == 0) { volatile LAS unsigned* st_ = (volatile LAS unsigned*)(lds + LDSCTL_OFF); const unsigned d_ = (TSEL >= 20 ? st_[40] : (st_[2 * (TSEL + 1)] - st_[2 * TSEL])) * TMULT;
            const unsigned long long t0_ = __builtin_amdgcn_s_memrealtime(); while ((unsigned)(__builtin_amdgcn_s_memrealtime() - t0_) < d_) __builtin_amdgcn_s_sleep(8); } }
#undef IN
#undef SEAM
}

static void launch_mega(const Params& p, int lo, int hi, int li, hipStream_t stream) {
    Args a{}; a.p = p; a.ph_lo = lo; a.ph_hi = hi; a.li = li; a.pad = 0;
    hipLaunchKernelGGL(mega, dim3(256), dim3(NTHR), LDS_BYTES, stream, a);
}
extern "C" void kernel_launch(void* const* d_in, const int* in_sizes, int n_in, void* d_out, int out_size, void* d_ws, size_t ws_size, hipStream_t stream) {
    if (n_in != 22 || out_size != T * DM || ws_size < WS_END) { fprintf(stderr, "kernel_launch: unexpected shapes (n_in %d out %d ws %zu)\n", n_in, out_size, ws_size); return; }
    Params p{};
    const float** f = (const float**)&p;
    for (int i = 0; i < 22; ++i) f[i] = (const float*)d_in[i];
    p.out = (float*)d_out; p.ws = (unsigned char*)d_ws;
    static bool attr = false;
    if (!attr) { attr = true;
        (void)hipFuncSetAttribute((const void*)k_mlstm_a, hipFuncAttributeMaxDynamicSharedMemorySize, 80 * 1024);
        (void)hipFuncSetAttribute((const void*)k_mlstm_c, hipFuncAttributeMaxDynamicSharedMemorySize, 128 * 1024);
        (void)hipFuncSetAttribute((const void*)mega, hipFuncAttributeMaxDynamicSharedMemorySize, LDS_BYTES); }
    (void)hipMemsetAsync((char*)d_ws + WS_CTL, 0, 1 * MiB, stream);
    launch_mega(p, PH_PRE, PH_N, 0, stream);
}
```

```cpp
#define DUP_PHASE -1
#define TSEL -1
#define TMULT 1
#define PWAVE 0
#define PBLK 0
#define PSUB 0
#include <hip/hip_runtime.h>
#include <cstdio>
#include <cstdint>

typedef unsigned short bf16_t;
typedef short bf16x8 __attribute__((ext_vector_type(8)));
typedef float f32x4 __attribute__((ext_vector_type(4)));
typedef unsigned u32x4 __attribute__((ext_vector_type(4)));
typedef unsigned u32x2 __attribute__((ext_vector_type(2)));

constexpr int NB = 4, SEQ = 8192, T = NB * SEQ, DM = 1024, DIN = 3592, NPJ = 3584;
constexpr int NCH = SEQ / 64;
constexpr int NE = 32, FF = 1024;
constexpr int PQ = 0, PK = 512, PV = 1024, PO = 1536, PAQ = 2048, PAK = 2560, PAV = 3072;
constexpr int PROWS = T * 4 + NE * 256;
constexpr float EPS = 1e-5f;
constexpr float LOG2E = 1.4426950408889634f;
constexpr float QSCALE = 0.125f * LOG2E;

constexpr size_t MiB = 1u << 20;
constexpr size_t WS_CTL = 0;
constexpr size_t WS_WIN = 2 * MiB;
constexpr size_t WS_WOUT = 10 * MiB;
constexpr size_t WS_GATES = 12 * MiB;
constexpr size_t WS_MISC = 14 * MiB;
constexpr size_t WS_WGU = 24 * MiB;
constexpr size_t WS_WDN = 152 * MiB;
constexpr size_t WS_XN = 216 * MiB;
constexpr size_t WS_PROJ = 280 * MiB;
constexpr size_t WS_MU = 504 * MiB;
constexpr size_t WS_MC = 568 * MiB;
constexpr size_t WS_AO = 632 * MiB;
constexpr size_t WS_MIX = 760 * MiB;
constexpr size_t WS_Y = 552 * MiB;
constexpr size_t WS_ACT = WS_PROJ;
constexpr size_t WS_H1 = 424 * MiB;
constexpr size_t WS_U2 = WS_XN;
constexpr size_t WS_END = 824 * MiB;
constexpr size_t MS_LIST = WS_MISC;
constexpr size_t MS_PAIR = WS_MISC + 4 * MiB;
constexpr size_t MS_PE = MS_PAIR;
constexpr size_t MS_PP = MS_PAIR + (size_t)T * 4 * 4;
constexpr size_t MS_PG = MS_PP + (size_t)T * 4 * 4;
constexpr size_t MS_MSC = WS_MISC + 6 * MiB;
constexpr size_t MS_NU = WS_MISC + 7 * MiB;
constexpr size_t MS_NC = WS_MISC + 8 * MiB;
constexpr int CW_CNT = 64;

struct Params {
    const float *x, *rel_bias, *norm1_g, *w_in, *conv_w, *conv_b, *gate_b, *mlstm_norm_g, *lam_q1, *lam_k1, *lam_q2, *lam_k2,
        *diff_norm_g, *w_out, *norm2_g, *router_w, *router_b, *w_gu, *b_gu, *w_down, *b_down, *final_g;
    float* out; unsigned char* ws;
};

__device__ __forceinline__ float bf2f(bf16_t v) { return __uint_as_float((unsigned)v << 16); }
__device__ __forceinline__ unsigned f2bf(float f) { unsigned u = __float_as_uint(f); return (u + 0x7fffu + ((u >> 16) & 1u)) >> 16; }
__device__ __forceinline__ unsigned pk2(float lo, float hi) { return f2bf(lo) | (f2bf(hi) << 16); }
__device__ __forceinline__ float wave_sum(float v) {
#pragma unroll
    for (int o = 1; o < 64; o <<= 1) v += __shfl_xor(v, o);
    return v;
}
__device__ __forceinline__ float sigmoidf_(float x) { return 1.f / (1.f + __expf(-x)); }
__device__ __forceinline__ float log_sigmoid(float x) { return fminf(x, 0.f) - log1pf(__expf(-fabsf(x))); }
#define LDS_WAIT() asm volatile("s_waitcnt lgkmcnt(0)" ::: "memory")

__device__ __forceinline__ void tr_item(const float* W, int ldw, int n0, int k0, bf16_t* WT, int dstrow0, int Kd, float* scr, int lane) {
#pragma unroll 8
    for (int i = 0; i < 32; ++i) { const int kk = 2 * i + (lane >> 5); scr[kk * 33 + (lane & 31)] = W[(size_t)(k0 + kk) * ldw + n0 + (lane & 31)]; }
    LDS_WAIT();
    const int c = lane & 7;
#pragma unroll
    for (int j = 0; j < 4; ++j) { const int n = (lane >> 3) + 8 * j; const float* s = scr + (8 * c) * 33 + n;
        u32x4 o; o.x = pk2(s[0 * 33], s[1 * 33]); o.y = pk2(s[2 * 33], s[3 * 33]); o.z = pk2(s[4 * 33], s[5 * 33]); o.w = pk2(s[6 * 33], s[7 * 33]);
        *(u32x4*)(WT + (size_t)(dstrow0 + n) * Kd + k0 + 8 * c) = o; }
    LDS_WAIT();
}
__device__ __forceinline__ void tr_item8(const float* W, int ldw, int n0, int k0, unsigned char* WT, int dstrow0, int Kd, float scale, float* scr, int lane) {
    const float* src = W + (size_t)(k0 + (lane >> 5)) * ldw + n0 + (lane & 31);
#pragma unroll
    for (int b = 0; b < 4; ++b) { float v[16];
#pragma unroll
        for (int i = 0; i < 16; ++i) v[i] = src[(size_t)(2 * (16 * b + i)) * ldw];
#pragma unroll
        for (int i = 0; i < 16; ++i) scr[(2 * (16 * b + i) + (lane >> 5)) * 33 + (lane & 31)] = v[i] * scale; }
    LDS_WAIT();
    const int c = lane & 3;
#pragma unroll
    for (int j = 0; j < 2; ++j) { const int n = (lane >> 2) + 16 * j; const float* s = scr + (32 * c) * 33 + n;
        u32x4 o0, o1;
#define Q4(b) ({ int w_ = __builtin_amdgcn_cvt_pk_fp8_f32(s[((b) + 0) * 33], s[((b) + 1) * 33], 0, false); (unsigned)__builtin_amdgcn_cvt_pk_fp8_f32(s[((b) + 2) * 33], s[((b) + 3) * 33], w_, true); })
        o0.x = Q4(0); o0.y = Q4(4); o0.z = Q4(8); o0.w = Q4(12); o1.x = Q4(16); o1.y = Q4(20); o1.z = Q4(24); o1.w = Q4(28);
#undef Q4
        unsigned char* d = WT + (size_t)(dstrow0 + n) * Kd + k0 + 32 * c; *(u32x4*)d = o0; *(u32x4*)(d + 16) = o1; }
    LDS_WAIT();
}
constexpr float W8_SCALE = 512.f, U8_SCALE = 16.f;
constexpr int CV_I0 = 1024, CV_I1 = 768, CV_I2 = 512, CV_I3 = 16384, CV_I4 = 8192, CV_N = CV_I0 + CV_I1 + CV_I2 + CV_I3 + CV_I4;
__device__ __forceinline__ void convert_item(const Params& p, int it, float* scr, int lane) {
    bf16_t* win = (bf16_t*)(p.ws + WS_WIN); bf16_t* wout = (bf16_t*)(p.ws + WS_WOUT); unsigned char* wgu = (unsigned char*)(p.ws + WS_WGU); unsigned char* wdn = (unsigned char*)(p.ws + WS_WDN);
    int r = it;
    if (r < CV_I0) { const int kb = r / 64, nb = r % 64; tr_item(p.w_in, DIN, 32 * nb, 64 * kb, win, 32 * nb, DM, scr, lane); return; } r -= CV_I0;
    if (r < CV_I1) { const int kb = r / 48, nb = r % 48; tr_item(p.w_in, DIN, 2056 + 32 * nb, 64 * kb, win, 2048 + 32 * nb, DM, scr, lane); return; } r -= CV_I1;
    if (r < CV_I2) { const int kb = r / 32, nb = r % 32; tr_item(p.w_out, DM, 32 * nb, 64 * kb, wout, 32 * nb, DM, scr, lane); return; } r -= CV_I2;
    if (r < CV_I3) { const int e = r / 512, q = r % 512, kb = q / 64, nb = q % 64; const int n0 = 32 * nb;
        const int dst = (n0 < 1024) ? (256 * (n0 / 128) + (n0 % 128)) : (256 * ((n0 - 1024) / 128) + 128 + ((n0 - 1024) % 128));
        tr_item8(p.w_gu + (size_t)e * DM * 2 * FF, 2 * FF, n0, 128 * kb, wgu + (size_t)e * 2 * FF * DM, dst, DM, W8_SCALE, scr, lane); return; } r -= CV_I3;
    { const int e = r / 256, q = r % 256, kb = q / 32, nb = q % 32;
        tr_item8(p.w_down + (size_t)e * FF * DM, DM, 32 * nb, 128 * kb, wdn + (size_t)e * DM * FF, 32 * nb, FF, W8_SCALE, scr, lane); }
}
__global__ void __launch_bounds__(256) k_convert(Params p) {
    __shared__ float scr[4][64 * 33 * 2];
    const int wave = threadIdx.x >> 6, lane = threadIdx.x & 63;
    for (int it = blockIdx.x * 4 + wave; it < CV_N; it += gridDim.x * 4) convert_item(p, it, scr[wave], lane);
}

__global__ void __launch_bounds__(256) k_norm1(Params p) {
    __shared__ float gw[DM * 8];
    for (int i = threadIdx.x; i < DM * 8; i += 256) gw[i] = p.w_in[(size_t)(i >> 3) * DIN + 2048 + (i & 7)];
    __syncthreads();
    const int wave = threadIdx.x >> 6, lane = threadIdx.x & 63;
    bf16_t* XN = (bf16_t*)(p.ws + WS_XN); float* gates = (float*)(p.ws + WS_GATES);
    for (int row = blockIdx.x * 4 + wave; row < T; row += gridDim.x * 4) {
        const f32x4* xr = (const f32x4*)(p.x + (size_t)row * DM) + lane;
        f32x4 v[4]; float s = 0.f;
#pragma unroll
        for (int j = 0; j < 4; ++j) { v[j] = xr[64 * j]; s += (v[j].x * v[j].x + v[j].y * v[j].y) + (v[j].z * v[j].z + v[j].w * v[j].w); }
        const float rstd = rsqrtf(wave_sum(s) * (1.f / DM) + EPS);
        float ga[8];
#pragma unroll
        for (int q = 0; q < 8; ++q) ga[q] = 0.f;
        unsigned long long* o8 = (unsigned long long*)(XN + (size_t)row * DM) + lane;
#pragma unroll
        for (int j = 0; j < 4; ++j) { const f32x4 g = ((const f32x4*)p.norm1_g)[64 * j + lane]; f32x4 u = v[j] * rstd * g;
            o8[64 * j] = (unsigned long long)pk2(u.x, u.y) | ((unsigned long long)pk2(u.z, u.w) << 32);
            const int k0 = 256 * j + 4 * lane;
#pragma unroll
            for (int c = 0; c < 4; ++c) { const float uu = u[c]; const float* w = gw + (k0 + c) * 8;
#pragma unroll
                for (int q = 0; q < 8; ++q) ga[q] += uu * w[q]; } }
#pragma unroll
        for (int q = 0; q < 8; ++q) ga[q] = wave_sum(ga[q]);
        if (lane == 0) {
#pragma unroll
            for (int q = 0; q < 8; ++q) gates[(size_t)row * 8 + q] = ga[q] + p.gate_b[q]; }
    }
}

__device__ __forceinline__ void wave_gemm_32x32(f32x4 (&acc)[2][2], const bf16_t* a0, const bf16_t* a1, const bf16_t* b0, const bf16_t* b1, int K) {
    for (int k = 0; k < K; k += 32) {
        const bf16x8 A0 = *(const bf16x8*)(a0 + k), A1 = *(const bf16x8*)(a1 + k), B0 = *(const bf16x8*)(b0 + k), B1 = *(const bf16x8*)(b1 + k);
        acc[0][0] = __builtin_amdgcn_mfma_f32_16x16x32_bf16(A0, B0, acc[0][0], 0, 0, 0);
        acc[0][1] = __builtin_amdgcn_mfma_f32_16x16x32_bf16(A0, B1, acc[0][1], 0, 0, 0);
        acc[1][0] = __builtin_amdgcn_mfma_f32_16x16x32_bf16(A1, B0, acc[1][0], 0, 0, 0);
        acc[1][1] = __builtin_amdgcn_mfma_f32_16x16x32_bf16(A1, B1, acc[1][1], 0, 0, 0);
    }
}
#define ZERO_ACC(acc) do { _Pragma("unroll") for (int a_ = 0; a_ < 2; ++a_) _Pragma("unroll") for (int b_ = 0; b_ < 2; ++b_) acc[a_][b_] = (f32x4){0.f, 0.f, 0.f, 0.f}; } while (0)

__global__ void __launch_bounds__(256) k_proj(Params p) {
    const int wave = threadIdx.x >> 6, lane = threadIdx.x & 63, fr = lane & 15, fq = lane >> 4;
    const bf16_t* XN = (const bf16_t*)(p.ws + WS_XN); const bf16_t* W = (const bf16_t*)(p.ws + WS_WIN); bf16_t* PR = (bf16_t*)(p.ws + WS_PROJ);
    constexpr int NCT = NPJ / 32, NIT = (T / 32) * NCT;
    for (int it = blockIdx.x * 4 + wave; it < NIT; it += gridDim.x * 4) {
        const int rt = it / NCT, ct = it % NCT, r0 = rt * 32, c0 = ct * 32;
        f32x4 acc[2][2]; ZERO_ACC(acc);
        wave_gemm_32x32(acc, XN + (size_t)(r0 + fr) * DM + fq * 8, XN + (size_t)(r0 + 16 + fr) * DM + fq * 8, W + (size_t)(c0 + fr) * DM + fq * 8, W + (size_t)(c0 + 16 + fr) * DM + fq * 8, DM);
        const float sc = (c0 >= PAQ && c0 < PAK) ? QSCALE : 1.f;
#pragma unroll
        for (int mi = 0; mi < 2; ++mi)
#pragma unroll
            for (int ni = 0; ni < 2; ++ni)
#pragma unroll
                for (int j = 0; j < 4; ++j) PR[(size_t)(r0 + mi * 16 + fq * 4 + j) * NPJ + c0 + ni * 16 + fr] = (bf16_t)f2bf(acc[mi][ni][j] * sc);
    }
}

__global__ void __launch_bounds__(256) k_outproj(Params p) {
    const int wave = threadIdx.x >> 6, lane = threadIdx.x & 63, fr = lane & 15, fq = lane >> 4;
    const bf16_t* A = (const bf16_t*)(p.ws + WS_MIX); const bf16_t* W = (const bf16_t*)(p.ws + WS_WOUT);
    constexpr int NCT = DM / 32, NIT = (T / 32) * NCT;
    for (int it = blockIdx.x * 4 + wave; it < NIT; it += gridDim.x * 4) {
        const int rt = it / NCT, ct = it % NCT, r0 = rt * 32, c0 = ct * 32;
        f32x4 acc[2][2]; ZERO_ACC(acc);
        wave_gemm_32x32(acc, A + (size_t)(r0 + fr) * DM + fq * 8, A + (size_t)(r0 + 16 + fr) * DM + fq * 8, W + (size_t)(c0 + fr) * DM + fq * 8, W + (size_t)(c0 + 16 + fr) * DM + fq * 8, DM);
#pragma unroll
        for (int mi = 0; mi < 2; ++mi)
#pragma unroll
            for (int ni = 0; ni < 2; ++ni)
#pragma unroll
                for (int j = 0; j < 4; ++j) { const size_t o = (size_t)(r0 + mi * 16 + fq * 4 + j) * DM + c0 + ni * 16 + fr; p.out[o] = p.x[o] + acc[mi][ni][j]; }
    }
}

__device__ __forceinline__ void load_conv_tile(const Params& p, float* dst, int LD, int b, int c, int col0, int cch, float scale) {
    const bf16_t* PR = (const bf16_t*)(p.ws + WS_PROJ);
    for (int i = threadIdx.x; i < 64 * 128; i += blockDim.x) {
        const int s = i >> 7, d = i & 127; const int tl = c * 64 + s; float a = p.conv_b[cch + d];
#pragma unroll
        for (int j = 0; j < 4; ++j) { const int tt = tl - 3 + j; if (tt >= 0) a += p.conv_w[j * 1024 + cch + d] * bf2f(PR[(size_t)(b * SEQ + tt) * NPJ + col0 + d]); }
        dst[s * LD + d] = a * sigmoidf_(a) * scale;
    }
}
__device__ __forceinline__ void load_gates(const Params& p, float* li, float* bcum, int b, int h, int c) {
    const float* gates = (const float*)(p.ws + WS_GATES);
    if (threadIdx.x < 64) { const size_t t = (size_t)b * SEQ + c * 64 + threadIdx.x; li[threadIdx.x] = gates[t * 8 + h]; bcum[threadIdx.x] = log_sigmoid(gates[t * 8 + 4 + h]); }
    __syncthreads();
    if (threadIdx.x == 0) { float a = 0.f; for (int s = 0; s < 64; ++s) { a += bcum[s]; bcum[s] = a; } }
    __syncthreads();
}

__global__ void __launch_bounds__(256) k_mlstm_a(Params p) {
    extern __shared__ __attribute__((aligned(16))) unsigned char smem[];
    float* kk = (float*)smem; float* vv = kk + 64 * 129; float* li = vv + 64 * 128; float* bcum = li + 64; float* wgt = bcum + 64;
    const bf16_t* PR = (const bf16_t*)(p.ws + WS_PROJ);
    bf16_t* MU = (bf16_t*)(p.ws + WS_MU); float* NU = (float*)(p.ws + MS_NU); float* msc = (float*)(p.ws + MS_MSC);
    for (int item = blockIdx.x; item < 16 * NCH; item += gridDim.x) {
        const int bh = item / NCH, c = item % NCH, b = bh >> 2, h = bh & 3;
        __syncthreads();
        load_gates(p, li, bcum, b, h, c);
        load_conv_tile(p, kk, 129, b, c, PK + h * 128, 512 + h * 128, 0.08838834764831845f);
        for (int i = threadIdx.x; i < 64 * 128; i += 256) { const int s = i >> 7, e = i & 127; vv[i] = bf2f(PR[(size_t)(b * SEQ + c * 64 + s) * NPJ + PV + h * 128 + e]); }
        const float blast = bcum[63];
        float gmax = -INFINITY;
        for (int s = 0; s < 64; ++s) gmax = fmaxf(gmax, blast - bcum[s] + li[s]);
        __syncthreads();
        if (threadIdx.x < 64) wgt[threadIdx.x] = __expf(blast - bcum[threadIdx.x] + li[threadIdx.x] - gmax);
        __syncthreads();
        const int d = threadIdx.x >> 1, e0 = (threadIdx.x & 1) * 64;
        float acc[64];
#pragma unroll
        for (int e = 0; e < 64; ++e) acc[e] = 0.f;
        for (int s = 0; s < 64; ++s) { const float kd = wgt[s] * kk[s * 129 + d];
#pragma unroll
            for (int e = 0; e < 64; ++e) acc[e] += kd * vv[s * 128 + e0 + e]; }
        bf16_t* uo = MU + ((size_t)item * 128 + d) * 128 + e0;
#pragma unroll
        for (int e = 0; e < 64; e += 2) *(unsigned*)(uo + e) = pk2(acc[e], acc[e + 1]);
        if (threadIdx.x < 128) { float a = 0.f; for (int s = 0; s < 64; ++s) a += wgt[s] * kk[s * 129 + threadIdx.x]; NU[(size_t)item * 128 + threadIdx.x] = a; }
        if (threadIdx.x == 0) { msc[item] = blast; msc[2048 + item] = gmax; }
    }
}
__global__ void __launch_bounds__(256) k_mlstm_scan(Params p) {
    __shared__ float dec[NCH], ac[NCH];
    const bf16_t* MU = (const bf16_t*)(p.ws + WS_MU); bf16_t* MC = (bf16_t*)(p.ws + WS_MC);
    const float* NU = (const float*)(p.ws + MS_NU); float* NC = (float*)(p.ws + MS_NC); float* msc = (float*)(p.ws + MS_MSC);
    for (int item = blockIdx.x; item < 16 * 64; item += gridDim.x) {
        const int bh = item >> 6, eb = item & 63;
        __syncthreads();
        if (threadIdx.x == 0) { float m = 0.f;
            for (int c = 0; c < NCH; ++c) { const float bl = msc[bh * NCH + c], gm = msc[2048 + bh * NCH + c]; const float m1 = fmaxf(bl + m, gm);
                dec[c] = __expf(bl + m - m1); ac[c] = __expf(gm - m1); if (eb == 0) msc[4096 + bh * NCH + c] = m; m = m1; } }
        __syncthreads();
        const int idx = eb * 256 + threadIdx.x; float C = 0.f;
        for (int c = 0; c < NCH; ++c) { const size_t o = ((size_t)(bh * NCH + c)) * 16384 + idx; MC[o] = (bf16_t)f2bf(C); C = dec[c] * C + ac[c] * bf2f(MU[o]); }
        if (eb == 0 && threadIdx.x < 128) { float n = 0.f;
            for (int c = 0; c < NCH; ++c) { const size_t o = ((size_t)(bh * NCH + c)) * 128 + threadIdx.x; NC[o] = n; n = dec[c] * n + ac[c] * NU[o]; } }
    }
}
__global__ void __launch_bounds__(256) k_mlstm_c(Params p) {
    extern __shared__ __attribute__((aligned(16))) unsigned char smem[];
    float* qq = (float*)smem; float* kk = qq + 64 * 129; float* vv = kk + 64 * 129; float* W = vv + 64 * 128; float* li = W + 64 * 65; float* bcum = li + 64;
    float* mx = bcum + 64; float* den = mx + 64; float* nn = den + 64;
    const bf16_t* PR = (const bf16_t*)(p.ws + WS_PROJ); const bf16_t* MC = (const bf16_t*)(p.ws + WS_MC);
    const float* NC = (const float*)(p.ws + MS_NC); const float* msc = (const float*)(p.ws + MS_MSC); bf16_t* MIX = (bf16_t*)(p.ws + WS_MIX);
    for (int item = blockIdx.x; item < 16 * NCH; item += gridDim.x) {
        const int bh = item / NCH, c = item % NCH, b = bh >> 2, h = bh & 3;
        __syncthreads();
        load_gates(p, li, bcum, b, h, c);
        load_conv_tile(p, qq, 129, b, c, PQ + h * 128, h * 128, 1.f);
        load_conv_tile(p, kk, 129, b, c, PK + h * 128, 512 + h * 128, 0.08838834764831845f);
        for (int i = threadIdx.x; i < 64 * 128; i += 256) { const int s = i >> 7, e = i & 127; vv[i] = bf2f(PR[(size_t)(b * SEQ + c * 64 + s) * NPJ + PV + h * 128 + e]); }
        if (threadIdx.x < 128) nn[threadIdx.x] = NC[(size_t)item * 128 + threadIdx.x];
        const float mc = msc[4096 + item];
        if (threadIdx.x < 64) { const int t = threadIdx.x; float m = bcum[t] + mc; for (int s = 0; s <= t; ++s) m = fmaxf(m, bcum[t] - bcum[s] + li[s]); mx[t] = m; }
        __syncthreads();
        for (int i = threadIdx.x; i < 64 * 64; i += 256) { const int t = i >> 6, s = i & 63; float w = 0.f;
            if (s <= t) { float dot = 0.f; for (int d = 0; d < 128; ++d) dot += qq[t * 129 + d] * kk[s * 129 + d]; w = __expf(bcum[t] - bcum[s] + li[s] - mx[t]) * dot; }
            W[t * 65 + s] = w; }
        __syncthreads();
        const int t = threadIdx.x >> 2, e0 = (threadIdx.x & 3) * 32;
        const float sc = __expf(bcum[t] + mc - mx[t]);
        if ((threadIdx.x & 3) == 0) { float a = 0.f; for (int s = 0; s <= t; ++s) a += W[t * 65 + s]; float qn = 0.f; for (int d = 0; d < 128; ++d) qn += qq[t * 129 + d] * nn[d]; den[t] = a + sc * qn; }
        float acc[32];
#pragma unroll
        for (int e = 0; e < 32; ++e) acc[e] = 0.f;
        const bf16_t* Cb = MC + (size_t)item * 16384 + e0;
        for (int d = 0; d < 128; ++d) { const float qd = qq[t * 129 + d]; const bf16_t* cr = Cb + d * 128;
#pragma unroll
            for (int e = 0; e < 32; ++e) acc[e] += qd * bf2f(cr[e]); }
#pragma unroll
        for (int e = 0; e < 32; ++e) acc[e] *= sc;
        for (int s = 0; s <= t; ++s) { const float w = W[t * 65 + s];
#pragma unroll
            for (int e = 0; e < 32; ++e) acc[e] += w * vv[s * 128 + e0 + e]; }
        __syncthreads();
        const float dn = fmaxf(fabsf(den[t]), __expf(-mx[t])); float ss = 0.f;
#pragma unroll
        for (int e = 0; e < 32; ++e) { acc[e] /= dn; ss += acc[e] * acc[e]; }
        ss += __shfl_xor(ss, 1); ss += __shfl_xor(ss, 2);
        const float rstd = rsqrtf(ss * (1.f / 128.f) + EPS);
        const size_t row = (size_t)b * SEQ + c * 64 + t;
#pragma unroll
        for (int e = 0; e < 32; ++e) { const int ch = h * 128 + e0 + e; const float og = sigmoidf_(bf2f(PR[row * NPJ + PO + ch]));
            MIX[row * DM + ch] = (bf16_t)f2bf(acc[e] * rstd * p.mlstm_norm_g[ch] * og); }
    }
}

__device__ __forceinline__ int t5_bucket(int rel) {
    const int n = rel < 0 ? -rel : rel; int b;
    if (n < 8) b = n; else if (n < 12) b = 8; else if (n < 16) b = 9; else if (n < 23) b = 10; else if (n < 32) b = 11; else if (n < 46) b = 12; else if (n < 64) b = 13; else if (n < 91) b = 14; else b = 15;
    return b + (rel > 0 ? 16 : 0);
}
__global__ void __launch_bounds__(256) k_attn_naive(Params p) {
    __shared__ __attribute__((aligned(16))) float Ks[64 * 64];
    __shared__ __attribute__((aligned(16))) float Vs[64 * 128];
    __shared__ float btab[256];
    const bf16_t* PR = (const bf16_t*)(p.ws + WS_PROJ); float* AO = (float*)(p.ws + WS_AO);
    for (int item = blockIdx.x; item < NB * 4 * 2 * 32; item += gridDim.x) {
        const int qb = 31 - (item >> 5), r5 = item & 31, b = r5 >> 3, h = (r5 >> 1) & 3, m = r5 & 1;
        __syncthreads();
        btab[threadIdx.x] = p.rel_bias[t5_bucket((int)threadIdx.x - 192) * 4 + h] * LOG2E;
        const float c15 = p.rel_bias[15 * 4 + h] * LOG2E;
        const int q = qb * 256 + threadIdx.x, cq = q >> 6;
        float qv[64];
        { const bf16_t* qp = PR + (size_t)(b * SEQ + q) * NPJ + PAQ + h * 128 + m * 64;
#pragma unroll
            for (int d = 0; d < 64; d += 8) { const u32x4 w = *(const u32x4*)(qp + d);
                qv[d] = __uint_as_float(w.x << 16); qv[d + 1] = __uint_as_float(w.x & 0xffff0000u); qv[d + 2] = __uint_as_float(w.y << 16); qv[d + 3] = __uint_as_float(w.y & 0xffff0000u);
                qv[d + 4] = __uint_as_float(w.z << 16); qv[d + 5] = __uint_as_float(w.z & 0xffff0000u); qv[d + 6] = __uint_as_float(w.w << 16); qv[d + 7] = __uint_as_float(w.w & 0xffff0000u); } }
        float o[128];
#pragma unroll
        for (int e = 0; e < 128; ++e) o[e] = 0.f;
        float mrun = -INFINITY, l = 0.f;
        const int ntile = 4 * qb + 4;
        for (int j = 0; j < ntile; ++j) {
            __syncthreads();
            for (int i = threadIdx.x; i < 64 * 64; i += 256) { const int kk = i >> 6, d = i & 63; Ks[i] = bf2f(PR[(size_t)(b * SEQ + j * 64 + kk) * NPJ + PAK + h * 128 + m * 64 + d]); }
            for (int i = threadIdx.x; i < 64 * 128; i += 256) { const int kk = i >> 7, e = i & 127; Vs[i] = bf2f(PR[(size_t)(b * SEQ + j * 64 + kk) * NPJ + PAV + h * 128 + e]); }
            __syncthreads();
            if (j <= cq) {
                for (int kk = 0; kk < 64; ++kk) {
                    float s = 0.f;
#pragma unroll
                    for (int d = 0; d < 64; d += 4) { const f32x4 kv = *(const f32x4*)(Ks + kk * 64 + d); s += qv[d] * kv.x + qv[d + 1] * kv.y + qv[d + 2] * kv.z + qv[d + 3] * kv.w; }
                    const int rel = j * 64 + kk - q;
                    s += (rel < -192) ? c15 : btab[rel + 192];
                    if (s > mrun) { const float f = exp2f(mrun - s); l *= f;
#pragma unroll
                        for (int e = 0; e < 128; ++e) o[e] *= f;
                        mrun = s; }
                    const float pw = exp2f(s - mrun); l += pw;
#pragma unroll
                    for (int e = 0; e < 128; e += 4) { const f32x4 vv = *(const f32x4*)(Vs + kk * 128 + e); o[e] += pw * vv.x; o[e + 1] += pw * vv.y; o[e + 2] += pw * vv.z; o[e + 3] += pw * vv.w; }
                }
            }
        }
        const float inv = 1.f / l;
        float* op = AO + (((size_t)(b * SEQ + q) * 4 + h) * 2 + m) * 128;
#pragma unroll
        for (int e = 0; e < 128; e += 4) *(f32x4*)(op + e) = (f32x4){o[e] * inv, o[e + 1] * inv, o[e + 2] * inv, o[e + 3] * inv};
    }
}
__global__ void __launch_bounds__(256) k_attn_combine(Params p) {
    __shared__ float lam_s;
    if (threadIdx.x == 0) { float a = 0.f, c = 0.f; for (int i = 0; i < 64; ++i) { a += p.lam_q1[i] * p.lam_k1[i]; c += p.lam_q2[i] * p.lam_k2[i]; } lam_s = __expf(a) - __expf(c) + 0.2f; }
    __syncthreads();
    const float lam = lam_s;
    const float* AO = (const float*)(p.ws + WS_AO); bf16_t* MIX = (bf16_t*)(p.ws + WS_MIX);
    const int wave = threadIdx.x >> 6, lane = threadIdx.x & 63;
    for (int it = blockIdx.x * 4 + wave; it < T * 4; it += gridDim.x * 4) {
        const float* o1 = AO + (size_t)it * 256; const float* o2 = o1 + 128;
        const float a0 = o1[2 * lane] - lam * o2[2 * lane], a1 = o1[2 * lane + 1] - lam * o2[2 * lane + 1];
        const float rstd = rsqrtf(wave_sum(a0 * a0 + a1 * a1) * (1.f / 128.f) + EPS);
        const int t = it >> 2, h = it & 3;
        *(unsigned*)(MIX + (size_t)t * DM + 512 + h * 128 + 2 * lane) = pk2(a0 * rstd * p.diff_norm_g[2 * lane] * 0.8f, a1 * rstd * p.diff_norm_g[2 * lane + 1] * 0.8f);
    }
}

__global__ void __launch_bounds__(256) k_route(Params p) {
    __shared__ float urow[4][DM];
    const int wave = threadIdx.x >> 6, lane = threadIdx.x & 63;
    bf16_t* U2 = (bf16_t*)(p.ws + WS_U2); unsigned* ctl = (unsigned*)(p.ws + WS_CTL);
    int* list = (int*)(p.ws + MS_LIST); int* pe = (int*)(p.ws + MS_PE); int* pp = (int*)(p.ws + MS_PP); float* pg = (float*)(p.ws + MS_PG);
    for (int row = blockIdx.x * 4 + wave; row < T; row += gridDim.x * 4) {
        const f32x4* xr = (const f32x4*)(p.out + (size_t)row * DM) + lane;
        f32x4 v[4]; float s = 0.f;
#pragma unroll
        for (int j = 0; j < 4; ++j) { v[j] = xr[64 * j]; s += (v[j].x * v[j].x + v[j].y * v[j].y) + (v[j].z * v[j].z + v[j].w * v[j].w); }
        const float rstd = rsqrtf(wave_sum(s) * (1.f / DM) + EPS);
        unsigned long long* o8 = (unsigned long long*)(U2 + (size_t)row * DM) + lane;
#pragma unroll
        for (int j = 0; j < 4; ++j) { const f32x4 g = ((const f32x4*)p.norm2_g)[64 * j + lane]; const f32x4 u = v[j] * rstd * g;
            o8[64 * j] = (unsigned long long)pk2(u.x, u.y) | ((unsigned long long)pk2(u.z, u.w) << 32);
            *(f32x4*)(&urow[wave][256 * j + 4 * lane]) = u; }
        LDS_WAIT();
        const int e = lane & 31, half = lane >> 5; float acc = 0.f;
        for (int k = half * 512; k < half * 512 + 512; ++k) acc += urow[wave][k] * p.router_w[(size_t)k * NE + e];
        acc += __shfl_xor(acc, 32);
        float val = acc + p.router_b[e];
        float tv[4]; int ti[4];
#pragma unroll
        for (int r = 0; r < 4; ++r) { float bv = val; int bi = e;
#pragma unroll
            for (int o = 1; o < 32; o <<= 1) { const float ov = __shfl_xor(bv, o); const int oi = __shfl_xor(bi, o); if (ov > bv || (ov == bv && oi < bi)) { bv = ov; bi = oi; } }
            tv[r] = bv; ti[r] = bi; if (e == bi) val = -INFINITY; }
        const float e1 = __expf(tv[1] - tv[0]), e2 = __expf(tv[2] - tv[0]), e3 = __expf(tv[3] - tv[0]); const float inv = 1.f / (1.f + e1 + e2 + e3);
        if (lane < 4) { const int ee = lane == 0 ? ti[0] : lane == 1 ? ti[1] : lane == 2 ? ti[2] : ti[3]; const float gg = (lane == 0 ? 1.f : lane == 1 ? e1 : lane == 2 ? e2 : e3) * inv;
            const int pos = (int)atomicAdd(&ctl[CW_CNT + ee], 1u);
            list[(size_t)ee * T + pos] = row; pe[row * 4 + lane] = ee; pp[row * 4 + lane] = pos; pg[row * 4 + lane] = gg; }
        LDS_WAIT();
    }
}

__device__ __forceinline__ void expert_starts(const unsigned* ctl, int* ps, int* cn) {
    if (threadIdx.x == 0) { int a = 0; for (int e = 0; e < NE; ++e) { const int c = (int)ctl[CW_CNT + e]; cn[e] = c; ps[e] = a; a += (c + 255) & ~255; } ps[NE] = a; }
    __syncthreads();
}
__global__ void __launch_bounds__(256) k_moe1(Params p) {
    __shared__ int ps[NE + 1], cn[NE];
    const unsigned* ctl = (const unsigned*)(p.ws + WS_CTL);
    expert_starts(ctl, ps, cn);
    const int wave = threadIdx.x >> 6, lane = threadIdx.x & 63, fr = lane & 15, fq = lane >> 4;
    const bf16_t* U2 = (const bf16_t*)(p.ws + WS_U2); const bf16_t* WG = (const bf16_t*)(p.ws + WS_WGU); bf16_t* ACT = (bf16_t*)(p.ws + WS_ACT); const int* list = (const int*)(p.ws + MS_LIST);
    const int nrt = ps[NE] / 32, NIT = nrt * 32;
    for (int it = blockIdx.x * 4 + wave; it < NIT; it += gridDim.x * 4) {
        const int rt = it >> 5, ct = it & 31, R = rt * 32, c0 = ct * 32;
        int e = 0; while (ps[e + 1] <= R) ++e;
        const int lr = R - ps[e]; if (lr >= cn[e]) continue;
        const int i0 = min(lr + fr, cn[e] - 1), i1 = min(lr + 16 + fr, cn[e] - 1);
        const int t0 = list[(size_t)e * T + i0], t1 = list[(size_t)e * T + i1];
        const bf16_t* Wb = WG + (size_t)e * 2 * FF * DM + (size_t)(256 * (c0 / 128) + (c0 % 128)) * DM;
        f32x4 ag[2][2], au[2][2]; ZERO_ACC(ag); ZERO_ACC(au);
        wave_gemm_32x32(ag, U2 + (size_t)t0 * DM + fq * 8, U2 + (size_t)t1 * DM + fq * 8, Wb + (size_t)fr * DM + fq * 8, Wb + (size_t)(16 + fr) * DM + fq * 8, DM);
        wave_gemm_32x32(au, U2 + (size_t)t0 * DM + fq * 8, U2 + (size_t)t1 * DM + fq * 8, Wb + (size_t)(128 + fr) * DM + fq * 8, Wb + (size_t)(128 + 16 + fr) * DM + fq * 8, DM);
#pragma unroll
        for (int mi = 0; mi < 2; ++mi)
#pragma unroll
            for (int ni = 0; ni < 2; ++ni)
#pragma unroll
                for (int j = 0; j < 4; ++j) { const int col = c0 + ni * 16 + fr;
                    float g = ag[mi][ni][j] + p.b_gu[(size_t)e * 2 * FF + col], u = au[mi][ni][j] + p.b_gu[(size_t)e * 2 * FF + FF + col];
                    g = fminf(g, 7.f); u = fminf(fmaxf(u, -7.f), 7.f);
                    ACT[(size_t)(R + mi * 16 + fq * 4 + j) * FF + col] = (bf16_t)f2bf((u + 1.f) * g * sigmoidf_(1.702f * g)); }
    }
}
__global__ void __launch_bounds__(256) k_moe2(Params p) {
    __shared__ int ps[NE + 1], cn[NE];
    const unsigned* ctl = (const unsigned*)(p.ws + WS_CTL);
    expert_starts(ctl, ps, cn);
    const int wave = threadIdx.x >> 6, lane = threadIdx.x & 63, fr = lane & 15, fq = lane >> 4;
    const bf16_t* ACT = (const bf16_t*)(p.ws + WS_ACT); const bf16_t* WD = (const bf16_t*)(p.ws + WS_WDN); bf16_t* Y = (bf16_t*)(p.ws + WS_Y);
    const int nrt = ps[NE] / 32, NIT = nrt * 32;
    for (int it = blockIdx.x * 4 + wave; it < NIT; it += gridDim.x * 4) {
        const int rt = it >> 5, ct = it & 31, R = rt * 32, c0 = ct * 32;
        int e = 0; while (ps[e + 1] <= R) ++e;
        const int lr = R - ps[e]; if (lr >= cn[e]) continue;
        const bf16_t* Wb = WD + (size_t)e * DM * FF + (size_t)c0 * FF;
        f32x4 acc[2][2]; ZERO_ACC(acc);
        wave_gemm_32x32(acc, ACT + (size_t)(R + fr) * FF + fq * 8, ACT + (size_t)(R + 16 + fr) * FF + fq * 8, Wb + (size_t)fr * FF + fq * 8, Wb + (size_t)(16 + fr) * FF + fq * 8, FF);
#pragma unroll
        for (int mi = 0; mi < 2; ++mi)
#pragma unroll
            for (int ni = 0; ni < 2; ++ni)
#pragma unroll
                for (int j = 0; j < 4; ++j) { const int col = c0 + ni * 16 + fr;
                    Y[(size_t)(R + mi * 16 + fq * 4 + j) * DM + col] = (bf16_t)f2bf(acc[mi][ni][j] + p.b_down[(size_t)e * DM + col]); }
    }
}
__global__ void __launch_bounds__(256) k_final(Params p) {
    __shared__ int ps[NE + 1], cn[NE];
    const unsigned* ctl = (const unsigned*)(p.ws + WS_CTL);
    expert_starts(ctl, ps, cn);
    const int wave = threadIdx.x >> 6, lane = threadIdx.x & 63;
    const bf16_t* Y = (const bf16_t*)(p.ws + WS_Y); const int* pe = (const int*)(p.ws + MS_PE); const int* pp = (const int*)(p.ws + MS_PP); const float* pg = (const float*)(p.ws + MS_PG);
    for (int row = blockIdx.x * 4 + wave; row < T; row += gridDim.x * 4) {
        f32x4* xr = (f32x4*)(p.out + (size_t)row * DM) + lane;
        f32x4 v[4];
#pragma unroll
        for (int j = 0; j < 4; ++j) v[j] = xr[64 * j];
#pragma unroll
        for (int r = 0; r < 4; ++r) { const int e = pe[row * 4 + r]; const size_t yr = (size_t)(ps[e] + pp[row * 4 + r]); const float g = pg[row * 4 + r];
            const u32x2* yp = (const u32x2*)(Y + yr * DM) + lane;
#pragma unroll
            for (int j = 0; j < 4; ++j) { const u32x2 w = yp[64 * j];
                v[j].x += g * __uint_as_float(w.x << 16); v[j].y += g * __uint_as_float(w.x & 0xffff0000u); v[j].z += g * __uint_as_float(w.y << 16); v[j].w += g * __uint_as_float(w.y & 0xffff0000u); } }
        float s = 0.f;
#pragma unroll
        for (int j = 0; j < 4; ++j) s += (v[j].x * v[j].x + v[j].y * v[j].y) + (v[j].z * v[j].z + v[j].w * v[j].w);
        const float rstd = rsqrtf(wave_sum(s) * (1.f / DM) + EPS);
#pragma unroll
        for (int j = 0; j < 4; ++j) { const f32x4 g = ((const f32x4*)p.final_g)[64 * j + lane]; xr[64 * j] = v[j] * rstd * g; }
    }
}

#define LAS __attribute__((address_space(3)))
#define GAS __attribute__((address_space(1)))
typedef GAS unsigned gu32;
#define RLX_AGENT __ATOMIC_RELAXED, __HIP_MEMORY_SCOPE_AGENT
#define VM_WAIT() asm volatile("s_waitcnt vmcnt(0)" ::: "memory")
constexpr int NWAVES = 8, NTHR = 512;
constexpr int RING_BYTES = 131072;
constexpr int LDSCTL_OFF = RING_BYTES, MISC_OFF = LDSCTL_OFF + 320;
constexpr int TAB_OFF = RING_BYTES + 1024;
constexpr int TAB_UL = TAB_OFF, TAB_PS = TAB_OFF + 256, TAB_CN = TAB_OFF + 256 + 160, TAB_NU = TAB_OFF + 256 + 160 + 128, TAB_UC = TAB_OFF + 256 + 160 + 128 + 16;
constexpr int GTAB_OFF = TAB_OFF + 1024;
constexpr int LDS_BYTES = 163840;
static_assert(GTAB_OFF + 20 * 256 * 4 <= LDS_BYTES, "LDS map");
constexpr int CW_BAR = 4096;

namespace pg8 {
constexpr int BM = 256, BK = 64, HALF = 128, HTB = HALF * BK * 2, STAGE_BYTES = 8 * HTB, NXCD = 8, WGM = 8;
__host__ __device__ __forceinline__ int lds_byte(int r, int c) { const int st = (r >> 4) * 2 + (c >> 5), rr = r & 15, cc = c & 31, ob = rr * 64 + cc * 2; return st * 1024 + (ob ^ (((ob >> 9) & 1) << 5)); }
__host__ __device__ __forceinline__ void stage_rc(int b, int& R, int& C) { const int st = b / 1024, sb = b % 1024, swz = sb ^ (((sb >> 9) & 1) << 5); R = (st >> 1) * 16 + swz / 64; C = (st & 1) * 32 + (swz % 64) / 2; }
__host__ __device__ __forceinline__ int perm32(int rho) { const int n = rho >> 4, i = rho & 15; return 8 * (i >> 2) + 4 * n + (i & 3); }
__device__ __forceinline__ unsigned cvt_pk_bf16(float lo, float hi) { unsigned r; asm volatile("v_cvt_pk_bf16_f32 %0, %1, %2" : "=v"(r) : "v"(lo), "v"(hi)); return r; }

struct Unit { const char* a; const char* b; int pm, pn, e, slot; };

__device__ __forceinline__ int xcd_remap(int L, int nwg) { const int q = nwg / NXCD, r = nwg % NXCD, xcd = L % NXCD, off = L / NXCD; return (xcd < r ? xcd * (q + 1) : r * (q + 1) + (xcd - r) * q) + off; }

struct StaticOrder {
    const char* A; const char* Bt; int nM, nN, nwg, G, c; size_t tstep;
    __device__ void init(const void* A_, const void* Bt_, int M, int N, int K, int G_, int c_) { A = (const char*)A_; Bt = (const char*)Bt_; nM = M / BM; nN = N / BM; nwg = nM * nN; G = G_; c = c_; tstep = (size_t)BM * K * 2; }
    __device__ __forceinline__ bool next(int i, Unit& u) const {
        const long L = (long)i * G + c; if (L >= nwg) return false;
        const int wgid = xcd_remap((int)L, nwg);
        const int nig = WGM * nN, gid = wgid / nig, fm = gid * WGM, gsz = (nM - fm) < WGM ? (nM - fm) : WGM;
        u.pm = fm + ((wgid % nig) % gsz); u.pn = (wgid % nig) / gsz; u.e = 0; u.slot = 0;
        u.a = A + (size_t)u.pm * tstep; u.b = Bt + (size_t)u.pn * tstep; return true;
    }
};

template <class Epi, class Sched, bool GATHER, bool F8 = false, int sA = 0x7f7f7f7f, int sB = 0x7f7f7f7f>
__device__ __forceinline__ void gemm_phase(LAS unsigned char* lds, const int rowbytes, const Sched& S, const Epi& E, const LAS unsigned* gtab) {
    int tid_ = threadIdx.x; asm volatile("" : "+v"(tid_));
    const int tid = tid_, wid = __builtin_amdgcn_readfirstlane(tid >> 6), lane = tid & 63, wr = wid >> 2, wc = wid & 3, fr = lane & 15, fq = lane >> 4;
    int nt = rowbytes / 128; asm volatile("" : "+s"(nt));
    int R0, C0; stage_rc(tid * 16, R0, C0); const int Rb0 = Epi::PERM ? ((R0 & ~31) + perm32(R0 & 31)) : R0;
    const unsigned vA0 = (unsigned)(R0 * rowbytes + C0 * 2), vB0 = (unsigned)(Rb0 * rowbytes + C0 * 2), coff = (unsigned)(C0 * 2);
    unsigned vAg[2][2] = {{0u, 0u}, {0u, 0u}};
    const size_t pstep = (size_t)64 * rowbytes;
    const size_t kstep = (size_t)(BK * 2);
    const size_t hstep = (size_t)HALF * rowbytes;
    const unsigned ldsw = (unsigned)wid * 1024u;
    const int aoff = lds_byte(wr * 64 + fr, fq * 8), boff = lds_byte(wc * 32 + fr, fq * 8);
#define PG8_SA(b, h) (((b) * 2 + (h)) * HTB)
#define PG8_SB(b, h) ((4 + (b) * 2 + (h)) * HTB)
#define PG8_STAGE_B(bufoff, gbase) do { _Pragma("unroll") for (int _i = 0; _i < 2; ++_i) \
        __builtin_amdgcn_global_load_lds((const unsigned*)((const char*)(gbase) + _i * pstep + vB0), (LAS unsigned*)(lds + (bufoff) + ldsw + _i * 8192), 16, 0, 0); } while (0)
#define PG8_STAGE_A(bufoff, gbase, h) do { _Pragma("unroll") for (int _i = 0; _i < 2; ++_i) { \
        if (GATHER) __builtin_amdgcn_global_load_lds((const unsigned*)((const char*)(gbase) + vAg[h][_i]), (LAS unsigned*)(lds + (bufoff) + ldsw + _i * 8192), 16, 0, 0); \
        else __builtin_amdgcn_global_load_lds((const unsigned*)((const char*)(gbase) + (h) * hstep + _i * pstep + vA0), (LAS unsigned*)(lds + (bufoff) + ldsw + _i * 8192), 16, 0, 0); } } while (0)
#define PG8_LD8(p_) __builtin_shufflevector(*(const LAS v4i_*)(p_), *(const LAS v4i_*)((p_) + 1024), 0, 1, 2, 3, 4, 5, 6, 7)
#define PG8_LDA(dst, b, h) do { _Pragma("unroll") for (int m = 0; m < 4; ++m) dst[m] = PG8_LD8(lds + PG8_SA(b, h) + aoff + m * 2048); } while (0)
#define PG8_LDB(dst, b, h) do { _Pragma("unroll") for (int n = 0; n < 2; ++n) dst[n] = PG8_LD8(lds + PG8_SB(b, h) + boff + n * 2048); } while (0)
#define PG8_LO(x) __builtin_bit_cast(bf16x8, __builtin_shufflevector(x, x, 0, 1, 2, 3))
#define PG8_HI(x) __builtin_bit_cast(bf16x8, __builtin_shufflevector(x, x, 4, 5, 6, 7))
#define PG8_MMA(ai, bj, At, Bt) do { __builtin_amdgcn_s_setprio(1); _Pragma("unroll") for (int m = 0; m < 4; ++m) _Pragma("unroll") for (int n = 0; n < 2; ++n) { \
        if constexpr (F8) acc[ai][bj][m][n] = __builtin_amdgcn_mfma_scale_f32_16x16x128_f8f6f4(Bt[n], At[m], acc[ai][bj][m][n], 0, 0, 0, sB, 0, sA); \
        else { acc[ai][bj][m][n] = __builtin_amdgcn_mfma_f32_16x16x32_bf16(PG8_LO(Bt[n]), PG8_LO(At[m]), acc[ai][bj][m][n], 0, 0, 0); \
               acc[ai][bj][m][n] = __builtin_amdgcn_mfma_f32_16x16x32_bf16(PG8_HI(Bt[n]), PG8_HI(At[m]), acc[ai][bj][m][n], 0, 0, 0); } } \
        __builtin_amdgcn_s_setprio(0); } while (0)
#define PG8_WAIT_V(n) asm volatile("s_waitcnt vmcnt(" #n ")" ::: "memory")
#define PG8_WAIT_L(n) asm volatile("s_waitcnt lgkmcnt(" #n ")" ::: "memory")
#define PG8_BAR __builtin_amdgcn_s_barrier()
#define PG8_SCHED __builtin_amdgcn_sched_barrier(0)
#define PG8_GATHER_OFFS(u) do { if (GATHER) { const LAS unsigned* _g = gtab + (u).slot * 256 + R0; \
        vAg[0][0] = _g[0] + coff; vAg[0][1] = _g[64] + coff; vAg[1][0] = _g[HALF] + coff; vAg[1][1] = _g[HALF + 64] + coff; } } while (0)
    Unit cur, nxt; int ui = 0;
    if (!S.next(0, cur)) return;
    f32x4 acc[2][2][4][2];
#pragma unroll
    for (int a = 0; a < 2; ++a)
#pragma unroll
        for (int b = 0; b < 2; ++b)
#pragma unroll
            for (int m = 0; m < 4; ++m)
#pragma unroll
                for (int n = 0; n < 2; ++n) acc[a][b][m][n] = (f32x4){0.f, 0.f, 0.f, 0.f};
    typedef int v4i_ __attribute__((ext_vector_type(4))); typedef int v8i_ __attribute__((ext_vector_type(8)));
    v8i_ At[4], B0[2], B1[2];
    const char* cA = cur.a; const char* cB = cur.b;
    PG8_GATHER_OFFS(cur);
    PG8_STAGE_B(PG8_SB(0, 0), cB); PG8_STAGE_B(PG8_SB(0, 1), cB + hstep); PG8_STAGE_A(PG8_SA(0, 0), cA, 0); PG8_STAGE_A(PG8_SA(0, 1), cA, 1);
    if (wr == 1) PG8_BAR;
    PG8_WAIT_V(2); PG8_BAR;
    PG8_STAGE_B(PG8_SB(1, 0), cB + kstep); PG8_STAGE_A(PG8_SA(1, 0), cA + kstep, 0); PG8_STAGE_B(PG8_SB(1, 1), cB + hstep + kstep);
    PG8_WAIT_V(6); PG8_BAR;
#if TSEL >= 60 && TSEL < 70
    unsigned long long tk0_ = __builtin_amdgcn_s_memrealtime();
#endif
    for (;;) {
        const bool has_next = S.next(ui + 1, nxt);
        const char* nA = has_next ? nxt.a : cA; const char* nB = has_next ? nxt.b : cB;
#pragma nounroll
        for (int t = 0; t < nt; t += 2) {
            const bool last = (t == nt - 2);
            const char* a1 = cA + (size_t)(t + 1) * kstep;
            const char* a2 = last ? nA : cA + (size_t)(t + 2) * kstep; const char* b2 = last ? nB : cB + (size_t)(t + 2) * kstep;
            const char* a3 = a2 + kstep; const char* b3 = b2 + kstep;
            PG8_LDB(B0, 0, 0); PG8_LDB(B1, 0, 1); PG8_SCHED; PG8_LDA(At, 0, 0); PG8_STAGE_A(PG8_SA(1, 1), a1, 1);
            if (GATHER) { if (last && has_next) PG8_GATHER_OFFS(nxt); }
            PG8_WAIT_V(8); PG8_WAIT_L(0); PG8_BAR; PG8_MMA(0, 0, At, B0); PG8_MMA(0, 1, At, B1); PG8_BAR; PG8_SCHED;
            PG8_LDA(At, 0, 1); PG8_STAGE_B(PG8_SB(0, 0), b2); PG8_STAGE_B(PG8_SB(0, 1), b2 + hstep); PG8_STAGE_A(PG8_SA(0, 0), a2, 0);
            PG8_WAIT_V(8); PG8_WAIT_L(0); PG8_BAR; PG8_MMA(1, 0, At, B0); PG8_MMA(1, 1, At, B1); PG8_BAR; PG8_SCHED;
            PG8_LDB(B0, 1, 0); PG8_LDB(B1, 1, 1); PG8_SCHED; PG8_LDA(At, 1, 0); PG8_STAGE_A(PG8_SA(0, 1), a2, 1);
            PG8_WAIT_V(8); PG8_WAIT_L(0); PG8_BAR; PG8_MMA(0, 0, At, B0); PG8_MMA(0, 1, At, B1); PG8_BAR; PG8_SCHED;
            PG8_LDA(At, 1, 1); PG8_STAGE_B(PG8_SB(1, 0), b3); PG8_STAGE_B(PG8_SB(1, 1), b3 + hstep); PG8_STAGE_A(PG8_SA(1, 0), a3, 0);
            PG8_WAIT_V(8); PG8_WAIT_L(0); PG8_BAR; PG8_MMA(1, 0, At, B0); PG8_MMA(1, 1, At, B1); PG8_BAR; PG8_SCHED;
        }
        if (wr == 0) PG8_BAR;
#if TSEL >= 60 && TSEL < 70
        const unsigned long long te0_ = __builtin_amdgcn_s_memrealtime();
        if (TSEL == 61 && blockIdx.x == PBLK && wid == PWAVE) ((volatile LAS unsigned*)(lds + LDSCTL_OFF))[40 + Epi::PID] += (unsigned)(te0_ - tk0_);
#endif
        E(acc, cur, wr, wc, fr, fq);
#if TSEL >= 60 && TSEL < 70
        if (TSEL == 60 && blockIdx.x == PBLK && wid == PWAVE) ((volatile LAS unsigned*)(lds + LDSCTL_OFF))[40 + Epi::PID] += (unsigned)(__builtin_amdgcn_s_memrealtime() - te0_);
        tk0_ = __builtin_amdgcn_s_memrealtime();
#endif
        if (!has_next) break;
#pragma unroll
        for (int a = 0; a < 2; ++a)
#pragma unroll
            for (int b = 0; b < 2; ++b)
#pragma unroll
                for (int m = 0; m < 4; ++m)
#pragma unroll
                    for (int n = 0; n < 2; ++n) acc[a][b][m][n] = (f32x4){0.f, 0.f, 0.f, 0.f};
        cur = nxt; cA = nA; cB = nB; ++ui;
        if (wr == 1) PG8_BAR;
    }
    PG8_WAIT_V(0);
    PG8_BAR;
#undef PG8_SA
#undef PG8_SB
#undef PG8_STAGE_A
#undef PG8_STAGE_B
#undef PG8_LDA
#undef PG8_LDB
#undef PG8_LD8
#undef PG8_LO
#undef PG8_HI
#undef PG8_MMA
#undef PG8_WAIT_V
#undef PG8_WAIT_L
#undef PG8_BAR
#undef PG8_SCHED
#undef PG8_GATHER_OFFS
}

constexpr size_t SEC = (size_t)16 * SEQ * 128;
struct EpiProj {
    static constexpr bool PERM = true; static constexpr int PID = 0;
    bf16_t* O;
    __device__ __forceinline__ void operator()(const f32x4 (&acc)[2][2][4][2], const Unit& u, int wr, int wc, int fr, int fq) const {
        const int row0 = u.pm * BM + wr * 64 + fr;
        const int b = row0 / SEQ, t0 = row0 % SEQ;
        const float sc = (u.pn == 8 || u.pn == 9) ? QSCALE : 1.f;
#pragma unroll
        for (int bj = 0; bj < 2; ++bj) { const int c0 = u.pn * BM + bj * HALF + wc * 32 + 8 * fq, sec = c0 >> 9, cs = c0 & 511, h = cs >> 7;
            bf16_t* base; int pitch;
            if (sec == 4 || sec == 5) { base = O + (size_t)sec * SEC + ((size_t)((b * 4 + h) * 2 + ((cs >> 6) & 1)) * SEQ + t0) * 64 + (cs & 63); pitch = 64; }
            else { base = O + (size_t)sec * SEC + ((size_t)(b * 4 + h) * SEQ + t0) * 128 + (cs & 127); pitch = 128; }
#pragma unroll
            for (int ai = 0; ai < 2; ++ai)
#pragma unroll
                for (int m = 0; m < 4; ++m) { const f32x4 v0 = acc[ai][bj][m][0] * sc, v1 = acc[ai][bj][m][1] * sc;
                    u32x4 w; w.x = cvt_pk_bf16(v0[0], v0[1]); w.y = cvt_pk_bf16(v0[2], v0[3]); w.z = cvt_pk_bf16(v1[0], v1[1]); w.w = cvt_pk_bf16(v1[2], v1[3]);
                    *(u32x4*)(base + (size_t)(ai * HALF + m * 16) * pitch) = w; } }
    }
};
struct EpiOut {
    static constexpr bool PERM = true; static constexpr int PID = 1;
    const float* X; bf16_t* O;
    __device__ __forceinline__ void operator()(const f32x4 (&acc)[2][2][4][2], const Unit& u, int wr, int wc, int fr, int fq) const {
        const int row0 = u.pm * BM + wr * 64 + fr, col0 = u.pn * BM + wc * 32 + 8 * fq;
#pragma unroll
        for (int ai = 0; ai < 2; ++ai)
#pragma unroll
            for (int m = 0; m < 4; ++m) { const size_t off = (size_t)(row0 + ai * HALF + m * 16) * DM + col0;
#pragma unroll
                for (int bj = 0; bj < 2; ++bj) { const f32x4 x0 = *(const f32x4*)(X + off + bj * HALF), x1 = *(const f32x4*)(X + off + bj * HALF + 4);
                    const f32x4 v0 = x0 + acc[ai][bj][m][0], v1 = x1 + acc[ai][bj][m][1];
                    u32x4 w; w.x = cvt_pk_bf16(v0[0], v0[1]); w.y = cvt_pk_bf16(v0[2], v0[3]); w.z = cvt_pk_bf16(v1[0], v1[1]); w.w = cvt_pk_bf16(v1[2], v1[3]);
                    *(u32x4*)(O + off + bj * HALF) = w; } }
    }
};
__device__ __forceinline__ unsigned pk4_fp8(float a, float b, float c, float d) { int w = __builtin_amdgcn_cvt_pk_fp8_f32(a, b, 0, false); w = __builtin_amdgcn_cvt_pk_fp8_f32(c, d, w, true); return (unsigned)w; }
constexpr float ACT_SCALE = 4.f;
struct EpiSwiglu {
    static constexpr bool PERM = true; static constexpr int PID = 2;
    unsigned char* O; const float* bgu;
    __device__ __forceinline__ void operator()(const f32x4 (&acc)[2][2][4][2], const Unit& u, int wr, int wc, int fr, int fq) const {
        const int row0 = u.pm * BM + wr * 64 + fr, col0 = u.pn * HALF + wc * 32 + 8 * fq;
        const float* bb = bgu + (size_t)u.e * 2 * FF + col0;
        const f32x4 bg0 = *(const f32x4*)(bb), bg1 = *(const f32x4*)(bb + 4), bu0 = *(const f32x4*)(bb + FF), bu1 = *(const f32x4*)(bb + FF + 4);
#pragma unroll
        for (int ai = 0; ai < 2; ++ai)
#pragma unroll
            for (int m = 0; m < 4; ++m) { unsigned char* rowp = O + (size_t)(row0 + ai * HALF + m * 16) * FF + col0;
                float r[8];
#pragma unroll
                for (int n = 0; n < 2; ++n) { const f32x4 gv = acc[ai][0][m][n] + (n ? bg1 : bg0), uv = acc[ai][1][m][n] + (n ? bu1 : bu0);
#pragma unroll
                    for (int j = 0; j < 4; ++j) { const float g = fminf(gv[j], 7.f), uu = fminf(fmaxf(uv[j], -7.f), 7.f);
                        r[n * 4 + j] = ACT_SCALE * (uu + 1.f) * g * __builtin_amdgcn_rcpf(1.f + __builtin_amdgcn_exp2f(-1.702f * LOG2E * g)); } }
                u32x2 w; w.x = pk4_fp8(r[0], r[1], r[2], r[3]); w.y = pk4_fp8(r[4], r[5], r[6], r[7]);
                *(u32x2*)(rowp) = w; }
    }
};
constexpr float Y8_SCALE = 16.f;
struct EpiDown {
    static constexpr bool PERM = true; static constexpr int PID = 3;
    unsigned char* O; const float* bd;
    __device__ __forceinline__ void operator()(const f32x4 (&acc)[2][2][4][2], const Unit& u, int wr, int wc, int fr, int fq) const {
        const int row0 = u.pm * BM + wr * 64 + fr, col0 = u.pn * BM + wc * 32 + 8 * fq;
        const float* bb = bd + (size_t)u.e * DM + col0;
#pragma unroll
        for (int bj = 0; bj < 2; ++bj) { const f32x4 bv0 = *(const f32x4*)(bb + bj * HALF), bv1 = *(const f32x4*)(bb + bj * HALF + 4);
#pragma unroll
            for (int ai = 0; ai < 2; ++ai)
#pragma unroll
                for (int m = 0; m < 4; ++m) { unsigned char* rowp = O + (size_t)(row0 + ai * HALF + m * 16) * DM + col0 + bj * HALF;
                    const f32x4 v0 = (acc[ai][bj][m][0] + bv0) * Y8_SCALE, v1 = (acc[ai][bj][m][1] + bv1) * Y8_SCALE;
                    u32x2 w; w.x = pk4_fp8(v0[0], v0[1], v0[2], v0[3]); w.y = pk4_fp8(v1[0], v1[1], v1[2], v1[3]);
                    *(u32x2*)(rowp) = w; } }
    }
};
}

#define XB_TMO      128
#define XB_XCNT(j)  (256  + 64 * (j))
#define XB_XSUB(j)  (1280 + 64 * (j))
#define XB_XGEN(j)  (2304 + 64 * (j))
#define XB_TOP      3328
#define XB_TOPGEN   3392
#define XCD_BAR_WORDS 3456
#define XB_SPIN_CAP (1u << 22)
__device__ __forceinline__ unsigned xb_ld(unsigned* p)              { return __hip_atomic_load(p, __ATOMIC_RELAXED, __HIP_MEMORY_SCOPE_AGENT); }
__device__ __forceinline__ unsigned xb_add(unsigned* p, unsigned v) { return __hip_atomic_fetch_add(p, v, __ATOMIC_RELAXED, __HIP_MEMORY_SCOPE_AGENT); }
__device__ __forceinline__ unsigned xb_xcc_id() { return (unsigned)__builtin_amdgcn_s_getreg((3 << 11) | 20) & 0xFu; }
#define XB_SPIN(cond, bar) do { unsigned _sp = 0; while (cond) { __builtin_amdgcn_s_sleep(1); \
    if ((++_sp & 255u) == 0u) { if (xb_ld(&(bar)[XB_TMO])) break; if (_sp > XB_SPIN_CAP) { atomicAdd(&(bar)[XB_TMO], 1u); break; } } } } while (0)
struct XcdBarrier { unsigned* bar; unsigned x; volatile LAS unsigned* st; };
__device__ __forceinline__ XcdBarrier xcd_barrier_post(unsigned* bar, volatile LAS unsigned* st) {
    XcdBarrier b; b.bar = bar; b.x = xb_xcc_id(); b.st = st;
    if (threadIdx.x == 0) (void)xb_add(&bar[XB_XCNT(b.x)], 1u);
    return b;
}
__device__ __forceinline__ void xcd_barrier_complete(unsigned* bar, unsigned x, unsigned& nloc, unsigned& nx) {
    const unsigned G = gridDim.x * gridDim.y * gridDim.z;
    unsigned sum, cnt, mine, sp = 0u;
    for (;;) {
        sum = 0u; cnt = 0u; mine = 0u;
#pragma unroll
        for (unsigned j = 0; j < 16; ++j) { const unsigned c = xb_ld(&bar[XB_XCNT(j)]); sum += c; cnt += (c > 0u) ? 1u : 0u; mine = (j == x) ? c : mine; }
        if (sum == G) break;
        __builtin_amdgcn_s_sleep(1);
        if ((++sp & 255u) == 0u) { if (xb_ld(&bar[XB_TMO])) break; if (sp > XB_SPIN_CAP) { atomicAdd(&bar[XB_TMO], 1u); break; } }
    }
    nloc = mine > 0u ? mine : 1u; nx = cnt > 0u ? cnt : 1u;
}
__device__ __forceinline__ void xcd_barrier(const XcdBarrier& b) {
    asm volatile("s_waitcnt vmcnt(0)" ::: "memory");
    __syncthreads();
    if (threadIdx.x == 0) {
        unsigned* bar = b.bar;
        __builtin_amdgcn_s_waitcnt(0);
        unsigned nloc = b.st[0], nx = b.st[1];
        if (nloc == 0u) { xcd_barrier_complete(bar, b.x, nloc, nx); b.st[0] = nloc; b.st[1] = nx; }
        const unsigned old = xb_add(&bar[XB_XSUB(b.x)], 1u);
        const unsigned gen = old / nloc;
        if (old + 1u == (gen + 1u) * nloc) {
            __builtin_amdgcn_fence(__ATOMIC_RELEASE, "agent");
            asm volatile("s_waitcnt vmcnt(0)" ::: "memory");
            const unsigned og = xb_add(&bar[XB_TOP], 1u);
            const unsigned tg = og / nx;
            if (og + 1u == (tg + 1u) * nx) xb_add(&bar[XB_TOPGEN], 1u);
            else XB_SPIN(xb_ld(&bar[XB_TOPGEN]) == tg, bar);
            __builtin_amdgcn_fence(__ATOMIC_ACQUIRE, "agent");
            xb_add(&bar[XB_XGEN(b.x)], 1u);
            asm volatile("s_waitcnt vmcnt(0)" ::: "memory");
        } else {
            XB_SPIN(xb_ld(&bar[XB_XGEN(b.x)]) == gen, bar);
            __builtin_amdgcn_fence(__ATOMIC_ACQUIRE, "agent");
            asm volatile("s_waitcnt vmcnt(0)" ::: "memory");
        }
    }
    __syncthreads();
}

template <int NN, bool GU, int EB>
struct MoeOrder {
    const LAS int* UL; const LAS int* PS; int n; const char* A; const char* B;
    __device__ __forceinline__ bool next(int i, pg8::Unit& u) const {
        if (i >= n) return false;
        const int w = __builtin_amdgcn_readfirstlane(UL[i]); const int e = w & 255, rt = (w >> 8) & 255, pn = w >> 16;
        const int ps = __builtin_amdgcn_readfirstlane(PS[e]);
        u.e = e; u.pn = pn; u.pm = (ps >> 8) + rt; u.slot = i;
        if (GU) { u.a = A; u.b = B + ((size_t)e * 2 * FF + (size_t)pn * 256) * DM * EB; }
        else { u.a = A + (size_t)u.pm * 256 * FF * EB; u.b = B + ((size_t)e * DM + (size_t)pn * 256) * FF * EB; }
        return true;
    }
};
template <int NN>
__device__ __forceinline__ int moe_build_units(LAS unsigned char* lds, const unsigned* ctl, int G, int c) {
    LAS int* UL = (LAS int*)(lds + TAB_UL); LAS int* PS = (LAS int*)(lds + TAB_PS); LAS int* CN = (LAS int*)(lds + TAB_CN); LAS int* NU = (LAS int*)(lds + TAB_NU); LAS int* UC = (LAS int*)(lds + TAB_UC);
    __syncthreads();
    if (threadIdx.x == 0) {
        int a = 0, uc = 0;
        for (int e = 0; e < NE; ++e) { const int cnt = (int)__hip_atomic_load(ctl + CW_CNT + e, RLX_AGENT); CN[e] = cnt; PS[e] = a; UC[e] = uc; const int nt = (cnt + 255) >> 8; a += nt << 8; uc += nt * NN; }
        PS[NE] = a; UC[NE] = uc;
        const int nwg = uc; int n = 0;
        for (int i = 0;; ++i) { const long L = (long)i * G + c; if (L >= nwg || n >= 20) break;
            const int wgid = pg8::xcd_remap((int)L, nwg);
            int e = 0; while (UC[e + 1] <= wgid) ++e;
            const int l = wgid - UC[e], nte = (CN[e] + 255) >> 8;
            const int nig = pg8::WGM * NN, gid = l / nig, fm = gid * pg8::WGM, gsz = (nte - fm) < pg8::WGM ? (nte - fm) : pg8::WGM;
            const int rt = fm + ((l % nig) % gsz), pn = (l % nig) / gsz;
            UL[n++] = e | (rt << 8) | (pn << 16); }
        NU[0] = n;
    }
    __syncthreads();
    return __builtin_amdgcn_readfirstlane(NU[0]);
}

namespace att {
using f32x16 = __attribute__((ext_vector_type(16))) float;
using s16x4 = __attribute__((ext_vector_type(4))) short;
constexpr int NW = 8, QBLK = 32, KVBLK = 64, LDQK = 64, LDV = 128;
constexpr int SHM_V = KVBLK * 128 * 2, SHM_K = KVBLK * 64 * 2;
constexpr int NSLOT = 3, OFF_V = 0, OFF_ST = NSLOT * SHM_V, OFF_K = 132096, OFF_WS = OFF_K + NSLOT * SHM_K, OFF_BT = OFF_WS + NW * 64 * 4, ATT_LDS_END = OFF_BT + 1024;
static_assert(OFF_ST + NW * 8192 <= 131072 && ATT_LDS_END <= 163840, "attention LDS map");
constexpr float THRL = 8.f;
#define KSWZ(row, colB) ((row) * 128 + ((colB) ^ ((((row) >> 1) & 7) << 4)))
#define SBAR() __builtin_amdgcn_sched_barrier(0)
__device__ __forceinline__ int crow(int r, int hi) { return (r & 3) + 8 * (r >> 2) + 4 * hi; }
__device__ __forceinline__ unsigned cvtpk(float lo, float hi) { unsigned r; asm volatile("v_cvt_pk_bf16_f32 %0, %1, %2" : "=v"(r) : "v"(lo), "v"(hi)); return r; }

__device__ __forceinline__ void partialSM(f32x16& p0, f32x16& p1, float& m_reg, float& alpha) {
  float pmax = p0[0];
#pragma unroll
  for (int r = 1; r < 16; ++r) pmax = fmaxf(pmax, p0[r]);
#pragma unroll
  for (int r = 0; r < 16; ++r) pmax = fmaxf(pmax, p1[r]);
  { auto rr = __builtin_amdgcn_permlane32_swap(__float_as_uint(pmax), __float_as_uint(pmax), false, false);
    pmax = fmaxf(__uint_as_float(rr[0]), __uint_as_float(rr[1])); }
  float mn;
  if (__builtin_expect(__all(pmax - m_reg <= THRL), 1)) { mn = m_reg; alpha = 1.f; }
  else { mn = fmaxf(m_reg, pmax); alpha = __builtin_amdgcn_exp2f(m_reg - mn); m_reg = mn; }
#pragma unroll
  for (int r = 0; r < 16; ++r) p0[r] = p0[r] - mn;
#pragma unroll
  for (int r = 0; r < 16; ++r) p1[r] = p1[r] - mn;
#pragma unroll
  for (int r = 0; r < 16; ++r) p0[r] = __builtin_amdgcn_exp2f(p0[r]);
}
__device__ __forceinline__ void finishSM(f32x16& p0, f32x16& p1, float alpha, float& l_reg, bf16x8& pa0, bf16x8& pa1, bf16x8& pa2, bf16x8& pa3) {
#pragma unroll
  for (int r = 0; r < 16; ++r) p1[r] = __builtin_amdgcn_exp2f(p1[r]);
  float ps = 0;
#pragma unroll
  for (int r = 0; r < 16; ++r) ps += p0[r];
#pragma unroll
  for (int r = 0; r < 16; ++r) ps += p1[r];
  { auto rr = __builtin_amdgcn_permlane32_swap(__float_as_uint(ps), __float_as_uint(ps), false, false);
    ps = __uint_as_float(rr[0]) + __uint_as_float(rr[1]); }
  l_reg = l_reg * alpha + ps;
#define PK4(P, BASE, OUT) do { unsigned a0 = cvtpk(P[BASE + 0], P[BASE + 1]), a1 = cvtpk(P[BASE + 2], P[BASE + 3]);   \
    unsigned b0 = cvtpk(P[BASE + 4], P[BASE + 5]), b1 = cvtpk(P[BASE + 6], P[BASE + 7]);                              \
    auto r0 = __builtin_amdgcn_permlane32_swap(a0, b0, false, false); auto r1 = __builtin_amdgcn_permlane32_swap(a1, b1, false, false); \
    u32x4 w = {r0[0], r1[0], r0[1], r1[1]}; OUT = *reinterpret_cast<bf16x8*>(&w); } while (0)
  PK4(p0, 0, pa0); PK4(p0, 8, pa1); PK4(p1, 0, pa2); PK4(p1, 8, pa3);
#undef PK4
}
__device__ __forceinline__ void qkt(f32x16& p0, f32x16& p1, const char* Ks, const bf16x8* qr, int r32, int hi) {
  p0 = f32x16{}; p1 = f32x16{};
#pragma unroll
  for (int d0 = 0; d0 < 4; ++d0) { const int cb = (d0 * 16 + hi * 8) * 2;
    const bf16x8 b0 = *reinterpret_cast<const bf16x8*>(Ks + KSWZ(r32, cb));
    const bf16x8 b1 = *reinterpret_cast<const bf16x8*>(Ks + KSWZ(32 + r32, cb));
    p0 = __builtin_amdgcn_mfma_f32_32x32x16_bf16(b0, qr[d0], p0, 0, 0, 0);
    p1 = __builtin_amdgcn_mfma_f32_32x32x16_bf16(b1, qr[d0], p1, 0, 0, 0); }
}
__device__ __forceinline__ int v_st(int k, int c) { const int kk = (k & ~0xC) | ((k & 4) << 1) | ((k & 8) >> 1); return ((kk >> 3) * 4 + (c >> 5)) * 512 + ((kk & 7) * 32 + (c & 31)) * 2; }
__device__ __forceinline__ int v_rd_base(int lane) { return ((lane & 3) << 3) | (((lane >> 2) & 3) << 6) | (((lane >> 4) & 1) << 5) | (((lane >> 5) & 1) << 8); }
constexpr int v_rd_off(int d0, int ks, int half) { return d0 * 512 + ks * 4096 + half * 2048; }
template <int OFF> __device__ __forceinline__ s16x4 tr_read(int vb) {
  s16x4 r; asm volatile("ds_read_b64_tr_b16 %0, %1 offset:%2" : "=&v"(r) : "v"(vb), "i"(OFF) : "memory"); return r;
}
typedef short v4i16_t __attribute__((ext_vector_type(4)));
template <int OFF> __device__ __forceinline__ s16x4 tr_rd(int vb) {
  return __builtin_bit_cast(s16x4, __builtin_amdgcn_ds_read_tr16_b64_v4i16((__attribute__((address_space(3))) v4i16_t*)(unsigned)(vb + OFF)));
}
template <int D0> __device__ __forceinline__ void pv_one(f32x16& od, int vb, bf16x8 pa0, bf16x8 pa1, bf16x8 pa2, bf16x8 pa3) {
  const s16x4 l0 = tr_rd<v_rd_off(D0, 0, 0)>(vb), h0 = tr_rd<v_rd_off(D0, 0, 1)>(vb), l1 = tr_rd<v_rd_off(D0, 1, 0)>(vb), h1 = tr_rd<v_rd_off(D0, 1, 1)>(vb);
  const s16x4 l2 = tr_rd<v_rd_off(D0, 2, 0)>(vb), h2 = tr_rd<v_rd_off(D0, 2, 1)>(vb), l3 = tr_rd<v_rd_off(D0, 3, 0)>(vb), h3 = tr_rd<v_rd_off(D0, 3, 1)>(vb);
#define PK(L, H) (bf16x8){L[0], L[1], L[2], L[3], H[0], H[1], H[2], H[3]}
  od = __builtin_amdgcn_mfma_f32_32x32x16_bf16(pa0, PK(l0, h0), od, 0, 0, 0);
  od = __builtin_amdgcn_mfma_f32_32x32x16_bf16(pa1, PK(l1, h1), od, 0, 0, 0);
  od = __builtin_amdgcn_mfma_f32_32x32x16_bf16(pa2, PK(l2, h2), od, 0, 0, 0);
  od = __builtin_amdgcn_mfma_f32_32x32x16_bf16(pa3, PK(l3, h3), od, 0, 0, 0);
#undef PK
}
#define PV_RD(D0, L0, H0, L1, H1, L2, H2, L3, H3) do { L0 = tr_rd<v_rd_off(D0, 0, 0)>(vb); H0 = tr_rd<v_rd_off(D0, 0, 1)>(vb); L1 = tr_rd<v_rd_off(D0, 1, 0)>(vb); H1 = tr_rd<v_rd_off(D0, 1, 1)>(vb); \
    L2 = tr_rd<v_rd_off(D0, 2, 0)>(vb); H2 = tr_rd<v_rd_off(D0, 2, 1)>(vb); L3 = tr_rd<v_rd_off(D0, 3, 0)>(vb); H3 = tr_rd<v_rd_off(D0, 3, 1)>(vb); } while (0)
#define PKV(L, H) (bf16x8){L[0], L[1], L[2], L[3], H[0], H[1], H[2], H[3]}
#define PV_MM(OD, L0, H0, L1, H1, L2, H2, L3, H3) do { OD = __builtin_amdgcn_mfma_f32_32x32x16_bf16(pa0, PKV(L0, H0), OD, 0, 0, 0); OD = __builtin_amdgcn_mfma_f32_32x32x16_bf16(pa1, PKV(L1, H1), OD, 0, 0, 0); \
    OD = __builtin_amdgcn_mfma_f32_32x32x16_bf16(pa2, PKV(L2, H2), OD, 0, 0, 0); OD = __builtin_amdgcn_mfma_f32_32x32x16_bf16(pa3, PKV(L3, H3), OD, 0, 0, 0); } while (0)
__device__ __forceinline__ void pv_d0(f32x16* o, int vb, bf16x8 pa0, bf16x8 pa1, bf16x8 pa2, bf16x8 pa3) {
  s16x4 a0, a1, a2, a3, a4, a5, a6, a7, b0, b1, b2, b3, b4, b5, b6, b7;
  PV_RD(0, a0, a1, a2, a3, a4, a5, a6, a7); PV_RD(1, b0, b1, b2, b3, b4, b5, b6, b7); SBAR();
  PV_MM(o[0], a0, a1, a2, a3, a4, a5, a6, a7); SBAR(); PV_RD(2, a0, a1, a2, a3, a4, a5, a6, a7); SBAR();
  PV_MM(o[1], b0, b1, b2, b3, b4, b5, b6, b7); SBAR(); PV_RD(3, b0, b1, b2, b3, b4, b5, b6, b7); SBAR();
  PV_MM(o[2], a0, a1, a2, a3, a4, a5, a6, a7); SBAR();
  PV_MM(o[3], b0, b1, b2, b3, b4, b5, b6, b7);
}
#undef PV_RD
#undef PV_MM
#undef PKV
__device__ __forceinline__ void bias_mask(f32x16& p0, f32x16& p1, int j, int cw, const float* bt, int qoff, int r32, int hi) {
  if (j > cw) {
#pragma unroll
    for (int r = 0; r < 16; ++r) { p0[r] = -INFINITY; p1[r] = -INFINITY; }
  } else if (j >= cw - 2) {
    const float* b = bt + (64 * (j - cw) + 192 - qoff - r32 + 4 * hi);
#pragma unroll
    for (int r = 0; r < 16; ++r) { p0[r] += b[(r & 3) + 8 * (r >> 2)]; p1[r] += b[32 + (r & 3) + 8 * (r >> 2)]; }
  }
}

__device__ __forceinline__ void glds16(const void* gsrc, unsigned lds_dst) { unsigned keep;
  asm volatile("s_mov_b32 %0, m0\n\ts_mov_b32 m0, %2\n\ts_nop 0\n\tglobal_load_lds_dwordx4 %1, off\n\ts_mov_b32 m0, %0" : "=&s"(keep) : "v"(gsrc), "s"(lds_dst) : "memory"); }
__device__ __forceinline__ void attn_unit(const Params& p, int b, int h, int m, int qb, float lam, char* lds, unsigned& g_tacc) {
  const bf16_t* PR = (const bf16_t*)(p.ws + WS_PROJ);
  int tid_ = threadIdx.x; asm volatile("" : "+v"(tid_));
  const int tid = tid_, wid = __builtin_amdgcn_readfirstlane(tid >> 6), lane = tid & 63, r32 = lane & 31, hi = lane >> 5;
  char* V_lds = lds + OFF_V; char* K_lds = lds + OFF_K;
  const unsigned ldsb = (unsigned)(uintptr_t)lds;
  float* ws = (float*)(lds + OFF_WS) + wid * 64; float* li_l = ws; float* al_l = ws + 32; float* bt = (float*)(lds + OFF_BT);
  bf16_t* stash = (bf16_t*)(lds + OFF_ST + wid * 8192);
  __syncthreads();
  if (m == 0 && tid < 256) bt[tid] = (p.rel_bias[t5_bucket(tid - 192) * 4 + h] - p.rel_bias[15 * 4 + h]) * LOG2E;
  const bf16_t* Qb = PR + 4 * pg8::SEC + ((size_t)((b * 4 + h) * 2 + m) * SEQ + qb * 256) * LDQK;
  const bf16_t* Kh = PR + 5 * pg8::SEC + (size_t)((b * 4 + h) * 2 + m) * SEQ * LDQK;
  const bf16_t* Vh = PR + 6 * pg8::SEC + (size_t)(b * 4 + h) * SEQ * LDV;
  const int cw = 4 * qb + (wid >> 1), qoff = 32 * (wid & 1);
  float l_reg = 0; f32x16 o[4] = {}; bf16x8 qr[4];
  const int krow = wid * 8 + (lane >> 3), kch = (lane & 7) ^ ((krow >> 1) & 7);
  const bf16_t* ksrc = Kh + (size_t)krow * LDQK + kch * 8;
  const bf16_t* vsrc0; const bf16_t* vsrc1;
  { const int sub0 = (wid * 2) * 2 + (lane >> 5), kk0 = (sub0 >> 2) * 8 + ((lane & 31) >> 2), k0_ = (kk0 & ~0xC) | ((kk0 & 4) << 1) | ((kk0 & 8) >> 1);
    vsrc0 = Vh + (size_t)k0_ * LDV + (sub0 & 3) * 32 + (lane & 3) * 8;
    const int sub1 = (wid * 2 + 1) * 2 + (lane >> 5), kk1 = (sub1 >> 2) * 8 + ((lane & 31) >> 2), k1_ = (kk1 & ~0xC) | ((kk1 & 4) << 1) | ((kk1 & 8) >> 1);
    vsrc1 = Vh + (size_t)k1_ * LDV + (sub1 & 3) * 32 + (lane & 3) * 8; }
#define DMA_K(tile, slot) glds16(ksrc + (size_t)(tile) * (KVBLK * LDQK), (unsigned)__builtin_amdgcn_readfirstlane((int)(ldsb + OFF_K + (slot) * SHM_K + wid * 1024)))
#define DMA_V(tile, slot) do { glds16(vsrc0 + (size_t)(tile) * (KVBLK * LDV), (unsigned)__builtin_amdgcn_readfirstlane((int)(ldsb + OFF_V + (slot) * SHM_V + wid * 2048))); \
    glds16(vsrc1 + (size_t)(tile) * (KVBLK * LDV), (unsigned)__builtin_amdgcn_readfirstlane((int)(ldsb + OFF_V + (slot) * SHM_V + wid * 2048 + 1024))); } while (0)
#define WAIT_BAR(N) asm volatile("s_waitcnt vmcnt(" #N ") lgkmcnt(0)\n\ts_barrier" ::: "memory")
  DMA_K(0, 0); DMA_V(0, 0); DMA_K(1, 1);
  const bf16_t* Qw = Qb + (size_t)(wid * QBLK + r32) * LDQK + hi * 8;
#pragma unroll
  for (int d0 = 0; d0 < 4; ++d0) qr[d0] = *reinterpret_cast<const bf16x8*>(Qw + d0 * 16);
  const int vb0 = (int)(uintptr_t)V_lds + v_rd_base(lane);
#define RESC(a) do { if (__any((a) < 1.f)) { if (hi == 0) al_l[r32] = (a); asm volatile("s_waitcnt lgkmcnt(0)" ::: "memory"); \
    _Pragma("unroll") for (int d = 0; d < 4; ++d) _Pragma("unroll") for (int r = 0; r < 16; ++r) o[d][r] *= al_l[crow(r, hi)]; } } while (0)
  f32x16 pA0, pA1, pB0, pB1; u32x4 pw0, pw1, pw2, pw3; const int NT = 4 * qb + 4;
  float mhat = 0.f; f32x16 negm = f32x16{}; asm volatile("" : "+v"(negm));
  bool resc = false;
  WAIT_BAR(0);
  DMA_K(2, 2); DMA_V(1, 1);
#define PIN(x) asm volatile("" : "+v"(x))
#define MX3(a, b, c) __builtin_fmaxf(__builtin_fmaxf((a), (b)), (c))
#define ROWMAX(C0, C1, rm) do { float a_ = MX3(C0[0], C0[1], C1[0]), b_ = MX3(C0[2], C0[3], C1[1]); a_ = MX3(a_, C1[2], C1[3]); \
    _Pragma("unroll") for (int r = 4; r < 16; r += 4) { a_ = MX3(a_, C0[r], C0[r + 1]); b_ = MX3(b_, C0[r + 2], C0[r + 3]); a_ = MX3(a_, C1[r], C1[r + 1]); b_ = MX3(b_, C1[r + 2], C1[r + 3]); } \
    rm = __builtin_fmaxf(a_, b_); { auto rr_ = __builtin_amdgcn_permlane32_swap(__float_as_uint(rm), __float_as_uint(rm), false, false); rm = __builtin_fmaxf(__uint_as_float(rr_[0]), __uint_as_float(rr_[1])); } } while (0)
#define RESCALE(C0, C1, dl) do { mhat += (dl); \
    _Pragma("unroll") for (int r = 0; r < 16; ++r) { C0[r] -= (dl); C1[r] -= (dl); } \
    _Pragma("unroll") for (int r = 0; r < 16; ++r) negm[r] = -mhat; PIN(negm); } while (0)
  { const char* Ks = K_lds;
#pragma unroll
    for (int d0 = 0; d0 < 4; ++d0) { const int cb = (d0 * 16 + hi * 8) * 2;
      const bf16x8 b0 = *reinterpret_cast<const bf16x8*>(Ks + KSWZ(r32, cb)), b1 = *reinterpret_cast<const bf16x8*>(Ks + KSWZ(32 + r32, cb));
      if (d0 == 0) { pA0 = __builtin_amdgcn_mfma_f32_32x32x16_bf16(b0, qr[0], negm, 0, 0, 0); pA1 = __builtin_amdgcn_mfma_f32_32x32x16_bf16(b1, qr[0], negm, 0, 0, 0); }
      else { pA0 = __builtin_amdgcn_mfma_f32_32x32x16_bf16(b0, qr[d0], pA0, 0, 0, 0); pA1 = __builtin_amdgcn_mfma_f32_32x32x16_bf16(b1, qr[d0], pA1, 0, 0, 0); } }
    bias_mask(pA0, pA1, 0, cw, bt, qoff, r32, hi);
    float rm; ROWMAX(pA0, pA1, rm); RESCALE(pA0, pA1, rm);
#pragma unroll
    for (int r = 0; r < 16; ++r) { pA0[r] = __builtin_amdgcn_exp2f(pA0[r]); pA1[r] = __builtin_amdgcn_exp2f(pA1[r]); } }
  int sk = 1, sv = 0;
  const bool lead = wid < 4;
#if TSEL >= 20 && TSEL < 30
  unsigned long long tq_;
#define TB() (tq_ = __builtin_amdgcn_s_memrealtime())
#define TE(k) do { if ((k) == TSEL - 20 && blockIdx.x == 0 && wid == PWAVE) g_tacc += (unsigned)(__builtin_amdgcn_s_memrealtime() - tq_); } while (0)
#else
#define TB() do {} while (0)
#define TE(k) do {} while (0)
#endif
#define WB_A(j) do { if ((j) + 2 >= NT) WAIT_BAR(0); else if (lead) WAIT_BAR(5); else WAIT_BAR(3); } while (0)
#define WB_B(j) do { if ((j) + 2 >= NT) WAIT_BAR(0); else if (lead) WAIT_BAR(4); else WAIT_BAR(3); } while (0)
#define KF(i) (*reinterpret_cast<const bf16x8*>(Kt_ + KSWZ(((i) & 1) * 32 + r32, ((((i) >> 1) * 16 + hi * 8) * 2))))
#define CVT(P, B) cvtpk(P[B], P[(B) + 1])
#define GAPA(MF, A0, A1, A2, A3, P, BA, BB, RO) do { MF; sacc += A0; sacb += A1; sacc2 += A2; sacd += A3; PIN(sacc); PIN(sacb); PIN(sacc2); PIN(sacd); \
    { const unsigned ca_ = CVT(P, BA), cb_ = CVT(P, BB); auto rr_ = __builtin_amdgcn_permlane32_swap(ca_, cb_, false, false); RO##l = rr_[0]; RO##h = rr_[1]; } SBAR(); } while (0)
#define HALF_A(j, C0, C1, P0, P1, GQ) do { TB(); WB_A(j); TE(0); TB(); \
    { const int sp = (sk == 0) ? 2 : sk - 1; if ((j) + 2 < NT) DMA_K((j) + 2, sp); } \
    const char* Kt_ = K_lds + sk * SHM_K; unsigned r0l, r0h, r1l, r1h; float sacc = P0[0], sacb = P0[1], sacc2 = 0.f, sacd = 0.f; SBAR(); \
    if (GQ) { const bf16x8 kf0 = KF(0), kf1 = KF(1), kf2 = KF(2), kf3 = KF(3), kf4 = KF(4), kf5 = KF(5), kf6 = KF(6), kf7 = KF(7); SBAR(); \
      GAPA(C0 = __builtin_amdgcn_mfma_f32_32x32x16_bf16(kf0, qr[0], negm, 0, 0, 0), P0[2], P0[3], P0[4], P0[5], P0, 0, 4, r0); \
      GAPA(C1 = __builtin_amdgcn_mfma_f32_32x32x16_bf16(kf1, qr[0], negm, 0, 0, 0), P0[6], P0[7], P0[8], P0[9], P0, 2, 6, r1); \
      pw0 = (u32x4){r0l, r1l, r0h, r1h}; \
      GAPA(C0 = __builtin_amdgcn_mfma_f32_32x32x16_bf16(kf2, qr[1], C0, 0, 0, 0), P0[10], P0[11], P0[12], P0[13], P0, 8, 12, r0); \
      GAPA(C1 = __builtin_amdgcn_mfma_f32_32x32x16_bf16(kf3, qr[1], C1, 0, 0, 0), P0[14], P0[15], P1[0], P1[1], P0, 10, 14, r1); \
      pw1 = (u32x4){r0l, r1l, r0h, r1h}; \
      GAPA(C0 = __builtin_amdgcn_mfma_f32_32x32x16_bf16(kf4, qr[2], C0, 0, 0, 0), P1[2], P1[3], P1[4], P1[5], P1, 0, 4, r0); \
      GAPA(C1 = __builtin_amdgcn_mfma_f32_32x32x16_bf16(kf5, qr[2], C1, 0, 0, 0), P1[6], P1[7], P1[8], P1[9], P1, 2, 6, r1); \
      pw2 = (u32x4){r0l, r1l, r0h, r1h}; \
      GAPA(C0 = __builtin_amdgcn_mfma_f32_32x32x16_bf16(kf6, qr[3], C0, 0, 0, 0), P1[10], P1[11], P1[12], P1[13], P1, 8, 12, r0); \
      GAPA(C1 = __builtin_amdgcn_mfma_f32_32x32x16_bf16(kf7, qr[3], C1, 0, 0, 0), P1[14], P1[15], 0.f, 0.f, P1, 10, 14, r1); \
      pw3 = (u32x4){r0l, r1l, r0h, r1h}; \
    } else { \
      GAPA((void)0, P0[2], P0[3], P0[4], P0[5], P0, 0, 4, r0); GAPA((void)0, P0[6], P0[7], P0[8], P0[9], P0, 2, 6, r1); pw0 = (u32x4){r0l, r1l, r0h, r1h}; \
      GAPA((void)0, P0[10], P0[11], P0[12], P0[13], P0, 8, 12, r0); GAPA((void)0, P0[14], P0[15], P1[0], P1[1], P0, 10, 14, r1); pw1 = (u32x4){r0l, r1l, r0h, r1h}; \
      GAPA((void)0, P1[2], P1[3], P1[4], P1[5], P1, 0, 4, r0); GAPA((void)0, P1[6], P1[7], P1[8], P1[9], P1, 2, 6, r1); pw2 = (u32x4){r0l, r1l, r0h, r1h}; \
      GAPA((void)0, P1[10], P1[11], P1[12], P1[13], P1, 8, 12, r0); GAPA((void)0, P1[14], P1[15], 0.f, 0.f, P1, 10, 14, r1); pw3 = (u32x4){r0l, r1l, r0h, r1h}; \
    } \
    l_reg += (sacc + sacb) + (sacc2 + sacd); resc = false; \
    if (GQ) { bias_mask(C0, C1, (j), cw, bt, qoff, r32, hi); float rm; ROWMAX(C0, C1, rm); \
      if (__builtin_expect(__any(rm > THRL), 0)) { const float dl = __builtin_fmaxf(rm, 0.f); RESCALE(C0, C1, dl); const float f = __builtin_amdgcn_exp2f(-dl); l_reg *= f; if (hi == 0) al_l[r32] = f; resc = true; } } \
    TE(1); } while (0)
#define PAF(k) __builtin_bit_cast(bf16x8, pw##k)
#define VFR(S, i) (bf16x8){S##l##i[0], S##l##i[1], S##l##i[2], S##l##i[3], S##h##i[0], S##h##i[1], S##h##i[2], S##h##i[3]}
#define VRD(S, D0, i) do { S##l##i = tr_rd<v_rd_off(D0, i, 0)>(vb_); S##h##i = tr_rd<v_rd_off(D0, i, 1)>(vb_); } while (0)
#define EX2(C, B) do { C[B] = __builtin_amdgcn_exp2f(C[B]); C[(B) + 1] = __builtin_amdgcn_exp2f(C[(B) + 1]); PIN(C); } while (0)
#define GAPB(OD, K, FR, EXS, RD) do { OD = __builtin_amdgcn_mfma_f32_32x32x16_bf16(PAF(K), FR, OD, 0, 0, 0); EXS; RD; SBAR(); } while (0)
#define HALF_B(j, C0, C1, GP) do { TB(); WB_B(j); TE(0); TB(); \
    { const int sn = (sk == 2) ? 0 : sk + 1; if ((j) + 1 < NT) DMA_V((j) + 1, sn); } \
    const int vb_ = vb0 + sv * SHM_V; s16x4 Fl0, Fh0, Fl1, Fh1, Fl2, Fh2, Fl3, Fh3, Gl0, Gh0, Gl1, Gh1, Gl2, Gh2, Gl3, Gh3; \
    VRD(F, 0, 0); VRD(F, 0, 1); VRD(F, 0, 2); VRD(F, 0, 3); SBAR(); \
    SBAR(); \
    GAPB(o[0], 0, VFR(F, 0), if (GP) EX2(C0, 0), VRD(G, 1, 0)); GAPB(o[0], 1, VFR(F, 1), if (GP) EX2(C0, 2), VRD(G, 1, 1)); \
    GAPB(o[0], 2, VFR(F, 2), if (GP) EX2(C0, 4), VRD(G, 1, 2)); GAPB(o[0], 3, VFR(F, 3), if (GP) EX2(C0, 6), VRD(G, 1, 3)); \
    GAPB(o[1], 0, VFR(G, 0), if (GP) EX2(C0, 8), VRD(F, 2, 0)); GAPB(o[1], 1, VFR(G, 1), if (GP) EX2(C0, 10), VRD(F, 2, 1)); \
    GAPB(o[1], 2, VFR(G, 2), if (GP) EX2(C0, 12), VRD(F, 2, 2)); GAPB(o[1], 3, VFR(G, 3), if (GP) EX2(C0, 14), VRD(F, 2, 3)); \
    GAPB(o[2], 0, VFR(F, 0), if (GP) EX2(C1, 0), VRD(G, 3, 0)); GAPB(o[2], 1, VFR(F, 1), if (GP) EX2(C1, 2), VRD(G, 3, 1)); \
    GAPB(o[2], 2, VFR(F, 2), if (GP) EX2(C1, 4), VRD(G, 3, 2)); GAPB(o[2], 3, VFR(F, 3), if (GP) EX2(C1, 6), VRD(G, 3, 3)); \
    GAPB(o[3], 0, VFR(G, 0), if (GP) EX2(C1, 8), (void)0); GAPB(o[3], 1, VFR(G, 1), if (GP) EX2(C1, 10), (void)0); \
    GAPB(o[3], 2, VFR(G, 2), if (GP) EX2(C1, 12), (void)0); GAPB(o[3], 3, VFR(G, 3), if (GP) EX2(C1, 14), (void)0); \
    if (resc) { asm volatile("s_waitcnt lgkmcnt(0)" ::: "memory"); \
      _Pragma("unroll") for (int d = 0; d < 4; ++d) _Pragma("unroll") for (int r = 0; r < 16; ++r) o[d][r] *= al_l[crow(r, hi)]; } \
    TE(2); sv = sk; sk = (sk == 2) ? 0 : sk + 1; } while (0)
  if (!lead) { asm volatile("s_barrier" ::: "memory"); __builtin_amdgcn_s_setprio(1); }
  for (int j = 1; j + 1 < NT; j += 2) {
    HALF_A(j, pB0, pB1, pA0, pA1, true); HALF_B(j, pB0, pB1, true);
    HALF_A(j + 1, pA0, pA1, pB0, pB1, true); HALF_B(j + 1, pA0, pA1, true);
  }
  HALF_A(NT - 1, pB0, pB1, pA0, pA1, true); HALF_B(NT - 1, pB0, pB1, true);
  HALF_A(NT, pA0, pA1, pB0, pB1, false); HALF_B(NT, pA0, pA1, false);
  if (lead) asm volatile("s_waitcnt lgkmcnt(0)\n\ts_barrier" ::: "memory");
  else __builtin_amdgcn_s_setprio(0);
  { auto rr_ = __builtin_amdgcn_permlane32_swap(__float_as_uint(l_reg), __float_as_uint(l_reg), false, false); l_reg = __uint_as_float(rr_[0]) + __uint_as_float(rr_[1]); }
#undef HALF_A
#undef HALF_B
#undef GAPA
#undef GAPB
#undef WB_A
#undef WB_B
#undef KF
#undef CVT
#undef PAF
#undef VFR
#undef VRD
#undef EX2
#undef PIN
#undef MX3
#undef ROWMAX
#undef RESCALE
#undef DMA_K
#undef DMA_V
#undef WAIT_BAR
  if (hi == 0) li_l[r32] = l_reg; asm volatile("s_waitcnt lgkmcnt(0)" ::: "memory");
  float rli[16];
#pragma unroll
  for (int r = 0; r < 16; ++r) rli[r] = __builtin_amdgcn_rcpf(li_l[crow(r, hi)]);
  int r32e = r32, hie = hi, lanee = lane; asm volatile("" : "+v"(r32e), "+v"(hie), "+v"(lanee));
  bf16_t* st = stash + r32e;
  if (m == 0) {
#pragma unroll
    for (int r = 0; r < 16; ++r) { const int orow = crow(r, hie);
#pragma unroll
      for (int d0 = 0; d0 < 4; ++d0) st[orow * 128 + d0 * 32] = (bf16_t)f2bf(o[d0][r] * rli[r]); }
  } else {
    float gv[4];
#pragma unroll
    for (int d0 = 0; d0 < 4; ++d0) gv[d0] = p.diff_norm_g[d0 * 32 + r32e] * 0.8f;
#pragma unroll
    for (int r = 0; r < 16; ++r) { const int orow = crow(r, hie); float s = 0.f; float av[4];
#pragma unroll
      for (int d0 = 0; d0 < 4; ++d0) { av[d0] = bf2f(st[orow * 128 + d0 * 32]) - lam * (o[d0][r] * rli[r]); s += av[d0] * av[d0]; }
#pragma unroll
      for (int of = 1; of < 32; of <<= 1) s += __shfl_xor(s, of);
      const float rs = rsqrtf(s * (1.f / 128.f) + EPS);
#pragma unroll
      for (int d0 = 0; d0 < 4; ++d0) st[orow * 128 + d0 * 32] = (bf16_t)f2bf(av[d0] * rs * gv[d0]); }
    asm volatile("s_waitcnt lgkmcnt(0)" ::: "memory");
    bf16_t* Mw = (bf16_t*)(p.ws + WS_MIX) + (size_t)(b * SEQ + qb * 256 + wid * QBLK + (lanee >> 4)) * DM + 512 + h * 128 + (lanee & 15) * 8;
    const bf16_t* sr2 = stash + (lanee >> 4) * 128 + (lanee & 15) * 8;
#pragma unroll
    for (int i = 0; i < 8; ++i) *(u32x4*)(Mw + (size_t)(i * 4) * DM) = *(const u32x4*)(sr2 + i * 4 * 128);
  }
#undef RESC
}
#undef SBAR
#undef KSWZ
}

namespace ml {
using att::f32x16; using att::s16x4; using att::crow; using att::v_st; using att::v_rd_base; using att::v_rd_off; using att::tr_read;
constexpr int ML_Q = 0, ML_K = 16384, ML_V = 32768, ML_KW = 49152, ML_W = 49152, ML_H = 65536, ML_G = 98304, ML_CW = 100352;
constexpr size_t MS_GS = WS_XN + 48 * MiB;
constexpr float KSCALE = 0.08838834764831845f;
#define QSWZ(row, colB) ((row) * 256 + ((colB) ^ (((row) & 7) << 4)))
#define WSWZ(row, colB) ((row) * 128 + ((colB) ^ ((((row) >> 1) & 7) << 4)))
#define PKF(L, H) (bf16x8){L[0], L[1], L[2], L[3], H[0], H[1], H[2], H[3]}
__device__ __forceinline__ float wave_incl_scan_add(float v, int lane) {
#pragma unroll
  for (int o = 1; o < 64; o <<= 1) { const float t = __shfl_up(v, o); if (lane >= o) v += t; }
  return v;
}
__device__ __forceinline__ float wave_incl_scan_max(float v, int lane) {
#pragma unroll
  for (int o = 1; o < 64; o <<= 1) { const float t = __shfl_up(v, o); if (lane >= o) v = fmaxf(v, t); }
  return v;
}
__device__ __forceinline__ float wave_max(float v) {
#pragma unroll
  for (int o = 1; o < 64; o <<= 1) v = fmaxf(v, __shfl_xor(v, o));
  return v;
}
struct Raw16 { u32x4 r[4][2]; };
__device__ __forceinline__ void raw16_load(const Params& p, Raw16& R, int b, int c, int s, int sec, int h, int d0) {
  const bf16_t* PR = (const bf16_t*)(p.ws + WS_PROJ) + (size_t)sec * pg8::SEC + (size_t)(b * 4 + h) * SEQ * 128;
  const int tl = c * 64 + s;
#pragma unroll
  for (int j = 0; j < 4; ++j) { const int tt = tl - 3 + j;
    if (tt >= 0) { const bf16_t* rp = PR + (size_t)tt * 128 + d0; R.r[j][0] = *(const u32x4*)rp; R.r[j][1] = *(const u32x4*)(rp + 8); }
    else { R.r[j][0] = (u32x4){0u, 0u, 0u, 0u}; R.r[j][1] = (u32x4){0u, 0u, 0u, 0u}; } }
}
__device__ __forceinline__ void conv16_compute(const float* cw, const float* cb, float (&y)[16], const Raw16& R, int cch, int d0) {
#pragma unroll
  for (int q = 0; q < 4; ++q) { const f32x4 bb = *(const f32x4*)(cb + cch + d0 + 4 * q); y[4 * q] = bb.x; y[4 * q + 1] = bb.y; y[4 * q + 2] = bb.z; y[4 * q + 3] = bb.w; }
#pragma unroll
  for (int j = 0; j < 4; ++j) { const unsigned rw[8] = {R.r[j][0].x, R.r[j][0].y, R.r[j][0].z, R.r[j][0].w, R.r[j][1].x, R.r[j][1].y, R.r[j][1].z, R.r[j][1].w};
#pragma unroll
    for (int q = 0; q < 4; ++q) { const f32x4 w = *(const f32x4*)(cw + j * 1024 + cch + d0 + 4 * q);
      y[4 * q] += w.x * __uint_as_float(rw[2 * q] << 16); y[4 * q + 1] += w.y * __uint_as_float(rw[2 * q] & 0xffff0000u);
      y[4 * q + 2] += w.z * __uint_as_float(rw[2 * q + 1] << 16); y[4 * q + 3] += w.w * __uint_as_float(rw[2 * q + 1] & 0xffff0000u); } }
#pragma unroll
  for (int i = 0; i < 16; ++i) y[i] = y[i] * __builtin_amdgcn_rcpf(1.f + __builtin_amdgcn_exp2f(-LOG2E * y[i]));
}
__device__ __forceinline__ void conv16(const Params& p, float (&y)[16], int b, int c, int s, int sec, int h, int cch, int d0) {
  Raw16 R; raw16_load(p, R, b, c, s, sec, h, d0); conv16_compute(p.conv_w, p.conv_b, y, R, cch, d0);
}
__device__ __forceinline__ u32x4 pack8(const float* y) { u32x4 w; w.x = pg8::cvt_pk_bf16(y[0], y[1]); w.y = pg8::cvt_pk_bf16(y[2], y[3]); w.z = pg8::cvt_pk_bf16(y[4], y[5]); w.w = pg8::cvt_pk_bf16(y[6], y[7]); return w; }

__device__ __forceinline__ void conv_weights_to_lds(const Params& p, char* lds) {
  float* cwl = (float*)(lds + ML_CW);
  for (int i = threadIdx.x; i < 5120; i += NTHR) cwl[i] = (i < 4096) ? p.conv_w[i] : p.conv_b[i - 4096];
  __syncthreads();
}
#define LBAR() asm volatile("s_waitcnt lgkmcnt(0)\n\ts_barrier" ::: "memory")
struct MaRaw { Raw16 k; u32x4 v0, v1; float li, lf; };
__device__ __forceinline__ void ma_load(const Params& p, MaRaw& R, int item, int tid) {
  const int bh = item / NCH, c = item % NCH, b = bh >> 2, h = bh & 3, s = tid >> 3, d0 = (tid & 7) * 16, lane = tid & 63;
  const bf16_t* PR = (const bf16_t*)(p.ws + WS_PROJ); const float* gates = (const float*)(p.ws + WS_GATES);
  raw16_load(p, R.k, b, c, s, 1, h, d0);
  const bf16_t* vp = PR + 2 * pg8::SEC + ((size_t)(b * 4 + h) * SEQ + c * 64 + s) * 128 + d0; R.v0 = *(const u32x4*)vp; R.v1 = *(const u32x4*)(vp + 8);
  const size_t gt = (size_t)b * SEQ + c * 64 + lane; R.li = gates[gt * 8 + h]; R.lf = gates[gt * 8 + 4 + h];
}
__device__ __forceinline__ void mlstm_a_phase(const Params& p, int vcu, int G, char* lds) {
  bf16_t* MU = (bf16_t*)(p.ws + WS_MU); float* NU = (float*)(p.ws + MS_NU); float* msc = (float*)(p.ws + MS_MSC); f32x4* GS = (f32x4*)(p.ws + MS_GS);
  const float* cwl = (const float*)(lds + ML_CW); const float* cbl = cwl + 4096;
  conv_weights_to_lds(p, lds);
  MaRaw P;
  if (vcu < 16 * NCH) ma_load(p, P, vcu, threadIdx.x);
  for (int item = vcu; item < 16 * NCH; item += G) {
    int tid_ = threadIdx.x; asm volatile("" : "+v"(tid_));
    const int tid = tid_, wid = __builtin_amdgcn_readfirstlane(tid >> 6), lane = tid & 63, r32 = lane & 31, hi = lane >> 5;
    const int bh = item / NCH, c = item % NCH, b = bh >> 2, h = bh & 3;
    float wrow;
    { const float li = P.li, lf = log_sigmoid(P.lf);
      const float bc = wave_incl_scan_add(lf, lane); const float blast = __shfl(bc, 63); const float g = blast - bc + li; const float gmax = wave_max(g);
      const float wl = __expf(g - gmax); wrow = __shfl(wl, 8 * wid + (lane >> 3));
      if (wid == 0) { const float a = li - bc; const float pm = wave_incl_scan_max(a, lane);
        GS[((size_t)b * SEQ + c * 64 + lane) * 4 + h] = (f32x4){bc, a, pm, 0.f}; if (lane == 0) { msc[item] = blast; msc[2048 + item] = gmax; } } }
    LBAR();
    { const int s = tid >> 3, d0 = (tid & 7) * 16; float y[16];
      conv16_compute(cwl, cbl, y, P.k, 512 + h * 128, d0);
      const float w = wrow * KSCALE;
#pragma unroll
      for (int i = 0; i < 16; ++i) y[i] *= w;
      *(u32x4*)(lds + ML_KW + v_st(s, d0)) = pack8(y); *(u32x4*)(lds + ML_KW + v_st(s, d0 + 8)) = pack8(y + 8);
      *(u32x4*)(lds + ML_V + v_st(s, d0)) = P.v0; *(u32x4*)(lds + ML_V + v_st(s, d0 + 8)) = P.v1; }
    LBAR();
    if (item + G < 16 * NCH) ma_load(p, P, item + G, tid);
    const int ei = wid >> 1, dj0 = 2 * (wid & 1);
    const int vbV = (int)(uintptr_t)(lds + ML_V) + v_rd_base(lane) + ei * 512, vbK = (int)(uintptr_t)(lds + ML_KW) + v_rd_base(lane) + dj0 * 512;
    f32x16 acc0 = {}, acc1 = {}, accn0 = {}, accn1 = {};
    const bf16x8 ones = {0x3F80, 0x3F80, 0x3F80, 0x3F80, 0x3F80, 0x3F80, 0x3F80, 0x3F80};
#define MLA_STEP(KS) do { const s16x4 al = tr_read<v_rd_off(0, KS, 0)>(vbV), ah = tr_read<v_rd_off(0, KS, 1)>(vbV); \
      const s16x4 b0l = tr_read<v_rd_off(0, KS, 0)>(vbK), b0h = tr_read<v_rd_off(0, KS, 1)>(vbK), b1l = tr_read<v_rd_off(1, KS, 0)>(vbK), b1h = tr_read<v_rd_off(1, KS, 1)>(vbK); \
      asm volatile("s_waitcnt lgkmcnt(0)" ::: "memory"); __builtin_amdgcn_sched_barrier(0); \
      acc0 = __builtin_amdgcn_mfma_f32_32x32x16_bf16(PKF(al, ah), PKF(b0l, b0h), acc0, 0, 0, 0); acc1 = __builtin_amdgcn_mfma_f32_32x32x16_bf16(PKF(al, ah), PKF(b1l, b1h), acc1, 0, 0, 0); \
      if (ei == 0) { accn0 = __builtin_amdgcn_mfma_f32_32x32x16_bf16(ones, PKF(b0l, b0h), accn0, 0, 0, 0); accn1 = __builtin_amdgcn_mfma_f32_32x32x16_bf16(ones, PKF(b1l, b1h), accn1, 0, 0, 0); } } while (0)
    MLA_STEP(0); MLA_STEP(1); MLA_STEP(2); MLA_STEP(3);
#undef MLA_STEP
    bf16_t* uo = MU + (size_t)item * 16384;
#pragma unroll
    for (int r = 0; r < 16; ++r) { const int e = 32 * ei + crow(r, hi);
      uo[e * 128 + 32 * dj0 + r32] = (bf16_t)f2bf(acc0[r]); uo[e * 128 + 32 * (dj0 + 1) + r32] = (bf16_t)f2bf(acc1[r]); }
    if (ei == 0 && hi == 0) { NU[(size_t)item * 128 + 32 * dj0 + r32] = accn0[0]; NU[(size_t)item * 128 + 32 * (dj0 + 1) + r32] = accn1[0]; }
  }
  __syncthreads();
}

__device__ __forceinline__ void mlstm_scan_item(const Params& p, int item, char* lds) {
  float* dec = (float*)(lds + ML_G); float* ac = dec + NCH;
  const unsigned* MU = (const unsigned*)(p.ws + WS_MU); unsigned* MC = (unsigned*)(p.ws + WS_MC);
  const float* NU = (const float*)(p.ws + MS_NU); float* NC = (float*)(p.ws + MS_NC); float* msc = (float*)(p.ws + MS_MSC);
  const int bh = item >> 4, eb = item & 15; const int lane = threadIdx.x & 63;
  __syncthreads();
  if (threadIdx.x < 64) { float Bc = 0.f, pm = 0.f, mcar = 0.f;
    for (int half = 0; half < 2; ++half) { const int c = half * 64 + lane;
      const float bl = msc[bh * NCH + c], gm = msc[2048 + bh * NCH + c];
      const float Bi = Bc + wave_incl_scan_add(bl, lane);
      const float px = fmaxf(pm, wave_incl_scan_max(gm - Bi, lane));
      const float m1 = Bi + px; float m0 = __shfl_up(m1, 1); if (lane == 0) m0 = mcar;
      dec[c] = __expf(bl + m0 - m1); ac[c] = __expf(gm - m1);
      if (eb == 0) msc[4096 + bh * NCH + c] = m0;
      Bc = __shfl(Bi, 63); pm = __shfl(px, 63); mcar = __shfl(m1, 63); } }
  __syncthreads();
  const int idx = eb * 512 + threadIdx.x;
  const bool ndo = (eb == 0 && threadIdx.x < 128);
  float C0 = 0.f, C1 = 0.f, nst = 0.f;
#pragma unroll 16
  for (int c = 0; c < NCH; ++c) { const size_t o = ((size_t)(bh * NCH + c)) * 8192 + idx; const unsigned u = MU[o];
    const size_t on = ((size_t)(bh * NCH + c)) * 128 + (threadIdx.x & 127); const float nu = ndo ? NU[on] : 0.f;
    MC[o] = pk2(C0, C1); C0 = dec[c] * C0 + ac[c] * __uint_as_float(u << 16); C1 = dec[c] * C1 + ac[c] * __uint_as_float(u & 0xffff0000u);
    if (ndo) { NC[on] = nst; nst = dec[c] * nst + ac[c] * nu; } }
}

#if TSEL >= 40 && TSEL < 50
#define MTB() (mtq_ = __builtin_amdgcn_s_memrealtime())
#define MTE(k) do { if ((k) == TSEL - 40 && blockIdx.x == 0 && wid == PWAVE) g_tacc += (unsigned)(__builtin_amdgcn_s_memrealtime() - mtq_); } while (0)
#else
#define MTB() do {} while (0)
#define MTE(k) do {} while (0)
#endif
struct McRaw { Raw16 q, k; u32x4 v0, v1; f32x4 gs; float mc; f32x4 nc[4]; };
__device__ __forceinline__ void mc_load(const Params& p, McRaw& R, int item, int tid) {
  const int bh = item / NCH, c = item % NCH, b = bh >> 2, h = bh & 3, s = tid >> 3, d0 = (tid & 7) * 16, lane = tid & 63;
  const bf16_t* PR = (const bf16_t*)(p.ws + WS_PROJ);
  const float* NC = (const float*)(p.ws + MS_NC); const float* msc = (const float*)(p.ws + MS_MSC);
  raw16_load(p, R.q, b, c, s, 0, h, d0); raw16_load(p, R.k, b, c, s, 1, h, d0);
  const bf16_t* vp = PR + 2 * pg8::SEC + ((size_t)(b * 4 + h) * SEQ + c * 64 + s) * 128 + d0; R.v0 = *(const u32x4*)vp; R.v1 = *(const u32x4*)(vp + 8);
  const size_t gt = (size_t)b * SEQ + c * 64 + lane; R.gs = ((const f32x4*)(p.ws + MS_GS))[gt * 4 + h]; R.mc = msc[4096 + item];
#pragma unroll
  for (int q = 0; q < 4; ++q) R.nc[q] = *(const f32x4*)(NC + (size_t)item * 128 + d0 + 4 * q);
}
__device__ __forceinline__ void mlstm_c_phase(const Params& p, int vcu, int G, char* lds, unsigned& g_tacc) {
  unsigned long long mtq_ = 0; (void)mtq_;
  const bf16_t* PR = (const bf16_t*)(p.ws + WS_PROJ); const bf16_t* MC = (const bf16_t*)(p.ws + WS_MC); bf16_t* MIX = (bf16_t*)(p.ws + WS_MIX);
  float* Gf = (float*)(lds + ML_G); float* bm = Gf; float* as_ = Gf + 64; float* mxv = Gf + 128; float* scv = Gf + 192; float* qn = Gf + 256;
  float* H = (float*)(lds + ML_H);
  const float* cwl = (const float*)(lds + ML_CW); const float* cbl = cwl + 4096;
  conv_weights_to_lds(p, lds);
  McRaw P;
  if (vcu < 16 * NCH) mc_load(p, P, vcu, threadIdx.x);
  for (int item = vcu; item < 16 * NCH; item += G) {
    int tid_ = threadIdx.x; asm volatile("" : "+v"(tid_));
    const int tid = tid_, wid = __builtin_amdgcn_readfirstlane(tid >> 6), lane = tid & 63, r32 = lane & 31, hi = lane >> 5;
    const int bh = item / NCH, c = item % NCH, b = bh >> 2, h = bh & 3;
    const int s_ = tid >> 3, d0_ = (tid & 7) * 16;
    MTB();
    bf16x8 ctf[8];
    { const bf16_t* ct = MC + (size_t)item * 16384 + (size_t)(32 * (wid & 3) + r32) * 128 + hi * 8;
#pragma unroll
      for (int ks = 0; ks < 8; ++ks) ctf[ks] = *(const bf16x8*)(ct + ks * 16); }
    LBAR(); MTE(4); MTB();
    if (wid == 0) { const float bc = P.gs.x, a = P.gs.y, pm = P.gs.z;
      const float mc = P.mc; const float mx = bc + fmaxf(mc, pm);
      bm[lane] = bc - mx; as_[lane] = a; mxv[lane] = mx; scv[lane] = __expf(bc + mc - mx); }
    MTE(5); MTB();
    { const int s = s_, d0 = d0_; float y[16];
      conv16_compute(cwl, cbl, y, P.q, h * 128, d0); asm volatile("" : "+v"(y[0])); MTE(6); MTB();
      float part = 0.f;
#pragma unroll
      for (int q = 0; q < 4; ++q) { const f32x4 nv = P.nc[q]; part += y[4 * q] * nv.x + y[4 * q + 1] * nv.y + y[4 * q + 2] * nv.z + y[4 * q + 3] * nv.w; }
      part += __shfl_xor(part, 1); part += __shfl_xor(part, 2); part += __shfl_xor(part, 4);
      if ((tid & 7) == 0) qn[s] = part;
      *(u32x4*)(lds + ML_Q + QSWZ(s, d0 * 2)) = pack8(y); *(u32x4*)(lds + ML_Q + QSWZ(s, d0 * 2 + 16)) = pack8(y + 8);
      conv16_compute(cwl, cbl, y, P.k, 512 + h * 128, d0);
#pragma unroll
      for (int i = 0; i < 16; ++i) y[i] *= KSCALE;
      *(u32x4*)(lds + ML_K + QSWZ(s, d0 * 2)) = pack8(y); *(u32x4*)(lds + ML_K + QSWZ(s, d0 * 2 + 16)) = pack8(y + 8);
      *(u32x4*)(lds + ML_V + v_st(s, d0)) = P.v0; *(u32x4*)(lds + ML_V + v_st(s, d0 + 8)) = P.v1; }
    MTE(7); MTB(); LBAR(); MTE(0); MTB();
    if (item + G < 16 * NCH) mc_load(p, P, item + G, tid);
    const bf16_t* mo_ = PR + 3 * pg8::SEC + ((size_t)(b * 4 + h) * SEQ + c * 64 + s_) * 128 + d0_; const u32x4 mo0 = *(const u32x4*)mo_, mo1 = *(const u32x4*)(mo_ + 8);
    if (wid < 4) {
      const int ti = wid >> 1, si = wid & 1; f32x16 acc = {};
      if (si <= ti) {
#pragma unroll
        for (int ks = 0; ks < 8; ++ks) { const int cb = (ks * 16 + hi * 8) * 2;
          const bf16x8 a = *(const bf16x8*)(lds + ML_Q + QSWZ(32 * ti + r32, cb)), bb = *(const bf16x8*)(lds + ML_K + QSWZ(32 * si + r32, cb));
          acc = __builtin_amdgcn_mfma_f32_32x32x16_bf16(a, bb, acc, 0, 0, 0); }
      }
      const int s = 32 * si + r32; const float av = as_[s];
#pragma unroll
      for (int r = 0; r < 16; ++r) { const int t = 32 * ti + crow(r, hi); const float w = (s <= t) ? __expf(bm[t] + av) * acc[r] : 0.f;
        *(bf16_t*)(lds + ML_W + WSWZ(t, s * 2)) = (bf16_t)f2bf(w); }
    }
    LBAR(); MTE(1); MTB();
    { const int ti = wid >> 2, ej = wid & 3; f32x16 acc = {}, accd = {};
#pragma unroll
      for (int ks = 0; ks < 8; ++ks) { const bf16x8 a = *(const bf16x8*)(lds + ML_Q + QSWZ(32 * ti + r32, (ks * 16 + hi * 8) * 2)); const bf16x8 bb = ctf[ks];
        acc = __builtin_amdgcn_mfma_f32_32x32x16_bf16(a, bb, acc, 0, 0, 0); }
#pragma unroll
      for (int r = 0; r < 16; ++r) acc[r] *= scv[32 * ti + crow(r, hi)];
      const int vbV = (int)(uintptr_t)(lds + ML_V) + v_rd_base(lane) + ej * 512;
      const bf16x8 ones = {0x3F80, 0x3F80, 0x3F80, 0x3F80, 0x3F80, 0x3F80, 0x3F80, 0x3F80};
#define MLC_STEP(KS) do { const s16x4 bl = tr_read<v_rd_off(0, KS, 0)>(vbV), bh_ = tr_read<v_rd_off(0, KS, 1)>(vbV); \
        const bf16x8 a = *(const bf16x8*)(lds + ML_W + WSWZ(32 * ti + r32, (KS * 16 + hi * 8) * 2)); \
        asm volatile("s_waitcnt lgkmcnt(0)" ::: "memory"); __builtin_amdgcn_sched_barrier(0); \
        acc = __builtin_amdgcn_mfma_f32_32x32x16_bf16(a, PKF(bl, bh_), acc, 0, 0, 0); accd = __builtin_amdgcn_mfma_f32_32x32x16_bf16(a, ones, accd, 0, 0, 0); } while (0)
      MLC_STEP(0); MLC_STEP(1); MLC_STEP(2); MLC_STEP(3);
#undef MLC_STEP
#pragma unroll
      for (int r = 0; r < 16; ++r) { const int t = 32 * ti + crow(r, hi); const float den = accd[r] + scv[t] * qn[t]; const float dn = fmaxf(fabsf(den), __expf(-mxv[t]));
        H[t * 128 + 32 * ej + r32] = acc[r] * __builtin_amdgcn_rcpf(dn); }
    }
    LBAR(); MTE(2); MTB();
    { const int t = s_, e0 = d0_; float y[16]; float ss = 0.f;
#pragma unroll
      for (int q = 0; q < 4; ++q) { const f32x4 v = *(const f32x4*)(H + t * 128 + e0 + 4 * q); y[4 * q] = v.x; y[4 * q + 1] = v.y; y[4 * q + 2] = v.z; y[4 * q + 3] = v.w; ss += v.x * v.x + v.y * v.y + v.z * v.z + v.w * v.w; }
      ss += __shfl_xor(ss, 1); ss += __shfl_xor(ss, 2); ss += __shfl_xor(ss, 4);
      const float rstd = rsqrtf(ss * (1.f / 128.f) + EPS);
      const size_t row = (size_t)b * SEQ + c * 64 + t; const int ch = h * 128 + e0;
      const unsigned mw[8] = {mo0.x, mo0.y, mo0.z, mo0.w, mo1.x, mo1.y, mo1.z, mo1.w};
      float gn[16];
#pragma unroll
      for (int q = 0; q < 4; ++q) { const f32x4 gq = *(const f32x4*)(p.mlstm_norm_g + ch + 4 * q); gn[4 * q] = gq.x; gn[4 * q + 1] = gq.y; gn[4 * q + 2] = gq.z; gn[4 * q + 3] = gq.w; }
#pragma unroll
      for (int i = 0; i < 16; ++i) { const float mov = (i & 1) ? __uint_as_float(mw[i >> 1] & 0xffff0000u) : __uint_as_float(mw[i >> 1] << 16);
        y[i] = y[i] * rstd * gn[i] * __builtin_amdgcn_rcpf(1.f + __builtin_amdgcn_exp2f(-LOG2E * mov)); }
      bf16_t* op = MIX + row * DM + ch; *(u32x4*)op = pack8(y); *(u32x4*)(op + 8) = pack8(y + 8); }
    MTE(3);
  }
}
#undef LBAR
#undef QSWZ
#undef WSWZ
#undef PKF
}

__device__ __forceinline__ void phase_combine(const Params& p, int vcu, int G, int wave, int lane) {
    const float lam = __expf(wave_sum(p.lam_q1[lane] * p.lam_k1[lane])) - __expf(wave_sum(p.lam_q2[lane] * p.lam_k2[lane])) + 0.2f;
    const float* AO = (const float*)(p.ws + WS_AO); bf16_t* MIX = (bf16_t*)(p.ws + WS_MIX);
    const float g0 = p.diff_norm_g[2 * lane] * 0.8f, g1 = p.diff_norm_g[2 * lane + 1] * 0.8f;
    for (int it = vcu * NWAVES + wave; it < T * 4; it += G * NWAVES) {
        const float* o1 = AO + (size_t)it * 256; const float* o2 = o1 + 128;
        const float a0 = o1[2 * lane] - lam * o2[2 * lane], a1 = o1[2 * lane + 1] - lam * o2[2 * lane + 1];
        const float rstd = rsqrtf(wave_sum(a0 * a0 + a1 * a1) * (1.f / 128.f) + EPS);
        const int t = it >> 2, h = it & 3;
        *(unsigned*)(MIX + (size_t)t * DM + 512 + h * 128 + 2 * lane) = pk2(a0 * rstd * g0, a1 * rstd * g1);
    }
}
__device__ __forceinline__ unsigned bf16_hi_lo(float x, float& lo) { const unsigned h = f2bf(x); lo = x - __uint_as_float(h << 16); return h; }
__device__ __forceinline__ void phase_route(const Params& p, unsigned char* lds, int vcu, int G, int wave, int lane) {
    constexpr int UP = 1032;
    bf16_t* UH = (bf16_t*)lds; bf16_t* UL = UH + 16 * UP;
    float* part = (float*)(lds + 67584);
    int* cnt = (int*)(lds + 83968); int* base = cnt + 32; int* cnt2 = cnt + 64; int* pel = cnt + 96;
    unsigned char* U2 = (unsigned char*)(p.ws + WS_U2); unsigned* ctl = (unsigned*)(p.ws + WS_CTL);
    int* list = (int*)(p.ws + MS_LIST); int* pe = (int*)(p.ws + MS_PE); int* pp = (int*)(p.ws + MS_PP); float* pg = (float*)(p.ws + MS_PG);
    const int RPW = T / G;
    const int fr = lane & 15, fq = lane >> 4;
    __syncthreads();
    if (threadIdx.x < 96) cnt[threadIdx.x] = 0;
    bf16x8 bh[4][2], bl[4][2];
#pragma unroll
    for (int ks = 0; ks < 4; ++ks)
#pragma unroll
        for (int nt = 0; nt < 2; ++nt) { const float* w0 = p.router_w + (size_t)(128 * wave + 32 * ks + 8 * fq) * NE + 16 * nt + fr; unsigned hw[8], lw[8];
#pragma unroll
            for (int j = 0; j < 8; ++j) { float lo; hw[j] = bf16_hi_lo(w0[(size_t)j * NE], lo); lw[j] = f2bf(lo); }
            const u32x4 hv = {hw[0] | (hw[1] << 16), hw[2] | (hw[3] << 16), hw[4] | (hw[5] << 16), hw[6] | (hw[7] << 16)}, lv = {lw[0] | (lw[1] << 16), lw[2] | (lw[3] << 16), lw[4] | (lw[5] << 16), lw[6] | (lw[7] << 16)};
            bh[ks][nt] = __builtin_bit_cast(bf16x8, hv); bl[ks][nt] = __builtin_bit_cast(bf16x8, lv); }
    const int e = lane & 31, half = lane >> 5;
    const float rb = p.router_b[e];
    f32x4 v[2][4];
    const bf16_t* H1 = (const bf16_t*)(p.ws + WS_H1);
#define LD_H1(dst, rowp) do { const u32x2* xr_ = (const u32x2*)(rowp) + lane; _Pragma("unroll") for (int j = 0; j < 4; ++j) { const u32x2 w_ = xr_[64 * j]; \
        dst[j] = (f32x4){__uint_as_float(w_.x << 16), __uint_as_float(w_.x & 0xffff0000u), __uint_as_float(w_.y << 16), __uint_as_float(w_.y & 0xffff0000u)}; } } while (0)
    for (int q = 0; q < 2; ++q) LD_H1(v[q], H1 + (size_t)(vcu * RPW + 2 * wave + q) * DM);
    for (int bt = 0; bt < RPW / 16; ++bt) {
#pragma unroll
        for (int q = 0; q < 2; ++q) { const int rl = 2 * wave + q, row = vcu * RPW + bt * 16 + rl; float s = 0.f;
#pragma unroll
            for (int j = 0; j < 4; ++j) s += (v[q][j].x * v[q][j].x + v[q][j].y * v[q][j].y) + (v[q][j].z * v[q][j].z + v[q][j].w * v[q][j].w);
            const float rstd = rsqrtf(wave_sum(s) * (1.f / DM) + EPS);
            unsigned* o4 = (unsigned*)(U2 + (size_t)row * DM) + lane;
#pragma unroll
            for (int j = 0; j < 4; ++j) { const f32x4 g = ((const f32x4*)p.norm2_g)[64 * j + lane]; const f32x4 u = v[q][j] * rstd * g;
                o4[64 * j] = pg8::pk4_fp8(u.x * U8_SCALE, u.y * U8_SCALE, u.z * U8_SCALE, u.w * U8_SCALE);
                float l0, l1, l2, l3; const unsigned h0 = bf16_hi_lo(u.x, l0), h1 = bf16_hi_lo(u.y, l1), h2 = bf16_hi_lo(u.z, l2), h3 = bf16_hi_lo(u.w, l3);
                *(u32x2*)(UH + rl * UP + 256 * j + 4 * lane) = (u32x2){h0 | (h1 << 16), h2 | (h3 << 16)};
                *(u32x2*)(UL + rl * UP + 256 * j + 4 * lane) = (u32x2){pk2(l0, l1), pk2(l2, l3)}; }
            if (bt + 1 < RPW / 16) LD_H1(v[q], H1 + (size_t)(row + 16) * DM); }
        __syncthreads();
        { f32x4 acc[2] = {{0.f, 0.f, 0.f, 0.f}, {0.f, 0.f, 0.f, 0.f}};
#pragma unroll
          for (int ks = 0; ks < 4; ++ks) { const int ko = 128 * wave + 32 * ks + 8 * fq;
              const bf16x8 ah = *(const bf16x8*)(UH + fr * UP + ko), al = *(const bf16x8*)(UL + fr * UP + ko);
#pragma unroll
              for (int nt = 0; nt < 2; ++nt) { acc[nt] = __builtin_amdgcn_mfma_f32_16x16x32_bf16(ah, bh[ks][nt], acc[nt], 0, 0, 0);
                  acc[nt] = __builtin_amdgcn_mfma_f32_16x16x32_bf16(ah, bl[ks][nt], acc[nt], 0, 0, 0); acc[nt] = __builtin_amdgcn_mfma_f32_16x16x32_bf16(al, bh[ks][nt], acc[nt], 0, 0, 0); } }
#pragma unroll
          for (int nt = 0; nt < 2; ++nt)
#pragma unroll
              for (int j = 0; j < 4; ++j) part[(wave * 16 + 4 * fq + j) * 32 + 16 * nt + fr] = acc[nt][j]; }
        __syncthreads();
        { const int rl = 2 * wave + half, row = vcu * RPW + bt * 16 + rl; float val = rb;
#pragma unroll
          for (int w = 0; w < 8; ++w) val += part[(w * 16 + rl) * 32 + e];
          float tv[4]; int ti[4];
#pragma unroll
          for (int r = 0; r < 4; ++r) { float bv = val; int bi = e;
#pragma unroll
              for (int o = 1; o < 32; o <<= 1) { const float ov = __shfl_xor(bv, o); const int oi = __shfl_xor(bi, o); if (ov > bv || (ov == bv && oi < bi)) { bv = ov; bi = oi; } }
              tv[r] = bv; ti[r] = bi; if (e == bi) val = -INFINITY; }
          const float e1 = __expf(tv[1] - tv[0]), e2 = __expf(tv[2] - tv[0]), e3 = __expf(tv[3] - tv[0]); const float inv = 1.f / (1.f + e1 + e2 + e3);
          if (e < 4) { const int ee = e == 0 ? ti[0] : e == 1 ? ti[1] : e == 2 ? ti[2] : ti[3]; const float gg = (e == 0 ? 1.f : e == 1 ? e1 : e == 2 ? e2 : e3) * inv;
              atomicAdd(&cnt[ee], 1); pel[(bt * 16 + rl) * 4 + e] = ee; pe[row * 4 + e] = ee; pg[row * 4 + e] = gg; } }
    }
    __syncthreads();
    if (threadIdx.x < 32) base[threadIdx.x] = (int)atomicAdd(&ctl[CW_CNT + threadIdx.x], (unsigned)cnt[threadIdx.x]);
    __syncthreads();
    for (int i = threadIdx.x; i < RPW * 4; i += NTHR) { const int row = vcu * RPW + (i >> 2); const int ee = pel[i]; const int pos = base[ee] + atomicAdd(&cnt2[ee], 1);
        pp[row * 4 + (i & 3)] = pos; list[(size_t)ee * T + pos] = row; }
    __syncthreads();
}
__device__ __forceinline__ void phase_final(const Params& p, unsigned char* lds, int vcu, int G, int wave, int lane) {
    int* ps = (int*)lds;
    const unsigned* ctl = (const unsigned*)(p.ws + WS_CTL);
    __syncthreads();
    if (threadIdx.x == 0) { int a = 0; for (int e = 0; e < NE; ++e) { const int c = (int)__hip_atomic_load(ctl + CW_CNT + e, RLX_AGENT); ps[e] = a; a += (c + 255) & ~255; } }
    __syncthreads();
    const unsigned char* Y = (const unsigned char*)(p.ws + WS_Y); const int* pe = (const int*)(p.ws + MS_PE); const int* pp = (const int*)(p.ws + MS_PP); const float* pg = (const float*)(p.ws + MS_PG);
    const int gw = vcu * NWAVES + wave, NGW = G * NWAVES, nrow = (T - gw + NGW - 1) / NGW;
    int yrow = 0; float yg = 0.f;
    { const int k = lane >> 2, r = lane & 3; if (k < nrow) { const int row = gw + k * NGW; const int e = pe[row * 4 + r]; yrow = ps[e] + pp[row * 4 + r]; yg = pg[row * 4 + r]; } }
    f32x4 v[4]; unsigned yv[4][4];
#define FIN_LOAD(k) do { const int row_ = gw + (k) * NGW; const u32x2* xr_ = (const u32x2*)((const bf16_t*)(p.ws + WS_H1) + (size_t)row_ * DM) + lane; \
        _Pragma("unroll") for (int j = 0; j < 4; ++j) { const u32x2 w_ = xr_[64 * j]; v[j] = (f32x4){__uint_as_float(w_.x << 16), __uint_as_float(w_.x & 0xffff0000u), __uint_as_float(w_.y << 16), __uint_as_float(w_.y & 0xffff0000u)}; } \
        _Pragma("unroll") for (int r = 0; r < 4; ++r) { const int yr_ = __shfl(yrow, (k) * 4 + r); const unsigned* yp_ = (const unsigned*)(Y + (size_t)yr_ * DM) + lane; \
            _Pragma("unroll") for (int j = 0; j < 4; ++j) yv[r][j] = yp_[64 * j]; } } while (0)
    if (nrow > 0) FIN_LOAD(0);
    for (int k = 0; k < nrow; ++k) {
        const int row = gw + k * NGW;
        f32x4 a[4];
#pragma unroll
        for (int j = 0; j < 4; ++j) a[j] = v[j];
#pragma unroll
        for (int r = 0; r < 4; ++r) { const float g = __shfl(yg, k * 4 + r) * (1.f / pg8::Y8_SCALE);
#pragma unroll
            for (int j = 0; j < 4; ++j) { const int w = (int)yv[r][j]; typedef float f2_ __attribute__((ext_vector_type(2)));
                const f2_ lo = __builtin_amdgcn_cvt_pk_f32_fp8(w, false), hi = __builtin_amdgcn_cvt_pk_f32_fp8(w, true);
                a[j].x += g * lo[0]; a[j].y += g * lo[1]; a[j].z += g * hi[0]; a[j].w += g * hi[1]; } }
        if (k + 1 < nrow) FIN_LOAD(k + 1);
        float s = 0.f;
#pragma unroll
        for (int j = 0; j < 4; ++j) s += (a[j].x * a[j].x + a[j].y * a[j].y) + (a[j].z * a[j].z + a[j].w * a[j].w);
        const float rstd = rsqrtf(wave_sum(s) * (1.f / DM) + EPS);
        f32x4* xo = (f32x4*)(p.out + (size_t)row * DM) + lane;
#pragma unroll
        for (int j = 0; j < 4; ++j) { const f32x4 g = ((const f32x4*)p.final_g)[64 * j + lane]; xo[64 * j] = a[j] * rstd * g; }
    }
#undef FIN_LOAD
}

enum { PH_PRE = 0, PH_PROJ = 1, PH_MLA = 2, PH_ATTN = 3, PH_MLC = 4, PH_OUT = 5, PH_ROUTE = 6, PH_MOE1 = 7, PH_MOE2 = 8, PH_FINAL = 9, PH_N = 10 };
struct Args { Params p; int ph_lo, ph_hi, li, pad; };

__device__ __forceinline__ void phase_pre(const Params& p, unsigned char* lds, int vcu, int G, int wave, int lane) {
    { float* scr = (float*)(lds + (wave < 7 ? wave * 16896 : TAB_OFF));
      for (int it = vcu * NWAVES + wave; it < CV_N; it += G * NWAVES) convert_item(p, it, scr, lane); }
    __syncthreads();
#if TSEL == 50
    if (blockIdx.x == PBLK && threadIdx.x == 0) ((volatile LAS unsigned*)((LAS unsigned char*)lds + LDSCTL_OFF))[40] = (unsigned)__builtin_amdgcn_s_memrealtime() - ((volatile LAS unsigned*)((LAS unsigned char*)lds + LDSCTL_OFF))[0];
#endif
    float* gw = (float*)lds;
    for (int i = threadIdx.x; i < DM * 8; i += NTHR) gw[i] = p.w_in[(size_t)(i >> 3) * DIN + 2048 + (i & 7)];
    __syncthreads();
    bf16_t* XN = (bf16_t*)(p.ws + WS_XN); float* gates = (float*)(p.ws + WS_GATES);
    f32x4 v[4];
    { const int row0 = vcu * NWAVES + wave; if (row0 < T) { const f32x4* xr = (const f32x4*)(p.x + (size_t)row0 * DM) + lane;
#pragma unroll
        for (int j = 0; j < 4; ++j) v[j] = xr[64 * j]; } }
    for (int row = vcu * NWAVES + wave; row < T; row += G * NWAVES) {
        f32x4 c[4]; float s = 0.f;
#pragma unroll
        for (int j = 0; j < 4; ++j) { c[j] = v[j]; s += (c[j].x * c[j].x + c[j].y * c[j].y) + (c[j].z * c[j].z + c[j].w * c[j].w); }
        if (row + G * NWAVES < T) { const f32x4* xn = (const f32x4*)(p.x + (size_t)(row + G * NWAVES) * DM) + lane;
#pragma unroll
            for (int j = 0; j < 4; ++j) v[j] = xn[64 * j]; }
        const float rstd = rsqrtf(wave_sum(s) * (1.f / DM) + EPS);
        float ga[8];
#pragma unroll
        for (int q = 0; q < 8; ++q) ga[q] = 0.f;
        unsigned long long* o8 = (unsigned long long*)(XN + (size_t)row * DM) + lane;
#pragma unroll
        for (int j = 0; j < 4; ++j) { const f32x4 g = ((const f32x4*)p.norm1_g)[64 * j + lane]; f32x4 u = c[j] * rstd * g;
            o8[64 * j] = (unsigned long long)pk2(u.x, u.y) | ((unsigned long long)pk2(u.z, u.w) << 32);
            const int k0 = 256 * j + 4 * lane;
#pragma unroll
            for (int cc = 0; cc < 4; ++cc) { const float uu = u[cc]; const float* w = gw + (k0 + cc) * 8;
#pragma unroll
                for (int q = 0; q < 8; ++q) ga[q] += uu * w[q]; } }
        float h4[4], h2[2], h1;
        { const bool up = (lane & 32) != 0;
#pragma unroll
          for (int q = 0; q < 4; ++q) { const float mine = up ? ga[4 + q] : ga[q], theirs = up ? ga[q] : ga[4 + q]; h4[q] = mine + __shfl_xor(theirs, 32); } }
        { const bool up = (lane & 16) != 0;
#pragma unroll
          for (int q = 0; q < 2; ++q) { const float mine = up ? h4[2 + q] : h4[q], theirs = up ? h4[q] : h4[2 + q]; h2[q] = mine + __shfl_xor(theirs, 16); } }
        { const bool up = (lane & 8) != 0; const float mine = up ? h2[1] : h2[0], theirs = up ? h2[0] : h2[1]; h1 = mine + __shfl_xor(theirs, 8); }
        h1 += __shfl_xor(h1, 4); h1 += __shfl_xor(h1, 2); h1 += __shfl_xor(h1, 1);
        if ((lane & 7) == 0) { const int q = ((lane >> 5) & 1) * 4 + ((lane >> 4) & 1) * 2 + ((lane >> 3) & 1); gates[(size_t)row * 8 + q] = h1 + p.gate_b[q]; }
    }
#if TSEL == 51
    if (blockIdx.x == PBLK && threadIdx.x == 0) ((volatile LAS unsigned*)((LAS unsigned char*)lds + LDSCTL_OFF))[40] = (unsigned)__builtin_amdgcn_s_memrealtime() - ((volatile LAS unsigned*)((LAS unsigned char*)lds + LDSCTL_OFF))[0];
#endif
    __syncthreads();
}

__global__ void __launch_bounds__(NTHR, 2) mega(Args args) {
    extern __shared__ __attribute__((aligned(16))) unsigned char lds_raw[];
    const Params& p = args.p;
    LAS unsigned char* lds = (LAS unsigned char*)lds_raw;
    const int tid = threadIdx.x, lane = tid & 63, wave = __builtin_amdgcn_readfirstlane(tid >> 6);
    const int G = gridDim.x, bx = blockIdx.x, vcu = (G % 8 == 0) ? (bx % 8) * (G / 8) + bx / 8 : bx;
    unsigned* ctl = (unsigned*)(p.ws + WS_CTL);
    for (int u = tid; u < (TAB_OFF - LDSCTL_OFF) / 4; u += NTHR) ((LAS unsigned*)(lds + LDSCTL_OFF))[u] = 0u;
    __syncthreads();
    volatile LAS unsigned* MISC = (volatile LAS unsigned*)(lds + MISC_OFF);
    XcdBarrier bar = xcd_barrier_post(ctl + CW_BAR + args.li * XCD_BAR_WORDS, MISC + 8);
    const int lo = args.ph_lo, hi = args.ph_hi;
#define IN(k) (lo <= (k) && (k) < hi)
#ifndef DUP_PHASE
#define DUP_PHASE -1
#endif
#define REP(k) for (int rep_ = 0; rep_ < ((k) == DUP_PHASE ? 2 : 1); ++rep_)
#ifndef TSEL
#define TSEL -1
#endif
#define STAMP(k) do { if (TSEL >= 0 && (TSEL < 20 || TSEL == 50 || TSEL == 51 || TSEL == 70) && bx == PBLK && tid == 0) { const unsigned long long t_ = __builtin_amdgcn_s_memrealtime(); ((volatile LAS unsigned*)(lds + LDSCTL_OFF))[2 * (k)] = (unsigned)t_; } } while (0)
#define SEAM(k) do { if (IN(k) && (k) + 1 < hi) xcd_barrier(bar); STAMP((k) + 1); } while (0)
    STAMP(0);

    if (IN(PH_PRE)) REP(PH_PRE) { phase_pre(p, lds_raw, vcu, G, wave, lane); }
    SEAM(PH_PRE);
    if (IN(PH_PROJ)) REP(PH_PROJ) {
        pg8::StaticOrder S; S.init(p.ws + WS_XN, p.ws + WS_WIN, T, NPJ, DM, G, bx);
        pg8::EpiProj E{(bf16_t*)(p.ws + WS_PROJ)};
        pg8::gemm_phase<pg8::EpiProj, pg8::StaticOrder, false>(lds, DM * 2, S, E, nullptr);
    }
    SEAM(PH_PROJ);
    if (IN(PH_MLA)) REP(PH_MLA) { ml::mlstm_a_phase(p, vcu, G, (char*)lds_raw); }
    SEAM(PH_MLA);
    if (IN(PH_ATTN)) {
        for (int it = vcu; it < 256; it += G) ml::mlstm_scan_item(p, it, (char*)lds_raw);
        unsigned g_tacc = 0; const unsigned long long mt0_ = (TSEL == 30) ? __builtin_amdgcn_s_memtime() : 0ull;
        const float lam = __expf(wave_sum(p.lam_q1[lane] * p.lam_k1[lane])) - __expf(wave_sum(p.lam_q2[lane] * p.lam_k2[lane])) + 0.2f;
        for (int U = vcu; U < (DUP_PHASE == PH_ATTN ? 1024 : 512); U += G) { const int i = (U >> 8) & 1, v = U & 255, bh = v >> 4, s = v & 15;
            const int qb = (i == 0) ? s : 31 - s;
#pragma nounroll
            for (int m = 0; m < 2; ++m) att::attn_unit(p, bh >> 2, bh & 3, m, qb, lam, (char*)lds_raw, g_tacc); }
        if (TSEL == 30) g_tacc = (unsigned)((__builtin_amdgcn_s_memtime() - mt0_) >> 4);
        if (TSEL >= 20 && bx == 0 && lane == 0 && wave == PWAVE) ((volatile LAS unsigned*)(lds + LDSCTL_OFF))[40] = g_tacc;
        __syncthreads();
    }
    SEAM(PH_ATTN);
    if (IN(PH_MLC)) REP(PH_MLC) { unsigned g_tacc = 0; ml::mlstm_c_phase(p, vcu, G, (char*)lds_raw, g_tacc);
        if (TSEL >= 40 && TSEL < 50 && bx == 0 && lane == 0 && wave == PWAVE) ((volatile LAS unsigned*)(lds + LDSCTL_OFF))[40] = g_tacc;
        __syncthreads(); }
    SEAM(PH_MLC);
    if (IN(PH_OUT)) REP(PH_OUT) {
        pg8::StaticOrder S; S.init(p.ws + WS_MIX, p.ws + WS_WOUT, T, DM, DM, G, bx);
        pg8::EpiOut E{p.x, (bf16_t*)(p.ws + WS_H1)};
        pg8::gemm_phase<pg8::EpiOut, pg8::StaticOrder, false>(lds, DM * 2, S, E, nullptr);
    }
    SEAM(PH_OUT);
    if (IN(PH_ROUTE)) phase_route(p, lds_raw, vcu, G, wave, lane);
    SEAM(PH_ROUTE);
    if (IN(PH_MOE1)) REP(PH_MOE1) {
        const int n = moe_build_units<8>(lds, ctl, G, bx);
        const LAS int* UL = (const LAS int*)(lds + TAB_UL); const LAS int* PS = (const LAS int*)(lds + TAB_PS); const LAS int* CN = (const LAS int*)(lds + TAB_CN);
        LAS unsigned* gtab = (LAS unsigned*)(lds + GTAB_OFF);
        const int* list = (const int*)(p.ws + MS_LIST);
        for (int i = tid; i < n * 256; i += NTHR) { const int w = UL[i >> 8], e = w & 255, rt = (w >> 8) & 255; const int idx = min(rt * 256 + (i & 255), CN[e] - 1);
            gtab[i] = (unsigned)list[(size_t)e * T + idx] * (unsigned)DM; }
        __syncthreads();
        MoeOrder<8, true, 1> S{UL, PS, n, (const char*)(p.ws + WS_U2), (const char*)(p.ws + WS_WGU)};
        pg8::EpiSwiglu E{(unsigned char*)(p.ws + WS_ACT), p.b_gu};
        pg8::gemm_phase<pg8::EpiSwiglu, MoeOrder<8, true, 1>, true, true, 0x7b7b7b7b  , 0x76767676  >(lds, DM, S, E, gtab);
    }
    SEAM(PH_MOE1);
    if (IN(PH_MOE2)) REP(PH_MOE2) {
        const int n = moe_build_units<4>(lds, ctl, G, bx);
        const LAS int* UL = (const LAS int*)(lds + TAB_UL); const LAS int* PS = (const LAS int*)(lds + TAB_PS);
        MoeOrder<4, false, 1> S{UL, PS, n, (const char*)(p.ws + WS_ACT), (const char*)(p.ws + WS_WDN)};
        pg8::EpiDown E{(unsigned char*)(p.ws + WS_Y), p.b_down};
        pg8::gemm_phase<pg8::EpiDown, MoeOrder<4, false, 1>, false, true, 0x7d7d7d7d  , 0x76767676  >(lds, FF, S, E, nullptr);
    }
    SEAM(PH_MOE2);
    if (IN(PH_FINAL)) phase_final(p, lds_raw, vcu, G, wave, lane);
    if (TSEL >= 0) { __syncthreads(); STAMP(PH_N);
        if (bx == PBLK && tid == 0) { volatile LAS unsigned* st_ = (volatile LAS unsigned*)(lds + LDSCTL_OFF); const unsigned d_ = (TSEL == 70 ? (st_[2 * PH_N] - st_[0]) : TSEL >= 60 ? st_[40 + PSUB] : TSEL >= 20 ? st_[40] : (st_[2 * (TSEL + 1)] - st_[2 * TSEL])) * TMULT;
            const unsigned long long t0_ = __builtin_amdgcn_s_memrealtime(); while ((unsigned)(__builtin_amdgcn_s_memrealtime() - t0_) < d_) __builtin_amdgcn_s_sleep(8); } }
#undef IN
#undef SEAM
}

static void launch_mega(const Params& p, int lo, int hi, int li, hipStream_t stream) {
    Args a{}; a.p = p; a.ph_lo = lo; a.ph_hi = hi; a.li = li; a.pad = 0;
    hipLaunchKernelGGL(mega, dim3(256), dim3(NTHR), LDS_BYTES, stream, a);
}
extern "C" void kernel_launch(void* const* d_in, const int* in_sizes, int n_in, void* d_out, int out_size, void* d_ws, size_t ws_size, hipStream_t stream) {
    if (n_in != 22 || out_size != T * DM || ws_size < WS_END) { fprintf(stderr, "kernel_launch: unexpected shapes (n_in %d out %d ws %zu)\n", n_in, out_size, ws_size); return; }
    Params p{};
    const float** f = (const float**)&p;
    for (int i = 0; i < 22; ++i) f[i] = (const float*)d_in[i];
    p.out = (float*)d_out; p.ws = (unsigned char*)d_ws;
    static bool attr = false;
    if (!attr) { attr = true;
        (void)hipFuncSetAttribute((const void*)k_mlstm_a, hipFuncAttributeMaxDynamicSharedMemorySize, 80 * 1024);
        (void)hipFuncSetAttribute((const void*)k_mlstm_c, hipFuncAttributeMaxDynamicSharedMemorySize, 128 * 1024);
        (void)hipFuncSetAttribute((const void*)mega, hipFuncAttributeMaxDynamicSharedMemorySize, LDS_BYTES); }
    (void)hipMemsetAsync((char*)d_ws + WS_CTL, 0, 32768, stream);
    launch_mega(p, PH_PRE, PH_N, 0, stream);
}
```

```cpp
#define DUP_PHASE -1
#define TSEL -1
#define TMULT 1
#define PWAVE 0
#define PBLK 0
#define PSUB 0
#include <hip/hip_runtime.h>
#include <cstdio>
#include <cstdint>

typedef unsigned short bf16_t;
typedef short bf16x8 __attribute__((ext_vector_type(8)));
typedef float f32x4 __attribute__((ext_vector_type(4)));
typedef unsigned u32x4 __attribute__((ext_vector_type(4)));
typedef unsigned u32x2 __attribute__((ext_vector_type(2)));

constexpr int NB = 4, SEQ = 8192, T = NB * SEQ, DM = 1024, DIN = 3592, NPJ = 3584;
constexpr int NCH = SEQ / 64;
constexpr int NE = 32, FF = 1024;
constexpr int PQ = 0, PK = 512, PV = 1024, PO = 1536, PAQ = 2048, PAK = 2560, PAV = 3072;
constexpr int PROWS = T * 4 + NE * 256;
constexpr float EPS = 1e-5f;
constexpr float LOG2E = 1.4426950408889634f;
constexpr float QSCALE = 0.125f * LOG2E;

constexpr size_t MiB = 1u << 20;
constexpr size_t WS_CTL = 0;
constexpr size_t WS_WIN = 2 * MiB;
constexpr size_t WS_WOUT = 10 * MiB;
constexpr size_t WS_GATES = 12 * MiB;
constexpr size_t WS_MISC = 14 * MiB;
constexpr size_t WS_WGU = 24 * MiB;
constexpr size_t WS_WDN = 152 * MiB;
constexpr size_t WS_XN = 216 * MiB;
constexpr size_t WS_PROJ = 280 * MiB;
constexpr size_t WS_MU = 504 * MiB;
constexpr size_t WS_MC = 568 * MiB;
constexpr size_t WS_AO = 632 * MiB;
constexpr size_t WS_MIX = 760 * MiB;
constexpr size_t WS_Y = 552 * MiB;
constexpr size_t WS_ACT = WS_PROJ;
constexpr size_t WS_H1 = 424 * MiB;
constexpr size_t WS_U2 = WS_XN;
constexpr size_t WS_END = 824 * MiB;
constexpr size_t MS_LIST = WS_MISC;
constexpr size_t MS_PAIR = WS_MISC + 4 * MiB;
constexpr size_t MS_PE = MS_PAIR;
constexpr size_t MS_PP = MS_PAIR + (size_t)T * 4 * 4;
constexpr size_t MS_PG = MS_PP + (size_t)T * 4 * 4;
constexpr size_t MS_MSC = WS_MISC + 6 * MiB;
constexpr size_t MS_NU = WS_MISC + 7 * MiB;
constexpr size_t MS_NC = WS_MISC + 8 * MiB;
constexpr int CW_CNT = 64;

struct Params {
    const float *x, *rel_bias, *norm1_g, *w_in, *conv_w, *conv_b, *gate_b, *mlstm_norm_g, *lam_q1, *lam_k1, *lam_q2, *lam_k2,
        *diff_norm_g, *w_out, *norm2_g, *router_w, *router_b, *w_gu, *b_gu, *w_down, *b_down, *final_g;
    float* out; unsigned char* ws;
};

__device__ __forceinline__ float bf2f(bf16_t v) { return __uint_as_float((unsigned)v << 16); }
__device__ __forceinline__ unsigned f2bf(float f) { unsigned u = __float_as_uint(f); return (u + 0x7fffu + ((u >> 16) & 1u)) >> 16; }
__device__ __forceinline__ unsigned pk2(float lo, float hi) { return f2bf(lo) | (f2bf(hi) << 16); }
__device__ __forceinline__ float wave_sum(float v) {
#pragma unroll
    for (int o = 1; o < 64; o <<= 1) v += __shfl_xor(v, o);
    return v;
}
__device__ __forceinline__ float sigmoidf_(float x) { return 1.f / (1.f + __expf(-x)); }
__device__ __forceinline__ float log_sigmoid(float x) { return fminf(x, 0.f) - log1pf(__expf(-fabsf(x))); }
#define LDS_WAIT() asm volatile("s_waitcnt lgkmcnt(0)" ::: "memory")

__device__ __forceinline__ void tr_item(const float* W, int ldw, int n0, int k0, bf16_t* WT, int dstrow0, int Kd, float* scr, int lane) {
#pragma unroll 8
    for (int i = 0; i < 32; ++i) { const int kk = 2 * i + (lane >> 5); scr[kk * 33 + (lane & 31)] = W[(size_t)(k0 + kk) * ldw + n0 + (lane & 31)]; }
    LDS_WAIT();
    const int c = lane & 7;
#pragma unroll
    for (int j = 0; j < 4; ++j) { const int n = (lane >> 3) + 8 * j; const float* s = scr + (8 * c) * 33 + n;
        u32x4 o; o.x = pk2(s[0 * 33], s[1 * 33]); o.y = pk2(s[2 * 33], s[3 * 33]); o.z = pk2(s[4 * 33], s[5 * 33]); o.w = pk2(s[6 * 33], s[7 * 33]);
        *(u32x4*)(WT + (size_t)(dstrow0 + n) * Kd + k0 + 8 * c) = o; }
    LDS_WAIT();
}
__device__ __forceinline__ void tr_item8(const float* W, int ldw, int n0, int k0, unsigned char* WT, int dstrow0, int Kd, float scale, float* scr, int lane) {
    const float* src = W + (size_t)(k0 + (lane >> 5)) * ldw + n0 + (lane & 31);
#pragma unroll
    for (int b = 0; b < 4; ++b) { float v[16];
#pragma unroll
        for (int i = 0; i < 16; ++i) v[i] = src[(size_t)(2 * (16 * b + i)) * ldw];
#pragma unroll
        for (int i = 0; i < 16; ++i) scr[(2 * (16 * b + i) + (lane >> 5)) * 33 + (lane & 31)] = v[i] * scale; }
    LDS_WAIT();
    const int c = lane & 3;
#pragma unroll
    for (int j = 0; j < 2; ++j) { const int n = (lane >> 2) + 16 * j; const float* s = scr + (32 * c) * 33 + n;
        u32x4 o0, o1;
#define Q4(b) ({ int w_ = __builtin_amdgcn_cvt_pk_fp8_f32(s[((b) + 0) * 33], s[((b) + 1) * 33], 0, false); (unsigned)__builtin_amdgcn_cvt_pk_fp8_f32(s[((b) + 2) * 33], s[((b) + 3) * 33], w_, true); })
        o0.x = Q4(0); o0.y = Q4(4); o0.z = Q4(8); o0.w = Q4(12); o1.x = Q4(16); o1.y = Q4(20); o1.z = Q4(24); o1.w = Q4(28);
#undef Q4
        unsigned char* d = WT + (size_t)(dstrow0 + n) * Kd + k0 + 32 * c; *(u32x4*)d = o0; *(u32x4*)(d + 16) = o1; }
    LDS_WAIT();
}
constexpr float W8_SCALE = 512.f, U8_SCALE = 16.f;
constexpr int CV_I0 = 1024, CV_I1 = 768, CV_I2 = 512, CV_I3 = 16384, CV_I4 = 8192, CV_N = CV_I0 + CV_I1 + CV_I2 + CV_I3 + CV_I4, CV_SMALL = CV_I0 + CV_I1 + CV_I2;
__device__ __forceinline__ void convert_item(const Params& p, int it, float* scr, int lane) {
    bf16_t* win = (bf16_t*)(p.ws + WS_WIN); bf16_t* wout = (bf16_t*)(p.ws + WS_WOUT); unsigned char* wgu = (unsigned char*)(p.ws + WS_WGU); unsigned char* wdn = (unsigned char*)(p.ws + WS_WDN);
    int r = it;
    if (r < CV_I0) { const int kb = r / 64, nb = r % 64; tr_item(p.w_in, DIN, 32 * nb, 64 * kb, win, 32 * nb, DM, scr, lane); return; } r -= CV_I0;
    if (r < CV_I1) { const int kb = r / 48, nb = r % 48; tr_item(p.w_in, DIN, 2056 + 32 * nb, 64 * kb, win, 2048 + 32 * nb, DM, scr, lane); return; } r -= CV_I1;
    if (r < CV_I2) { const int kb = r / 32, nb = r % 32; tr_item(p.w_out, DM, 32 * nb, 64 * kb, wout, 32 * nb, DM, scr, lane); return; } r -= CV_I2;
    if (r < CV_I3) { const int e = r / 512, q = r % 512, kb = q / 64, nb = q % 64; const int n0 = 32 * nb;
        const int dst = (n0 < 1024) ? (256 * (n0 / 128) + (n0 % 128)) : (256 * ((n0 - 1024) / 128) + 128 + ((n0 - 1024) % 128));
        tr_item8(p.w_gu + (size_t)e * DM * 2 * FF, 2 * FF, n0, 128 * kb, wgu + (size_t)e * 2 * FF * DM, dst, DM, W8_SCALE, scr, lane); return; } r -= CV_I3;
    { const int e = r / 256, q = r % 256, kb = q / 32, nb = q % 32;
        tr_item8(p.w_down + (size_t)e * FF * DM, DM, 32 * nb, 128 * kb, wdn + (size_t)e * DM * FF, 32 * nb, FF, W8_SCALE, scr, lane); }
}
__device__ __forceinline__ int t5_bucket(int rel) {
    const int n = rel < 0 ? -rel : rel; int b;
    if (n < 8) b = n; else if (n < 12) b = 8; else if (n < 16) b = 9; else if (n < 23) b = 10; else if (n < 32) b = 11; else if (n < 46) b = 12; else if (n < 64) b = 13; else if (n < 91) b = 14; else b = 15;
    return b + (rel > 0 ? 16 : 0);
}
#define LAS __attribute__((address_space(3)))
#define GAS __attribute__((address_space(1)))
typedef GAS unsigned gu32;
#define RLX_AGENT __ATOMIC_RELAXED, __HIP_MEMORY_SCOPE_AGENT
#define VM_WAIT() asm volatile("s_waitcnt vmcnt(0)" ::: "memory")
constexpr int NWAVES = 8, NTHR = 512;
constexpr int RING_BYTES = 131072;
constexpr int LDSCTL_OFF = RING_BYTES, MISC_OFF = LDSCTL_OFF + 320;
constexpr int TAB_OFF = RING_BYTES + 1024;
constexpr int TAB_UL = TAB_OFF, TAB_PS = TAB_OFF + 256, TAB_CN = TAB_OFF + 256 + 160, TAB_NU = TAB_OFF + 256 + 160 + 128, TAB_UC = TAB_OFF + 256 + 160 + 128 + 16;
constexpr int GTAB_OFF = TAB_OFF + 1024;
constexpr int LDS_BYTES = 163840;
static_assert(GTAB_OFF + 20 * 256 * 4 <= LDS_BYTES, "LDS map");
constexpr int CW_BAR = 4096;

namespace pg8 {
constexpr int BM = 256, BK = 64, HALF = 128, HTB = HALF * BK * 2, STAGE_BYTES = 8 * HTB, NXCD = 8, WGM = 8;
__host__ __device__ __forceinline__ int lds_byte(int r, int c) { const int st = (r >> 4) * 2 + (c >> 5), rr = r & 15, cc = c & 31, ob = rr * 64 + cc * 2; return st * 1024 + (ob ^ (((ob >> 9) & 1) << 5)); }
__host__ __device__ __forceinline__ void stage_rc(int b, int& R, int& C) { const int st = b / 1024, sb = b % 1024, swz = sb ^ (((sb >> 9) & 1) << 5); R = (st >> 1) * 16 + swz / 64; C = (st & 1) * 32 + (swz % 64) / 2; }
__host__ __device__ __forceinline__ int perm32(int rho) { const int n = rho >> 4, i = rho & 15; return 8 * (i >> 2) + 4 * n + (i & 3); }
__device__ __forceinline__ unsigned cvt_pk_bf16(float lo, float hi) { unsigned r; asm volatile("v_cvt_pk_bf16_f32 %0, %1, %2" : "=v"(r) : "v"(lo), "v"(hi)); return r; }

struct Unit { const char* a; const char* b; int pm, pn, e, slot; };

__device__ __forceinline__ int xcd_remap(int L, int nwg) { const int q = nwg / NXCD, r = nwg % NXCD, xcd = L % NXCD, off = L / NXCD; return (xcd < r ? xcd * (q + 1) : r * (q + 1) + (xcd - r) * q) + off; }

struct StaticOrder {
    const char* A; const char* Bt; int nM, nN, nwg, G, c; size_t tstep;
    __device__ void init(const void* A_, const void* Bt_, int M, int N, int K, int G_, int c_) { A = (const char*)A_; Bt = (const char*)Bt_; nM = M / BM; nN = N / BM; nwg = nM * nN; G = G_; c = c_; tstep = (size_t)BM * K * 2; }
    __device__ __forceinline__ bool next(int i, Unit& u) const {
        const long L = (long)i * G + c; if (L >= nwg) return false;
        const int wgid = xcd_remap((int)L, nwg);
        const int nig = WGM * nN, gid = wgid / nig, fm = gid * WGM, gsz = (nM - fm) < WGM ? (nM - fm) : WGM;
        u.pm = fm + ((wgid % nig) % gsz); u.pn = (wgid % nig) / gsz; u.e = 0; u.slot = 0;
        u.a = A + (size_t)u.pm * tstep; u.b = Bt + (size_t)u.pn * tstep; return true;
    }
};

template <class Epi, class Sched, bool GATHER, bool F8 = false, int sA = 0x7f7f7f7f, int sB = 0x7f7f7f7f>
__device__ __forceinline__ void gemm_phase(LAS unsigned char* lds, const int rowbytes, const Sched& S, const Epi& E, const LAS unsigned* gtab) {
    int tid_ = threadIdx.x; asm volatile("" : "+v"(tid_));
    const int tid = tid_, wid = __builtin_amdgcn_readfirstlane(tid >> 6), lane = tid & 63, wr = wid >> 2, wc = wid & 3, fr = lane & 15, fq = lane >> 4;
    int nt = rowbytes / 128; asm volatile("" : "+s"(nt));
    int R0, C0; stage_rc(tid * 16, R0, C0); const int Rb0 = Epi::PERM ? ((R0 & ~31) + perm32(R0 & 31)) : R0;
    const unsigned vA0 = (unsigned)(R0 * rowbytes + C0 * 2), vB0 = (unsigned)(Rb0 * rowbytes + C0 * 2), coff = (unsigned)(C0 * 2);
    unsigned vAg[2][2] = {{0u, 0u}, {0u, 0u}};
    const size_t pstep = (size_t)64 * rowbytes;
    const size_t kstep = (size_t)(BK * 2);
    const size_t hstep = (size_t)HALF * rowbytes;
    const unsigned ldsw = (unsigned)wid * 1024u;
    const int aoff = lds_byte(wr * 64 + fr, fq * 8), boff = lds_byte(wc * 32 + fr, fq * 8);
#define PG8_SA(b, h) (((b) * 2 + (h)) * HTB)
#define PG8_SB(b, h) ((4 + (b) * 2 + (h)) * HTB)
#define PG8_STAGE_B(bufoff, gbase) do { _Pragma("unroll") for (int _i = 0; _i < 2; ++_i) \
        __builtin_amdgcn_global_load_lds((const unsigned*)((const char*)(gbase) + _i * pstep + vB0), (LAS unsigned*)(lds + (bufoff) + ldsw + _i * 8192), 16, 0, 0); } while (0)
#define PG8_STAGE_A(bufoff, gbase, h) do { _Pragma("unroll") for (int _i = 0; _i < 2; ++_i) { \
        if (GATHER) __builtin_amdgcn_global_load_lds((const unsigned*)((const char*)(gbase) + vAg[h][_i]), (LAS unsigned*)(lds + (bufoff) + ldsw + _i * 8192), 16, 0, 0); \
        else __builtin_amdgcn_global_load_lds((const unsigned*)((const char*)(gbase) + (h) * hstep + _i * pstep + vA0), (LAS unsigned*)(lds + (bufoff) + ldsw + _i * 8192), 16, 0, 0); } } while (0)
#define PG8_LD8(p_) __builtin_shufflevector(*(const LAS v4i_*)(p_), *(const LAS v4i_*)((p_) + 1024), 0, 1, 2, 3, 4, 5, 6, 7)
#define PG8_LDA(dst, b, h) do { _Pragma("unroll") for (int m = 0; m < 4; ++m) dst[m] = PG8_LD8(lds + PG8_SA(b, h) + aoff + m * 2048); } while (0)
#define PG8_LDB(dst, b, h) do { _Pragma("unroll") for (int n = 0; n < 2; ++n) dst[n] = PG8_LD8(lds + PG8_SB(b, h) + boff + n * 2048); } while (0)
#define PG8_LO(x) __builtin_bit_cast(bf16x8, __builtin_shufflevector(x, x, 0, 1, 2, 3))
#define PG8_HI(x) __builtin_bit_cast(bf16x8, __builtin_shufflevector(x, x, 4, 5, 6, 7))
#define PG8_MMA(ai, bj, At, Bt) do { __builtin_amdgcn_s_setprio(1); _Pragma("unroll") for (int m = 0; m < 4; ++m) _Pragma("unroll") for (int n = 0; n < 2; ++n) { \
        if constexpr (F8) acc[ai][bj][m][n] = __builtin_amdgcn_mfma_scale_f32_16x16x128_f8f6f4(Bt[n], At[m], acc[ai][bj][m][n], 0, 0, 0, sB, 0, sA); \
        else { acc[ai][bj][m][n] = __builtin_amdgcn_mfma_f32_16x16x32_bf16(PG8_LO(Bt[n]), PG8_LO(At[m]), acc[ai][bj][m][n], 0, 0, 0); \
               acc[ai][bj][m][n] = __builtin_amdgcn_mfma_f32_16x16x32_bf16(PG8_HI(Bt[n]), PG8_HI(At[m]), acc[ai][bj][m][n], 0, 0, 0); } } \
        __builtin_amdgcn_s_setprio(0); } while (0)
#define PG8_WAIT_V(n) asm volatile("s_waitcnt vmcnt(" #n ")" ::: "memory")
#define PG8_WAIT_L(n) asm volatile("s_waitcnt lgkmcnt(" #n ")" ::: "memory")
#define PG8_BAR __builtin_amdgcn_s_barrier()
#define PG8_SCHED __builtin_amdgcn_sched_barrier(0)
#define PG8_GATHER_OFFS(u) do { if (GATHER) { const LAS unsigned* _g = gtab + (u).slot * 256 + R0; \
        vAg[0][0] = _g[0] + coff; vAg[0][1] = _g[64] + coff; vAg[1][0] = _g[HALF] + coff; vAg[1][1] = _g[HALF + 64] + coff; } } while (0)
    Unit cur, nxt; int ui = 0;
    if (!S.next(0, cur)) return;
    f32x4 acc[2][2][4][2];
#pragma unroll
    for (int a = 0; a < 2; ++a)
#pragma unroll
        for (int b = 0; b < 2; ++b)
#pragma unroll
            for (int m = 0; m < 4; ++m)
#pragma unroll
                for (int n = 0; n < 2; ++n) acc[a][b][m][n] = (f32x4){0.f, 0.f, 0.f, 0.f};
    typedef int v4i_ __attribute__((ext_vector_type(4))); typedef int v8i_ __attribute__((ext_vector_type(8)));
    v8i_ At[4], B0[2], B1[2];
    const char* cA = cur.a; const char* cB = cur.b;
    PG8_GATHER_OFFS(cur);
    PG8_STAGE_B(PG8_SB(0, 0), cB); PG8_STAGE_B(PG8_SB(0, 1), cB + hstep); PG8_STAGE_A(PG8_SA(0, 0), cA, 0); PG8_STAGE_A(PG8_SA(0, 1), cA, 1);
    if (wr == 1) PG8_BAR;
    PG8_WAIT_V(2); PG8_BAR;
    PG8_STAGE_B(PG8_SB(1, 0), cB + kstep); PG8_STAGE_A(PG8_SA(1, 0), cA + kstep, 0); PG8_STAGE_B(PG8_SB(1, 1), cB + hstep + kstep);
    PG8_WAIT_V(6); PG8_BAR;
#if TSEL >= 60 && TSEL < 70
    unsigned long long tk0_ = __builtin_amdgcn_s_memrealtime();
#endif
    for (;;) {
        const bool has_next = S.next(ui + 1, nxt);
        const char* nA = has_next ? nxt.a : cA; const char* nB = has_next ? nxt.b : cB;
#pragma nounroll
        for (int t = 0; t < nt; t += 2) {
            const bool last = (t == nt - 2);
            const char* a1 = cA + (size_t)(t + 1) * kstep;
            const char* a2 = last ? nA : cA + (size_t)(t + 2) * kstep; const char* b2 = last ? nB : cB + (size_t)(t + 2) * kstep;
            const char* a3 = a2 + kstep; const char* b3 = b2 + kstep;
            PG8_LDB(B0, 0, 0); PG8_LDB(B1, 0, 1); PG8_SCHED; PG8_LDA(At, 0, 0); PG8_STAGE_A(PG8_SA(1, 1), a1, 1);
            if (GATHER) { if (last && has_next) PG8_GATHER_OFFS(nxt); }
            PG8_WAIT_V(8); PG8_WAIT_L(0); PG8_BAR; PG8_MMA(0, 0, At, B0); PG8_MMA(0, 1, At, B1); PG8_BAR; PG8_SCHED;
            PG8_LDA(At, 0, 1); PG8_STAGE_B(PG8_SB(0, 0), b2); PG8_STAGE_B(PG8_SB(0, 1), b2 + hstep); PG8_STAGE_A(PG8_SA(0, 0), a2, 0);
            PG8_WAIT_V(8); PG8_WAIT_L(0); PG8_BAR; PG8_MMA(1, 0, At, B0); PG8_MMA(1, 1, At, B1); PG8_BAR; PG8_SCHED;
            PG8_LDB(B0, 1, 0); PG8_LDB(B1, 1, 1); PG8_SCHED; PG8_LDA(At, 1, 0); PG8_STAGE_A(PG8_SA(0, 1), a2, 1);
            PG8_WAIT_V(8); PG8_WAIT_L(0); PG8_BAR; PG8_MMA(0, 0, At, B0); PG8_MMA(0, 1, At, B1); PG8_BAR; PG8_SCHED;
            PG8_LDA(At, 1, 1); PG8_STAGE_B(PG8_SB(1, 0), b3); PG8_STAGE_B(PG8_SB(1, 1), b3 + hstep); PG8_STAGE_A(PG8_SA(1, 0), a3, 0);
            PG8_WAIT_V(8); PG8_WAIT_L(0); PG8_BAR; PG8_MMA(1, 0, At, B0); PG8_MMA(1, 1, At, B1); PG8_BAR; PG8_SCHED;
        }
        if (wr == 0) PG8_BAR;
#if TSEL >= 60 && TSEL < 70
        const unsigned long long te0_ = __builtin_amdgcn_s_memrealtime();
        if (TSEL == 61 && blockIdx.x == PBLK && wid == PWAVE) ((volatile LAS unsigned*)(lds + LDSCTL_OFF))[40 + Epi::PID] += (unsigned)(te0_ - tk0_);
#endif
        E(acc, cur, wr, wc, fr, fq);
#if TSEL >= 60 && TSEL < 70
        if (TSEL == 60 && blockIdx.x == PBLK && wid == PWAVE) ((volatile LAS unsigned*)(lds + LDSCTL_OFF))[40 + Epi::PID] += (unsigned)(__builtin_amdgcn_s_memrealtime() - te0_);
        tk0_ = __builtin_amdgcn_s_memrealtime();
#endif
        if (!has_next) break;
#pragma unroll
        for (int a = 0; a < 2; ++a)
#pragma unroll
            for (int b = 0; b < 2; ++b)
#pragma unroll
                for (int m = 0; m < 4; ++m)
#pragma unroll
                    for (int n = 0; n < 2; ++n) acc[a][b][m][n] = (f32x4){0.f, 0.f, 0.f, 0.f};
        cur = nxt; cA = nA; cB = nB; ++ui;
        if (wr == 1) PG8_BAR;
    }
    PG8_WAIT_V(0);
    PG8_BAR;
#undef PG8_SA
#undef PG8_SB
#undef PG8_STAGE_A
#undef PG8_STAGE_B
#undef PG8_LDA
#undef PG8_LDB
#undef PG8_LD8
#undef PG8_LO
#undef PG8_HI
#undef PG8_MMA
#undef PG8_WAIT_V
#undef PG8_WAIT_L
#undef PG8_BAR
#undef PG8_SCHED
#undef PG8_GATHER_OFFS
}

constexpr size_t SEC = (size_t)16 * SEQ * 128;
struct EpiProj {
    static constexpr bool PERM = true; static constexpr int PID = 0;
    bf16_t* O;
    __device__ __forceinline__ void operator()(const f32x4 (&acc)[2][2][4][2], const Unit& u, int wr, int wc, int fr, int fq) const {
        const int row0 = u.pm * BM + wr * 64 + fr;
        const int b = row0 / SEQ, t0 = row0 % SEQ;
        const float sc = (u.pn == 8 || u.pn == 9) ? QSCALE : 1.f;
#pragma unroll
        for (int bj = 0; bj < 2; ++bj) { const int c0 = u.pn * BM + bj * HALF + wc * 32 + 8 * fq, sec = c0 >> 9, cs = c0 & 511, h = cs >> 7;
            bf16_t* base; int pitch;
            if (sec == 4 || sec == 5) { base = O + (size_t)sec * SEC + ((size_t)((b * 4 + h) * 2 + ((cs >> 6) & 1)) * SEQ + t0) * 64 + (cs & 63); pitch = 64; }
            else { base = O + (size_t)sec * SEC + ((size_t)(b * 4 + h) * SEQ + t0) * 128 + (cs & 127); pitch = 128; }
#pragma unroll
            for (int ai = 0; ai < 2; ++ai)
#pragma unroll
                for (int m = 0; m < 4; ++m) { const f32x4 v0 = acc[ai][bj][m][0] * sc, v1 = acc[ai][bj][m][1] * sc;
                    u32x4 w; w.x = cvt_pk_bf16(v0[0], v0[1]); w.y = cvt_pk_bf16(v0[2], v0[3]); w.z = cvt_pk_bf16(v1[0], v1[1]); w.w = cvt_pk_bf16(v1[2], v1[3]);
                    *(u32x4*)(base + (size_t)(ai * HALF + m * 16) * pitch) = w; } }
    }
};
struct EpiOut {
    static constexpr bool PERM = true; static constexpr int PID = 1;
    const float* X; bf16_t* O;
    __device__ __forceinline__ void operator()(const f32x4 (&acc)[2][2][4][2], const Unit& u, int wr, int wc, int fr, int fq) const {
        const int row0 = u.pm * BM + wr * 64 + fr, col0 = u.pn * BM + wc * 32 + 8 * fq;
#pragma unroll
        for (int ai = 0; ai < 2; ++ai)
#pragma unroll
            for (int m = 0; m < 4; ++m) { const size_t off = (size_t)(row0 + ai * HALF + m * 16) * DM + col0;
#pragma unroll
                for (int bj = 0; bj < 2; ++bj) { const f32x4 x0 = *(const f32x4*)(X + off + bj * HALF), x1 = *(const f32x4*)(X + off + bj * HALF + 4);
                    const f32x4 v0 = x0 + acc[ai][bj][m][0], v1 = x1 + acc[ai][bj][m][1];
                    u32x4 w; w.x = cvt_pk_bf16(v0[0], v0[1]); w.y = cvt_pk_bf16(v0[2], v0[3]); w.z = cvt_pk_bf16(v1[0], v1[1]); w.w = cvt_pk_bf16(v1[2], v1[3]);
                    *(u32x4*)(O + off + bj * HALF) = w; } }
    }
};
__device__ __forceinline__ unsigned pk4_fp8(float a, float b, float c, float d) { int w = __builtin_amdgcn_cvt_pk_fp8_f32(a, b, 0, false); w = __builtin_amdgcn_cvt_pk_fp8_f32(c, d, w, true); return (unsigned)w; }
constexpr float ACT_SCALE = 4.f;
struct EpiSwiglu {
    static constexpr bool PERM = true; static constexpr int PID = 2;
    unsigned char* O; const float* bgu;
    __device__ __forceinline__ void operator()(const f32x4 (&acc)[2][2][4][2], const Unit& u, int wr, int wc, int fr, int fq) const {
        const int row0 = u.pm * BM + wr * 64 + fr, col0 = u.pn * HALF + wc * 32 + 8 * fq;
        const float* bb = bgu + (size_t)u.e * 2 * FF + col0;
        const f32x4 bg0 = *(const f32x4*)(bb), bg1 = *(const f32x4*)(bb + 4), bu0 = *(const f32x4*)(bb + FF), bu1 = *(const f32x4*)(bb + FF + 4);
#pragma unroll
        for (int ai = 0; ai < 2; ++ai)
#pragma unroll
            for (int m = 0; m < 4; ++m) { unsigned char* rowp = O + (size_t)(row0 + ai * HALF + m * 16) * FF + col0;
                float r[8];
#pragma unroll
                for (int n = 0; n < 2; ++n) { const f32x4 gv = acc[ai][0][m][n] + (n ? bg1 : bg0), uv = acc[ai][1][m][n] + (n ? bu1 : bu0);
#pragma unroll
                    for (int j = 0; j < 4; ++j) { const float g = fminf(gv[j], 7.f), uu = fminf(fmaxf(uv[j], -7.f), 7.f);
                        r[n * 4 + j] = ACT_SCALE * (uu + 1.f) * g * __builtin_amdgcn_rcpf(1.f + __builtin_amdgcn_exp2f(-1.702f * LOG2E * g)); } }
                u32x2 w; w.x = pk4_fp8(r[0], r[1], r[2], r[3]); w.y = pk4_fp8(r[4], r[5], r[6], r[7]);
                *(u32x2*)(rowp) = w; }
    }
};
constexpr float Y8_SCALE = 16.f;
struct EpiDown {
    static constexpr bool PERM = true; static constexpr int PID = 3;
    unsigned char* O; const float* bd;
    __device__ __forceinline__ void operator()(const f32x4 (&acc)[2][2][4][2], const Unit& u, int wr, int wc, int fr, int fq) const {
        const int row0 = u.pm * BM + wr * 64 + fr, col0 = u.pn * BM + wc * 32 + 8 * fq;
        const float* bb = bd + (size_t)u.e * DM + col0;
#pragma unroll
        for (int bj = 0; bj < 2; ++bj) { const f32x4 bv0 = *(const f32x4*)(bb + bj * HALF), bv1 = *(const f32x4*)(bb + bj * HALF + 4);
#pragma unroll
            for (int ai = 0; ai < 2; ++ai)
#pragma unroll
                for (int m = 0; m < 4; ++m) { unsigned char* rowp = O + (size_t)(row0 + ai * HALF + m * 16) * DM + col0 + bj * HALF;
                    const f32x4 v0 = (acc[ai][bj][m][0] + bv0) * Y8_SCALE, v1 = (acc[ai][bj][m][1] + bv1) * Y8_SCALE;
                    u32x2 w; w.x = pk4_fp8(v0[0], v0[1], v0[2], v0[3]); w.y = pk4_fp8(v1[0], v1[1], v1[2], v1[3]);
                    *(u32x2*)(rowp) = w; } }
    }
};
}

#define XB_TMO      128
#define XB_XCNT(j)  (256  + 64 * (j))
#define XB_XSUB(j)  (1280 + 64 * (j))
#define XB_XGEN(j)  (2304 + 64 * (j))
#define XB_TOP      3328
#define XB_TOPGEN   3392
#define XCD_BAR_WORDS 3456
#define XB_SPIN_CAP (1u << 22)
__device__ __forceinline__ unsigned xb_ld(unsigned* p)              { return __hip_atomic_load(p, __ATOMIC_RELAXED, __HIP_MEMORY_SCOPE_AGENT); }
__device__ __forceinline__ unsigned xb_add(unsigned* p, unsigned v) { return __hip_atomic_fetch_add(p, v, __ATOMIC_RELAXED, __HIP_MEMORY_SCOPE_AGENT); }
__device__ __forceinline__ unsigned xb_xcc_id() { return (unsigned)__builtin_amdgcn_s_getreg((3 << 11) | 20) & 0xFu; }
#define XB_SPIN(cond, bar) do { unsigned _sp = 0; while (cond) { __builtin_amdgcn_s_sleep(1); \
    if ((++_sp & 255u) == 0u) { if (xb_ld(&(bar)[XB_TMO])) break; if (_sp > XB_SPIN_CAP) { atomicAdd(&(bar)[XB_TMO], 1u); break; } } } } while (0)
struct XcdBarrier { unsigned* bar; unsigned x; volatile LAS unsigned* st; };
__device__ __forceinline__ XcdBarrier xcd_barrier_post(unsigned* bar, volatile LAS unsigned* st) {
    XcdBarrier b; b.bar = bar; b.x = xb_xcc_id(); b.st = st;
    if (threadIdx.x == 0) (void)xb_add(&bar[XB_XCNT(b.x)], 1u);
    return b;
}
__device__ __forceinline__ void xcd_barrier_complete(unsigned* bar, unsigned x, unsigned& nloc, unsigned& nx) {
    const unsigned G = gridDim.x * gridDim.y * gridDim.z;
    unsigned sum, cnt, mine, sp = 0u;
    for (;;) {
        sum = 0u; cnt = 0u; mine = 0u;
#pragma unroll
        for (unsigned j = 0; j < 16; ++j) { const unsigned c = xb_ld(&bar[XB_XCNT(j)]); sum += c; cnt += (c > 0u) ? 1u : 0u; mine = (j == x) ? c : mine; }
        if (sum == G) break;
        __builtin_amdgcn_s_sleep(1);
        if ((++sp & 255u) == 0u) { if (xb_ld(&bar[XB_TMO])) break; if (sp > XB_SPIN_CAP) { atomicAdd(&bar[XB_TMO], 1u); break; } }
    }
    nloc = mine > 0u ? mine : 1u; nx = cnt > 0u ? cnt : 1u;
}
__device__ __forceinline__ void xcd_barrier(const XcdBarrier& b) {
    asm volatile("s_waitcnt vmcnt(0)" ::: "memory");
    __syncthreads();
    if (threadIdx.x == 0) {
        unsigned* bar = b.bar;
        __builtin_amdgcn_s_waitcnt(0);
        unsigned nloc = b.st[0], nx = b.st[1];
        if (nloc == 0u) { xcd_barrier_complete(bar, b.x, nloc, nx); b.st[0] = nloc; b.st[1] = nx; }
        const unsigned old = xb_add(&bar[XB_XSUB(b.x)], 1u);
        const unsigned gen = old / nloc;
        if (old + 1u == (gen + 1u) * nloc) {
            __builtin_amdgcn_fence(__ATOMIC_RELEASE, "agent");
            asm volatile("s_waitcnt vmcnt(0)" ::: "memory");
            const unsigned og = xb_add(&bar[XB_TOP], 1u);
            const unsigned tg = og / nx;
            if (og + 1u == (tg + 1u) * nx) xb_add(&bar[XB_TOPGEN], 1u);
            else XB_SPIN(xb_ld(&bar[XB_TOPGEN]) == tg, bar);
            __builtin_amdgcn_fence(__ATOMIC_ACQUIRE, "agent");
            xb_add(&bar[XB_XGEN(b.x)], 1u);
            asm volatile("s_waitcnt vmcnt(0)" ::: "memory");
        } else {
            XB_SPIN(xb_ld(&bar[XB_XGEN(b.x)]) == gen, bar);
            __builtin_amdgcn_fence(__ATOMIC_ACQUIRE, "agent");
            asm volatile("s_waitcnt vmcnt(0)" ::: "memory");
        }
    }
    __syncthreads();
}

template <int NN, bool GU, int EB>
struct MoeOrder {
    const LAS int* UL; const LAS int* PS; int n; const char* A; const char* B;
    __device__ __forceinline__ bool next(int i, pg8::Unit& u) const {
        if (i >= n) return false;
        const int w = __builtin_amdgcn_readfirstlane(UL[i]); const int e = w & 255, rt = (w >> 8) & 255, pn = w >> 16;
        const int ps = __builtin_amdgcn_readfirstlane(PS[e]);
        u.e = e; u.pn = pn; u.pm = (ps >> 8) + rt; u.slot = i;
        if (GU) { u.a = A; u.b = B + ((size_t)e * 2 * FF + (size_t)pn * 256) * DM * EB; }
        else { u.a = A + (size_t)u.pm * 256 * FF * EB; u.b = B + ((size_t)e * DM + (size_t)pn * 256) * FF * EB; }
        return true;
    }
};
template <int NN>
__device__ __forceinline__ int moe_build_units(LAS unsigned char* lds, const unsigned* ctl, int G, int c) {
    LAS int* UL = (LAS int*)(lds + TAB_UL); LAS int* PS = (LAS int*)(lds + TAB_PS); LAS int* CN = (LAS int*)(lds + TAB_CN); LAS int* NU = (LAS int*)(lds + TAB_NU); LAS int* UC = (LAS int*)(lds + TAB_UC);
    __syncthreads();
    if (threadIdx.x == 0) {
        int a = 0, uc = 0;
        for (int e = 0; e < NE; ++e) { const int cnt = (int)__hip_atomic_load(ctl + CW_CNT + e, RLX_AGENT); CN[e] = cnt; PS[e] = a; UC[e] = uc; const int nt = (cnt + 255) >> 8; a += nt << 8; uc += nt * NN; }
        PS[NE] = a; UC[NE] = uc;
        const int nwg = uc; int n = 0;
        for (int i = 0;; ++i) { const long L = (long)i * G + c; if (L >= nwg || n >= 20) break;
            const int wgid = pg8::xcd_remap((int)L, nwg);
            int e = 0; while (UC[e + 1] <= wgid) ++e;
            const int l = wgid - UC[e], nte = (CN[e] + 255) >> 8;
            const int nig = pg8::WGM * NN, gid = l / nig, fm = gid * pg8::WGM, gsz = (nte - fm) < pg8::WGM ? (nte - fm) : pg8::WGM;
            const int rt = fm + ((l % nig) % gsz), pn = (l % nig) / gsz;
            UL[n++] = e | (rt << 8) | (pn << 16); }
        NU[0] = n;
    }
    __syncthreads();
    return __builtin_amdgcn_readfirstlane(NU[0]);
}

namespace att {
using f32x16 = __attribute__((ext_vector_type(16))) float;
using s16x4 = __attribute__((ext_vector_type(4))) short;
constexpr int NW = 8, QBLK = 32, KVBLK = 64, LDQK = 64, LDV = 128;
constexpr int SHM_V = KVBLK * 128 * 2, SHM_K = KVBLK * 64 * 2;
constexpr int NSLOT = 3, OFF_V = 0, OFF_ST = NSLOT * SHM_V, OFF_K = 132096, OFF_WS = OFF_K + NSLOT * SHM_K, OFF_BT = OFF_WS + NW * 64 * 4, ATT_LDS_END = OFF_BT + 1024;
static_assert(OFF_ST + NW * 8192 <= 131072 && ATT_LDS_END <= 163840, "attention LDS map");
constexpr float THRL = 8.f;
#define KSWZ(row, colB) ((row) * 128 + ((colB) ^ ((((row) >> 1) & 7) << 4)))
#define SBAR() __builtin_amdgcn_sched_barrier(0)
__device__ __forceinline__ int crow(int r, int hi) { return (r & 3) + 8 * (r >> 2) + 4 * hi; }
__device__ __forceinline__ unsigned cvtpk(float lo, float hi) { unsigned r; asm volatile("v_cvt_pk_bf16_f32 %0, %1, %2" : "=v"(r) : "v"(lo), "v"(hi)); return r; }

__device__ __forceinline__ void partialSM(f32x16& p0, f32x16& p1, float& m_reg, float& alpha) {
  float pmax = p0[0];
#pragma unroll
  for (int r = 1; r < 16; ++r) pmax = fmaxf(pmax, p0[r]);
#pragma unroll
  for (int r = 0; r < 16; ++r) pmax = fmaxf(pmax, p1[r]);
  { auto rr = __builtin_amdgcn_permlane32_swap(__float_as_uint(pmax), __float_as_uint(pmax), false, false);
    pmax = fmaxf(__uint_as_float(rr[0]), __uint_as_float(rr[1])); }
  float mn;
  if (__builtin_expect(__all(pmax - m_reg <= THRL), 1)) { mn = m_reg; alpha = 1.f; }
  else { mn = fmaxf(m_reg, pmax); alpha = __builtin_amdgcn_exp2f(m_reg - mn); m_reg = mn; }
#pragma unroll
  for (int r = 0; r < 16; ++r) p0[r] = p0[r] - mn;
#pragma unroll
  for (int r = 0; r < 16; ++r) p1[r] = p1[r] - mn;
#pragma unroll
  for (int r = 0; r < 16; ++r) p0[r] = __builtin_amdgcn_exp2f(p0[r]);
}
__device__ __forceinline__ void finishSM(f32x16& p0, f32x16& p1, float alpha, float& l_reg, bf16x8& pa0, bf16x8& pa1, bf16x8& pa2, bf16x8& pa3) {
#pragma unroll
  for (int r = 0; r < 16; ++r) p1[r] = __builtin_amdgcn_exp2f(p1[r]);
  float ps = 0;
#pragma unroll
  for (int r = 0; r < 16; ++r) ps += p0[r];
#pragma unroll
  for (int r = 0; r < 16; ++r) ps += p1[r];
  { auto rr = __builtin_amdgcn_permlane32_swap(__float_as_uint(ps), __float_as_uint(ps), false, false);
    ps = __uint_as_float(rr[0]) + __uint_as_float(rr[1]); }
  l_reg = l_reg * alpha + ps;
#define PK4(P, BASE, OUT) do { unsigned a0 = cvtpk(P[BASE + 0], P[BASE + 1]), a1 = cvtpk(P[BASE + 2], P[BASE + 3]);   \
    unsigned b0 = cvtpk(P[BASE + 4], P[BASE + 5]), b1 = cvtpk(P[BASE + 6], P[BASE + 7]);                              \
    auto r0 = __builtin_amdgcn_permlane32_swap(a0, b0, false, false); auto r1 = __builtin_amdgcn_permlane32_swap(a1, b1, false, false); \
    u32x4 w = {r0[0], r1[0], r0[1], r1[1]}; OUT = *reinterpret_cast<bf16x8*>(&w); } while (0)
  PK4(p0, 0, pa0); PK4(p0, 8, pa1); PK4(p1, 0, pa2); PK4(p1, 8, pa3);
#undef PK4
}
__device__ __forceinline__ void qkt(f32x16& p0, f32x16& p1, const char* Ks, const bf16x8* qr, int r32, int hi) {
  p0 = f32x16{}; p1 = f32x16{};
#pragma unroll
  for (int d0 = 0; d0 < 4; ++d0) { const int cb = (d0 * 16 + hi * 8) * 2;
    const bf16x8 b0 = *reinterpret_cast<const bf16x8*>(Ks + KSWZ(r32, cb));
    const bf16x8 b1 = *reinterpret_cast<const bf16x8*>(Ks + KSWZ(32 + r32, cb));
    p0 = __builtin_amdgcn_mfma_f32_32x32x16_bf16(b0, qr[d0], p0, 0, 0, 0);
    p1 = __builtin_amdgcn_mfma_f32_32x32x16_bf16(b1, qr[d0], p1, 0, 0, 0); }
}
__device__ __forceinline__ int v_st(int k, int c) { const int kk = (k & ~0xC) | ((k & 4) << 1) | ((k & 8) >> 1); return ((kk >> 3) * 4 + (c >> 5)) * 512 + ((kk & 7) * 32 + (c & 31)) * 2; }
__device__ __forceinline__ int v_rd_base(int lane) { return ((lane & 3) << 3) | (((lane >> 2) & 3) << 6) | (((lane >> 4) & 1) << 5) | (((lane >> 5) & 1) << 8); }
constexpr int v_rd_off(int d0, int ks, int half) { return d0 * 512 + ks * 4096 + half * 2048; }
template <int OFF> __device__ __forceinline__ s16x4 tr_read(int vb) {
  s16x4 r; asm volatile("ds_read_b64_tr_b16 %0, %1 offset:%2" : "=&v"(r) : "v"(vb), "i"(OFF) : "memory"); return r;
}
typedef short v4i16_t __attribute__((ext_vector_type(4)));
template <int OFF> __device__ __forceinline__ s16x4 tr_rd(int vb) {
  return __builtin_bit_cast(s16x4, __builtin_amdgcn_ds_read_tr16_b64_v4i16((__attribute__((address_space(3))) v4i16_t*)(unsigned)(vb + OFF)));
}
template <int D0> __device__ __forceinline__ void pv_one(f32x16& od, int vb, bf16x8 pa0, bf16x8 pa1, bf16x8 pa2, bf16x8 pa3) {
  const s16x4 l0 = tr_rd<v_rd_off(D0, 0, 0)>(vb), h0 = tr_rd<v_rd_off(D0, 0, 1)>(vb), l1 = tr_rd<v_rd_off(D0, 1, 0)>(vb), h1 = tr_rd<v_rd_off(D0, 1, 1)>(vb);
  const s16x4 l2 = tr_rd<v_rd_off(D0, 2, 0)>(vb), h2 = tr_rd<v_rd_off(D0, 2, 1)>(vb), l3 = tr_rd<v_rd_off(D0, 3, 0)>(vb), h3 = tr_rd<v_rd_off(D0, 3, 1)>(vb);
#define PK(L, H) (bf16x8){L[0], L[1], L[2], L[3], H[0], H[1], H[2], H[3]}
  od = __builtin_amdgcn_mfma_f32_32x32x16_bf16(pa0, PK(l0, h0), od, 0, 0, 0);
  od = __builtin_amdgcn_mfma_f32_32x32x16_bf16(pa1, PK(l1, h1), od, 0, 0, 0);
  od = __builtin_amdgcn_mfma_f32_32x32x16_bf16(pa2, PK(l2, h2), od, 0, 0, 0);
  od = __builtin_amdgcn_mfma_f32_32x32x16_bf16(pa3, PK(l3, h3), od, 0, 0, 0);
#undef PK
}
#define PV_RD(D0, L0, H0, L1, H1, L2, H2, L3, H3) do { L0 = tr_rd<v_rd_off(D0, 0, 0)>(vb); H0 = tr_rd<v_rd_off(D0, 0, 1)>(vb); L1 = tr_rd<v_rd_off(D0, 1, 0)>(vb); H1 = tr_rd<v_rd_off(D0, 1, 1)>(vb); \
    L2 = tr_rd<v_rd_off(D0, 2, 0)>(vb); H2 = tr_rd<v_rd_off(D0, 2, 1)>(vb); L3 = tr_rd<v_rd_off(D0, 3, 0)>(vb); H3 = tr_rd<v_rd_off(D0, 3, 1)>(vb); } while (0)
#define PKV(L, H) (bf16x8){L[0], L[1], L[2], L[3], H[0], H[1], H[2], H[3]}
#define PV_MM(OD, L0, H0, L1, H1, L2, H2, L3, H3) do { OD = __builtin_amdgcn_mfma_f32_32x32x16_bf16(pa0, PKV(L0, H0), OD, 0, 0, 0); OD = __builtin_amdgcn_mfma_f32_32x32x16_bf16(pa1, PKV(L1, H1), OD, 0, 0, 0); \
    OD = __builtin_amdgcn_mfma_f32_32x32x16_bf16(pa2, PKV(L2, H2), OD, 0, 0, 0); OD = __builtin_amdgcn_mfma_f32_32x32x16_bf16(pa3, PKV(L3, H3), OD, 0, 0, 0); } while (0)
__device__ __forceinline__ void pv_d0(f32x16* o, int vb, bf16x8 pa0, bf16x8 pa1, bf16x8 pa2, bf16x8 pa3) {
  s16x4 a0, a1, a2, a3, a4, a5, a6, a7, b0, b1, b2, b3, b4, b5, b6, b7;
  PV_RD(0, a0, a1, a2, a3, a4, a5, a6, a7); PV_RD(1, b0, b1, b2, b3, b4, b5, b6, b7); SBAR();
  PV_MM(o[0], a0, a1, a2, a3, a4, a5, a6, a7); SBAR(); PV_RD(2, a0, a1, a2, a3, a4, a5, a6, a7); SBAR();
  PV_MM(o[1], b0, b1, b2, b3, b4, b5, b6, b7); SBAR(); PV_RD(3, b0, b1, b2, b3, b4, b5, b6, b7); SBAR();
  PV_MM(o[2], a0, a1, a2, a3, a4, a5, a6, a7); SBAR();
  PV_MM(o[3], b0, b1, b2, b3, b4, b5, b6, b7);
}
#undef PV_RD
#undef PV_MM
#undef PKV
__device__ __forceinline__ void bias_mask(f32x16& p0, f32x16& p1, int j, int cw, const float* bt, int qoff, int r32, int hi) {
  if (j > cw) {
#pragma unroll
    for (int r = 0; r < 16; ++r) { p0[r] = -INFINITY; p1[r] = -INFINITY; }
  } else if (j >= cw - 2) {
    const float* b = bt + (64 * (j - cw) + 192 - qoff - r32 + 4 * hi);
#pragma unroll
    for (int r = 0; r < 16; ++r) { p0[r] += b[(r & 3) + 8 * (r >> 2)]; p1[r] += b[32 + (r & 3) + 8 * (r >> 2)]; }
  }
}

__device__ __forceinline__ void glds16(const void* gsrc, unsigned lds_dst) { unsigned keep;
  asm volatile("s_mov_b32 %0, m0\n\ts_mov_b32 m0, %2\n\ts_nop 0\n\tglobal_load_lds_dwordx4 %1, off\n\ts_mov_b32 m0, %0" : "=&s"(keep) : "v"(gsrc), "s"(lds_dst) : "memory"); }
__device__ __forceinline__ void attn_unit(const Params& p, int b, int h, int m, int qb, float lam, char* lds, unsigned& g_tacc) {
  const bf16_t* PR = (const bf16_t*)(p.ws + WS_PROJ);
  int tid_ = threadIdx.x; asm volatile("" : "+v"(tid_));
  const int tid = tid_, wid = __builtin_amdgcn_readfirstlane(tid >> 6), lane = tid & 63, r32 = lane & 31, hi = lane >> 5;
  char* V_lds = lds + OFF_V; char* K_lds = lds + OFF_K;
  const unsigned ldsb = (unsigned)(uintptr_t)lds;
  float* ws = (float*)(lds + OFF_WS) + wid * 64; float* li_l = ws; float* al_l = ws + 32; float* bt = (float*)(lds + OFF_BT);
  bf16_t* stash = (bf16_t*)(lds + OFF_ST + wid * 8192);
  __syncthreads();
  if (m == 0 && tid < 256) bt[tid] = (p.rel_bias[t5_bucket(tid - 192) * 4 + h] - p.rel_bias[15 * 4 + h]) * LOG2E;
  const bf16_t* Qb = PR + 4 * pg8::SEC + ((size_t)((b * 4 + h) * 2 + m) * SEQ + qb * 256) * LDQK;
  const bf16_t* Kh = PR + 5 * pg8::SEC + (size_t)((b * 4 + h) * 2 + m) * SEQ * LDQK;
  const bf16_t* Vh = PR + 6 * pg8::SEC + (size_t)(b * 4 + h) * SEQ * LDV;
  const int cw = 4 * qb + (wid >> 1), qoff = 32 * (wid & 1);
  float l_reg = 0; f32x16 o[4] = {}; bf16x8 qr[4];
  const int krow = wid * 8 + (lane >> 3), kch = (lane & 7) ^ ((krow >> 1) & 7);
  const bf16_t* ksrc = Kh + (size_t)krow * LDQK + kch * 8;
  const bf16_t* vsrc0; const bf16_t* vsrc1;
  { const int sub0 = (wid * 2) * 2 + (lane >> 5), kk0 = (sub0 >> 2) * 8 + ((lane & 31) >> 2), k0_ = (kk0 & ~0xC) | ((kk0 & 4) << 1) | ((kk0 & 8) >> 1);
    vsrc0 = Vh + (size_t)k0_ * LDV + (sub0 & 3) * 32 + (lane & 3) * 8;
    const int sub1 = (wid * 2 + 1) * 2 + (lane >> 5), kk1 = (sub1 >> 2) * 8 + ((lane & 31) >> 2), k1_ = (kk1 & ~0xC) | ((kk1 & 4) << 1) | ((kk1 & 8) >> 1);
    vsrc1 = Vh + (size_t)k1_ * LDV + (sub1 & 3) * 32 + (lane & 3) * 8; }
#define DMA_K(tile, slot) glds16(ksrc + (size_t)(tile) * (KVBLK * LDQK), (unsigned)__builtin_amdgcn_readfirstlane((int)(ldsb + OFF_K + (slot) * SHM_K + wid * 1024)))
#define DMA_V(tile, slot) do { glds16(vsrc0 + (size_t)(tile) * (KVBLK * LDV), (unsigned)__builtin_amdgcn_readfirstlane((int)(ldsb + OFF_V + (slot) * SHM_V + wid * 2048))); \
    glds16(vsrc1 + (size_t)(tile) * (KVBLK * LDV), (unsigned)__builtin_amdgcn_readfirstlane((int)(ldsb + OFF_V + (slot) * SHM_V + wid * 2048 + 1024))); } while (0)
#define WAIT_BAR(N) asm volatile("s_waitcnt vmcnt(" #N ") lgkmcnt(0)\n\ts_barrier" ::: "memory")
  DMA_K(0, 0); DMA_V(0, 0); DMA_K(1, 1);
  const bf16_t* Qw = Qb + (size_t)(wid * QBLK + r32) * LDQK + hi * 8;
#pragma unroll
  for (int d0 = 0; d0 < 4; ++d0) qr[d0] = *reinterpret_cast<const bf16x8*>(Qw + d0 * 16);
  const int vb0 = (int)(uintptr_t)V_lds + v_rd_base(lane);
#define RESC(a) do { if (__any((a) < 1.f)) { if (hi == 0) al_l[r32] = (a); asm volatile("s_waitcnt lgkmcnt(0)" ::: "memory"); \
    _Pragma("unroll") for (int d = 0; d < 4; ++d) _Pragma("unroll") for (int r = 0; r < 16; ++r) o[d][r] *= al_l[crow(r, hi)]; } } while (0)
  f32x16 pA0, pA1, pB0, pB1; u32x4 pw0, pw1, pw2, pw3; const int NT = 4 * qb + 4;
  float mhat = 0.f; f32x16 negm = f32x16{}; asm volatile("" : "+v"(negm));
  bool resc = false;
  WAIT_BAR(0);
  DMA_K(2, 2); DMA_V(1, 1);
#define PIN(x) asm volatile("" : "+v"(x))
#define MX3(a, b, c) __builtin_fmaxf(__builtin_fmaxf((a), (b)), (c))
#define ROWMAX(C0, C1, rm) do { float a_ = MX3(C0[0], C0[1], C1[0]), b_ = MX3(C0[2], C0[3], C1[1]); a_ = MX3(a_, C1[2], C1[3]); \
    _Pragma("unroll") for (int r = 4; r < 16; r += 4) { a_ = MX3(a_, C0[r], C0[r + 1]); b_ = MX3(b_, C0[r + 2], C0[r + 3]); a_ = MX3(a_, C1[r], C1[r + 1]); b_ = MX3(b_, C1[r + 2], C1[r + 3]); } \
    rm = __builtin_fmaxf(a_, b_); { auto rr_ = __builtin_amdgcn_permlane32_swap(__float_as_uint(rm), __float_as_uint(rm), false, false); rm = __builtin_fmaxf(__uint_as_float(rr_[0]), __uint_as_float(rr_[1])); } } while (0)
#define RESCALE(C0, C1, dl) do { mhat += (dl); \
    _Pragma("unroll") for (int r = 0; r < 16; ++r) { C0[r] -= (dl); C1[r] -= (dl); } \
    _Pragma("unroll") for (int r = 0; r < 16; ++r) negm[r] = -mhat; PIN(negm); } while (0)
  { const char* Ks = K_lds;
#pragma unroll
    for (int d0 = 0; d0 < 4; ++d0) { const int cb = (d0 * 16 + hi * 8) * 2;
      const bf16x8 b0 = *reinterpret_cast<const bf16x8*>(Ks + KSWZ(r32, cb)), b1 = *reinterpret_cast<const bf16x8*>(Ks + KSWZ(32 + r32, cb));
      if (d0 == 0) { pA0 = __builtin_amdgcn_mfma_f32_32x32x16_bf16(b0, qr[0], negm, 0, 0, 0); pA1 = __builtin_amdgcn_mfma_f32_32x32x16_bf16(b1, qr[0], negm, 0, 0, 0); }
      else { pA0 = __builtin_amdgcn_mfma_f32_32x32x16_bf16(b0, qr[d0], pA0, 0, 0, 0); pA1 = __builtin_amdgcn_mfma_f32_32x32x16_bf16(b1, qr[d0], pA1, 0, 0, 0); } }
    bias_mask(pA0, pA1, 0, cw, bt, qoff, r32, hi);
    float rm; ROWMAX(pA0, pA1, rm); RESCALE(pA0, pA1, rm);
#pragma unroll
    for (int r = 0; r < 16; ++r) { pA0[r] = __builtin_amdgcn_exp2f(pA0[r]); pA1[r] = __builtin_amdgcn_exp2f(pA1[r]); } }
  int sk = 1, sv = 0;
  const bool lead = wid < 4;
#if TSEL >= 20 && TSEL < 30
  unsigned long long tq_;
#define TB() (tq_ = __builtin_amdgcn_s_memrealtime())
#define TE(k) do { if ((k) == TSEL - 20 && blockIdx.x == 0 && wid == PWAVE) g_tacc += (unsigned)(__builtin_amdgcn_s_memrealtime() - tq_); } while (0)
#else
#define TB() do {} while (0)
#define TE(k) do {} while (0)
#endif
#define WB_A(j) do { if ((j) + 2 >= NT) WAIT_BAR(0); else if (lead) WAIT_BAR(5); else WAIT_BAR(3); } while (0)
#define WB_B(j) do { if ((j) + 2 >= NT) WAIT_BAR(0); else if (lead) WAIT_BAR(4); else WAIT_BAR(3); } while (0)
#define KF(i) (*reinterpret_cast<const bf16x8*>(Kt_ + KSWZ(((i) & 1) * 32 + r32, ((((i) >> 1) * 16 + hi * 8) * 2))))
#define CVT(P, B) cvtpk(P[B], P[(B) + 1])
#define GAPA(MF, A0, A1, A2, A3, P, BA, BB, RO) do { MF; sacc += A0; sacb += A1; sacc2 += A2; sacd += A3; PIN(sacc); PIN(sacb); PIN(sacc2); PIN(sacd); \
    { const unsigned ca_ = CVT(P, BA), cb_ = CVT(P, BB); auto rr_ = __builtin_amdgcn_permlane32_swap(ca_, cb_, false, false); RO##l = rr_[0]; RO##h = rr_[1]; } SBAR(); } while (0)
#define HALF_A(j, C0, C1, P0, P1, GQ) do { TB(); WB_A(j); TE(0); TB(); \
    { const int sp = (sk == 0) ? 2 : sk - 1; if ((j) + 2 < NT) DMA_K((j) + 2, sp); } \
    const char* Kt_ = K_lds + sk * SHM_K; unsigned r0l, r0h, r1l, r1h; float sacc = P0[0], sacb = P0[1], sacc2 = 0.f, sacd = 0.f; SBAR(); \
    if (GQ) { const bf16x8 kf0 = KF(0), kf1 = KF(1), kf2 = KF(2), kf3 = KF(3), kf4 = KF(4), kf5 = KF(5), kf6 = KF(6), kf7 = KF(7); SBAR(); \
      GAPA(C0 = __builtin_amdgcn_mfma_f32_32x32x16_bf16(kf0, qr[0], negm, 0, 0, 0), P0[2], P0[3], P0[4], P0[5], P0, 0, 4, r0); \
      GAPA(C1 = __builtin_amdgcn_mfma_f32_32x32x16_bf16(kf1, qr[0], negm, 0, 0, 0), P0[6], P0[7], P0[8], P0[9], P0, 2, 6, r1); \
      pw0 = (u32x4){r0l, r1l, r0h, r1h}; \
      GAPA(C0 = __builtin_amdgcn_mfma_f32_32x32x16_bf16(kf2, qr[1], C0, 0, 0, 0), P0[10], P0[11], P0[12], P0[13], P0, 8, 12, r0); \
      GAPA(C1 = __builtin_amdgcn_mfma_f32_32x32x16_bf16(kf3, qr[1], C1, 0, 0, 0), P0[14], P0[15], P1[0], P1[1], P0, 10, 14, r1); \
      pw1 = (u32x4){r0l, r1l, r0h, r1h}; \
      GAPA(C0 = __builtin_amdgcn_mfma_f32_32x32x16_bf16(kf4, qr[2], C0, 0, 0, 0), P1[2], P1[3], P1[4], P1[5], P1, 0, 4, r0); \
      GAPA(C1 = __builtin_amdgcn_mfma_f32_32x32x16_bf16(kf5, qr[2], C1, 0, 0, 0), P1[6], P1[7], P1[8], P1[9], P1, 2, 6, r1); \
      pw2 = (u32x4){r0l, r1l, r0h, r1h}; \
      GAPA(C0 = __builtin_amdgcn_mfma_f32_32x32x16_bf16(kf6, qr[3], C0, 0, 0, 0), P1[10], P1[11], P1[12], P1[13], P1, 8, 12, r0); \
      GAPA(C1 = __builtin_amdgcn_mfma_f32_32x32x16_bf16(kf7, qr[3], C1, 0, 0, 0), P1[14], P1[15], 0.f, 0.f, P1, 10, 14, r1); \
      pw3 = (u32x4){r0l, r1l, r0h, r1h}; \
    } else { \
      GAPA((void)0, P0[2], P0[3], P0[4], P0[5], P0, 0, 4, r0); GAPA((void)0, P0[6], P0[7], P0[8], P0[9], P0, 2, 6, r1); pw0 = (u32x4){r0l, r1l, r0h, r1h}; \
      GAPA((void)0, P0[10], P0[11], P0[12], P0[13], P0, 8, 12, r0); GAPA((void)0, P0[14], P0[15], P1[0], P1[1], P0, 10, 14, r1); pw1 = (u32x4){r0l, r1l, r0h, r1h}; \
      GAPA((void)0, P1[2], P1[3], P1[4], P1[5], P1, 0, 4, r0); GAPA((void)0, P1[6], P1[7], P1[8], P1[9], P1, 2, 6, r1); pw2 = (u32x4){r0l, r1l, r0h, r1h}; \
      GAPA((void)0, P1[10], P1[11], P1[12], P1[13], P1, 8, 12, r0); GAPA((void)0, P1[14], P1[15], 0.f, 0.f, P1, 10, 14, r1); pw3 = (u32x4){r0l, r1l, r0h, r1h}; \
    } \
    l_reg += (sacc + sacb) + (sacc2 + sacd); resc = false; \
    if (GQ) { bias_mask(C0, C1, (j), cw, bt, qoff, r32, hi); float rm; ROWMAX(C0, C1, rm); \
      if (__builtin_expect(__any(rm > THRL), 0)) { const float dl = __builtin_fmaxf(rm, 0.f); RESCALE(C0, C1, dl); const float f = __builtin_amdgcn_exp2f(-dl); l_reg *= f; if (hi == 0) al_l[r32] = f; resc = true; } } \
    TE(1); } while (0)
#define PAF(k) __builtin_bit_cast(bf16x8, pw##k)
#define VFR(S, i) (bf16x8){S##l##i[0], S##l##i[1], S##l##i[2], S##l##i[3], S##h##i[0], S##h##i[1], S##h##i[2], S##h##i[3]}
#define VRD(S, D0, i) do { S##l##i = tr_rd<v_rd_off(D0, i, 0)>(vb_); S##h##i = tr_rd<v_rd_off(D0, i, 1)>(vb_); } while (0)
#define EX2(C, B) do { C[B] = __builtin_amdgcn_exp2f(C[B]); C[(B) + 1] = __builtin_amdgcn_exp2f(C[(B) + 1]); PIN(C); } while (0)
#define GAPB(OD, K, FR, EXS, RD) do { OD = __builtin_amdgcn_mfma_f32_32x32x16_bf16(PAF(K), FR, OD, 0, 0, 0); EXS; RD; SBAR(); } while (0)
#define HALF_B(j, C0, C1, GP) do { TB(); WB_B(j); TE(0); TB(); \
    { const int sn = (sk == 2) ? 0 : sk + 1; if ((j) + 1 < NT) DMA_V((j) + 1, sn); } \
    const int vb_ = vb0 + sv * SHM_V; s16x4 Fl0, Fh0, Fl1, Fh1, Fl2, Fh2, Fl3, Fh3, Gl0, Gh0, Gl1, Gh1, Gl2, Gh2, Gl3, Gh3; \
    VRD(F, 0, 0); VRD(F, 0, 1); VRD(F, 0, 2); VRD(F, 0, 3); SBAR(); \
    SBAR(); \
    GAPB(o[0], 0, VFR(F, 0), if (GP) EX2(C0, 0), VRD(G, 1, 0)); GAPB(o[0], 1, VFR(F, 1), if (GP) EX2(C0, 2), VRD(G, 1, 1)); \
    GAPB(o[0], 2, VFR(F, 2), if (GP) EX2(C0, 4), VRD(G, 1, 2)); GAPB(o[0], 3, VFR(F, 3), if (GP) EX2(C0, 6), VRD(G, 1, 3)); \
    GAPB(o[1], 0, VFR(G, 0), if (GP) EX2(C0, 8), VRD(F, 2, 0)); GAPB(o[1], 1, VFR(G, 1), if (GP) EX2(C0, 10), VRD(F, 2, 1)); \
    GAPB(o[1], 2, VFR(G, 2), if (GP) EX2(C0, 12), VRD(F, 2, 2)); GAPB(o[1], 3, VFR(G, 3), if (GP) EX2(C0, 14), VRD(F, 2, 3)); \
    GAPB(o[2], 0, VFR(F, 0), if (GP) EX2(C1, 0), VRD(G, 3, 0)); GAPB(o[2], 1, VFR(F, 1), if (GP) EX2(C1, 2), VRD(G, 3, 1)); \
    GAPB(o[2], 2, VFR(F, 2), if (GP) EX2(C1, 4), VRD(G, 3, 2)); GAPB(o[2], 3, VFR(F, 3), if (GP) EX2(C1, 6), VRD(G, 3, 3)); \
    GAPB(o[3], 0, VFR(G, 0), if (GP) EX2(C1, 8), (void)0); GAPB(o[3], 1, VFR(G, 1), if (GP) EX2(C1, 10), (void)0); \
    GAPB(o[3], 2, VFR(G, 2), if (GP) EX2(C1, 12), (void)0); GAPB(o[3], 3, VFR(G, 3), if (GP) EX2(C1, 14), (void)0); \
    if (resc) { asm volatile("s_waitcnt lgkmcnt(0)" ::: "memory"); \
      _Pragma("unroll") for (int d = 0; d < 4; ++d) _Pragma("unroll") for (int r = 0; r < 16; ++r) o[d][r] *= al_l[crow(r, hi)]; } \
    TE(2); sv = sk; sk = (sk == 2) ? 0 : sk + 1; } while (0)
  if (!lead) { asm volatile("s_barrier" ::: "memory"); __builtin_amdgcn_s_setprio(1); }
  for (int j = 1; j + 1 < NT; j += 2) {
    HALF_A(j, pB0, pB1, pA0, pA1, true); HALF_B(j, pB0, pB1, true);
    HALF_A(j + 1, pA0, pA1, pB0, pB1, true); HALF_B(j + 1, pA0, pA1, true);
  }
  HALF_A(NT - 1, pB0, pB1, pA0, pA1, true); HALF_B(NT - 1, pB0, pB1, true);
  HALF_A(NT, pA0, pA1, pB0, pB1, false); HALF_B(NT, pA0, pA1, false);
  if (lead) asm volatile("s_waitcnt lgkmcnt(0)\n\ts_barrier" ::: "memory");
  else __builtin_amdgcn_s_setprio(0);
  { auto rr_ = __builtin_amdgcn_permlane32_swap(__float_as_uint(l_reg), __float_as_uint(l_reg), false, false); l_reg = __uint_as_float(rr_[0]) + __uint_as_float(rr_[1]); }
#undef HALF_A
#undef HALF_B
#undef GAPA
#undef GAPB
#undef WB_A
#undef WB_B
#undef KF
#undef CVT
#undef PAF
#undef VFR
#undef VRD
#undef EX2
#undef PIN
#undef MX3
#undef ROWMAX
#undef RESCALE
#undef DMA_K
#undef DMA_V
#undef WAIT_BAR
  if (hi == 0) li_l[r32] = l_reg; asm volatile("s_waitcnt lgkmcnt(0)" ::: "memory");
  float rli[16];
#pragma unroll
  for (int r = 0; r < 16; ++r) rli[r] = __builtin_amdgcn_rcpf(li_l[crow(r, hi)]);
  int r32e = r32, hie = hi, lanee = lane; asm volatile("" : "+v"(r32e), "+v"(hie), "+v"(lanee));
  bf16_t* st = stash + r32e;
  if (m == 0) {
#pragma unroll
    for (int r = 0; r < 16; ++r) { const int orow = crow(r, hie);
#pragma unroll
      for (int d0 = 0; d0 < 4; ++d0) st[orow * 128 + d0 * 32] = (bf16_t)f2bf(o[d0][r] * rli[r]); }
  } else {
    float gv[4];
#pragma unroll
    for (int d0 = 0; d0 < 4; ++d0) gv[d0] = p.diff_norm_g[d0 * 32 + r32e] * 0.8f;
#pragma unroll
    for (int r = 0; r < 16; ++r) { const int orow = crow(r, hie); float s = 0.f; float av[4];
#pragma unroll
      for (int d0 = 0; d0 < 4; ++d0) { av[d0] = bf2f(st[orow * 128 + d0 * 32]) - lam * (o[d0][r] * rli[r]); s += av[d0] * av[d0]; }
#pragma unroll
      for (int of = 1; of < 32; of <<= 1) s += __shfl_xor(s, of);
      const float rs = rsqrtf(s * (1.f / 128.f) + EPS);
#pragma unroll
      for (int d0 = 0; d0 < 4; ++d0) st[orow * 128 + d0 * 32] = (bf16_t)f2bf(av[d0] * rs * gv[d0]); }
    asm volatile("s_waitcnt lgkmcnt(0)" ::: "memory");
    bf16_t* Mw = (bf16_t*)(p.ws + WS_MIX) + (size_t)(b * SEQ + qb * 256 + wid * QBLK + (lanee >> 4)) * DM + 512 + h * 128 + (lanee & 15) * 8;
    const bf16_t* sr2 = stash + (lanee >> 4) * 128 + (lanee & 15) * 8;
#pragma unroll
    for (int i = 0; i < 8; ++i) *(u32x4*)(Mw + (size_t)(i * 4) * DM) = *(const u32x4*)(sr2 + i * 4 * 128);
  }
#undef RESC
}
#undef SBAR
#undef KSWZ
}

namespace ml {
using att::f32x16; using att::s16x4; using att::crow; using att::v_st; using att::v_rd_base; using att::v_rd_off; using att::tr_read;
constexpr int ML_Q = 0, ML_K = 16384, ML_V = 32768, ML_KW = 49152, ML_W = 49152, ML_H = 65536, ML_G = 98304, ML_CW = 100352;
constexpr size_t MS_GS = WS_XN + 48 * MiB;
constexpr float KSCALE = 0.08838834764831845f;
#define QSWZ(row, colB) ((row) * 256 + ((colB) ^ (((row) & 7) << 4)))
#define WSWZ(row, colB) ((row) * 128 + ((colB) ^ ((((row) >> 1) & 7) << 4)))
#define PKF(L, H) (bf16x8){L[0], L[1], L[2], L[3], H[0], H[1], H[2], H[3]}
__device__ __forceinline__ float wave_incl_scan_add(float v, int lane) {
#pragma unroll
  for (int o = 1; o < 64; o <<= 1) { const float t = __shfl_up(v, o); if (lane >= o) v += t; }
  return v;
}
__device__ __forceinline__ float wave_incl_scan_max(float v, int lane) {
#pragma unroll
  for (int o = 1; o < 64; o <<= 1) { const float t = __shfl_up(v, o); if (lane >= o) v = fmaxf(v, t); }
  return v;
}
__device__ __forceinline__ float wave_max(float v) {
#pragma unroll
  for (int o = 1; o < 64; o <<= 1) v = fmaxf(v, __shfl_xor(v, o));
  return v;
}
struct Raw16 { u32x4 r[4][2]; };
__device__ __forceinline__ void raw16_load(const Params& p, Raw16& R, int b, int c, int s, int sec, int h, int d0) {
  const bf16_t* PR = (const bf16_t*)(p.ws + WS_PROJ) + (size_t)sec * pg8::SEC + (size_t)(b * 4 + h) * SEQ * 128;
  const int tl = c * 64 + s;
#pragma unroll
  for (int j = 0; j < 4; ++j) { const int tt = tl - 3 + j;
    if (tt >= 0) { const bf16_t* rp = PR + (size_t)tt * 128 + d0; R.r[j][0] = *(const u32x4*)rp; R.r[j][1] = *(const u32x4*)(rp + 8); }
    else { R.r[j][0] = (u32x4){0u, 0u, 0u, 0u}; R.r[j][1] = (u32x4){0u, 0u, 0u, 0u}; } }
}
__device__ __forceinline__ void conv16_compute(const float* cw, const float* cb, float (&y)[16], const Raw16& R, int cch, int d0) {
#pragma unroll
  for (int q = 0; q < 4; ++q) { const f32x4 bb = *(const f32x4*)(cb + cch + d0 + 4 * q); y[4 * q] = bb.x; y[4 * q + 1] = bb.y; y[4 * q + 2] = bb.z; y[4 * q + 3] = bb.w; }
#pragma unroll
  for (int j = 0; j < 4; ++j) { const unsigned rw[8] = {R.r[j][0].x, R.r[j][0].y, R.r[j][0].z, R.r[j][0].w, R.r[j][1].x, R.r[j][1].y, R.r[j][1].z, R.r[j][1].w};
#pragma unroll
    for (int q = 0; q < 4; ++q) { const f32x4 w = *(const f32x4*)(cw + j * 1024 + cch + d0 + 4 * q);
      y[4 * q] += w.x * __uint_as_float(rw[2 * q] << 16); y[4 * q + 1] += w.y * __uint_as_float(rw[2 * q] & 0xffff0000u);
      y[4 * q + 2] += w.z * __uint_as_float(rw[2 * q + 1] << 16); y[4 * q + 3] += w.w * __uint_as_float(rw[2 * q + 1] & 0xffff0000u); } }
#pragma unroll
  for (int i = 0; i < 16; ++i) y[i] = y[i] * __builtin_amdgcn_rcpf(1.f + __builtin_amdgcn_exp2f(-LOG2E * y[i]));
}
__device__ __forceinline__ void conv16(const Params& p, float (&y)[16], int b, int c, int s, int sec, int h, int cch, int d0) {
  Raw16 R; raw16_load(p, R, b, c, s, sec, h, d0); conv16_compute(p.conv_w, p.conv_b, y, R, cch, d0);
}
__device__ __forceinline__ u32x4 pack8(const float* y) { u32x4 w; w.x = pg8::cvt_pk_bf16(y[0], y[1]); w.y = pg8::cvt_pk_bf16(y[2], y[3]); w.z = pg8::cvt_pk_bf16(y[4], y[5]); w.w = pg8::cvt_pk_bf16(y[6], y[7]); return w; }

__device__ __forceinline__ void conv_weights_to_lds(const Params& p, char* lds) {
  float* cwl = (float*)(lds + ML_CW);
  for (int i = threadIdx.x; i < 5120; i += NTHR) cwl[i] = (i < 4096) ? p.conv_w[i] : p.conv_b[i - 4096];
  __syncthreads();
}
#define LBAR() asm volatile("s_waitcnt lgkmcnt(0)\n\ts_barrier" ::: "memory")
struct MaRaw { Raw16 k; u32x4 v0, v1; float li, lf; };
__device__ __forceinline__ void ma_load(const Params& p, MaRaw& R, int item, int tid) {
  const int bh = item / NCH, c = item % NCH, b = bh >> 2, h = bh & 3, s = tid >> 3, d0 = (tid & 7) * 16, lane = tid & 63;
  const bf16_t* PR = (const bf16_t*)(p.ws + WS_PROJ); const float* gates = (const float*)(p.ws + WS_GATES);
  raw16_load(p, R.k, b, c, s, 1, h, d0);
  const bf16_t* vp = PR + 2 * pg8::SEC + ((size_t)(b * 4 + h) * SEQ + c * 64 + s) * 128 + d0; R.v0 = *(const u32x4*)vp; R.v1 = *(const u32x4*)(vp + 8);
  const size_t gt = (size_t)b * SEQ + c * 64 + lane; R.li = gates[gt * 8 + h]; R.lf = gates[gt * 8 + 4 + h];
}
__device__ __forceinline__ void mlstm_a_phase(const Params& p, int vcu, int G, char* lds) {
  bf16_t* MU = (bf16_t*)(p.ws + WS_MU); float* NU = (float*)(p.ws + MS_NU); float* msc = (float*)(p.ws + MS_MSC); f32x4* GS = (f32x4*)(p.ws + MS_GS);
  const float* cwl = (const float*)(lds + ML_CW); const float* cbl = cwl + 4096;
  conv_weights_to_lds(p, lds);
  MaRaw P;
  if (vcu < 16 * NCH) ma_load(p, P, vcu, threadIdx.x);
  for (int item = vcu; item < 16 * NCH; item += G) {
    int tid_ = threadIdx.x; asm volatile("" : "+v"(tid_));
    const int tid = tid_, wid = __builtin_amdgcn_readfirstlane(tid >> 6), lane = tid & 63, r32 = lane & 31, hi = lane >> 5;
    const int bh = item / NCH, c = item % NCH, b = bh >> 2, h = bh & 3;
    float wrow;
    { const float li = P.li, lf = log_sigmoid(P.lf);
      const float bc = wave_incl_scan_add(lf, lane); const float blast = __shfl(bc, 63); const float g = blast - bc + li; const float gmax = wave_max(g);
      const float wl = __expf(g - gmax); wrow = __shfl(wl, 8 * wid + (lane >> 3));
      if (wid == 0) { const float a = li - bc; const float pm = wave_incl_scan_max(a, lane);
        GS[((size_t)b * SEQ + c * 64 + lane) * 4 + h] = (f32x4){bc, a, pm, 0.f}; if (lane == 0) { msc[item] = blast; msc[2048 + item] = gmax; } } }
    LBAR();
    { const int s = tid >> 3, d0 = (tid & 7) * 16; float y[16];
      conv16_compute(cwl, cbl, y, P.k, 512 + h * 128, d0);
      const float w = wrow * KSCALE;
#pragma unroll
      for (int i = 0; i < 16; ++i) y[i] *= w;
      *(u32x4*)(lds + ML_KW + v_st(s, d0)) = pack8(y); *(u32x4*)(lds + ML_KW + v_st(s, d0 + 8)) = pack8(y + 8);
      *(u32x4*)(lds + ML_V + v_st(s, d0)) = P.v0; *(u32x4*)(lds + ML_V + v_st(s, d0 + 8)) = P.v1; }
    LBAR();
    if (item + G < 16 * NCH) ma_load(p, P, item + G, tid);
    const int ei = wid >> 1, dj0 = 2 * (wid & 1);
    const int vbV = (int)(uintptr_t)(lds + ML_V) + v_rd_base(lane) + ei * 512, vbK = (int)(uintptr_t)(lds + ML_KW) + v_rd_base(lane) + dj0 * 512;
    f32x16 acc0 = {}, acc1 = {}, accn0 = {}, accn1 = {};
    const bf16x8 ones = {0x3F80, 0x3F80, 0x3F80, 0x3F80, 0x3F80, 0x3F80, 0x3F80, 0x3F80};
#define MLA_STEP(KS) do { const s16x4 al = tr_read<v_rd_off(0, KS, 0)>(vbV), ah = tr_read<v_rd_off(0, KS, 1)>(vbV); \
      const s16x4 b0l = tr_read<v_rd_off(0, KS, 0)>(vbK), b0h = tr_read<v_rd_off(0, KS, 1)>(vbK), b1l = tr_read<v_rd_off(1, KS, 0)>(vbK), b1h = tr_read<v_rd_off(1, KS, 1)>(vbK); \
      asm volatile("s_waitcnt lgkmcnt(0)" ::: "memory"); __builtin_amdgcn_sched_barrier(0); \
      acc0 = __builtin_amdgcn_mfma_f32_32x32x16_bf16(PKF(al, ah), PKF(b0l, b0h), acc0, 0, 0, 0); acc1 = __builtin_amdgcn_mfma_f32_32x32x16_bf16(PKF(al, ah), PKF(b1l, b1h), acc1, 0, 0, 0); \
      if (ei == 0) { accn0 = __builtin_amdgcn_mfma_f32_32x32x16_bf16(ones, PKF(b0l, b0h), accn0, 0, 0, 0); accn1 = __builtin_amdgcn_mfma_f32_32x32x16_bf16(ones, PKF(b1l, b1h), accn1, 0, 0, 0); } } while (0)
    MLA_STEP(0); MLA_STEP(1); MLA_STEP(2); MLA_STEP(3);
#undef MLA_STEP
    bf16_t* uo = MU + (size_t)item * 16384;
#pragma unroll
    for (int r = 0; r < 16; ++r) { const int e = 32 * ei + crow(r, hi);
      uo[e * 128 + 32 * dj0 + r32] = (bf16_t)f2bf(acc0[r]); uo[e * 128 + 32 * (dj0 + 1) + r32] = (bf16_t)f2bf(acc1[r]); }
    if (ei == 0 && hi == 0) { NU[(size_t)item * 128 + 32 * dj0 + r32] = accn0[0]; NU[(size_t)item * 128 + 32 * (dj0 + 1) + r32] = accn1[0]; }
  }
  __syncthreads();
}

__device__ __forceinline__ void mlstm_scan_item(const Params& p, int item, char* lds) {
  float* dec = (float*)(lds + ML_G); float* ac = dec + NCH;
  const unsigned* MU = (const unsigned*)(p.ws + WS_MU); unsigned* MC = (unsigned*)(p.ws + WS_MC);
  const float* NU = (const float*)(p.ws + MS_NU); float* NC = (float*)(p.ws + MS_NC); float* msc = (float*)(p.ws + MS_MSC);
  const int bh = item >> 4, eb = item & 15; const int lane = threadIdx.x & 63;
  __syncthreads();
  if (threadIdx.x < 64) { float Bc = 0.f, pm = 0.f, mcar = 0.f;
    for (int half = 0; half < 2; ++half) { const int c = half * 64 + lane;
      const float bl = msc[bh * NCH + c], gm = msc[2048 + bh * NCH + c];
      const float Bi = Bc + wave_incl_scan_add(bl, lane);
      const float px = fmaxf(pm, wave_incl_scan_max(gm - Bi, lane));
      const float m1 = Bi + px; float m0 = __shfl_up(m1, 1); if (lane == 0) m0 = mcar;
      dec[c] = __expf(bl + m0 - m1); ac[c] = __expf(gm - m1);
      if (eb == 0) msc[4096 + bh * NCH + c] = m0;
      Bc = __shfl(Bi, 63); pm = __shfl(px, 63); mcar = __shfl(m1, 63); } }
  __syncthreads();
  const int idx = eb * 512 + threadIdx.x;
  const bool ndo = (eb == 0 && threadIdx.x < 128);
  float C0 = 0.f, C1 = 0.f, nst = 0.f;
#pragma unroll 16
  for (int c = 0; c < NCH; ++c) { const size_t o = ((size_t)(bh * NCH + c)) * 8192 + idx; const unsigned u = MU[o];
    const size_t on = ((size_t)(bh * NCH + c)) * 128 + (threadIdx.x & 127); const float nu = ndo ? NU[on] : 0.f;
    MC[o] = pk2(C0, C1); C0 = dec[c] * C0 + ac[c] * __uint_as_float(u << 16); C1 = dec[c] * C1 + ac[c] * __uint_as_float(u & 0xffff0000u);
    if (ndo) { NC[on] = nst; nst = dec[c] * nst + ac[c] * nu; } }
}

#if TSEL >= 40 && TSEL < 50
#define MTB() (mtq_ = __builtin_amdgcn_s_memrealtime())
#define MTE(k) do { if ((k) == TSEL - 40 && blockIdx.x == 0 && wid == PWAVE) g_tacc += (unsigned)(__builtin_amdgcn_s_memrealtime() - mtq_); } while (0)
#else
#define MTB() do {} while (0)
#define MTE(k) do {} while (0)
#endif
struct McRaw { Raw16 q, k; u32x4 v0, v1; f32x4 gs; float mc; f32x4 nc[4]; };
__device__ __forceinline__ void mc_load(const Params& p, McRaw& R, int item, int tid) {
  const int bh = item / NCH, c = item % NCH, b = bh >> 2, h = bh & 3, s = tid >> 3, d0 = (tid & 7) * 16, lane = tid & 63;
  const bf16_t* PR = (const bf16_t*)(p.ws + WS_PROJ);
  const float* NC = (const float*)(p.ws + MS_NC); const float* msc = (const float*)(p.ws + MS_MSC);
  raw16_load(p, R.q, b, c, s, 0, h, d0); raw16_load(p, R.k, b, c, s, 1, h, d0);
  const bf16_t* vp = PR + 2 * pg8::SEC + ((size_t)(b * 4 + h) * SEQ + c * 64 + s) * 128 + d0; R.v0 = *(const u32x4*)vp; R.v1 = *(const u32x4*)(vp + 8);
  const size_t gt = (size_t)b * SEQ + c * 64 + lane; R.gs = ((const f32x4*)(p.ws + MS_GS))[gt * 4 + h]; R.mc = msc[4096 + item];
#pragma unroll
  for (int q = 0; q < 4; ++q) R.nc[q] = *(const f32x4*)(NC + (size_t)item * 128 + d0 + 4 * q);
}
__device__ __forceinline__ void mlstm_c_phase(const Params& p, int vcu, int G, char* lds, unsigned& g_tacc) {
  unsigned long long mtq_ = 0; (void)mtq_;
  const bf16_t* PR = (const bf16_t*)(p.ws + WS_PROJ); const bf16_t* MC = (const bf16_t*)(p.ws + WS_MC); bf16_t* MIX = (bf16_t*)(p.ws + WS_MIX);
  float* Gf = (float*)(lds + ML_G); float* bm = Gf; float* as_ = Gf + 64; float* mxv = Gf + 128; float* scv = Gf + 192; float* qn = Gf + 256;
  float* H = (float*)(lds + ML_H);
  const float* cwl = (const float*)(lds + ML_CW); const float* cbl = cwl + 4096;
  conv_weights_to_lds(p, lds);
  McRaw P;
  if (vcu < 16 * NCH) mc_load(p, P, vcu, threadIdx.x);
  for (int item = vcu; item < 16 * NCH; item += G) {
    int tid_ = threadIdx.x; asm volatile("" : "+v"(tid_));
    const int tid = tid_, wid = __builtin_amdgcn_readfirstlane(tid >> 6), lane = tid & 63, r32 = lane & 31, hi = lane >> 5;
    const int bh = item / NCH, c = item % NCH, b = bh >> 2, h = bh & 3;
    const int s_ = tid >> 3, d0_ = (tid & 7) * 16;
    MTB();
    bf16x8 ctf[8];
    { const bf16_t* ct = MC + (size_t)item * 16384 + (size_t)(32 * (wid & 3) + r32) * 128 + hi * 8;
#pragma unroll
      for (int ks = 0; ks < 8; ++ks) ctf[ks] = *(const bf16x8*)(ct + ks * 16); }
    LBAR(); MTB();
    if (wid == 0) { const float bc = P.gs.x, a = P.gs.y, pm = P.gs.z;
      const float mc = P.mc; const float mx = bc + fmaxf(mc, pm);
      bm[lane] = bc - mx; as_[lane] = a; mxv[lane] = mx; scv[lane] = __expf(bc + mc - mx); }
    { const int s = s_, d0 = d0_; float y[16];
      conv16_compute(cwl, cbl, y, P.q, h * 128, d0);
      float part = 0.f;
#pragma unroll
      for (int q = 0; q < 4; ++q) { const f32x4 nv = P.nc[q]; part += y[4 * q] * nv.x + y[4 * q + 1] * nv.y + y[4 * q + 2] * nv.z + y[4 * q + 3] * nv.w; }
      part += __shfl_xor(part, 1); part += __shfl_xor(part, 2); part += __shfl_xor(part, 4);
      if ((tid & 7) == 0) qn[s] = part;
      *(u32x4*)(lds + ML_Q + QSWZ(s, d0 * 2)) = pack8(y); *(u32x4*)(lds + ML_Q + QSWZ(s, d0 * 2 + 16)) = pack8(y + 8);
      conv16_compute(cwl, cbl, y, P.k, 512 + h * 128, d0);
#pragma unroll
      for (int i = 0; i < 16; ++i) y[i] *= KSCALE;
      *(u32x4*)(lds + ML_K + QSWZ(s, d0 * 2)) = pack8(y); *(u32x4*)(lds + ML_K + QSWZ(s, d0 * 2 + 16)) = pack8(y + 8);
      *(u32x4*)(lds + ML_V + v_st(s, d0)) = P.v0; *(u32x4*)(lds + ML_V + v_st(s, d0 + 8)) = P.v1; }
    LBAR(); MTE(0); MTB();
    if (item + G < 16 * NCH) mc_load(p, P, item + G, tid);
    const bf16_t* mo_ = PR + 3 * pg8::SEC + ((size_t)(b * 4 + h) * SEQ + c * 64 + s_) * 128 + d0_; const u32x4 mo0 = *(const u32x4*)mo_, mo1 = *(const u32x4*)(mo_ + 8);
    MTE(4); MTB();
    if (wid < 4) {
      const int ti = wid >> 1, si = wid & 1; f32x16 acc = {};
      if (si <= ti) { bf16x8 fa[8], fb[8];
#pragma unroll
        for (int ks = 0; ks < 8; ++ks) { const int cb = (ks * 16 + hi * 8) * 2;
          fa[ks] = *(const bf16x8*)(lds + ML_Q + QSWZ(32 * ti + r32, cb)); fb[ks] = *(const bf16x8*)(lds + ML_K + QSWZ(32 * si + r32, cb)); }
#pragma unroll
        for (int ks = 0; ks < 8; ++ks) acc = __builtin_amdgcn_mfma_f32_32x32x16_bf16(fa[ks], fb[ks], acc, 0, 0, 0);
      }
      asm volatile("" : "+v"(acc)); MTE(5); MTB();
      const int s = 32 * si + r32; const float av = as_[s]; float bmv[16];
#pragma unroll
      for (int r = 0; r < 16; ++r) bmv[r] = bm[32 * ti + crow(r, hi)];
#pragma unroll
      for (int r = 0; r < 16; ++r) { const int t = 32 * ti + crow(r, hi); const float w = __expf(fminf(bmv[r] + av, 0.f)) * acc[r];
        *(bf16_t*)(lds + ML_W + WSWZ(t, s * 2)) = (bf16_t)f2bf((s <= t) ? w : 0.f); }
    }
    LBAR(); MTE(1); MTB();
    { const int ti = wid >> 2, ej = wid & 3; f32x16 acc = {}, accd = {};
      { bf16x8 fa[8];
#pragma unroll
        for (int ks = 0; ks < 8; ++ks) fa[ks] = *(const bf16x8*)(lds + ML_Q + QSWZ(32 * ti + r32, (ks * 16 + hi * 8) * 2));
#pragma unroll
        for (int ks = 0; ks < 8; ++ks) acc = __builtin_amdgcn_mfma_f32_32x32x16_bf16(fa[ks], ctf[ks], acc, 0, 0, 0); }
      { float sv0[16];
#pragma unroll
        for (int r = 0; r < 16; ++r) sv0[r] = scv[32 * ti + crow(r, hi)];
#pragma unroll
        for (int r = 0; r < 16; ++r) acc[r] *= sv0[r]; }
      const int vbV = (int)(uintptr_t)(lds + ML_V) + v_rd_base(lane) + ej * 512;
      const bf16x8 ones = {0x3F80, 0x3F80, 0x3F80, 0x3F80, 0x3F80, 0x3F80, 0x3F80, 0x3F80};
#define MLC_STEP(KS) do { const s16x4 bl = tr_read<v_rd_off(0, KS, 0)>(vbV), bh_ = tr_read<v_rd_off(0, KS, 1)>(vbV); \
        const bf16x8 a = *(const bf16x8*)(lds + ML_W + WSWZ(32 * ti + r32, (KS * 16 + hi * 8) * 2)); \
        asm volatile("s_waitcnt lgkmcnt(0)" ::: "memory"); __builtin_amdgcn_sched_barrier(0); \
        acc = __builtin_amdgcn_mfma_f32_32x32x16_bf16(a, PKF(bl, bh_), acc, 0, 0, 0); accd = __builtin_amdgcn_mfma_f32_32x32x16_bf16(a, ones, accd, 0, 0, 0); } while (0)
      MLC_STEP(0); MLC_STEP(1); MLC_STEP(2); MLC_STEP(3);
#undef MLC_STEP
      float sv_[16], qv_[16], mv_[16];
#pragma unroll
      for (int r = 0; r < 16; ++r) { const int t = 32 * ti + crow(r, hi); sv_[r] = scv[t]; qv_[r] = qn[t]; mv_[r] = mxv[t]; }
#pragma unroll
      for (int r = 0; r < 16; ++r) { const int t = 32 * ti + crow(r, hi); const float den = accd[r] + sv_[r] * qv_[r]; const float dn = fmaxf(fabsf(den), __expf(-mv_[r]));
        H[t * 128 + 32 * ej + r32] = acc[r] * __builtin_amdgcn_rcpf(dn); }
    }
    LBAR(); MTE(2); MTB();
    { const int t = s_, e0 = d0_; float y[16]; float ss = 0.f;
#pragma unroll
      for (int q = 0; q < 4; ++q) { const f32x4 v = *(const f32x4*)(H + t * 128 + e0 + 4 * q); y[4 * q] = v.x; y[4 * q + 1] = v.y; y[4 * q + 2] = v.z; y[4 * q + 3] = v.w; ss += v.x * v.x + v.y * v.y + v.z * v.z + v.w * v.w; }
      ss += __shfl_xor(ss, 1); ss += __shfl_xor(ss, 2); ss += __shfl_xor(ss, 4);
      const float rstd = rsqrtf(ss * (1.f / 128.f) + EPS);
      const size_t row = (size_t)b * SEQ + c * 64 + t; const int ch = h * 128 + e0;
      const unsigned mw[8] = {mo0.x, mo0.y, mo0.z, mo0.w, mo1.x, mo1.y, mo1.z, mo1.w};
      float gn[16];
#pragma unroll
      for (int q = 0; q < 4; ++q) { const f32x4 gq = *(const f32x4*)(p.mlstm_norm_g + ch + 4 * q); gn[4 * q] = gq.x; gn[4 * q + 1] = gq.y; gn[4 * q + 2] = gq.z; gn[4 * q + 3] = gq.w; }
#pragma unroll
      for (int i = 0; i < 16; ++i) { const float mov = (i & 1) ? __uint_as_float(mw[i >> 1] & 0xffff0000u) : __uint_as_float(mw[i >> 1] << 16);
        y[i] = y[i] * rstd * gn[i] * __builtin_amdgcn_rcpf(1.f + __builtin_amdgcn_exp2f(-LOG2E * mov)); }
      bf16_t* op = MIX + row * DM + ch; *(u32x4*)op = pack8(y); *(u32x4*)(op + 8) = pack8(y + 8); }
    MTE(3);
  }
}
#undef LBAR
#undef QSWZ
#undef WSWZ
#undef PKF
}

__device__ __forceinline__ void phase_combine(const Params& p, int vcu, int G, int wave, int lane) {
    const float lam = __expf(wave_sum(p.lam_q1[lane] * p.lam_k1[lane])) - __expf(wave_sum(p.lam_q2[lane] * p.lam_k2[lane])) + 0.2f;
    const float* AO = (const float*)(p.ws + WS_AO); bf16_t* MIX = (bf16_t*)(p.ws + WS_MIX);
    const float g0 = p.diff_norm_g[2 * lane] * 0.8f, g1 = p.diff_norm_g[2 * lane + 1] * 0.8f;
    for (int it = vcu * NWAVES + wave; it < T * 4; it += G * NWAVES) {
        const float* o1 = AO + (size_t)it * 256; const float* o2 = o1 + 128;
        const float a0 = o1[2 * lane] - lam * o2[2 * lane], a1 = o1[2 * lane + 1] - lam * o2[2 * lane + 1];
        const float rstd = rsqrtf(wave_sum(a0 * a0 + a1 * a1) * (1.f / 128.f) + EPS);
        const int t = it >> 2, h = it & 3;
        *(unsigned*)(MIX + (size_t)t * DM + 512 + h * 128 + 2 * lane) = pk2(a0 * rstd * g0, a1 * rstd * g1);
    }
}
__device__ __forceinline__ unsigned bf16_hi_lo(float x, float& lo) { const unsigned h = f2bf(x); lo = x - __uint_as_float(h << 16); return h; }
__device__ __forceinline__ void phase_route(const Params& p, unsigned char* lds, int vcu, int G, int wave, int lane) {
    constexpr int UP = 1032;
    bf16_t* UH = (bf16_t*)lds; bf16_t* UL = UH + 16 * UP;
    float* part = (float*)(lds + 67584);
    int* cnt = (int*)(lds + 83968); int* base = cnt + 32; int* cnt2 = cnt + 64; int* pel = cnt + 96;
    unsigned char* U2 = (unsigned char*)(p.ws + WS_U2); unsigned* ctl = (unsigned*)(p.ws + WS_CTL);
    int* list = (int*)(p.ws + MS_LIST); int* pe = (int*)(p.ws + MS_PE); int* pp = (int*)(p.ws + MS_PP); float* pg = (float*)(p.ws + MS_PG);
    const int RPW = T / G;
    const int fr = lane & 15, fq = lane >> 4;
    __syncthreads();
    if (threadIdx.x < 96) cnt[threadIdx.x] = 0;
    bf16x8 bh[4][2], bl[4][2];
#pragma unroll
    for (int ks = 0; ks < 4; ++ks)
#pragma unroll
        for (int nt = 0; nt < 2; ++nt) { const float* w0 = p.router_w + (size_t)(128 * wave + 32 * ks + 8 * fq) * NE + 16 * nt + fr; unsigned hw[8], lw[8];
#pragma unroll
            for (int j = 0; j < 8; ++j) { float lo; hw[j] = bf16_hi_lo(w0[(size_t)j * NE], lo); lw[j] = f2bf(lo); }
            const u32x4 hv = {hw[0] | (hw[1] << 16), hw[2] | (hw[3] << 16), hw[4] | (hw[5] << 16), hw[6] | (hw[7] << 16)}, lv = {lw[0] | (lw[1] << 16), lw[2] | (lw[3] << 16), lw[4] | (lw[5] << 16), lw[6] | (lw[7] << 16)};
            bh[ks][nt] = __builtin_bit_cast(bf16x8, hv); bl[ks][nt] = __builtin_bit_cast(bf16x8, lv); }
    const int e = lane & 31, half = lane >> 5;
    const float rb = p.router_b[e];
    f32x4 v[2][4];
    const bf16_t* H1 = (const bf16_t*)(p.ws + WS_H1);
#define LD_H1(dst, rowp) do { const u32x2* xr_ = (const u32x2*)(rowp) + lane; _Pragma("unroll") for (int j = 0; j < 4; ++j) { const u32x2 w_ = xr_[64 * j]; \
        dst[j] = (f32x4){__uint_as_float(w_.x << 16), __uint_as_float(w_.x & 0xffff0000u), __uint_as_float(w_.y << 16), __uint_as_float(w_.y & 0xffff0000u)}; } } while (0)
    for (int q = 0; q < 2; ++q) LD_H1(v[q], H1 + (size_t)(vcu * RPW + 2 * wave + q) * DM);
    for (int bt = 0; bt < RPW / 16; ++bt) {
#pragma unroll
        for (int q = 0; q < 2; ++q) { const int rl = 2 * wave + q, row = vcu * RPW + bt * 16 + rl; float s = 0.f;
#pragma unroll
            for (int j = 0; j < 4; ++j) s += (v[q][j].x * v[q][j].x + v[q][j].y * v[q][j].y) + (v[q][j].z * v[q][j].z + v[q][j].w * v[q][j].w);
            const float rstd = rsqrtf(wave_sum(s) * (1.f / DM) + EPS);
            unsigned* o4 = (unsigned*)(U2 + (size_t)row * DM) + lane;
#pragma unroll
            for (int j = 0; j < 4; ++j) { const f32x4 g = ((const f32x4*)p.norm2_g)[64 * j + lane]; const f32x4 u = v[q][j] * rstd * g;
                o4[64 * j] = pg8::pk4_fp8(u.x * U8_SCALE, u.y * U8_SCALE, u.z * U8_SCALE, u.w * U8_SCALE);
                float l0, l1, l2, l3; const unsigned h0 = bf16_hi_lo(u.x, l0), h1 = bf16_hi_lo(u.y, l1), h2 = bf16_hi_lo(u.z, l2), h3 = bf16_hi_lo(u.w, l3);
                *(u32x2*)(UH + rl * UP + 256 * j + 4 * lane) = (u32x2){h0 | (h1 << 16), h2 | (h3 << 16)};
                *(u32x2*)(UL + rl * UP + 256 * j + 4 * lane) = (u32x2){pk2(l0, l1), pk2(l2, l3)}; }
            if (bt + 1 < RPW / 16) LD_H1(v[q], H1 + (size_t)(row + 16) * DM); }
        __syncthreads();
        { f32x4 acc[2] = {{0.f, 0.f, 0.f, 0.f}, {0.f, 0.f, 0.f, 0.f}};
#pragma unroll
          for (int ks = 0; ks < 4; ++ks) { const int ko = 128 * wave + 32 * ks + 8 * fq;
              const bf16x8 ah = *(const bf16x8*)(UH + fr * UP + ko), al = *(const bf16x8*)(UL + fr * UP + ko);
#pragma unroll
              for (int nt = 0; nt < 2; ++nt) { acc[nt] = __builtin_amdgcn_mfma_f32_16x16x32_bf16(ah, bh[ks][nt], acc[nt], 0, 0, 0);
                  acc[nt] = __builtin_amdgcn_mfma_f32_16x16x32_bf16(ah, bl[ks][nt], acc[nt], 0, 0, 0); acc[nt] = __builtin_amdgcn_mfma_f32_16x16x32_bf16(al, bh[ks][nt], acc[nt], 0, 0, 0); } }
#pragma unroll
          for (int nt = 0; nt < 2; ++nt)
#pragma unroll
              for (int j = 0; j < 4; ++j) part[(wave * 16 + 4 * fq + j) * 32 + 16 * nt + fr] = acc[nt][j]; }
        __syncthreads();
        { const int rl = 2 * wave + half, row = vcu * RPW + bt * 16 + rl; float val = rb;
#pragma unroll
          for (int w = 0; w < 8; ++w) val += part[(w * 16 + rl) * 32 + e];
          float tv[4]; int ti[4];
#pragma unroll
          for (int r = 0; r < 4; ++r) { float bv = val; int bi = e;
#pragma unroll
              for (int o = 1; o < 32; o <<= 1) { const float ov = __shfl_xor(bv, o); const int oi = __shfl_xor(bi, o); if (ov > bv || (ov == bv && oi < bi)) { bv = ov; bi = oi; } }
              tv[r] = bv; ti[r] = bi; if (e == bi) val = -INFINITY; }
          const float e1 = __expf(tv[1] - tv[0]), e2 = __expf(tv[2] - tv[0]), e3 = __expf(tv[3] - tv[0]); const float inv = 1.f / (1.f + e1 + e2 + e3);
          if (e < 4) { const int ee = e == 0 ? ti[0] : e == 1 ? ti[1] : e == 2 ? ti[2] : ti[3]; const float gg = (e == 0 ? 1.f : e == 1 ? e1 : e == 2 ? e2 : e3) * inv;
              atomicAdd(&cnt[ee], 1); pel[(bt * 16 + rl) * 4 + e] = ee; pe[row * 4 + e] = ee; pg[row * 4 + e] = gg; } }
    }
    __syncthreads();
    if (threadIdx.x < 32) base[threadIdx.x] = (int)atomicAdd(&ctl[CW_CNT + threadIdx.x], (unsigned)cnt[threadIdx.x]);
    __syncthreads();
    for (int i = threadIdx.x; i < RPW * 4; i += NTHR) { const int row = vcu * RPW + (i >> 2); const int ee = pel[i]; const int pos = base[ee] + atomicAdd(&cnt2[ee], 1);
        pp[row * 4 + (i & 3)] = pos; list[(size_t)ee * T + pos] = row; }
    __syncthreads();
}
__device__ __forceinline__ void phase_final(const Params& p, unsigned char* lds, int vcu, int G, int wave, int lane) {
    int* ps = (int*)lds;
    const unsigned* ctl = (const unsigned*)(p.ws + WS_CTL);
    __syncthreads();
    if (threadIdx.x == 0) { int a = 0; for (int e = 0; e < NE; ++e) { const int c = (int)__hip_atomic_load(ctl + CW_CNT + e, RLX_AGENT); ps[e] = a; a += (c + 255) & ~255; } }
    __syncthreads();
    const unsigned char* Y = (const unsigned char*)(p.ws + WS_Y); const int* pe = (const int*)(p.ws + MS_PE); const int* pp = (const int*)(p.ws + MS_PP); const float* pg = (const float*)(p.ws + MS_PG);
    const int gw = vcu * NWAVES + wave, NGW = G * NWAVES, nrow = (T - gw + NGW - 1) / NGW;
    int yrow = 0; float yg = 0.f;
    { const int k = lane >> 2, r = lane & 3; if (k < nrow) { const int row = gw + k * NGW; const int e = pe[row * 4 + r]; yrow = ps[e] + pp[row * 4 + r]; yg = pg[row * 4 + r]; } }
    f32x4 v[4]; unsigned yv[4][4];
#define FIN_LOAD(k) do { const int row_ = gw + (k) * NGW; const u32x2* xr_ = (const u32x2*)((const bf16_t*)(p.ws + WS_H1) + (size_t)row_ * DM) + lane; \
        _Pragma("unroll") for (int j = 0; j < 4; ++j) { const u32x2 w_ = xr_[64 * j]; v[j] = (f32x4){__uint_as_float(w_.x << 16), __uint_as_float(w_.x & 0xffff0000u), __uint_as_float(w_.y << 16), __uint_as_float(w_.y & 0xffff0000u)}; } \
        _Pragma("unroll") for (int r = 0; r < 4; ++r) { const int yr_ = __shfl(yrow, (k) * 4 + r); const unsigned* yp_ = (const unsigned*)(Y + (size_t)yr_ * DM) + lane; \
            _Pragma("unroll") for (int j = 0; j < 4; ++j) yv[r][j] = yp_[64 * j]; } } while (0)
    if (nrow > 0) FIN_LOAD(0);
    for (int k = 0; k < nrow; ++k) {
        const int row = gw + k * NGW;
        f32x4 a[4];
#pragma unroll
        for (int j = 0; j < 4; ++j) a[j] = v[j];
#pragma unroll
        for (int r = 0; r < 4; ++r) { const float g = __shfl(yg, k * 4 + r) * (1.f / pg8::Y8_SCALE);
#pragma unroll
            for (int j = 0; j < 4; ++j) { const int w = (int)yv[r][j]; typedef float f2_ __attribute__((ext_vector_type(2)));
                const f2_ lo = __builtin_amdgcn_cvt_pk_f32_fp8(w, false), hi = __builtin_amdgcn_cvt_pk_f32_fp8(w, true);
                a[j].x += g * lo[0]; a[j].y += g * lo[1]; a[j].z += g * hi[0]; a[j].w += g * hi[1]; } }
        if (k + 1 < nrow) FIN_LOAD(k + 1);
        float s = 0.f;
#pragma unroll
        for (int j = 0; j < 4; ++j) s += (a[j].x * a[j].x + a[j].y * a[j].y) + (a[j].z * a[j].z + a[j].w * a[j].w);
        const float rstd = rsqrtf(wave_sum(s) * (1.f / DM) + EPS);
        f32x4* xo = (f32x4*)(p.out + (size_t)row * DM) + lane;
#pragma unroll
        for (int j = 0; j < 4; ++j) { const f32x4 g = ((const f32x4*)p.final_g)[64 * j + lane]; xo[64 * j] = a[j] * rstd * g; }
    }
#undef FIN_LOAD
}

enum { PH_PRE = 0, PH_PROJ = 1, PH_MLA = 2, PH_ATTN = 3, PH_MLC = 4, PH_OUT = 5, PH_ROUTE = 6, PH_MOE1 = 7, PH_MOE2 = 8, PH_FINAL = 9, PH_N = 10 };
struct Args { Params p; int ph_lo, ph_hi, li, pad; };

__device__ __forceinline__ void phase_pre(const Params& p, unsigned char* lds, int vcu, int G, int wave, int lane) {
    { float* scr = (float*)(lds + wave * 8448);
      for (int it = vcu * NWAVES + wave; it < CV_SMALL; it += G * NWAVES) convert_item(p, it, scr, lane); }
    { float* tl = (float*)lds; const int t = threadIdx.x; constexpr int NT8 = 32 * 128 + 32 * 64;
      unsigned char* wgu = (unsigned char*)(p.ws + WS_WGU); unsigned char* wdn = (unsigned char*)(p.ws + WS_WDN);
      f32x4 v[8];
#define CV8_SRC(tile, srcp, ldw_) do { int r_ = (tile); if (r_ < 32 * 128) { const int e_ = r_ >> 7, q_ = r_ & 127, kb_ = q_ >> 4, nb_ = q_ & 15; ldw_ = 2 * FF; \
            srcp = p.w_gu + (size_t)e_ * DM * 2 * FF + (size_t)(128 * kb_) * (2 * FF) + 128 * nb_; } \
        else { r_ -= 32 * 128; const int e_ = r_ >> 6, q_ = r_ & 63, kb_ = q_ >> 3, nb_ = q_ & 7; ldw_ = DM; srcp = p.w_down + (size_t)e_ * FF * DM + (size_t)(128 * kb_) * DM + 128 * nb_; } } while (0)
#define CV8_LOAD(tile) do { const float* s_; int ld_; CV8_SRC(tile, s_, ld_); s_ += (size_t)(t >> 5) * ld_ + 4 * (t & 31); \
        _Pragma("unroll") for (int i = 0; i < 8; ++i) v[i] = *(const f32x4*)(s_ + (size_t)(16 * i) * ld_); } while (0)
      int tile = vcu;
      if (tile < NT8) CV8_LOAD(tile);
      for (; tile < NT8; tile += G) {
        asm volatile("s_waitcnt lgkmcnt(0)\n\ts_barrier" ::: "memory");
#pragma unroll
        for (int i = 0; i < 8; ++i) *(f32x4*)(tl + (16 * i + (t >> 5)) * 132 + 4 * (t & 31)) = v[i] * W8_SCALE;
        if (tile + G < NT8) CV8_LOAD(tile + G);
        asm volatile("s_waitcnt lgkmcnt(0)\n\ts_barrier" ::: "memory");
        unsigned char* dstp;
        { int r_ = tile; if (r_ < 32 * 128) { const int e_ = r_ >> 7, q_ = r_ & 127, kb_ = q_ >> 4, nb_ = q_ & 15; const int drow = (nb_ < 8) ? 256 * nb_ : 256 * (nb_ - 8) + 128;
              dstp = wgu + ((size_t)e_ * 2 * FF + drow) * DM + 128 * kb_; }
          else { r_ -= 32 * 128; const int e_ = r_ >> 6, q_ = r_ & 63, kb_ = q_ >> 3, nb_ = q_ & 7; dstp = wdn + ((size_t)e_ * DM + 128 * nb_) * FF + 128 * kb_; } }
        const int n = t >> 2, c = t & 3; const float* s = tl + (32 * c) * 132 + n;
        u32x4 o0, o1;
#define Q4(b) ({ int w_ = __builtin_amdgcn_cvt_pk_fp8_f32(s[((b) + 0) * 132], s[((b) + 1) * 132], 0, false); (unsigned)__builtin_amdgcn_cvt_pk_fp8_f32(s[((b) + 2) * 132], s[((b) + 3) * 132], w_, true); })
        o0.x = Q4(0); o0.y = Q4(4); o0.z = Q4(8); o0.w = Q4(12); o1.x = Q4(16); o1.y = Q4(20); o1.z = Q4(24); o1.w = Q4(28);
#undef Q4
        unsigned char* d = dstp + (size_t)n * 1024 + 32 * c; *(u32x4*)d = o0; *(u32x4*)(d + 16) = o1;
      }
#undef CV8_LOAD
#undef CV8_SRC
    }
    __syncthreads();
#if TSEL == 50
    if (blockIdx.x == PBLK && threadIdx.x == 0) ((volatile LAS unsigned*)((LAS unsigned char*)lds + LDSCTL_OFF))[40] = (unsigned)__builtin_amdgcn_s_memrealtime() - ((volatile LAS unsigned*)((LAS unsigned char*)lds + LDSCTL_OFF))[0];
#endif
    float* gw = (float*)lds;
    for (int i = threadIdx.x; i < DM * 8; i += NTHR) gw[i] = p.w_in[(size_t)(i >> 3) * DIN + 2048 + (i & 7)];
    __syncthreads();
    bf16_t* XN = (bf16_t*)(p.ws + WS_XN); float* gates = (float*)(p.ws + WS_GATES);
    f32x4 v[4];
    { const int row0 = vcu * NWAVES + wave; if (row0 < T) { const f32x4* xr = (const f32x4*)(p.x + (size_t)row0 * DM) + lane;
#pragma unroll
        for (int j = 0; j < 4; ++j) v[j] = xr[64 * j]; } }
    for (int row = vcu * NWAVES + wave; row < T; row += G * NWAVES) {
        f32x4 c[4]; float s = 0.f;
#pragma unroll
        for (int j = 0; j < 4; ++j) { c[j] = v[j]; s += (c[j].x * c[j].x + c[j].y * c[j].y) + (c[j].z * c[j].z + c[j].w * c[j].w); }
        if (row + G * NWAVES < T) { const f32x4* xn = (const f32x4*)(p.x + (size_t)(row + G * NWAVES) * DM) + lane;
#pragma unroll
            for (int j = 0; j < 4; ++j) v[j] = xn[64 * j]; }
        const float rstd = rsqrtf(wave_sum(s) * (1.f / DM) + EPS);
        float ga[8];
#pragma unroll
        for (int q = 0; q < 8; ++q) ga[q] = 0.f;
        unsigned long long* o8 = (unsigned long long*)(XN + (size_t)row * DM) + lane;
#pragma unroll
        for (int j = 0; j < 4; ++j) { const f32x4 g = ((const f32x4*)p.norm1_g)[64 * j + lane]; f32x4 u = c[j] * rstd * g;
            o8[64 * j] = (unsigned long long)pk2(u.x, u.y) | ((unsigned long long)pk2(u.z, u.w) << 32);
            const int k0 = 256 * j + 4 * lane;
#pragma unroll
            for (int cc = 0; cc < 4; ++cc) { const float uu = u[cc]; const float* w = gw + (k0 + cc) * 8;
#pragma unroll
                for (int q = 0; q < 8; ++q) ga[q] += uu * w[q]; } }
        float h4[4], h2[2], h1;
        { const bool up = (lane & 32) != 0;
#pragma unroll
          for (int q = 0; q < 4; ++q) { const float mine = up ? ga[4 + q] : ga[q], theirs = up ? ga[q] : ga[4 + q]; h4[q] = mine + __shfl_xor(theirs, 32); } }
        { const bool up = (lane & 16) != 0;
#pragma unroll
          for (int q = 0; q < 2; ++q) { const float mine = up ? h4[2 + q] : h4[q], theirs = up ? h4[q] : h4[2 + q]; h2[q] = mine + __shfl_xor(theirs, 16); } }
        { const bool up = (lane & 8) != 0; const float mine = up ? h2[1] : h2[0], theirs = up ? h2[0] : h2[1]; h1 = mine + __shfl_xor(theirs, 8); }
        h1 += __shfl_xor(h1, 4); h1 += __shfl_xor(h1, 2); h1 += __shfl_xor(h1, 1);
        if ((lane & 7) == 0) { const int q = ((lane >> 5) & 1) * 4 + ((lane >> 4) & 1) * 2 + ((lane >> 3) & 1); gates[(size_t)row * 8 + q] = h1 + p.gate_b[q]; }
    }
#if TSEL == 51
    if (blockIdx.x == PBLK && threadIdx.x == 0) ((volatile LAS unsigned*)((LAS unsigned char*)lds + LDSCTL_OFF))[40] = (unsigned)__builtin_amdgcn_s_memrealtime() - ((volatile LAS unsigned*)((LAS unsigned char*)lds + LDSCTL_OFF))[0];
#endif
    __syncthreads();
}

__global__ void __launch_bounds__(NTHR, 2) mega(Args args) {
    extern __shared__ __attribute__((aligned(16))) unsigned char lds_raw[];
    const Params& p = args.p;
    LAS unsigned char* lds = (LAS unsigned char*)lds_raw;
    const int tid = threadIdx.x, lane = tid & 63, wave = __builtin_amdgcn_readfirstlane(tid >> 6);
    const int G = gridDim.x, bx = blockIdx.x, vcu = (G % 8 == 0) ? (bx % 8) * (G / 8) + bx / 8 : bx;
    unsigned* ctl = (unsigned*)(p.ws + WS_CTL);
    for (int u = tid; u < (TAB_OFF - LDSCTL_OFF) / 4; u += NTHR) ((LAS unsigned*)(lds + LDSCTL_OFF))[u] = 0u;
    __syncthreads();
    volatile LAS unsigned* MISC = (volatile LAS unsigned*)(lds + MISC_OFF);
    XcdBarrier bar = xcd_barrier_post(ctl + CW_BAR + args.li * XCD_BAR_WORDS, MISC + 8);
    const int lo = args.ph_lo, hi = args.ph_hi;
#define IN(k) (lo <= (k) && (k) < hi)
#ifndef DUP_PHASE
#define DUP_PHASE -1
#endif
#define REP(k) for (int rep_ = 0; rep_ < ((k) == DUP_PHASE ? 2 : 1); ++rep_)
#ifndef TSEL
#define TSEL -1
#endif
#define STAMP(k) do { if (TSEL >= 0 && (TSEL < 20 || TSEL == 50 || TSEL == 51 || TSEL == 70) && bx == PBLK && tid == 0) { const unsigned long long t_ = __builtin_amdgcn_s_memrealtime(); ((volatile LAS unsigned*)(lds + LDSCTL_OFF))[2 * (k)] = (unsigned)t_; } } while (0)
#define SEAM(k) do { if (IN(k) && (k) + 1 < hi) xcd_barrier(bar); STAMP((k) + 1); } while (0)
    STAMP(0);

    if (IN(PH_PRE)) REP(PH_PRE) { phase_pre(p, lds_raw, vcu, G, wave, lane); }
    SEAM(PH_PRE);
    if (IN(PH_PROJ)) REP(PH_PROJ) {
        pg8::StaticOrder S; S.init(p.ws + WS_XN, p.ws + WS_WIN, T, NPJ, DM, G, bx);
        pg8::EpiProj E{(bf16_t*)(p.ws + WS_PROJ)};
        pg8::gemm_phase<pg8::EpiProj, pg8::StaticOrder, false>(lds, DM * 2, S, E, nullptr);
    }
    SEAM(PH_PROJ);
    if (IN(PH_MLA)) REP(PH_MLA) { ml::mlstm_a_phase(p, vcu, G, (char*)lds_raw); }
    SEAM(PH_MLA);
    if (IN(PH_ATTN)) {
        for (int it = vcu; it < 256; it += G) ml::mlstm_scan_item(p, it, (char*)lds_raw);
        unsigned g_tacc = 0; const unsigned long long mt0_ = (TSEL == 30) ? __builtin_amdgcn_s_memtime() : 0ull;
        const float lam = __expf(wave_sum(p.lam_q1[lane] * p.lam_k1[lane])) - __expf(wave_sum(p.lam_q2[lane] * p.lam_k2[lane])) + 0.2f;
        for (int U = vcu; U < (DUP_PHASE == PH_ATTN ? 1024 : 512); U += G) { const int i = (U >> 8) & 1, v = U & 255, bh = v >> 4, s = v & 15;
            const int qb = (i == 0) ? s : 31 - s;
#pragma nounroll
            for (int m = 0; m < 2; ++m) att::attn_unit(p, bh >> 2, bh & 3, m, qb, lam, (char*)lds_raw, g_tacc); }
        if (TSEL == 30) g_tacc = (unsigned)((__builtin_amdgcn_s_memtime() - mt0_) >> 4);
        if (TSEL >= 20 && bx == 0 && lane == 0 && wave == PWAVE) ((volatile LAS unsigned*)(lds + LDSCTL_OFF))[40] = g_tacc;
        __syncthreads();
    }
    SEAM(PH_ATTN);
    if (IN(PH_MLC)) REP(PH_MLC) { unsigned g_tacc = 0; ml::mlstm_c_phase(p, vcu, G, (char*)lds_raw, g_tacc);
        if (TSEL >= 40 && TSEL < 50 && bx == 0 && lane == 0 && wave == PWAVE) ((volatile LAS unsigned*)(lds + LDSCTL_OFF))[40] = g_tacc;
        __syncthreads(); }
    SEAM(PH_MLC);
    if (IN(PH_OUT)) REP(PH_OUT) {
        pg8::StaticOrder S; S.init(p.ws + WS_MIX, p.ws + WS_WOUT, T, DM, DM, G, bx);
        pg8::EpiOut E{p.x, (bf16_t*)(p.ws + WS_H1)};
        pg8::gemm_phase<pg8::EpiOut, pg8::StaticOrder, false>(lds, DM * 2, S, E, nullptr);
    }
    SEAM(PH_OUT);
    if (IN(PH_ROUTE)) phase_route(p, lds_raw, vcu, G, wave, lane);
    SEAM(PH_ROUTE);
    if (IN(PH_MOE1)) REP(PH_MOE1) {
        const int n = moe_build_units<8>(lds, ctl, G, bx);
        const LAS int* UL = (const LAS int*)(lds + TAB_UL); const LAS int* PS = (const LAS int*)(lds + TAB_PS); const LAS int* CN = (const LAS int*)(lds + TAB_CN);
        LAS unsigned* gtab = (LAS unsigned*)(lds + GTAB_OFF);
        const int* list = (const int*)(p.ws + MS_LIST);
        for (int i = tid; i < n * 256; i += NTHR) { const int w = UL[i >> 8], e = w & 255, rt = (w >> 8) & 255; const int idx = min(rt * 256 + (i & 255), CN[e] - 1);
            gtab[i] = (unsigned)list[(size_t)e * T + idx] * (unsigned)DM; }
        __syncthreads();
        MoeOrder<8, true, 1> S{UL, PS, n, (const char*)(p.ws + WS_U2), (const char*)(p.ws + WS_WGU)};
        pg8::EpiSwiglu E{(unsigned char*)(p.ws + WS_ACT), p.b_gu};
        pg8::gemm_phase<pg8::EpiSwiglu, MoeOrder<8, true, 1>, true, true, 0x7b7b7b7b  , 0x76767676  >(lds, DM, S, E, gtab);
    }
    SEAM(PH_MOE1);
    if (IN(PH_MOE2)) REP(PH_MOE2) {
        const int n = moe_build_units<4>(lds, ctl, G, bx);
        const LAS int* UL = (const LAS int*)(lds + TAB_UL); const LAS int* PS = (const LAS int*)(lds + TAB_PS);
        MoeOrder<4, false, 1> S{UL, PS, n, (const char*)(p.ws + WS_ACT), (const char*)(p.ws + WS_WDN)};
        pg8::EpiDown E{(unsigned char*)(p.ws + WS_Y), p.b_down};
        pg8::gemm_phase<pg8::EpiDown, MoeOrder<4, false, 1>, false, true, 0x7d7d7d7d  , 0x76767676  >(lds, FF, S, E, nullptr);
    }
    SEAM(PH_MOE2);
    if (IN(PH_FINAL)) phase_final(p, lds_raw, vcu, G, wave, lane);
    if (TSEL >= 0) { __syncthreads(); STAMP(PH_N);
        if (bx == PBLK && tid == 0) { volatile LAS unsigned* st_ = (volatile LAS unsigned*)(lds + LDSCTL_OFF); const unsigned d_ = (TSEL == 70 ? (st_[2 * PH_N] - st_[0]) : TSEL >= 60 ? st_[40 + PSUB] : TSEL >= 20 ? st_[40] : (st_[2 * (TSEL + 1)] - st_[2 * TSEL])) * TMULT;
            const unsigned long long t0_ = __builtin_amdgcn_s_memrealtime(); while ((unsigned)(__builtin_amdgcn_s_memrealtime() - t0_) < d_) __builtin_amdgcn_s_sleep(8); } }
#undef IN
#undef SEAM
}

static void launch_mega(const Params& p, int lo, int hi, int li, hipStream_t stream) {
    Args a{}; a.p = p; a.ph_lo = lo; a.ph_hi = hi; a.li = li; a.pad = 0;
    hipLaunchKernelGGL(mega, dim3(256), dim3(NTHR), LDS_BYTES, stream, a);
}
extern "C" void kernel_launch(void* const* d_in, const int* in_sizes, int n_in, void* d_out, int out_size, void* d_ws, size_t ws_size, hipStream_t stream) {
    if (n_in != 22 || out_size != T * DM || ws_size < WS_END) { fprintf(stderr, "kernel_launch: unexpected shapes (n_in %d out %d ws %zu)\n", n_in, out_size, ws_size); return; }
    Params p{};
    const float** f = (const float**)&p;
    for (int i = 0; i < 22; ++i) f[i] = (const float*)d_in[i];
    p.out = (float*)d_out; p.ws = (unsigned char*)d_ws;
    static bool attr = false;
    if (!attr) { attr = true;
        (void)hipFuncSetAttribute((const void*)mega, hipFuncAttributeMaxDynamicSharedMemorySize, LDS_BYTES); }
    (void)hipMemsetAsync((char*)d_ws + WS_CTL, 0, 32768, stream);
    launch_mega(p, PH_PRE, PH_N, 0, stream);
}
```
